# Optimizing an MI355X kernel written in HIP

```python
import jax, jax.numpy as jnp
from jax import lax
import numpy as np

D_MODEL = 1024
BATCH = 2
SEQ = 8192
DEPTH = 2

N_A_LAYERS = DEPTH // 2
N_B_LAYERS = DEPTH - N_A_LAYERS

RET_HEADS = 4
RET_DK = D_MODEL // 8
RET_DV = 2 * RET_DK
RET_QK_W = RET_HEADS * RET_DK
RET_V_W = RET_HEADS * RET_DV
RET_CHUNK = 128
ROPE_BASE = 10000.0

SB_HEADS = 8
SB_DH = D_MODEL // SB_HEADS
SB_W = SB_HEADS * SB_DH
SB_BLOCK = 128

MEM_LEN = 256
MEM_HEADS = 4
MEM_DH = D_MODEL // 8
MEM_W = MEM_HEADS * MEM_DH

A_IN_W = RET_QK_W + RET_QK_W + RET_V_W + RET_V_W + MEM_W + MEM_W
A_OUT_IN = RET_V_W + MEM_W
B_IN_W = SB_W + SB_W + MEM_W + MEM_W
B_OUT_IN = SB_W + MEM_W

EPS = 1e-6

kernel_name = 'yoco_retention_stickbreaking_memory_trunk'


def rms_norm(x, g):
    xf = x.astype(jnp.float32)
    y = xf * lax.rsqrt(jnp.mean(xf * xf, axis=-1, keepdims=True) + EPS)
    return (y * g.astype(jnp.float32)).astype(x.dtype)


def split_heads(t, n_heads):
    b, s, w = t.shape
    return t.reshape(b, s, n_heads, w // n_heads).transpose(0, 2, 1, 3)


def merge_heads(t):
    b, h, s, d = t.shape
    return t.transpose(0, 2, 1, 3).reshape(b, s, h * d)


def apply_rotary(t, positions):
    d = t.shape[-1]
    inv_freq = ROPE_BASE ** (-jnp.arange(0, d // 2, dtype=jnp.float32) * 2.0 / d)
    ang = positions.astype(jnp.float32)[:, None, :, None] * inv_freq
    cos, sin = jnp.cos(ang), jnp.sin(ang)
    tf = t.astype(jnp.float32)
    t1, t2 = tf[..., : d // 2], tf[..., d // 2:]
    return jnp.concatenate([t1 * cos - t2 * sin, t1 * sin + t2 * cos], axis=-1)


def retention_chunkwise(q, k, v):
    b, h, s, dk = q.shape
    dv = v.shape[-1]
    c = RET_CHUNK
    nc = s // c
    gamma = (1.0 - np.exp2(-5.0 - np.arange(h))).astype(np.float32)
    lg = jnp.log(jnp.asarray(gamma))
    k = k * (dk ** -0.5)
    qc = q.reshape(b, h, nc, c, dk)
    kc = k.reshape(b, h, nc, c, dk)
    vc = v.astype(jnp.float32).reshape(b, h, nc, c, dv)
    idx = jnp.arange(c, dtype=jnp.float32)
    rel = idx[:, None] - idx[None, :]
    decay = jnp.where(rel[None] >= 0, jnp.exp(jnp.maximum(rel, 0.0)[None] * lg[:, None, None]), 0.0)
    scores = jnp.einsum('bhncd,bhnmd->bhncm', qc, kc) * decay[None, :, None]
    intra = jnp.einsum('bhncm,bhnme->bhnce', scores, vc)
    zeta = jnp.exp((c - 1.0 - idx)[None, :] * lg[:, None])
    chunk_kv = jnp.einsum('bhnmd,bhnme->bhnde', kc * zeta[None, :, None, :, None], vc)
    gamma_c = jnp.exp(c * lg)[None, :, None, None]

    def step(state, kv_n):
        return gamma_c * state + kv_n, state

    _, prev = lax.scan(step, jnp.zeros((b, h, dk, dv), jnp.float32), chunk_kv.transpose(2, 0, 1, 3, 4))
    prev = prev.transpose(1, 2, 0, 3, 4)
    xi = jnp.exp((idx + 1.0)[None, :] * lg[:, None])
    cross = jnp.einsum('bhncd,bhnde->bhnce', qc, prev) * xi[None, :, None, :, None]
    return (intra + cross).reshape(b, h, s, dv)


def stick_breaking_attention(q, k, v):
    b, h, s, d = q.shape
    bq = SB_BLOCK
    nb = s // bq
    scale = d ** -0.5
    q_blocks = q.reshape(b, h, nb, bq, d).transpose(2, 0, 1, 3, 4)
    ar = jnp.arange(bq)

    def per_block(args):
        qb, qi = args
        t_idx = qi * bq + ar

        def body(n, carry):
            acc, logsum = carry
            start = (qi - n) * bq
            kb = lax.dynamic_slice_in_dim(k, start, bq, axis=2)
            vb = lax.dynamic_slice_in_dim(v, start, bq, axis=2)
            z = jnp.einsum('bhqd,bhkd->bhqk', qb, kb).astype(jnp.float32) * scale
            mask = (start + ar)[None, :] < t_idx[:, None]
            l_fail = jnp.where(mask, jax.nn.log_sigmoid(-z), 0.0)
            suffix = lax.cumsum(l_fail, axis=3, reverse=True) - l_fail
            log_a = jax.nn.log_sigmoid(z) + suffix + logsum[..., None]
            a = jnp.where(mask, jnp.exp(log_a), 0.0)
            acc = acc + jnp.einsum('bhqk,bhkd->bhqd', a, vb.astype(jnp.float32))
            return acc, logsum + jnp.sum(l_fail, axis=-1)

        init = (jnp.zeros((b, h, bq, d), jnp.float32), jnp.zeros((b, h, bq), jnp.float32))
        acc, _ = lax.fori_loop(0, qi + 1, body, init)
        return acc

    out = lax.map(per_block, (q_blocks, jnp.arange(nb)))
    return out.transpose(1, 2, 0, 3, 4).reshape(b, h, s, d).astype(q.dtype)


def memory_kv(mem, g_mem_l, w_mem_kv_l):
    kv = rms_norm(mem, g_mem_l) @ w_mem_kv_l
    return split_heads(kv[..., :MEM_W], MEM_HEADS), split_heads(kv[..., MEM_W:], MEM_HEADS)


def memory_attention(q, mk, mv, g_q, g_k):
    qh = rms_norm(split_heads(q, MEM_HEADS), g_q).astype(jnp.float32)
    kh = rms_norm(mk, g_k).astype(jnp.float32)
    logits = jnp.einsum('bhsd,bhmd->bhsm', qh, kh) * (MEM_DH ** -0.5)
    p = jax.nn.softmax(logits, axis=-1)
    o = jnp.einsum('bhsm,bhmd->bhsd', p, mv.astype(jnp.float32))
    return merge_heads(o).astype(q.dtype)


def setup_inputs(seed: int = 0) -> dict:
    key = jax.random.key(seed)
    ks = jax.random.split(key, 20)

    def w(k, shape, fan_in):
        return jax.random.normal(k, shape, jnp.float32) * (fan_in ** -0.5)

    def gain(k, shape):
        return 1.0 + 0.02 * jax.random.normal(k, shape, jnp.float32)

    x = jax.random.normal(ks[0], (BATCH, SEQ, D_MODEL), jnp.float32)
    mem = jax.random.normal(ks[1], (BATCH, MEM_LEN, D_MODEL), jnp.float32)
    offset = jax.random.randint(ks[2], (BATCH, 1), 0, 1024, dtype=jnp.int32)
    positions = (jnp.arange(SEQ, dtype=jnp.int32)[None, :] + offset).astype(jnp.int32)
    return {
        'x': x,
        'mem': mem,
        'positions': positions,
        'g_norm_a': gain(ks[3], (N_A_LAYERS, D_MODEL)),
        'w_in_a': w(ks[4], (N_A_LAYERS, D_MODEL, A_IN_W), D_MODEL),
        'g_ret_head': gain(ks[5], (N_A_LAYERS, RET_DV)),
        'w_out_a': w(ks[6], (N_A_LAYERS, A_OUT_IN, D_MODEL), A_OUT_IN),
        'g_kv': gain(ks[7], (D_MODEL,)),
        'w_kv': w(ks[8], (D_MODEL, 2 * SB_W), D_MODEL),
        'g_norm_b': gain(ks[9], (N_B_LAYERS, D_MODEL)),
        'w_in_b': w(ks[10], (N_B_LAYERS, D_MODEL, B_IN_W), D_MODEL),
        'w_out_b': w(ks[11], (N_B_LAYERS, B_OUT_IN, D_MODEL), B_OUT_IN),
        'g_mem': gain(ks[12], (DEPTH, D_MODEL)),
        'w_mem_kv': w(ks[13], (DEPTH, D_MODEL, 2 * MEM_W), D_MODEL),
        'g_mem_q': gain(ks[14], (DEPTH, MEM_DH)),
        'g_mem_k': gain(ks[15], (DEPTH, MEM_DH)),
    }


def reference(x, mem, positions, g_norm_a, w_in_a, g_ret_head, w_out_a, g_kv, w_kv,
              g_norm_b, w_in_b, w_out_b, g_mem, w_mem_kv, g_mem_q, g_mem_k):
    k_shared = None
    v_shared = None
    for layer in range(DEPTH):
        mk, mv = memory_kv(mem, g_mem[layer], w_mem_kv[layer])
        if layer < N_A_LAYERS:
            la = layer
            u = rms_norm(x, g_norm_a[la]) @ w_in_a[la]
            o1 = RET_QK_W
            o2 = o1 + RET_QK_W
            o3 = o2 + RET_V_W
            o4 = o3 + RET_V_W
            o5 = o4 + MEM_W
            q = apply_rotary(split_heads(u[..., :o1], RET_HEADS), positions)
            k = apply_rotary(split_heads(u[..., o1:o2], RET_HEADS), positions)
            v = split_heads(u[..., o2:o3], RET_HEADS)
            ret = rms_norm(retention_chunkwise(q, k, v), g_ret_head[la])
            ret = merge_heads(ret).astype(x.dtype) * jax.nn.silu(u[..., o3:o4])
            mo = memory_attention(u[..., o4:o5], mk, mv, g_mem_q[layer], g_mem_k[layer])
            mo = mo * jax.nn.silu(u[..., o5:])
            x = x + jnp.concatenate([ret, mo], axis=-1) @ w_out_a[la]
        else:
            lb = layer - N_A_LAYERS
            if layer == N_A_LAYERS:
                kv = rms_norm(x, g_kv) @ w_kv
                k_shared = split_heads(kv[..., :SB_W], SB_HEADS)
                v_shared = split_heads(kv[..., SB_W:], SB_HEADS)
            u = rms_norm(x, g_norm_b[lb]) @ w_in_b[lb]
            o1 = SB_W
            o2 = o1 + SB_W
            o3 = o2 + MEM_W
            q = split_heads(u[..., :o1], SB_HEADS)
            sb = merge_heads(stick_breaking_attention(q, k_shared, v_shared)) * jax.nn.silu(u[..., o1:o2])
            mo = memory_attention(u[..., o2:o3], mk, mv, g_mem_q[layer], g_mem_k[layer])
            mo = mo * jax.nn.silu(u[..., o3:])
            x = x + jnp.concatenate([sb, mo], axis=-1) @ w_out_b[lb]
    return x
```

```cpp
#include <hip/hip_runtime.h>
#include <stdint.h>

typedef unsigned short bf16_t;

constexpr int NB_ = 2, S_ = 8192, T_ = NB_ * S_, D_ = 1024;
constexpr int NA_ = 4096, NBW_ = 5120, KO_ = 1536;
constexpr float EPS_ = 1e-6f;
constexpr float QK_SCALE = 0.08838834764831845f;

constexpr size_t MiB = 1u << 20;
constexpr size_t WS_CTL = 0;
constexpr size_t WS_WINA = 1 * MiB;
constexpr size_t WS_WOUTA = 9 * MiB;
constexpr size_t WS_WB = 12 * MiB;
constexpr size_t WS_WOUTB = 22 * MiB;
constexpr size_t WS_MEMK = 25 * MiB;
constexpr size_t WS_MEMV = 26 * MiB;
constexpr size_t WS_RS0 = 27 * MiB;
constexpr size_t WS_SS1P = 28 * MiB;
constexpr size_t WS_UA = 30 * MiB;
constexpr size_t WS_KVT = 158 * MiB;
constexpr size_t WS_XB = 158 * MiB;
constexpr size_t WS_X1B = 190 * MiB;
constexpr size_t WS_UB = 30 * MiB;


__device__ __forceinline__ float bf2f(bf16_t v) { return __uint_as_float(((unsigned)v) << 16); }
__device__ __forceinline__ bf16_t f2bf(float f) { unsigned u = __float_as_uint(f); u += 0x7fffu + ((u >> 16) & 1u); return (bf16_t)(u >> 16); }
__device__ __forceinline__ float silu_f(float v) { return v / (1.0f + __expf(-v)); }
__device__ __forceinline__ float softplus_f(float z) { return fmaxf(z, 0.f) + log1pf(__expf(-fabsf(z))); }
__device__ __forceinline__ float ret_lg(int h) { return logf(1.0f - exp2f(-5.0f - (float)h)); }

__device__ __forceinline__ void rot_sincos(float ang, float& s, float& c) {
    const float n = rintf(ang * 0.15915494309189535f);
    float r = fmaf(-n, 6.28318548202514648f, ang);
    r = fmaf(-n, -1.74845553e-7f, r);
    const float rev = r * 0.15915494309189535f;
    s = __builtin_amdgcn_sinf(rev); c = __builtin_amdgcn_cosf(rev);
}
__device__ __forceinline__ float rope_inv_freq(int i) { return exp2f(-(float)i * 0.20762050593046014f); }

__global__ __launch_bounds__(256) void n0_x(const float* __restrict__ x, bf16_t* __restrict__ xb, float* __restrict__ rs) {
    const int row = blockIdx.x * 4 + (threadIdx.x >> 6), lane = threadIdx.x & 63;
    const float* xr = x + (size_t)row * D_; float s = 0.f;
    for (int j = lane; j < D_; j += 64) { const float v = xr[j]; s += v * v; xb[(size_t)row * D_ + j] = f2bf(v); }
    for (int o = 32; o; o >>= 1) s += __shfl_xor(s, o);
    if (lane == 0) rs[row] = 1.0f / sqrtf(s * (1.0f / D_) + EPS_);
}

struct WArgs { const float* w_in_a; const float* w_out_a; const float* w_kv; const float* w_in_b; const float* w_out_b;
               const float* g_norm_a; const float* g_ret_head; const float* g_kv; const float* g_norm_b; };
__device__ __forceinline__ int permA_src(int n) {
    if (n >= 1024) return n;
    const int tile = n >> 8, c = n & 255, bj = c >> 7, p = c & 127, hit = p >> 6, i = p & 63;
    return tile * 256 + hit * 128 + bj * 64 + i;
}
__global__ __launch_bounds__(256) void n0_w(WArgs a, int mode, bf16_t* __restrict__ out) {
    const int K = (mode == 0 || mode == 2) ? 1024 : 1536;
    const int N = mode == 0 ? 4096 : (mode == 2 ? 5120 : 1024);
    const size_t idx = (size_t)blockIdx.x * 256 + threadIdx.x; if (idx >= (size_t)N * K) return;
    const int k = (int)(idx % K), n = (int)(idx / K);
    float v;
    if (mode == 0) v = a.w_in_a[(size_t)k * 4096 + permA_src(n)] * a.g_norm_a[k];
    else if (mode == 1) v = a.w_out_a[(size_t)k * 1024 + n] * (k < 1024 ? a.g_ret_head[k & 255] : 1.0f);
    else if (mode == 2) {
        if (n < 2048) v = a.w_kv[(size_t)k * 2048 + n] * a.g_kv[k];
        else { const int c = n - 2048; const int src = c < 1024 ? 1024 + c : (c < 2048 ? c - 1024 : c);
               v = a.w_in_b[(size_t)k * 3072 + src] * a.g_norm_b[k]; }
    } else v = a.w_out_b[(size_t)k * 1024 + n];
    out[idx] = f2bf(v);
}

__global__ __launch_bounds__(256) void n0_mem(const float* __restrict__ mem, const float* __restrict__ g_mem, const float* __restrict__ w_mem_kv,
                                              const float* __restrict__ g_mem_q, const float* __restrict__ g_mem_k, bf16_t* __restrict__ memK, bf16_t* __restrict__ memV) {
    __shared__ float sm[1024]; __shared__ float skv[1024]; __shared__ float red[256]; __shared__ float hn[4];
    const int l = blockIdx.x >> 9, b = (blockIdx.x >> 8) & 1, m = blockIdx.x & 255, tid = threadIdx.x;
    const float* mr = mem + ((size_t)b * 256 + m) * D_;
    float s = 0.f; for (int j = tid; j < D_; j += 256) { const float v = mr[j]; s += v * v; }
    red[tid] = s; __syncthreads();
    for (int o = 128; o; o >>= 1) { if (tid < o) red[tid] += red[tid + o]; __syncthreads(); }
    const float r = 1.0f / sqrtf(red[0] * (1.0f / D_) + EPS_);
    for (int j = tid; j < D_; j += 256) sm[j] = mr[j] * r * g_mem[l * D_ + j];
    __syncthreads();
    const float* W = w_mem_kv + (size_t)l * D_ * 1024;
    float acc[4] = {0.f, 0.f, 0.f, 0.f};
    for (int k = 0; k < D_; ++k) { const float a = sm[k];
#pragma unroll
        for (int j = 0; j < 4; ++j) acc[j] += a * W[(size_t)k * 1024 + tid + 256 * j]; }
#pragma unroll
    for (int j = 0; j < 4; ++j) skv[tid + 256 * j] = acc[j];
    __syncthreads();
    if (tid < 4) { float q = 0.f; for (int d = 0; d < 128; ++d) { const float v = skv[tid * 128 + d]; q += v * v; } hn[tid] = 1.0f / sqrtf(q * (1.0f / 128) + EPS_); }
    __syncthreads();
    for (int j = tid; j < 512; j += 256) { const int h = j >> 7, d = j & 127;
        const size_t o = ((((size_t)l * 2 + b) * 4 + h) * 256 + m) * 128 + d;
        memK[o] = f2bf(skv[j] * hn[h] * g_mem_k[l * 128 + d] * g_mem_q[l * 128 + d] * QK_SCALE);
        memV[o] = f2bf(skv[512 + j]); }
}

struct GArgs { const bf16_t* A; int lda; const bf16_t* Bt; int K; int N;
               const float* rs0; const int* pos; bf16_t* U; const float* xres; float* out; bf16_t* x1b; float* ss1p; };
template <int EPI> __global__ __launch_bounds__(256) void n_gemm(GArgs g) {
    __shared__ float sA[16][36]; __shared__ float sC[16][257];
    const int ntn = g.N / 256, pm = blockIdx.x / ntn, pn = blockIdx.x % ntn, row0 = pm * 16, c = threadIdx.x;
    const bf16_t* brow = g.Bt + (size_t)(pn * 256 + c) * g.K;
    float acc[16];
#pragma unroll
    for (int r = 0; r < 16; ++r) acc[r] = 0.f;
    for (int k0 = 0; k0 < g.K; k0 += 32) {
        __syncthreads();
        for (int e = threadIdx.x; e < 512; e += 256) { const int r = e >> 5, kk = e & 31; sA[r][kk] = bf2f(g.A[(size_t)(row0 + r) * g.lda + k0 + kk]); }
        __syncthreads();
#pragma unroll
        for (int j = 0; j < 4; ++j) { const uint4 bv = *(const uint4*)(brow + k0 + 8 * j); const unsigned w[4] = {bv.x, bv.y, bv.z, bv.w};
#pragma unroll
            for (int q = 0; q < 4; ++q) { const float b0 = __uint_as_float(w[q] << 16), b1 = __uint_as_float(w[q] & 0xffff0000u); const int kk = 8 * j + 2 * q;
#pragma unroll
                for (int r = 0; r < 16; ++r) acc[r] += sA[r][kk] * b0 + sA[r][kk + 1] * b1; } }
    }
#pragma unroll
    for (int r = 0; r < 16; ++r) sC[r][c] = acc[r];
    __syncthreads();
    if (EPI == 0) {
        for (int r = 0; r < 16; ++r) { const int row = row0 + r; const float rs = g.rs0[row]; bf16_t* urow = g.U + (size_t)row * NA_;
            if (pn < 4) { if (c < 128) { const int hit = c >> 6, i = c & 63; const float x1 = sC[r][c] * rs, x2 = sC[r][c + 128] * rs;
                    float sn, cs; rot_sincos((float)g.pos[row] * rope_inv_freq(i), sn, cs); const float sc = pn >= 2 ? QK_SCALE : 1.0f;
                    urow[pn * 256 + hit * 128 + i] = f2bf((x1 * cs - x2 * sn) * sc); urow[pn * 256 + hit * 128 + 64 + i] = f2bf((x1 * sn + x2 * cs) * sc); } }
            else { const float v = sC[r][c] * rs; const bool silu = (pn >= 8 && pn < 12) || pn >= 14; urow[pn * 256 + c] = f2bf(silu ? silu_f(v) : v); } }
    } else if (EPI == 1) {
        for (int r = 0; r < 16; ++r) { const size_t o = (size_t)(row0 + r) * D_ + pn * 256 + c; const float v = g.xres[o] + sC[r][c]; g.out[o] = v; g.x1b[o] = f2bf(v); sC[r][c] = v * v; }
        __syncthreads();
        if (c < 16) { float s = 0.f; for (int j = 0; j < 256; ++j) s += sC[c][j]; float* p = g.ss1p + (size_t)(row0 + c) * 16 + pn * 4; p[0] = s; p[1] = 0.f; p[2] = 0.f; p[3] = 0.f; }
    } else if (EPI == 2) {
        for (int r = 0; r < 16; ++r) { const int row = row0 + r; const float* sp = g.ss1p + (size_t)row * 16; float ss = 0.f; for (int j = 0; j < 16; ++j) ss += sp[j];
            const float rs = 1.0f / sqrtf(ss * (1.0f / D_) + EPS_); float v = sC[r][c] * rs;
            if ((pn >= 8 && pn < 12) || pn >= 18) v = silu_f(v); else if (pn >= 12 && pn < 16) v *= QK_SCALE;
            g.U[(size_t)row * NBW_ + pn * 256 + c] = f2bf(v); }
    } else {
        for (int r = 0; r < 16; ++r) { const size_t o = (size_t)(row0 + r) * D_ + pn * 256 + c; g.out[o] = g.out[o] + sC[r][c]; }
    }
}

__global__ __launch_bounds__(256) void n2_kv(const bf16_t* __restrict__ UA, bf16_t* __restrict__ KVT) {
    const int u = blockIdx.x >> 2, eg = blockIdx.x & 3, tid = threadIdx.x, e = eg * 64 + (tid & 63), dq = tid >> 6;
    const int b = u >> 8, h = (u >> 6) & 3, n = u & 63; const size_t row0 = (size_t)b * S_ + n * 128; const float lg = ret_lg(h);
    float acc[32];
#pragma unroll
    for (int j = 0; j < 32; ++j) acc[j] = 0.f;
    for (int m = 0; m < 128; ++m) { const bf16_t* ur = UA + (row0 + m) * NA_; const float vz = bf2f(ur[1024 + h * 256 + e]) * __expf((float)(127 - m) * lg);
#pragma unroll
        for (int j = 0; j < 32; ++j) acc[j] += vz * bf2f(ur[512 + h * 128 + dq * 32 + j]); }
#pragma unroll
    for (int j = 0; j < 32; ++j) KVT[((size_t)u * 256 + e) * 128 + dq * 32 + j] = f2bf(acc[j]);
}
__global__ __launch_bounds__(256) void n3_scan(bf16_t* __restrict__ KVT) {
    const int idx = blockIdx.x * 256 + threadIdx.x; const int bh = idx >> 15, off = idx & 32767; const float gc = __expf(128.0f * ret_lg(bh & 3));
    float s = 0.f;
    for (int n = 0; n < 64; ++n) { bf16_t* p = KVT + ((size_t)(bh * 64 + n) << 15) + off; const float t = bf2f(*p); *p = f2bf(s); s = gc * s + t; }
}
__global__ __launch_bounds__(256) void n4_ret(bf16_t* __restrict__ UA, const bf16_t* __restrict__ KVT) {
    __shared__ float sq[128], ss[128], red[256];
    const int u = blockIdx.x >> 7, c = blockIdx.x & 127, tid = threadIdx.x; const int b = u >> 8, h = (u >> 6) & 3, n = u & 63;
    const size_t row0 = (size_t)b * S_ + n * 128, row = row0 + c; const float lg = ret_lg(h);
    if (tid < 128) sq[tid] = bf2f(UA[row * NA_ + h * 128 + tid]);
    __syncthreads();
    if (tid < 128) { float d = 0.f; if (tid <= c) { const bf16_t* kr = UA + (row0 + tid) * NA_ + 512 + h * 128; for (int j = 0; j < 128; ++j) d += sq[j] * bf2f(kr[j]); d *= __expf((float)(c - tid) * lg); } ss[tid] = d; }
    __syncthreads();
    const int e = tid; float o = 0.f;
    for (int m = 0; m <= c; ++m) o += ss[m] * bf2f(UA[(row0 + m) * NA_ + 1024 + h * 256 + e]);
    float cr = 0.f; const bf16_t* st = KVT + ((size_t)u * 256 + e) * 128; for (int j = 0; j < 128; ++j) cr += sq[j] * bf2f(st[j]);
    o += __expf((float)(c + 1) * lg) * cr;
    red[tid] = o * o; __syncthreads();
    for (int w = 128; w; w >>= 1) { if (tid < w) red[tid] += red[tid + w]; __syncthreads(); }
    const float r = 1.0f / sqrtf(red[0] * (1.0f / 256) + EPS_);
    bf16_t* gp = UA + row * NA_ + 2048 + h * 256 + e; *gp = f2bf(o * r * bf2f(*gp));
}
__global__ __launch_bounds__(256) void n_memattn(bf16_t* __restrict__ U, int ld, int qoff, int goff, const bf16_t* __restrict__ memK, const bf16_t* __restrict__ memV, int layer) {
    __shared__ float sq[4][128]; __shared__ float sp[4][256];
    const int w = threadIdx.x >> 6, lane = threadIdx.x & 63; const int gw = blockIdx.x * 4 + w, row = gw >> 2, hd = gw & 3, b = row / S_;
    bf16_t* qp = U + (size_t)row * ld + qoff + hd * 128; const bf16_t* gp = U + (size_t)row * ld + goff + hd * 128;
    const float q0 = bf2f(qp[lane]), q1 = bf2f(qp[lane + 64]); sq[w][lane] = q0; sq[w][lane + 64] = q1;
    float s = q0 * q0 + q1 * q1; for (int o = 32; o; o >>= 1) s += __shfl_xor(s, o);
    const float rq = 1.0f / sqrtf(s * (1.0f / 128) + EPS_);
    __syncthreads();
    const bf16_t* Kb = memK + (((size_t)layer * 2 + b) * 4 + hd) * 256 * 128; const bf16_t* Vb = memV + (((size_t)layer * 2 + b) * 4 + hd) * 256 * 128;
    float lgt[4]; float mx = -1e30f;
    for (int j = 0; j < 4; ++j) { const bf16_t* kr = Kb + (size_t)(lane + 64 * j) * 128; float d = 0.f; for (int t = 0; t < 128; ++t) d += sq[w][t] * bf2f(kr[t]); lgt[j] = d * rq; mx = fmaxf(mx, lgt[j]); }
    for (int o = 32; o; o >>= 1) mx = fmaxf(mx, __shfl_xor(mx, o));
    float ps = 0.f; for (int j = 0; j < 4; ++j) { lgt[j] = __expf(lgt[j] - mx); ps += lgt[j]; }
    for (int o = 32; o; o >>= 1) ps += __shfl_xor(ps, o);
    for (int j = 0; j < 4; ++j) sp[w][lane + 64 * j] = lgt[j] / ps;
    __syncthreads();
    float o0 = 0.f, o1 = 0.f;
    for (int m = 0; m < 256; ++m) { const float p = sp[w][m]; o0 += p * bf2f(Vb[(size_t)m * 128 + lane]); o1 += p * bf2f(Vb[(size_t)m * 128 + lane + 64]); }
    const float g0 = bf2f(gp[lane]), g1 = bf2f(gp[lane + 64]);
    qp[lane] = f2bf(o0 * g0); qp[lane + 64] = f2bf(o1 * g1);
}
#ifndef NAIVE_SB_EXIT
#define NAIVE_SB_EXIT 0
#endif
__global__ __launch_bounds__(256) void n7_sb(bf16_t* __restrict__ UB) {
    __shared__ float sq[128]; __shared__ float sa[256]; __shared__ float wtot[4]; __shared__ float wpre[4];
    const int t = blockIdx.x & (S_ - 1), h = (blockIdx.x >> 13) & 7, b = blockIdx.x >> 16, tid = threadIdx.x, lane = tid & 63, w = tid >> 6;
    const size_t rowb = (size_t)b * S_; bf16_t* qp = UB + (rowb + t) * NBW_ + 3072 + h * 128;
    if (tid < 128) sq[tid] = bf2f(qp[tid]);
    __syncthreads();
    float carry = 0.f, od = 0.f;
    for (int s_hi = t - 1; s_hi >= 0; s_hi -= 256) {
        const int s = s_hi - tid; const bool valid = s >= 0;
        float z = 0.f; if (valid) { const bf16_t* kr = UB + (rowb + s) * NBW_ + h * 128; for (int j = 0; j < 128; ++j) z += sq[j] * bf2f(kr[j]); }
        const float spv = softplus_f(z); const float lf = valid ? -spv : 0.f;
        float inc = lf;
        for (int o = 1; o < 64; o <<= 1) { const float v = __shfl_up(inc, o); if (lane >= o) inc += v; }
        if (lane == 63) wtot[w] = inc;
        __syncthreads();
        if (tid == 0) { float a = 0.f; for (int j = 0; j < 4; ++j) { wpre[j] = a; a += wtot[j]; } }
        __syncthreads();
        const float pre = wpre[w] + inc - lf;
        const float tot = wpre[3] + wtot[3];
        sa[tid] = valid ? __expf((z - spv) + pre + carry) : 0.f;
        __syncthreads();
        if (tid < 128) { const int cnt = min(256, s_hi + 1); const bf16_t* vb = UB + rowb * NBW_ + 1024 + h * 128 + tid;
            for (int i = 0; i < cnt; ++i) od += sa[i] * bf2f(vb[(size_t)(s_hi - i) * NBW_]); }
        carry += tot;
        __syncthreads();
        if (NAIVE_SB_EXIT && carry < -104.0f) break;
    }
    if (tid < 128) { const float g = bf2f(UB[(rowb + t) * NBW_ + 2048 + h * 128 + tid]); qp[tid] = f2bf(od * g); }
}

extern "C" void kernel_launch(void* const* d_in, const int* in_sizes, int n_in, void* d_out, int out_size, void* d_ws, size_t ws_size, hipStream_t stream) {
    const float* x = (const float*)d_in[0]; const float* mem = (const float*)d_in[1]; const int* pos = (const int*)d_in[2];
    const float* g_norm_a = (const float*)d_in[3]; const float* w_in_a = (const float*)d_in[4]; const float* g_ret_head = (const float*)d_in[5];
    const float* w_out_a = (const float*)d_in[6]; const float* g_kv = (const float*)d_in[7]; const float* w_kv = (const float*)d_in[8];
    const float* g_norm_b = (const float*)d_in[9]; const float* w_in_b = (const float*)d_in[10]; const float* w_out_b = (const float*)d_in[11];
    const float* g_mem = (const float*)d_in[12]; const float* w_mem_kv = (const float*)d_in[13]; const float* g_mem_q = (const float*)d_in[14]; const float* g_mem_k = (const float*)d_in[15];
    unsigned char* ws = (unsigned char*)d_ws; float* out = (float*)d_out;
    bf16_t* WINA = (bf16_t*)(ws + WS_WINA); bf16_t* WOUTA = (bf16_t*)(ws + WS_WOUTA); bf16_t* WB = (bf16_t*)(ws + WS_WB); bf16_t* WOUTB = (bf16_t*)(ws + WS_WOUTB);
    bf16_t* MEMK = (bf16_t*)(ws + WS_MEMK); bf16_t* MEMV = (bf16_t*)(ws + WS_MEMV); float* RS0 = (float*)(ws + WS_RS0); float* SS1P = (float*)(ws + WS_SS1P);
    bf16_t* UA = (bf16_t*)(ws + WS_UA); bf16_t* KVT = (bf16_t*)(ws + WS_KVT); bf16_t* XB = (bf16_t*)(ws + WS_XB); bf16_t* X1B = (bf16_t*)(ws + WS_X1B); bf16_t* UB = (bf16_t*)(ws + WS_UB);

    n0_x<<<T_ / 4, 256, 0, stream>>>(x, XB, RS0);
    WArgs wa{w_in_a, w_out_a, w_kv, w_in_b, w_out_b, g_norm_a, g_ret_head, g_kv, g_norm_b};
    n0_w<<<(4096 * 1024) / 256, 256, 0, stream>>>(wa, 0, WINA);
    n0_w<<<(1024 * 1536) / 256, 256, 0, stream>>>(wa, 1, WOUTA);
    n0_w<<<(5120 * 1024) / 256, 256, 0, stream>>>(wa, 2, WB);
    n0_w<<<(1024 * 1536) / 256, 256, 0, stream>>>(wa, 3, WOUTB);
    n0_mem<<<2 * 2 * 256, 256, 0, stream>>>(mem, g_mem, w_mem_kv, g_mem_q, g_mem_k, MEMK, MEMV);
    { GArgs g{}; g.A = XB; g.lda = 1024; g.Bt = WINA; g.K = 1024; g.N = 4096; g.rs0 = RS0; g.pos = pos; g.U = UA;
      n_gemm<0><<<(T_ / 16) * (4096 / 256), 256, 0, stream>>>(g); }
    n2_kv<<<512 * 4, 256, 0, stream>>>(UA, KVT);
    n_memattn<<<T_, 256, 0, stream>>>(UA, NA_, 3072, 3584, MEMK, MEMV, 0);
    n3_scan<<<(8 * 32768) / 256, 256, 0, stream>>>(KVT);
    n4_ret<<<512 * 128, 256, 0, stream>>>(UA, KVT);
    { GArgs g{}; g.A = UA + 2048; g.lda = 4096; g.Bt = WOUTA; g.K = 1536; g.N = 1024; g.xres = x; g.out = out; g.x1b = X1B; g.ss1p = SS1P;
      n_gemm<1><<<(T_ / 16) * 4, 256, 0, stream>>>(g); }
    { GArgs g{}; g.A = X1B; g.lda = 1024; g.Bt = WB; g.K = 1024; g.N = 5120; g.U = UB; g.ss1p = SS1P;
      n_gemm<2><<<(T_ / 16) * 20, 256, 0, stream>>>(g); }
    n7_sb<<<NB_ * 8 * S_, 256, 0, stream>>>(UB);
    n_memattn<<<T_, 256, 0, stream>>>(UB, NBW_, 4096, 4608, MEMK, MEMV, 1);
    { GArgs g{}; g.A = UB + 3072; g.lda = 5120; g.Bt = WOUTB; g.K = 1536; g.N = 1024; g.out = out;
      n_gemm<3><<<(T_ / 16) * 4, 256, 0, stream>>>(g); }
}
```

```cpp
#include <hip/hip_runtime.h>
#include <stdint.h>

typedef unsigned short bf16_t;

constexpr int NB_ = 2, S_ = 8192, T_ = NB_ * S_, D_ = 1024;
constexpr int NA_ = 4096, NBW_ = 5120, KO_ = 1536;
constexpr float EPS_ = 1e-6f;
constexpr float QK_SCALE = 0.08838834764831845f;

constexpr size_t MiB = 1u << 20;
constexpr size_t WS_CTL = 0;
constexpr size_t WS_WINA = 1 * MiB;
constexpr size_t WS_WOUTA = 9 * MiB;
constexpr size_t WS_WB = 12 * MiB;
constexpr size_t WS_WOUTB = 22 * MiB;
constexpr size_t WS_MEMK = 25 * MiB;
constexpr size_t WS_MEMV = 26 * MiB;
constexpr size_t WS_RS0 = 27 * MiB;
constexpr size_t WS_SS1P = 28 * MiB;
constexpr size_t WS_UA = 30 * MiB;
constexpr size_t WS_KVT = 158 * MiB;
constexpr size_t WS_XB = 158 * MiB;
constexpr size_t WS_X1B = 190 * MiB;
constexpr size_t WS_UB = 30 * MiB;


__device__ __forceinline__ float bf2f(bf16_t v) { return __uint_as_float(((unsigned)v) << 16); }
__device__ __forceinline__ bf16_t f2bf(float f) { unsigned u = __float_as_uint(f); u += 0x7fffu + ((u >> 16) & 1u); return (bf16_t)(u >> 16); }
__device__ __forceinline__ float silu_f(float v) { return v / (1.0f + __expf(-v)); }
__device__ __forceinline__ float softplus_f(float z) { return fmaxf(z, 0.f) + log1pf(__expf(-fabsf(z))); }
__device__ __forceinline__ float ret_lg(int h) { return logf(1.0f - exp2f(-5.0f - (float)h)); }

__device__ __forceinline__ void rot_sincos(float ang, float& s, float& c) {
    const float n = rintf(ang * 0.15915494309189535f);
    float r = fmaf(-n, 6.28318548202514648f, ang);
    r = fmaf(-n, -1.74845553e-7f, r);
    const float rev = r * 0.15915494309189535f;
    s = __builtin_amdgcn_sinf(rev); c = __builtin_amdgcn_cosf(rev);
}
__device__ __forceinline__ float rope_inv_freq(int i) { return exp2f(-(float)i * 0.20762050593046014f); }

__global__ __launch_bounds__(256) void n0_x(const float* __restrict__ x, bf16_t* __restrict__ xb, float* __restrict__ rs) {
    const int row = blockIdx.x * 4 + (threadIdx.x >> 6), lane = threadIdx.x & 63;
    const float* xr = x + (size_t)row * D_; float s = 0.f;
    for (int j = lane; j < D_; j += 64) { const float v = xr[j]; s += v * v; xb[(size_t)row * D_ + j] = f2bf(v); }
    for (int o = 32; o; o >>= 1) s += __shfl_xor(s, o);
    if (lane == 0) rs[row] = 1.0f / sqrtf(s * (1.0f / D_) + EPS_);
}

struct WArgs { const float* w_in_a; const float* w_out_a; const float* w_kv; const float* w_in_b; const float* w_out_b;
               const float* g_norm_a; const float* g_ret_head; const float* g_kv; const float* g_norm_b; };
__device__ __forceinline__ int permA_src(int n) {
    if (n >= 1024) return n;
    const int tile = n >> 8, c = n & 255, bj = c >> 7, p = c & 127, hit = p >> 6, i = p & 63;
    return tile * 256 + hit * 128 + bj * 64 + i;
}
__global__ __launch_bounds__(256) void n0_w(WArgs a, int mode, bf16_t* __restrict__ out) {
    const int K = (mode == 0 || mode == 2) ? 1024 : 1536;
    const int N = mode == 0 ? 4096 : (mode == 2 ? 5120 : 1024);
    const size_t idx = (size_t)blockIdx.x * 256 + threadIdx.x; if (idx >= (size_t)N * K) return;
    const int k = (int)(idx % K), n = (int)(idx / K);
    float v;
    if (mode == 0) v = a.w_in_a[(size_t)k * 4096 + permA_src(n)] * a.g_norm_a[k];
    else if (mode == 1) v = a.w_out_a[(size_t)k * 1024 + n] * (k < 1024 ? a.g_ret_head[k & 255] : 1.0f);
    else if (mode == 2) {
        if (n < 2048) v = a.w_kv[(size_t)k * 2048 + n] * a.g_kv[k];
        else { const int c = n - 2048; const int src = c < 1024 ? 1024 + c : (c < 2048 ? c - 1024 : c);
               v = a.w_in_b[(size_t)k * 3072 + src] * a.g_norm_b[k]; }
    } else v = a.w_out_b[(size_t)k * 1024 + n];
    out[idx] = f2bf(v);
}

__global__ __launch_bounds__(256) void n0_mem(const float* __restrict__ mem, const float* __restrict__ g_mem, const float* __restrict__ w_mem_kv,
                                              const float* __restrict__ g_mem_q, const float* __restrict__ g_mem_k, bf16_t* __restrict__ memK, bf16_t* __restrict__ memV) {
    __shared__ float sm[1024]; __shared__ float skv[1024]; __shared__ float red[256]; __shared__ float hn[4];
    const int l = blockIdx.x >> 9, b = (blockIdx.x >> 8) & 1, m = blockIdx.x & 255, tid = threadIdx.x;
    const float* mr = mem + ((size_t)b * 256 + m) * D_;
    float s = 0.f; for (int j = tid; j < D_; j += 256) { const float v = mr[j]; s += v * v; }
    red[tid] = s; __syncthreads();
    for (int o = 128; o; o >>= 1) { if (tid < o) red[tid] += red[tid + o]; __syncthreads(); }
    const float r = 1.0f / sqrtf(red[0] * (1.0f / D_) + EPS_);
    for (int j = tid; j < D_; j += 256) sm[j] = mr[j] * r * g_mem[l * D_ + j];
    __syncthreads();
    const float* W = w_mem_kv + (size_t)l * D_ * 1024;
    float acc[4] = {0.f, 0.f, 0.f, 0.f};
    for (int k = 0; k < D_; ++k) { const float a = sm[k];
#pragma unroll
        for (int j = 0; j < 4; ++j) acc[j] += a * W[(size_t)k * 1024 + tid + 256 * j]; }
#pragma unroll
    for (int j = 0; j < 4; ++j) skv[tid + 256 * j] = acc[j];
    __syncthreads();
    if (tid < 4) { float q = 0.f; for (int d = 0; d < 128; ++d) { const float v = skv[tid * 128 + d]; q += v * v; } hn[tid] = 1.0f / sqrtf(q * (1.0f / 128) + EPS_); }
    __syncthreads();
    for (int j = tid; j < 512; j += 256) { const int h = j >> 7, d = j & 127;
        const size_t o = ((((size_t)l * 2 + b) * 4 + h) * 256 + m) * 128 + d;
        memK[o] = f2bf(skv[j] * hn[h] * g_mem_k[l * 128 + d] * g_mem_q[l * 128 + d] * QK_SCALE);
        memV[o] = f2bf(skv[512 + j]); }
}

struct GArgs { const bf16_t* A; int lda; const bf16_t* Bt; int K; int N;
               const float* rs0; const int* pos; bf16_t* U; const float* xres; float* out; bf16_t* x1b; float* ss1p; };
template <int EPI> __global__ __launch_bounds__(256) void n_gemm(GArgs g) {
    __shared__ float sA[16][36]; __shared__ float sC[16][257];
    const int ntn = g.N / 256, pm = blockIdx.x / ntn, pn = blockIdx.x % ntn, row0 = pm * 16, c = threadIdx.x;
    const bf16_t* brow = g.Bt + (size_t)(pn * 256 + c) * g.K;
    float acc[16];
#pragma unroll
    for (int r = 0; r < 16; ++r) acc[r] = 0.f;
    for (int k0 = 0; k0 < g.K; k0 += 32) {
        __syncthreads();
        for (int e = threadIdx.x; e < 512; e += 256) { const int r = e >> 5, kk = e & 31; sA[r][kk] = bf2f(g.A[(size_t)(row0 + r) * g.lda + k0 + kk]); }
        __syncthreads();
#pragma unroll
        for (int j = 0; j < 4; ++j) { const uint4 bv = *(const uint4*)(brow + k0 + 8 * j); const unsigned w[4] = {bv.x, bv.y, bv.z, bv.w};
#pragma unroll
            for (int q = 0; q < 4; ++q) { const float b0 = __uint_as_float(w[q] << 16), b1 = __uint_as_float(w[q] & 0xffff0000u); const int kk = 8 * j + 2 * q;
#pragma unroll
                for (int r = 0; r < 16; ++r) acc[r] += sA[r][kk] * b0 + sA[r][kk + 1] * b1; } }
    }
#pragma unroll
    for (int r = 0; r < 16; ++r) sC[r][c] = acc[r];
    __syncthreads();
    if (EPI == 0) {
        for (int r = 0; r < 16; ++r) { const int row = row0 + r; const float rs = g.rs0[row]; bf16_t* urow = g.U + (size_t)row * NA_;
            if (pn < 4) { if (c < 128) { const int hit = c >> 6, i = c & 63; const float x1 = sC[r][c] * rs, x2 = sC[r][c + 128] * rs;
                    float sn, cs; rot_sincos((float)g.pos[row] * rope_inv_freq(i), sn, cs); const float sc = pn >= 2 ? QK_SCALE : 1.0f;
                    urow[pn * 256 + hit * 128 + i] = f2bf((x1 * cs - x2 * sn) * sc); urow[pn * 256 + hit * 128 + 64 + i] = f2bf((x1 * sn + x2 * cs) * sc); } }
            else { const float v = sC[r][c] * rs; const bool silu = (pn >= 8 && pn < 12) || pn >= 14; urow[pn * 256 + c] = f2bf(silu ? silu_f(v) : v); } }
    } else if (EPI == 1) {
        for (int r = 0; r < 16; ++r) { const size_t o = (size_t)(row0 + r) * D_ + pn * 256 + c; const float v = g.xres[o] + sC[r][c]; g.out[o] = v; g.x1b[o] = f2bf(v); sC[r][c] = v * v; }
        __syncthreads();
        if (c < 16) { float s = 0.f; for (int j = 0; j < 256; ++j) s += sC[c][j]; float* p = g.ss1p + (size_t)(row0 + c) * 16 + pn * 4; p[0] = s; p[1] = 0.f; p[2] = 0.f; p[3] = 0.f; }
    } else if (EPI == 2) {
        for (int r = 0; r < 16; ++r) { const int row = row0 + r; const float* sp = g.ss1p + (size_t)row * 16; float ss = 0.f; for (int j = 0; j < 16; ++j) ss += sp[j];
            const float rs = 1.0f / sqrtf(ss * (1.0f / D_) + EPS_); float v = sC[r][c] * rs;
            if ((pn >= 8 && pn < 12) || pn >= 18) v = silu_f(v); else if (pn >= 12 && pn < 16) v *= QK_SCALE;
            g.U[(size_t)row * NBW_ + pn * 256 + c] = f2bf(v); }
    } else {
        for (int r = 0; r < 16; ++r) { const size_t o = (size_t)(row0 + r) * D_ + pn * 256 + c; g.out[o] = g.out[o] + sC[r][c]; }
    }
}

__global__ __launch_bounds__(256) void n2_kv(const bf16_t* __restrict__ UA, bf16_t* __restrict__ KVT) {
    const int u = blockIdx.x >> 2, eg = blockIdx.x & 3, tid = threadIdx.x, e = eg * 64 + (tid & 63), dq = tid >> 6;
    const int b = u >> 8, h = (u >> 6) & 3, n = u & 63; const size_t row0 = (size_t)b * S_ + n * 128; const float lg = ret_lg(h);
    float acc[32];
#pragma unroll
    for (int j = 0; j < 32; ++j) acc[j] = 0.f;
    for (int m = 0; m < 128; ++m) { const bf16_t* ur = UA + (row0 + m) * NA_; const float vz = bf2f(ur[1024 + h * 256 + e]) * __expf((float)(127 - m) * lg);
#pragma unroll
        for (int j = 0; j < 32; ++j) acc[j] += vz * bf2f(ur[512 + h * 128 + dq * 32 + j]); }
#pragma unroll
    for (int j = 0; j < 32; ++j) KVT[((size_t)u * 256 + e) * 128 + dq * 32 + j] = f2bf(acc[j]);
}
__global__ __launch_bounds__(256) void n3_scan(bf16_t* __restrict__ KVT) {
    const int idx = blockIdx.x * 256 + threadIdx.x; const int bh = idx >> 15, off = idx & 32767; const float gc = __expf(128.0f * ret_lg(bh & 3));
    float s = 0.f;
    for (int n = 0; n < 64; ++n) { bf16_t* p = KVT + ((size_t)(bh * 64 + n) << 15) + off; const float t = bf2f(*p); *p = f2bf(s); s = gc * s + t; }
}
__global__ __launch_bounds__(256) void n4_ret(bf16_t* __restrict__ UA, const bf16_t* __restrict__ KVT) {
    __shared__ float sq[128], ss[128], red[256];
    const int u = blockIdx.x >> 7, c = blockIdx.x & 127, tid = threadIdx.x; const int b = u >> 8, h = (u >> 6) & 3, n = u & 63;
    const size_t row0 = (size_t)b * S_ + n * 128, row = row0 + c; const float lg = ret_lg(h);
    if (tid < 128) sq[tid] = bf2f(UA[row * NA_ + h * 128 + tid]);
    __syncthreads();
    if (tid < 128) { float d = 0.f; if (tid <= c) { const bf16_t* kr = UA + (row0 + tid) * NA_ + 512 + h * 128; for (int j = 0; j < 128; ++j) d += sq[j] * bf2f(kr[j]); d *= __expf((float)(c - tid) * lg); } ss[tid] = d; }
    __syncthreads();
    const int e = tid; float o = 0.f;
    for (int m = 0; m <= c; ++m) o += ss[m] * bf2f(UA[(row0 + m) * NA_ + 1024 + h * 256 + e]);
    float cr = 0.f; const bf16_t* st = KVT + ((size_t)u * 256 + e) * 128; for (int j = 0; j < 128; ++j) cr += sq[j] * bf2f(st[j]);
    o += __expf((float)(c + 1) * lg) * cr;
    red[tid] = o * o; __syncthreads();
    for (int w = 128; w; w >>= 1) { if (tid < w) red[tid] += red[tid + w]; __syncthreads(); }
    const float r = 1.0f / sqrtf(red[0] * (1.0f / 256) + EPS_);
    bf16_t* gp = UA + row * NA_ + 2048 + h * 256 + e; *gp = f2bf(o * r * bf2f(*gp));
}
__global__ __launch_bounds__(256) void n_memattn(bf16_t* __restrict__ U, int ld, int qoff, int goff, const bf16_t* __restrict__ memK, const bf16_t* __restrict__ memV, int layer) {
    __shared__ float sq[4][128]; __shared__ float sp[4][256];
    const int w = threadIdx.x >> 6, lane = threadIdx.x & 63; const int gw = blockIdx.x * 4 + w, row = gw >> 2, hd = gw & 3, b = row / S_;
    bf16_t* qp = U + (size_t)row * ld + qoff + hd * 128; const bf16_t* gp = U + (size_t)row * ld + goff + hd * 128;
    const float q0 = bf2f(qp[lane]), q1 = bf2f(qp[lane + 64]); sq[w][lane] = q0; sq[w][lane + 64] = q1;
    float s = q0 * q0 + q1 * q1; for (int o = 32; o; o >>= 1) s += __shfl_xor(s, o);
    const float rq = 1.0f / sqrtf(s * (1.0f / 128) + EPS_);
    __syncthreads();
    const bf16_t* Kb = memK + (((size_t)layer * 2 + b) * 4 + hd) * 256 * 128; const bf16_t* Vb = memV + (((size_t)layer * 2 + b) * 4 + hd) * 256 * 128;
    float lgt[4]; float mx = -1e30f;
    for (int j = 0; j < 4; ++j) { const bf16_t* kr = Kb + (size_t)(lane + 64 * j) * 128; float d = 0.f; for (int t = 0; t < 128; ++t) d += sq[w][t] * bf2f(kr[t]); lgt[j] = d * rq; mx = fmaxf(mx, lgt[j]); }
    for (int o = 32; o; o >>= 1) mx = fmaxf(mx, __shfl_xor(mx, o));
    float ps = 0.f; for (int j = 0; j < 4; ++j) { lgt[j] = __expf(lgt[j] - mx); ps += lgt[j]; }
    for (int o = 32; o; o >>= 1) ps += __shfl_xor(ps, o);
    for (int j = 0; j < 4; ++j) sp[w][lane + 64 * j] = lgt[j] / ps;
    __syncthreads();
    float o0 = 0.f, o1 = 0.f;
    for (int m = 0; m < 256; ++m) { const float p = sp[w][m]; o0 += p * bf2f(Vb[(size_t)m * 128 + lane]); o1 += p * bf2f(Vb[(size_t)m * 128 + lane + 64]); }
    const float g0 = bf2f(gp[lane]), g1 = bf2f(gp[lane + 64]);
    qp[lane] = f2bf(o0 * g0); qp[lane + 64] = f2bf(o1 * g1);
}
#ifndef NAIVE_SB_EXIT
#define NAIVE_SB_EXIT 1
#endif
__global__ __launch_bounds__(256) void n7_sb(bf16_t* __restrict__ UB) {
    __shared__ float sq[128]; __shared__ float sa[256]; __shared__ float wtot[4]; __shared__ float wpre[4];
    const int t = blockIdx.x & (S_ - 1), h = (blockIdx.x >> 13) & 7, b = blockIdx.x >> 16, tid = threadIdx.x, lane = tid & 63, w = tid >> 6;
    const size_t rowb = (size_t)b * S_; bf16_t* qp = UB + (rowb + t) * NBW_ + 3072 + h * 128;
    if (tid < 128) sq[tid] = bf2f(qp[tid]);
    __syncthreads();
    float carry = 0.f, od = 0.f;
    for (int s_hi = t - 1; s_hi >= 0; s_hi -= 256) {
        const int s = s_hi - tid; const bool valid = s >= 0;
        float z = 0.f; if (valid) { const bf16_t* kr = UB + (rowb + s) * NBW_ + h * 128; for (int j = 0; j < 128; ++j) z += sq[j] * bf2f(kr[j]); }
        const float spv = softplus_f(z); const float lf = valid ? -spv : 0.f;
        float inc = lf;
        for (int o = 1; o < 64; o <<= 1) { const float v = __shfl_up(inc, o); if (lane >= o) inc += v; }
        if (lane == 63) wtot[w] = inc;
        __syncthreads();
        if (tid == 0) { float a = 0.f; for (int j = 0; j < 4; ++j) { wpre[j] = a; a += wtot[j]; } }
        __syncthreads();
        const float pre = wpre[w] + inc - lf;
        const float tot = wpre[3] + wtot[3];
        sa[tid] = valid ? __expf((z - spv) + pre + carry) : 0.f;
        __syncthreads();
        if (tid < 128) { const int cnt = min(256, s_hi + 1); const bf16_t* vb = UB + rowb * NBW_ + 1024 + h * 128 + tid;
            for (int i = 0; i < cnt; ++i) od += sa[i] * bf2f(vb[(size_t)(s_hi - i) * NBW_]); }
        carry += tot;
        __syncthreads();
        if (NAIVE_SB_EXIT && carry < -104.0f) break;
    }
    if (tid < 128) { const float g = bf2f(UB[(rowb + t) * NBW_ + 2048 + h * 128 + tid]); qp[tid] = f2bf(od * g); }
}


namespace pg8 {
#define PG8_LAS __attribute__((address_space(3)))
typedef unsigned short bf16_t;
typedef short bf16x8 __attribute__((ext_vector_type(8)));
typedef float f32x4 __attribute__((ext_vector_type(4)));
typedef unsigned u32x4 __attribute__((ext_vector_type(4)));
constexpr int BM = 256, BK = 64, HALF = 128, HTB = HALF * BK * 2  , STAGE_BYTES = 8 * HTB, NXCD = 8, WGM = 8;

__host__ __device__ __forceinline__ int lds_byte(int r, int c) { const int st = (r >> 4) * 2 + (c >> 5), rr = r & 15, cc = c & 31, ob = rr * 64 + cc * 2; return st * 1024 + (ob ^ (((ob >> 9) & 1) << 5)); }
__host__ __device__ __forceinline__ void stage_rc(int b, int& R, int& C) { const int st = b / 1024, sb = b % 1024, swz = sb ^ (((sb >> 9) & 1) << 5); R = (st >> 1) * 16 + swz / 64; C = (st & 1) * 32 + (swz % 64) / 2; }
__host__ __device__ __forceinline__ int perm32(int rho) { const int n = rho >> 4, i = rho & 15; return 8 * (i >> 2) + 4 * n + (i & 3); }

struct Unit { int pm, pn; };
struct Gemm { const bf16_t* A; const bf16_t* Bt; int M, N, K, lda; };

struct StaticOrder {
    int nM, nN, nwg, G, c;
    __host__ __device__ void init(int M, int N, int G_, int c_) { nM = M / BM; nN = N / BM; nwg = nM * nN; G = G_; c = c_; }
    __host__ __device__ bool next(int i, Unit& u) const {
        const long L = (long)i * G + c; if (L >= nwg) return false;
        int wgid = (int)L; { const int q = nwg / NXCD, r = nwg % NXCD, xcd = wgid % NXCD, off = wgid / NXCD; wgid = (xcd < r ? xcd * (q + 1) : r * (q + 1) + (xcd - r) * q) + off; }
        const int nig = WGM * nN, gid = wgid / nig, fm = gid * WGM, gsz = (nM - fm) < WGM ? (nM - fm) : WGM;
        u.pm = fm + ((wgid % nig) % gsz); u.pn = (wgid % nig) / gsz; return true;
    }
    __device__ __forceinline__ void a_ready(const Unit&) const {}
    __device__ __forceinline__ void done(const Unit&) const {}
};

__device__ __forceinline__ unsigned cvt_pk_bf16(float lo, float hi) { unsigned r; asm volatile("v_cvt_pk_bf16_f32 %0, %1, %2" : "=v"(r) : "v"(lo), "v"(hi)); return r; }
__device__ __forceinline__ float silu_fast(float v) { return v * __builtin_amdgcn_rcpf(1.0f + __builtin_amdgcn_exp2f(-1.4426950408889634f * v)); }
__device__ __forceinline__ u32x4 pack8(const f32x4 a, const f32x4 b) { u32x4 w; w.x = cvt_pk_bf16(a[0], a[1]); w.y = cvt_pk_bf16(a[2], a[3]); w.z = cvt_pk_bf16(b[0], b[1]); w.w = cvt_pk_bf16(b[2], b[3]); return w; }

struct EpiA {
    static constexpr bool PERM = true, AFTER_DRAIN = false;
    bf16_t* U; const float* rs0; const int* pos;
    __device__ __forceinline__ void operator()(const f32x4 (&acc)[2][2][4][2], const Unit& u, int wr, int wc, int fr, int fq) const {
        const int row0 = u.pm * BM + wr * 64 + fr;
        if (u.pn < 4) {
            const int hit = wc >> 1, i0 = 32 * (wc & 1) + 8 * fq; const float sc = u.pn >= 2 ? QK_SCALE : 1.0f;
            float inv[8];
#pragma unroll
            for (int j = 0; j < 8; ++j) inv[j] = rope_inv_freq(i0 + j);
#pragma unroll
            for (int ai = 0; ai < 2; ++ai)
#pragma unroll
                for (int m = 0; m < 4; ++m) { const int row = row0 + ai * HALF + m * 16; const float rs = rs0[row] * sc, pf = (float)pos[row];
                    bf16_t* up = U + (size_t)row * NA_ + u.pn * BM + hit * 128 + i0;
                    f32x4 o1[2], o2[2];
#pragma unroll
                    for (int n = 0; n < 2; ++n)
#pragma unroll
                        for (int e = 0; e < 4; ++e) { float sn, cs; rot_sincos(pf * inv[4 * n + e], sn, cs); const float x1 = acc[ai][0][m][n][e] * rs, x2 = acc[ai][1][m][n][e] * rs;
                            o1[n][e] = x1 * cs - x2 * sn; o2[n][e] = x1 * sn + x2 * cs; }
                    *(u32x4*)up = pack8(o1[0], o1[1]); *(u32x4*)(up + 64) = pack8(o2[0], o2[1]); }
        } else {
            const bool silu = (u.pn >= 8 && u.pn < 12) || u.pn >= 14;
#pragma unroll
            for (int ai = 0; ai < 2; ++ai)
#pragma unroll
                for (int m = 0; m < 4; ++m) { const int row = row0 + ai * HALF + m * 16; const float rs = rs0[row]; bf16_t* rowp = U + (size_t)row * NA_ + u.pn * BM + wc * 32 + 8 * fq;
#pragma unroll
                    for (int bj = 0; bj < 2; ++bj) { f32x4 v0 = acc[ai][bj][m][0] * rs, v1 = acc[ai][bj][m][1] * rs;
                        if (silu) {
#pragma unroll
                            for (int e = 0; e < 4; ++e) { v0[e] = silu_fast(v0[e]); v1[e] = silu_fast(v1[e]); } }
                        *(u32x4*)(rowp + bj * HALF) = pack8(v0, v1); } }
        }
    }
};
struct EpiOutA {
    static constexpr bool PERM = true, AFTER_DRAIN = false;
    const float* xres; float* out; bf16_t* x1b; float* ss1p;
    __device__ __forceinline__ void operator()(const f32x4 (&acc)[2][2][4][2], const Unit& u, int wr, int wc, int fr, int fq) const {
        const int row0 = u.pm * BM + wr * 64 + fr;
#pragma unroll
        for (int ai = 0; ai < 2; ++ai)
#pragma unroll
            for (int m = 0; m < 4; ++m) { const int row = row0 + ai * HALF + m * 16; const size_t off = (size_t)row * D_ + u.pn * BM + wc * 32 + 8 * fq; float ssq = 0.f;
#pragma unroll
                for (int bj = 0; bj < 2; ++bj) { const f32x4 r0 = *(const f32x4*)(xres + off + bj * HALF), r1 = *(const f32x4*)(xres + off + bj * HALF + 4);
                    const f32x4 v0 = acc[ai][bj][m][0] + r0, v1 = acc[ai][bj][m][1] + r1;
                    *(f32x4*)(out + off + bj * HALF) = v0; *(f32x4*)(out + off + bj * HALF + 4) = v1; *(u32x4*)(x1b + off + bj * HALF) = pack8(v0, v1);
                    ssq += (v0[0] * v0[0] + v0[1] * v0[1]) + (v0[2] * v0[2] + v0[3] * v0[3]) + (v1[0] * v1[0] + v1[1] * v1[1]) + (v1[2] * v1[2] + v1[3] * v1[3]); }
                ssq += __shfl_xor(ssq, 16); ssq += __shfl_xor(ssq, 32);
                if (fq == 0) ss1p[(size_t)row * 16 + u.pn * 4 + wc] = ssq; }
    }
};
struct EpiB {
    static constexpr bool PERM = true, AFTER_DRAIN = false;
    bf16_t* U; const float* ss1p;
    __device__ __forceinline__ void operator()(const f32x4 (&acc)[2][2][4][2], const Unit& u, int wr, int wc, int fr, int fq) const {
        const int row0 = u.pm * BM + wr * 64 + fr; const bool silu = (u.pn >= 8 && u.pn < 12) || u.pn >= 18; const float sc = (u.pn >= 12 && u.pn < 16) ? QK_SCALE : 1.0f;
#pragma unroll
        for (int ai = 0; ai < 2; ++ai)
#pragma unroll
            for (int m = 0; m < 4; ++m) { const int row = row0 + ai * HALF + m * 16; const f32x4 pv = *(const f32x4*)(ss1p + (size_t)row * 16 + 4 * fq);
                float s = (pv[0] + pv[1]) + (pv[2] + pv[3]); s += __shfl_xor(s, 16); s += __shfl_xor(s, 32);
                const float rs = sc / sqrtf(s * (1.0f / D_) + EPS_); bf16_t* rowp = U + (size_t)row * NBW_ + u.pn * BM + wc * 32 + 8 * fq;
#pragma unroll
                for (int bj = 0; bj < 2; ++bj) { f32x4 v0 = acc[ai][bj][m][0] * rs, v1 = acc[ai][bj][m][1] * rs;
                    if (silu) {
#pragma unroll
                        for (int e = 0; e < 4; ++e) { v0[e] = silu_fast(v0[e]); v1[e] = silu_fast(v1[e]); } }
                    *(u32x4*)(rowp + bj * HALF) = pack8(v0, v1); } }
    }
};
struct EpiOutB {
    static constexpr bool PERM = true, AFTER_DRAIN = false;
    float* out;
    __device__ __forceinline__ void operator()(const f32x4 (&acc)[2][2][4][2], const Unit& u, int wr, int wc, int fr, int fq) const {
        const int row0 = u.pm * BM + wr * 64 + fr;
#pragma unroll
        for (int ai = 0; ai < 2; ++ai)
#pragma unroll
            for (int m = 0; m < 4; ++m) { const size_t off = (size_t)(row0 + ai * HALF + m * 16) * D_ + u.pn * BM + wc * 32 + 8 * fq;
#pragma unroll
                for (int bj = 0; bj < 2; ++bj) { const f32x4 r0 = *(const f32x4*)(out + off + bj * HALF), r1 = *(const f32x4*)(out + off + bj * HALF + 4);
                    *(f32x4*)(out + off + bj * HALF) = acc[ai][bj][m][0] + r0; *(f32x4*)(out + off + bj * HALF + 4) = acc[ai][bj][m][1] + r1; } }
    }
};

template <class Epi, class Sched, bool ALIGN_EPI = false, bool SP2 = false>
__device__ __forceinline__ void gemm_phase(PG8_LAS unsigned char* lds, const Gemm g, const Sched& S, const Epi& E) {
    const int tid = threadIdx.x, wid = __builtin_amdgcn_readfirstlane(tid >> 6), lane = tid & 63, wr = wid >> 2, wc = wid & 3, fr = lane & 15, fq = lane >> 4;
    const int K = g.K, nt = K / BK;
    unsigned voffA[2], voffB[2];
#pragma unroll
    for (int i = 0; i < 2; ++i) { int R, C; stage_rc(tid * 16 + i * 8192, R, C); const int Rb = Epi::PERM ? ((R & ~31) + perm32(R & 31)) : R;
        voffA[i] = (unsigned)(R * g.lda + C) * 2u; voffB[i] = (unsigned)(Rb * K + C) * 2u; }
    const size_t kstep = (size_t)(BK * 2);
    const size_t hstepA = (size_t)HALF * g.lda * 2, hstepB = (size_t)HALF * K * 2;
    const size_t tstepA = 2 * hstepA, tstepB = 2 * hstepB;
    const unsigned ldsw = (unsigned)wid * 1024u;
    const int aoff = lds_byte(wr * 64 + fr, fq * 8), boff = lds_byte(wc * 32 + fr, fq * 8);
#define PG8_SA(b, h) (((b) * 2 + (h)) * HTB)
#define PG8_SB(b, h) ((4 + (b) * 2 + (h)) * HTB)
#define PG8_STAGE(bufoff, gbase, voff) do { _Pragma("unroll") for (int _i = 0; _i < 2; ++_i) \
        __builtin_amdgcn_global_load_lds((const unsigned*)((const char*)(gbase) + (voff)[_i]), (PG8_LAS unsigned*)(lds + (bufoff) + ldsw + _i * 8192), 16, 0, 0); } while (0)
#define PG8_LDA(dst, b, h) do { _Pragma("unroll") for (int m = 0; m < 4; ++m) _Pragma("unroll") for (int k = 0; k < 2; ++k) dst[m][k] = *(const PG8_LAS bf16x8*)(lds + PG8_SA(b, h) + aoff + m * 2048 + k * 1024); } while (0)
#define PG8_LDB(dst, b, h) do { _Pragma("unroll") for (int n = 0; n < 2; ++n) _Pragma("unroll") for (int k = 0; k < 2; ++k) dst[n][k] = *(const PG8_LAS bf16x8*)(lds + PG8_SB(b, h) + boff + n * 2048 + k * 1024); } while (0)
#define PG8_MMA(ai, bj, At, Bt) do { __builtin_amdgcn_s_setprio(1); _Pragma("unroll") for (int m = 0; m < 4; ++m) _Pragma("unroll") for (int n = 0; n < 2; ++n) _Pragma("unroll") for (int k = 0; k < 2; ++k) \
        acc[ai][bj][m][n] = __builtin_amdgcn_mfma_f32_16x16x32_bf16(Bt[n][k], At[m][k], acc[ai][bj][m][n], 0, 0, 0); __builtin_amdgcn_s_setprio(0); } while (0)
#define PG8_WAIT_V(n) asm volatile("s_waitcnt vmcnt(" #n ")" ::: "memory")
#define PG8_WAIT_L(n) asm volatile("s_waitcnt lgkmcnt(" #n ")" ::: "memory")
#define PG8_BAR __builtin_amdgcn_s_barrier()
#define PG8_SCHED __builtin_amdgcn_sched_barrier(0)
    Unit cur, nxt; int ui = 0;
    if (!S.next(0, cur)) return;
    f32x4 acc[2][2][4][2];
#pragma unroll
    for (int a = 0; a < 2; ++a)
#pragma unroll
        for (int b = 0; b < 2; ++b)
#pragma unroll
            for (int m = 0; m < 4; ++m)
#pragma unroll
                for (int n = 0; n < 2; ++n) acc[a][b][m][n] = (f32x4){0.f, 0.f, 0.f, 0.f};
    bf16x8 At[4][2], B0[2][2], B1[2][2];
    const char* cA = (const char*)g.A + (size_t)cur.pm * tstepA; const char* cB = (const char*)g.Bt + (size_t)cur.pn * tstepB;
    S.a_ready(cur);
    if constexpr (SP2) {
        PG8_STAGE(PG8_SB(0, 0), cB, voffB); PG8_STAGE(PG8_SB(0, 1), cB + hstepB, voffB); PG8_STAGE(PG8_SA(0, 0), cA, voffA); PG8_STAGE(PG8_SA(0, 1), cA + hstepA, voffA);
        if (wr == 1) PG8_BAR;
        PG8_WAIT_V(2); PG8_BAR;
        PG8_STAGE(PG8_SB(1, 0), cB + kstep, voffB); PG8_STAGE(PG8_SA(1, 0), cA + kstep, voffA); PG8_STAGE(PG8_SB(1, 1), cB + hstepB + kstep, voffB);
        PG8_WAIT_V(6); PG8_BAR;
    } else {
        PG8_STAGE(PG8_SB(0, 0), cB, voffB); PG8_STAGE(PG8_SA(0, 0), cA, voffA); PG8_STAGE(PG8_SB(0, 1), cB + hstepB, voffB); PG8_STAGE(PG8_SA(0, 1), cA + hstepA, voffA);
        if (wr == 1) PG8_BAR;
        PG8_WAIT_V(4); PG8_BAR;
        PG8_STAGE(PG8_SB(1, 0), cB + kstep, voffB); PG8_STAGE(PG8_SA(1, 0), cA + kstep, voffA); PG8_STAGE(PG8_SB(1, 1), cB + hstepB + kstep, voffB);
        PG8_WAIT_V(6); PG8_BAR;
    }
    for (;;) {
        const bool has_next = S.next(ui + 1, nxt);
        const char* nA = has_next ? (const char*)g.A + (size_t)nxt.pm * tstepA : cA; const char* nB = has_next ? (const char*)g.Bt + (size_t)nxt.pn * tstepB : cB;
        for (int t = 0; t < nt; t += 2) {
            const bool last = (t == nt - 2);
            const char* a1 = cA + (size_t)(t + 1) * kstep;
            const char* a2 = last ? nA : cA + (size_t)(t + 2) * kstep; const char* b2 = last ? nB : cB + (size_t)(t + 2) * kstep;
            const char* a3 = a2 + kstep; const char* b3 = b2 + kstep;
            if (last && has_next) S.a_ready(nxt);
            if constexpr (SP2) {
            PG8_LDB(B0, 0, 0); PG8_LDB(B1, 0, 1); PG8_SCHED; PG8_LDA(At, 0, 0); PG8_STAGE(PG8_SA(1, 1), a1 + hstepA, voffA);
            PG8_WAIT_V(8); PG8_WAIT_L(0); PG8_BAR; PG8_MMA(0, 0, At, B0); PG8_MMA(0, 1, At, B1); PG8_BAR; PG8_SCHED;
            PG8_LDA(At, 0, 1); PG8_STAGE(PG8_SB(0, 0), b2, voffB); PG8_STAGE(PG8_SB(0, 1), b2 + hstepB, voffB); PG8_STAGE(PG8_SA(0, 0), a2, voffA);
            PG8_WAIT_V(8); PG8_WAIT_L(0); PG8_BAR; PG8_MMA(1, 0, At, B0); PG8_MMA(1, 1, At, B1); PG8_BAR; PG8_SCHED;
            PG8_LDB(B0, 1, 0); PG8_LDB(B1, 1, 1); PG8_SCHED; PG8_LDA(At, 1, 0); PG8_STAGE(PG8_SA(0, 1), a2 + hstepA, voffA);
            PG8_WAIT_V(8); PG8_WAIT_L(0); PG8_BAR; PG8_MMA(0, 0, At, B0); PG8_MMA(0, 1, At, B1); PG8_BAR; PG8_SCHED;
            PG8_LDA(At, 1, 1); PG8_STAGE(PG8_SB(1, 0), b3, voffB); PG8_STAGE(PG8_SB(1, 1), b3 + hstepB, voffB); PG8_STAGE(PG8_SA(1, 0), a3, voffA);
            PG8_WAIT_V(8); PG8_WAIT_L(0); PG8_BAR; PG8_MMA(1, 0, At, B0); PG8_MMA(1, 1, At, B1); PG8_BAR; PG8_SCHED;
            } else {
            PG8_LDB(B0, 0, 0); PG8_SCHED; PG8_LDA(At, 0, 0); PG8_STAGE(PG8_SA(1, 1), a1 + hstepA, voffA);
            PG8_WAIT_L(8); PG8_BAR; PG8_WAIT_L(0); PG8_MMA(0, 0, At, B0); PG8_BAR; PG8_SCHED;
            PG8_LDB(B1, 0, 1); PG8_STAGE(PG8_SB(0, 0), b2, voffB);
            PG8_BAR; PG8_WAIT_L(0); PG8_MMA(0, 1, At, B1); PG8_BAR;
            PG8_LDA(At, 0, 1); PG8_STAGE(PG8_SA(0, 0), a2, voffA);
            PG8_BAR; PG8_WAIT_L(0); PG8_MMA(1, 0, At, B0); PG8_BAR; PG8_SCHED;
            PG8_STAGE(PG8_SB(0, 1), b2 + hstepB, voffB);
            PG8_WAIT_V(6); PG8_BAR; PG8_MMA(1, 1, At, B1); PG8_BAR;
            PG8_LDB(B0, 1, 0); PG8_SCHED; PG8_LDA(At, 1, 0); PG8_STAGE(PG8_SA(0, 1), a2 + hstepA, voffA);
            PG8_WAIT_L(8); PG8_BAR; PG8_WAIT_L(0); PG8_MMA(0, 0, At, B0); PG8_BAR; PG8_SCHED;
            PG8_LDB(B1, 1, 1); PG8_STAGE(PG8_SB(1, 0), b3, voffB);
            PG8_BAR; PG8_WAIT_L(0); PG8_MMA(0, 1, At, B1); PG8_BAR;
            PG8_LDA(At, 1, 1); PG8_STAGE(PG8_SA(1, 0), a3, voffA);
            PG8_BAR; PG8_WAIT_L(0); PG8_MMA(1, 0, At, B0); PG8_BAR; PG8_SCHED;
            PG8_STAGE(PG8_SB(1, 1), b3 + hstepB, voffB);
            PG8_WAIT_V(6); PG8_BAR; PG8_MMA(1, 1, At, B1); PG8_BAR;
            }
        }
        if constexpr (ALIGN_EPI) { if (wr == 0) PG8_BAR; }
        if constexpr (!Epi::AFTER_DRAIN) { E(acc, cur, wr, wc, fr, fq); S.done(cur); }
        if (!has_next) break;
#pragma unroll
        for (int a = 0; a < 2; ++a)
#pragma unroll
            for (int b = 0; b < 2; ++b)
#pragma unroll
                for (int m = 0; m < 4; ++m)
#pragma unroll
                    for (int n = 0; n < 2; ++n) acc[a][b][m][n] = (f32x4){0.f, 0.f, 0.f, 0.f};
        cur = nxt; cA = nA; cB = nB; ++ui;
        if constexpr (ALIGN_EPI) { if (wr == 1) PG8_BAR; }
    }
    PG8_WAIT_V(0);
    if constexpr (!ALIGN_EPI) { if (wr == 0) PG8_BAR; }
    PG8_BAR;
    if constexpr (Epi::AFTER_DRAIN) { E.fused(acc, cur, wr, wc, fr, fq, lds, wid, lane); S.done(cur); }
#undef PG8_SA
#undef PG8_SB
#undef PG8_STAGE
#undef PG8_LDA
#undef PG8_LDB
#undef PG8_MMA
#undef PG8_WAIT_V
#undef PG8_WAIT_L
#undef PG8_BAR
#undef PG8_SCHED
}
}

#define LAS __attribute__((address_space(3)))
#define XB_TMO      128
#define XB_XCNT(j)  (256  + 64 * (j))
#define XB_XSUB(j)  (1280 + 64 * (j))
#define XB_XGEN(j)  (2304 + 64 * (j))
#define XB_TOP      3328
#define XB_TOPGEN   3392
#define XCD_BAR_WORDS 3456
#define XB_SPIN_CAP (1u << 18)

__device__ __forceinline__ unsigned xb_ld(unsigned* p)              { return __hip_atomic_load(p, __ATOMIC_RELAXED, __HIP_MEMORY_SCOPE_AGENT); }
__device__ __forceinline__ unsigned xb_add(unsigned* p, unsigned v) { return __hip_atomic_fetch_add(p, v, __ATOMIC_RELAXED, __HIP_MEMORY_SCOPE_AGENT); }
__device__ __forceinline__ unsigned xb_xcc_id() { return (unsigned)__builtin_amdgcn_s_getreg((3 << 11) | 20) & 0xFu; }
#define XB_SPIN(cond, bar) do { unsigned _sp = 0; while (cond) { __builtin_amdgcn_s_sleep(1); \
    if ((++_sp & 255u) == 0u) { if (xb_ld(&(bar)[XB_TMO])) break; if (_sp > XB_SPIN_CAP) { atomicAdd(&(bar)[XB_TMO], 1u); break; } } } } while (0)

struct XcdBarrier {
    unsigned* bar; unsigned x;
    volatile LAS unsigned* st;
};

__device__ __forceinline__ XcdBarrier xcd_barrier_post(unsigned* bar, volatile LAS unsigned* st) {
    XcdBarrier b; b.bar = bar; b.x = xb_xcc_id(); b.st = st;
    if (threadIdx.x == 0) (void)xb_add(&bar[XB_XCNT(b.x)], 1u);
    return b;
}
__device__ __forceinline__ void xcd_barrier_complete(unsigned* bar, unsigned x, unsigned& nloc, unsigned& nx) {
    const unsigned G = gridDim.x * gridDim.y * gridDim.z;
    unsigned sum, cnt, mine, sp = 0u;
    for (;;) {
        sum = 0u; cnt = 0u; mine = 0u;
#pragma unroll
        for (unsigned j = 0; j < 16; ++j) { const unsigned c = xb_ld(&bar[XB_XCNT(j)]); sum += c; cnt += (c > 0u) ? 1u : 0u; mine = (j == x) ? c : mine; }
        if (sum == G) break;
        __builtin_amdgcn_s_sleep(1);
        if ((++sp & 255u) == 0u) { if (xb_ld(&bar[XB_TMO])) break; if (sp > XB_SPIN_CAP) { atomicAdd(&bar[XB_TMO], 1u); break; } }
    }
    nloc = mine > 0u ? mine : 1u; nx = cnt > 0u ? cnt : 1u;
}

__device__ __forceinline__ void xcd_barrier(const XcdBarrier& b) {
    asm volatile("s_waitcnt vmcnt(0)" ::: "memory");
    __syncthreads();
    if (threadIdx.x == 0) {
        unsigned* bar = b.bar;
        __builtin_amdgcn_s_waitcnt(0);
        unsigned nloc = b.st[0], nx = b.st[1];
        if (nloc == 0u) { xcd_barrier_complete(bar, b.x, nloc, nx); b.st[0] = nloc; b.st[1] = nx; }
        const unsigned old = xb_add(&bar[XB_XSUB(b.x)], 1u);
        const unsigned gen = old / nloc;
        if (old + 1u == (gen + 1u) * nloc) {
            __builtin_amdgcn_fence(__ATOMIC_RELEASE, "agent");
            asm volatile("s_waitcnt vmcnt(0)" ::: "memory");
            const unsigned og = xb_add(&bar[XB_TOP], 1u);
            const unsigned tg = og / nx;
            if (og + 1u == (tg + 1u) * nx) xb_add(&bar[XB_TOPGEN], 1u);
            else XB_SPIN(xb_ld(&bar[XB_TOPGEN]) == tg, bar);
            __builtin_amdgcn_fence(__ATOMIC_ACQUIRE, "agent");
            xb_add(&bar[XB_XGEN(b.x)], 1u);
            asm volatile("s_waitcnt vmcnt(0)" ::: "memory");
        } else {
            XB_SPIN(xb_ld(&bar[XB_XGEN(b.x)]) == gen, bar);
            __builtin_amdgcn_fence(__ATOMIC_ACQUIRE, "agent");
            asm volatile("s_waitcnt vmcnt(0)" ::: "memory");
        }
    }
    __syncthreads();
}

constexpr int NWAVES = 8;
constexpr int RING_BYTES = 131072;
constexpr int LDSCTL_OFF = RING_BYTES;
constexpr int LDS_BYTES = 147456;
constexpr int CW_BAR = 4096;
constexpr size_t CTL_ZERO_BYTES = 65536;

typedef float f32x4 __attribute__((ext_vector_type(4)));
typedef unsigned u32x4v __attribute__((ext_vector_type(4)));
typedef unsigned u32x2v __attribute__((ext_vector_type(2)));
typedef short bf16x8 __attribute__((ext_vector_type(8)));
#define LDS_WAIT() asm volatile("s_waitcnt lgkmcnt(0)" ::: "memory")

struct MArgs { const float* in[16]; float* out; unsigned char* ws; int ph_lo, ph_hi, li, pad; };
struct Frame { LAS unsigned char* lds; int tid, lane, wave, G, bid; const float* in[16]; float* out; unsigned char* ws; };

__device__ __forceinline__ unsigned pk2(float lo, float hi) { return pg8::cvt_pk_bf16(lo, hi); }
__device__ __forceinline__ float wave_sum(float v) {
#pragma unroll
    for (int o = 1; o < 64; o <<= 1) v += __shfl_xor(v, o);
    return v;
}

__device__ __forceinline__ void p0_x_row(const float* xrow, bf16_t* orow, float* rs, int lane) {
    const f32x4* xr = (const f32x4*)xrow + lane; f32x4 v[4]; float s = 0.f;
#pragma unroll
    for (int j = 0; j < 4; ++j) { v[j] = xr[64 * j]; s += (v[j][0] * v[j][0] + v[j][1] * v[j][1]) + (v[j][2] * v[j][2] + v[j][3] * v[j][3]); }
    s = wave_sum(s);
    u32x2v* o8 = (u32x2v*)orow + lane;
#pragma unroll
    for (int j = 0; j < 4; ++j) { u32x2v w; w.x = pk2(v[j][0], v[j][1]); w.y = pk2(v[j][2], v[j][3]); o8[64 * j] = w; }
    if (lane == 0) *rs = 1.0f / sqrtf(s * (1.0f / D_) + EPS_);
}
__device__ __forceinline__ void p0_transpose_item(const float* W, int ldw, int csrc, const float* gain, int gmask, bf16_t* WT, int K, int nrow, int k0, LAS float* scr, int lane) {
#pragma unroll 8
    for (int i = 0; i < 32; ++i) { const int kk = 2 * i + (lane >> 5); const float g = gain ? gain[(k0 + kk) & gmask] : 1.0f; scr[kk * 33 + (lane & 31)] = W[(size_t)(k0 + kk) * ldw + csrc + (lane & 31)] * g; }
    LDS_WAIT(); asm volatile("" ::: "memory");
    const int c = lane & 7;
#pragma unroll
    for (int j = 0; j < 4; ++j) { const int n = (lane >> 3) + 8 * j; const LAS float* s = scr + (8 * c) * 33 + n;
        u32x4v o; o.x = pk2(s[0 * 33], s[1 * 33]); o.y = pk2(s[2 * 33], s[3 * 33]); o.z = pk2(s[4 * 33], s[5 * 33]); o.w = pk2(s[6 * 33], s[7 * 33]);
        *(u32x4v*)(WT + (size_t)(nrow + n) * K + k0 + 8 * c) = o; }
    LDS_WAIT(); asm volatile("" ::: "memory");
}
__device__ __forceinline__ void p0_memkv(const Frame& F, int unit) {
    const int l = unit >> 7, b = (unit >> 6) & 1, mt = (unit >> 3) & 7, cg = unit & 7, lane = F.lane, w = F.wave, c = lane & 15, g4 = lane >> 4, cgw = w & 1, kq = w >> 1;
    const float* mem = F.in[1] + ((size_t)b * 256 + mt * 32) * D_; const float* W = F.in[13] + (size_t)l * D_ * 1024 + cg * 128 + 64 * cgw + 4 * c; const float* gm = F.in[12] + l * D_;
    f32x4 acc[4][2];
#pragma unroll
    for (int t = 0; t < 4; ++t) { acc[t][0] = (f32x4){0.f, 0.f, 0.f, 0.f}; acc[t][1] = (f32x4){0.f, 0.f, 0.f, 0.f}; }
#pragma unroll 2
    for (int ks = 0; ks < 8; ++ks) { const int kb = kq * 256 + ks * 32 + 8 * g4;
        const f32x4 g0 = *(const f32x4*)(gm + kb), g1 = *(const f32x4*)(gm + kb + 4);
        bf16x8 afr[2], bfr[4];
#pragma unroll
        for (int rb = 0; rb < 2; ++rb) { const float* p = mem + (size_t)(rb * 16 + c) * D_ + kb; const f32x4 a0 = *(const f32x4*)p * g0, a1 = *(const f32x4*)(p + 4) * g1;
            u32x4v t; t.x = pk2(a0[0], a0[1]); t.y = pk2(a0[2], a0[3]); t.z = pk2(a1[0], a1[1]); t.w = pk2(a1[2], a1[3]); afr[rb] = __builtin_bit_cast(bf16x8, t); }
        f32x4 wv[8];
#pragma unroll
        for (int j = 0; j < 8; ++j) wv[j] = *(const f32x4*)(W + (size_t)(kb + j) * 1024);
#pragma unroll
        for (int t = 0; t < 4; ++t) { u32x4v q; q.x = pk2(wv[0][t], wv[1][t]); q.y = pk2(wv[2][t], wv[3][t]); q.z = pk2(wv[4][t], wv[5][t]); q.w = pk2(wv[6][t], wv[7][t]); bfr[t] = __builtin_bit_cast(bf16x8, q); }
#pragma unroll
        for (int t = 0; t < 4; ++t)
#pragma unroll
            for (int rb = 0; rb < 2; ++rb) acc[t][rb] = __builtin_amdgcn_mfma_f32_16x16x32_bf16(afr[rb], bfr[t], acc[t][rb], 0, 0, 0);
    }
    LAS float* P = (LAS float*)F.lds;
#pragma unroll
    for (int rb = 0; rb < 2; ++rb)
#pragma unroll
        for (int r = 0; r < 4; ++r) { const int tok = rb * 16 + 4 * g4 + r; *(LAS f32x4*)(P + ((kq * 32 + tok) * 128 + 64 * cgw + 4 * c)) = (f32x4){acc[0][rb][r], acc[1][rb][r], acc[2][rb][r], acc[3][rb][r]}; }
    __syncthreads();
    const int tok = F.tid >> 4, cb = F.tid & 15;
    f32x4 s0 = (f32x4){0.f, 0.f, 0.f, 0.f}, s1 = s0;
#pragma unroll
    for (int q = 0; q < 4; ++q) { s0 += *(const LAS f32x4*)(P + ((q * 32 + tok) * 128 + cb * 8)); s1 += *(const LAS f32x4*)(P + ((q * 32 + tok) * 128 + cb * 8 + 4)); }
    float ms = 0.f; { const f32x4* mr = (const f32x4*)(mem + (size_t)tok * D_ + cb * 64);
#pragma unroll
        for (int j = 0; j < 16; ++j) { const f32x4 v = mr[j]; ms += (v[0] * v[0] + v[1] * v[1]) + (v[2] * v[2] + v[3] * v[3]); } }
    ms += __shfl_xor(ms, 1); ms += __shfl_xor(ms, 2); ms += __shfl_xor(ms, 4); ms += __shfl_xor(ms, 8);
    const float rm = 1.0f / sqrtf(ms * (1.0f / D_) + EPS_);
    s0 *= rm; s1 *= rm;
    const size_t orow = ((((size_t)l * 2 + b) * 4 + (cg & 3)) * 256 + mt * 32 + tok) * 128 + cb * 8;
    if (cg < 4) {
        float q = (s0[0] * s0[0] + s0[1] * s0[1]) + (s0[2] * s0[2] + s0[3] * s0[3]) + (s1[0] * s1[0] + s1[1] * s1[1]) + (s1[2] * s1[2] + s1[3] * s1[3]);
        q += __shfl_xor(q, 1); q += __shfl_xor(q, 2); q += __shfl_xor(q, 4); q += __shfl_xor(q, 8);
        const float hn = QK_SCALE / sqrtf(q * (1.0f / 128) + EPS_);
        const f32x4 gk0 = *(const f32x4*)(F.in[15] + l * 128 + cb * 8), gk1 = *(const f32x4*)(F.in[15] + l * 128 + cb * 8 + 4);
        const f32x4 gq0 = *(const f32x4*)(F.in[14] + l * 128 + cb * 8), gq1 = *(const f32x4*)(F.in[14] + l * 128 + cb * 8 + 4);
        s0 = s0 * hn * gk0 * gq0; s1 = s1 * hn * gk1 * gq1;
        *(u32x4v*)((bf16_t*)(F.ws + WS_MEMK) + orow) = pg8::pack8(s0, s1);
    } else *(u32x4v*)((bf16_t*)(F.ws + WS_MEMV) + orow) = pg8::pack8(s0, s1);
    __syncthreads();
}
__device__ __forceinline__ void p0_prologue(const Frame& F) {
    const int gw = F.bid * NWAVES + F.wave, NGW = F.G * NWAVES;
    for (int u = F.bid; u < 256; u += F.G) p0_memkv(F, u);
    { bf16_t* XB = (bf16_t*)(F.ws + WS_XB); float* RS0 = (float*)(F.ws + WS_RS0);
      for (int m = gw; m < T_; m += NGW) p0_x_row(F.in[0] + (size_t)m * D_, XB + (size_t)m * D_, RS0 + m, F.lane); }
    LAS float* scr = (LAS float*)(F.lds + F.wave * 16384);
    constexpr int I_A = 16 * 128, I_OA = 24 * 32, I_B = 16 * 160, I_OB = 24 * 32, NITEMS = I_A + I_OA + I_B + I_OB;
    for (int it = gw; it < NITEMS; it += NGW) {
        int r = it;
        if (r < I_A) { const int kb = r / 128, nb = r % 128, n0 = 32 * nb; p0_transpose_item(F.in[4], 4096, permA_src(n0), F.in[3], 0xffff, (bf16_t*)(F.ws + WS_WINA), 1024, n0, 64 * kb, scr, F.lane); continue; } r -= I_A;
        if (r < I_OA) { const int kb = r / 32, nb = r % 32; p0_transpose_item(F.in[6], 1024, 32 * nb, kb < 16 ? F.in[5] : nullptr, 255, (bf16_t*)(F.ws + WS_WOUTA), 1536, 32 * nb, 64 * kb, scr, F.lane); continue; } r -= I_OA;
        if (r < I_B) { const int kb = r / 160, nb = r % 160, n0 = 32 * nb;
            if (n0 < 2048) p0_transpose_item(F.in[8], 2048, n0, F.in[7], 0xffff, (bf16_t*)(F.ws + WS_WB), 1024, n0, 64 * kb, scr, F.lane);
            else { const int c = n0 - 2048, src = c < 1024 ? 1024 + c : (c < 2048 ? c - 1024 : c); p0_transpose_item(F.in[10], 3072, src, F.in[9], 0xffff, (bf16_t*)(F.ws + WS_WB), 1024, n0, 64 * kb, scr, F.lane); }
            continue; } r -= I_B;
        { const int kb = r / 32, nb = r % 32; p0_transpose_item(F.in[11], 1024, 32 * nb, nullptr, 0, (bf16_t*)(F.ws + WS_WOUTB), 1536, 32 * nb, 64 * kb, scr, F.lane); }
    }
}

#ifndef PG8_SP2
#define PG8_SP2 true
#endif
#ifndef PG8_ALIGN
#define PG8_ALIGN true
#endif
__global__ void __launch_bounds__(NWAVES * 64, 2) mega(MArgs args) {
    extern __shared__ __attribute__((aligned(16))) unsigned char lds_raw[];
    Frame F;
    F.lds = (LAS unsigned char*)lds_raw; F.tid = threadIdx.x; F.lane = F.tid & 63; F.wave = __builtin_amdgcn_readfirstlane(F.tid >> 6); F.G = gridDim.x; F.bid = blockIdx.x;
#pragma unroll
    for (int i = 0; i < 16; ++i) F.in[i] = args.in[i];
    F.out = args.out; F.ws = args.ws;
    for (int u = F.tid; u < (LDS_BYTES - LDSCTL_OFF) / 4; u += NWAVES * 64) ((LAS unsigned*)(F.lds + LDSCTL_OFF))[u] = 0u;
    __syncthreads();
    unsigned* ctl = (unsigned*)(F.ws + WS_CTL);
    XcdBarrier bar = xcd_barrier_post(ctl + CW_BAR + args.li * XCD_BAR_WORDS, (volatile LAS unsigned*)(F.lds + LDSCTL_OFF) + 8);
    const int lo = args.ph_lo, hi = args.ph_hi;
#define IN(k) (lo <= (k) && (k) < hi)
#define BOTH(k) (IN(k) && IN((k) + 1))

    if (IN(0)) { p0_prologue(F); if (BOTH(0)) xcd_barrier(bar); }
    if (IN(1)) {
        pg8::Gemm g{(const bf16_t*)(F.ws + WS_XB), (const bf16_t*)(F.ws + WS_WINA), T_, NA_, D_, D_}; pg8::StaticOrder S; S.init(T_, NA_, F.G, F.bid);
        pg8::EpiA E{(bf16_t*)(F.ws + WS_UA), (const float*)(F.ws + WS_RS0), (const int*)F.in[2]};
        pg8::gemm_phase<pg8::EpiA, pg8::StaticOrder, PG8_ALIGN, PG8_SP2>(F.lds, g, S, E);
        if (BOTH(1)) xcd_barrier(bar);
    }
    if (IN(5)) {
        pg8::Gemm g{(const bf16_t*)(F.ws + WS_UA) + 2048, (const bf16_t*)(F.ws + WS_WOUTA), T_, D_, KO_, NA_}; pg8::StaticOrder S; S.init(T_, D_, F.G, F.bid);
        pg8::EpiOutA E{F.in[0], F.out, (bf16_t*)(F.ws + WS_X1B), (float*)(F.ws + WS_SS1P)};
        pg8::gemm_phase<pg8::EpiOutA, pg8::StaticOrder, PG8_ALIGN, PG8_SP2>(F.lds, g, S, E);
        if (BOTH(5)) xcd_barrier(bar);
    }
    if (IN(6)) {
        pg8::Gemm g{(const bf16_t*)(F.ws + WS_X1B), (const bf16_t*)(F.ws + WS_WB), T_, NBW_, D_, D_}; pg8::StaticOrder S; S.init(T_, NBW_, F.G, F.bid);
        pg8::EpiB E{(bf16_t*)(F.ws + WS_UB), (const float*)(F.ws + WS_SS1P)};
        pg8::gemm_phase<pg8::EpiB, pg8::StaticOrder, PG8_ALIGN, PG8_SP2>(F.lds, g, S, E);
        if (BOTH(6)) xcd_barrier(bar);
    }
    if (IN(8)) {
        pg8::Gemm g{(const bf16_t*)(F.ws + WS_UB) + 3072, (const bf16_t*)(F.ws + WS_WOUTB), T_, D_, KO_, NBW_}; pg8::StaticOrder S; S.init(T_, D_, F.G, F.bid);
        pg8::EpiOutB E{F.out};
        pg8::gemm_phase<pg8::EpiOutB, pg8::StaticOrder, PG8_ALIGN, PG8_SP2>(F.lds, g, S, E);
    }
#undef IN
#undef BOTH
}

static void launch_mega(const MArgs& base, int lo, int hi, int li, int grid, hipStream_t stream) {
    MArgs a = base; a.ph_lo = lo; a.ph_hi = hi; a.li = li; a.pad = 0;
    hipLaunchKernelGGL(mega, dim3(grid), dim3(NWAVES * 64), LDS_BYTES, stream, a);
}
extern "C" void kernel_launch(void* const* d_in, const int* in_sizes, int n_in, void* d_out, int out_size, void* d_ws, size_t ws_size, hipStream_t stream) {
    static int grid = 0;
    if (grid == 0) {
        int dev = 0, cus = 0;
        if (hipGetDevice(&dev) != hipSuccess || hipDeviceGetAttribute(&cus, hipDeviceAttributeMultiprocessorCount, dev) != hipSuccess) { grid = -1; return; }
        if (hipFuncSetAttribute((const void*)mega, hipFuncAttributeMaxDynamicSharedMemorySize, LDS_BYTES) != hipSuccess) { grid = -1; return; }
        (void)hipGetLastError();
        grid = cus;
    }
    if (grid < 0) return;
    const float* x = (const float*)d_in[0]; const int* pos = (const int*)d_in[2];
    unsigned char* ws = (unsigned char*)d_ws; float* out = (float*)d_out;
    bf16_t* MEMK = (bf16_t*)(ws + WS_MEMK); bf16_t* MEMV = (bf16_t*)(ws + WS_MEMV);
    bf16_t* UA = (bf16_t*)(ws + WS_UA); bf16_t* KVT = (bf16_t*)(ws + WS_KVT); bf16_t* UB = (bf16_t*)(ws + WS_UB);
    (void)x; (void)pos; (void)out;
    (void)hipMemsetAsync(ws + WS_CTL, 0, CTL_ZERO_BYTES, stream);
    MArgs a{};
    for (int i = 0; i < 16; ++i) a.in[i] = (const float*)d_in[i];
    a.out = out; a.ws = ws;
    launch_mega(a, 0, 2, 0, grid, stream);
    n2_kv<<<512 * 4, 256, 0, stream>>>(UA, KVT);
    n_memattn<<<T_, 256, 0, stream>>>(UA, NA_, 3072, 3584, MEMK, MEMV, 0);
    n3_scan<<<(8 * 32768) / 256, 256, 0, stream>>>(KVT);
    n4_ret<<<512 * 128, 256, 0, stream>>>(UA, KVT);
    launch_mega(a, 5, 7, 1, grid, stream);
    n7_sb<<<NB_ * 8 * S_, 256, 0, stream>>>(UB);
    n_memattn<<<T_, 256, 0, stream>>>(UB, NBW_, 4096, 4608, MEMK, MEMV, 1);
    launch_mega(a, 8, 9, 2, grid, stream);
}
```

```cpp
#include <hip/hip_runtime.h>
#include <stdint.h>

typedef unsigned short bf16_t;

constexpr int NB_ = 2, S_ = 8192, T_ = NB_ * S_, D_ = 1024;
constexpr int NA_ = 4096, NBW_ = 5120, KO_ = 1536;
constexpr float EPS_ = 1e-6f;
constexpr float QK_SCALE = 0.08838834764831845f;

constexpr size_t MiB = 1u << 20;
constexpr size_t WS_CTL = 0;
constexpr size_t WS_WINA = 1 * MiB;
constexpr size_t WS_WOUTA = 9 * MiB;
constexpr size_t WS_WB = 12 * MiB;
constexpr size_t WS_WOUTB = 22 * MiB;
constexpr size_t WS_MEMK = 25 * MiB;
constexpr size_t WS_MEMV = 26 * MiB;
constexpr size_t WS_RS0 = 27 * MiB;
constexpr size_t WS_SS1P = 28 * MiB;
constexpr size_t WS_UA = 30 * MiB;
constexpr size_t WS_KVT = 158 * MiB;
constexpr size_t WS_XB = 158 * MiB;
constexpr size_t WS_X1B = 190 * MiB;
constexpr size_t WS_UB = 30 * MiB;


__device__ __forceinline__ float bf2f(bf16_t v) { return __uint_as_float(((unsigned)v) << 16); }
__device__ __forceinline__ bf16_t f2bf(float f) { unsigned u = __float_as_uint(f); u += 0x7fffu + ((u >> 16) & 1u); return (bf16_t)(u >> 16); }
__device__ __forceinline__ float silu_f(float v) { return v / (1.0f + __expf(-v)); }
__device__ __forceinline__ float softplus_f(float z) { return fmaxf(z, 0.f) + log1pf(__expf(-fabsf(z))); }
__device__ __forceinline__ float ret_lg(int h) { return logf(1.0f - exp2f(-5.0f - (float)h)); }

__device__ __forceinline__ void rot_sincos(float ang, float& s, float& c) {
    const float n = rintf(ang * 0.15915494309189535f);
    float r = fmaf(-n, 6.28318548202514648f, ang);
    r = fmaf(-n, -1.74845553e-7f, r);
    const float rev = r * 0.15915494309189535f;
    s = __builtin_amdgcn_sinf(rev); c = __builtin_amdgcn_cosf(rev);
}
__device__ __forceinline__ float rope_inv_freq(int i) { return exp2f(-(float)i * 0.20762050593046014f); }

__global__ __launch_bounds__(256) void n0_x(const float* __restrict__ x, bf16_t* __restrict__ xb, float* __restrict__ rs) {
    const int row = blockIdx.x * 4 + (threadIdx.x >> 6), lane = threadIdx.x & 63;
    const float* xr = x + (size_t)row * D_; float s = 0.f;
    for (int j = lane; j < D_; j += 64) { const float v = xr[j]; s += v * v; xb[(size_t)row * D_ + j] = f2bf(v); }
    for (int o = 32; o; o >>= 1) s += __shfl_xor(s, o);
    if (lane == 0) rs[row] = 1.0f / sqrtf(s * (1.0f / D_) + EPS_);
}

struct WArgs { const float* w_in_a; const float* w_out_a; const float* w_kv; const float* w_in_b; const float* w_out_b;
               const float* g_norm_a; const float* g_ret_head; const float* g_kv; const float* g_norm_b; };
__device__ __forceinline__ int permA_src(int n) {
    if (n >= 1024) return n;
    const int tile = n >> 8, c = n & 255, bj = c >> 7, p = c & 127, hit = p >> 6, i = p & 63;
    return tile * 256 + hit * 128 + bj * 64 + i;
}
__global__ __launch_bounds__(256) void n0_w(WArgs a, int mode, bf16_t* __restrict__ out) {
    const int K = (mode == 0 || mode == 2) ? 1024 : 1536;
    const int N = mode == 0 ? 4096 : (mode == 2 ? 5120 : 1024);
    const size_t idx = (size_t)blockIdx.x * 256 + threadIdx.x; if (idx >= (size_t)N * K) return;
    const int k = (int)(idx % K), n = (int)(idx / K);
    float v;
    if (mode == 0) v = a.w_in_a[(size_t)k * 4096 + permA_src(n)] * a.g_norm_a[k];
    else if (mode == 1) v = a.w_out_a[(size_t)k * 1024 + n] * (k < 1024 ? a.g_ret_head[k & 255] : 1.0f);
    else if (mode == 2) {
        if (n < 2048) v = a.w_kv[(size_t)k * 2048 + n] * a.g_kv[k];
        else { const int c = n - 2048; const int src = c < 1024 ? 1024 + c : (c < 2048 ? c - 1024 : c);
               v = a.w_in_b[(size_t)k * 3072 + src] * a.g_norm_b[k]; }
    } else v = a.w_out_b[(size_t)k * 1024 + n];
    out[idx] = f2bf(v);
}

__global__ __launch_bounds__(256) void n0_mem(const float* __restrict__ mem, const float* __restrict__ g_mem, const float* __restrict__ w_mem_kv,
                                              const float* __restrict__ g_mem_q, const float* __restrict__ g_mem_k, bf16_t* __restrict__ memK, bf16_t* __restrict__ memV) {
    __shared__ float sm[1024]; __shared__ float skv[1024]; __shared__ float red[256]; __shared__ float hn[4];
    const int l = blockIdx.x >> 9, b = (blockIdx.x >> 8) & 1, m = blockIdx.x & 255, tid = threadIdx.x;
    const float* mr = mem + ((size_t)b * 256 + m) * D_;
    float s = 0.f; for (int j = tid; j < D_; j += 256) { const float v = mr[j]; s += v * v; }
    red[tid] = s; __syncthreads();
    for (int o = 128; o; o >>= 1) { if (tid < o) red[tid] += red[tid + o]; __syncthreads(); }
    const float r = 1.0f / sqrtf(red[0] * (1.0f / D_) + EPS_);
    for (int j = tid; j < D_; j += 256) sm[j] = mr[j] * r * g_mem[l * D_ + j];
    __syncthreads();
    const float* W = w_mem_kv + (size_t)l * D_ * 1024;
    float acc[4] = {0.f, 0.f, 0.f, 0.f};
    for (int k = 0; k < D_; ++k) { const float a = sm[k];
#pragma unroll
        for (int j = 0; j < 4; ++j) acc[j] += a * W[(size_t)k * 1024 + tid + 256 * j]; }
#pragma unroll
    for (int j = 0; j < 4; ++j) skv[tid + 256 * j] = acc[j];
    __syncthreads();
    if (tid < 4) { float q = 0.f; for (int d = 0; d < 128; ++d) { const float v = skv[tid * 128 + d]; q += v * v; } hn[tid] = 1.0f / sqrtf(q * (1.0f / 128) + EPS_); }
    __syncthreads();
    for (int j = tid; j < 512; j += 256) { const int h = j >> 7, d = j & 127;
        const size_t o = ((((size_t)l * 2 + b) * 4 + h) * 256 + m) * 128 + d;
        memK[o] = f2bf(skv[j] * hn[h] * g_mem_k[l * 128 + d] * g_mem_q[l * 128 + d] * QK_SCALE);
        memV[o] = f2bf(skv[512 + j]); }
}

struct GArgs { const bf16_t* A; int lda; const bf16_t* Bt; int K; int N;
               const float* rs0; const int* pos; bf16_t* U; const float* xres; float* out; bf16_t* x1b; float* ss1p; };
template <int EPI> __global__ __launch_bounds__(256) void n_gemm(GArgs g) {
    __shared__ float sA[16][36]; __shared__ float sC[16][257];
    const int ntn = g.N / 256, pm = blockIdx.x / ntn, pn = blockIdx.x % ntn, row0 = pm * 16, c = threadIdx.x;
    const bf16_t* brow = g.Bt + (size_t)(pn * 256 + c) * g.K;
    float acc[16];
#pragma unroll
    for (int r = 0; r < 16; ++r) acc[r] = 0.f;
    for (int k0 = 0; k0 < g.K; k0 += 32) {
        __syncthreads();
        for (int e = threadIdx.x; e < 512; e += 256) { const int r = e >> 5, kk = e & 31; sA[r][kk] = bf2f(g.A[(size_t)(row0 + r) * g.lda + k0 + kk]); }
        __syncthreads();
#pragma unroll
        for (int j = 0; j < 4; ++j) { const uint4 bv = *(const uint4*)(brow + k0 + 8 * j); const unsigned w[4] = {bv.x, bv.y, bv.z, bv.w};
#pragma unroll
            for (int q = 0; q < 4; ++q) { const float b0 = __uint_as_float(w[q] << 16), b1 = __uint_as_float(w[q] & 0xffff0000u); const int kk = 8 * j + 2 * q;
#pragma unroll
                for (int r = 0; r < 16; ++r) acc[r] += sA[r][kk] * b0 + sA[r][kk + 1] * b1; } }
    }
#pragma unroll
    for (int r = 0; r < 16; ++r) sC[r][c] = acc[r];
    __syncthreads();
    if (EPI == 0) {
        for (int r = 0; r < 16; ++r) { const int row = row0 + r; const float rs = g.rs0[row]; bf16_t* urow = g.U + (size_t)row * NA_;
            if (pn < 4) { if (c < 128) { const int hit = c >> 6, i = c & 63; const float x1 = sC[r][c] * rs, x2 = sC[r][c + 128] * rs;
                    float sn, cs; rot_sincos((float)g.pos[row] * rope_inv_freq(i), sn, cs); const float sc = pn >= 2 ? QK_SCALE : 1.0f;
                    urow[pn * 256 + hit * 128 + i] = f2bf((x1 * cs - x2 * sn) * sc); urow[pn * 256 + hit * 128 + 64 + i] = f2bf((x1 * sn + x2 * cs) * sc); } }
            else { const float v = sC[r][c] * rs; const bool silu = (pn >= 8 && pn < 12) || pn >= 14; urow[pn * 256 + c] = f2bf(silu ? silu_f(v) : v); } }
    } else if (EPI == 1) {
        for (int r = 0; r < 16; ++r) { const size_t o = (size_t)(row0 + r) * D_ + pn * 256 + c; const float v = g.xres[o] + sC[r][c]; g.out[o] = v; g.x1b[o] = f2bf(v); sC[r][c] = v * v; }
        __syncthreads();
        if (c < 16) { float s = 0.f; for (int j = 0; j < 256; ++j) s += sC[c][j]; float* p = g.ss1p + (size_t)(row0 + c) * 16 + pn * 4; p[0] = s; p[1] = 0.f; p[2] = 0.f; p[3] = 0.f; }
    } else if (EPI == 2) {
        for (int r = 0; r < 16; ++r) { const int row = row0 + r; const float* sp = g.ss1p + (size_t)row * 16; float ss = 0.f; for (int j = 0; j < 16; ++j) ss += sp[j];
            const float rs = 1.0f / sqrtf(ss * (1.0f / D_) + EPS_); float v = sC[r][c] * rs;
            if ((pn >= 8 && pn < 12) || pn >= 18) v = silu_f(v); else if (pn >= 12 && pn < 16) v *= QK_SCALE;
            g.U[(size_t)row * NBW_ + pn * 256 + c] = f2bf(v); }
    } else {
        for (int r = 0; r < 16; ++r) { const size_t o = (size_t)(row0 + r) * D_ + pn * 256 + c; g.out[o] = g.out[o] + sC[r][c]; }
    }
}

__global__ __launch_bounds__(256) void n2_kv(const bf16_t* __restrict__ UA, bf16_t* __restrict__ KVT) {
    const int u = blockIdx.x >> 2, eg = blockIdx.x & 3, tid = threadIdx.x, e = eg * 64 + (tid & 63), dq = tid >> 6;
    const int b = u >> 8, h = (u >> 6) & 3, n = u & 63; const size_t row0 = (size_t)b * S_ + n * 128; const float lg = ret_lg(h);
    float acc[32];
#pragma unroll
    for (int j = 0; j < 32; ++j) acc[j] = 0.f;
    for (int m = 0; m < 128; ++m) { const bf16_t* ur = UA + (row0 + m) * NA_; const float vz = bf2f(ur[1024 + h * 256 + e]) * __expf((float)(127 - m) * lg);
#pragma unroll
        for (int j = 0; j < 32; ++j) acc[j] += vz * bf2f(ur[512 + h * 128 + dq * 32 + j]); }
#pragma unroll
    for (int j = 0; j < 32; ++j) KVT[((size_t)u * 256 + e) * 128 + dq * 32 + j] = f2bf(acc[j]);
}
__global__ __launch_bounds__(256) void n3_scan(bf16_t* __restrict__ KVT) {
    const int idx = blockIdx.x * 256 + threadIdx.x; const int bh = idx >> 15, off = idx & 32767; const float gc = __expf(128.0f * ret_lg(bh & 3));
    float s = 0.f;
    for (int n = 0; n < 64; ++n) { bf16_t* p = KVT + ((size_t)(bh * 64 + n) << 15) + off; const float t = bf2f(*p); *p = f2bf(s); s = gc * s + t; }
}
__global__ __launch_bounds__(256) void n4_ret(bf16_t* __restrict__ UA, const bf16_t* __restrict__ KVT) {
    __shared__ float sq[128], ss[128], red[256];
    const int u = blockIdx.x >> 7, c = blockIdx.x & 127, tid = threadIdx.x; const int b = u >> 8, h = (u >> 6) & 3, n = u & 63;
    const size_t row0 = (size_t)b * S_ + n * 128, row = row0 + c; const float lg = ret_lg(h);
    if (tid < 128) sq[tid] = bf2f(UA[row * NA_ + h * 128 + tid]);
    __syncthreads();
    if (tid < 128) { float d = 0.f; if (tid <= c) { const bf16_t* kr = UA + (row0 + tid) * NA_ + 512 + h * 128; for (int j = 0; j < 128; ++j) d += sq[j] * bf2f(kr[j]); d *= __expf((float)(c - tid) * lg); } ss[tid] = d; }
    __syncthreads();
    const int e = tid; float o = 0.f;
    for (int m = 0; m <= c; ++m) o += ss[m] * bf2f(UA[(row0 + m) * NA_ + 1024 + h * 256 + e]);
    float cr = 0.f; const bf16_t* st = KVT + ((size_t)u * 256 + e) * 128; for (int j = 0; j < 128; ++j) cr += sq[j] * bf2f(st[j]);
    o += __expf((float)(c + 1) * lg) * cr;
    red[tid] = o * o; __syncthreads();
    for (int w = 128; w; w >>= 1) { if (tid < w) red[tid] += red[tid + w]; __syncthreads(); }
    const float r = 1.0f / sqrtf(red[0] * (1.0f / 256) + EPS_);
    bf16_t* gp = UA + row * NA_ + 2048 + h * 256 + e; *gp = f2bf(o * r * bf2f(*gp));
}
__global__ __launch_bounds__(256) void n_memattn(bf16_t* __restrict__ U, int ld, int qoff, int goff, const bf16_t* __restrict__ memK, const bf16_t* __restrict__ memV, int layer) {
    __shared__ float sq[4][128]; __shared__ float sp[4][256];
    const int w = threadIdx.x >> 6, lane = threadIdx.x & 63; const int gw = blockIdx.x * 4 + w, row = gw >> 2, hd = gw & 3, b = row / S_;
    bf16_t* qp = U + (size_t)row * ld + qoff + hd * 128; const bf16_t* gp = U + (size_t)row * ld + goff + hd * 128;
    const float q0 = bf2f(qp[lane]), q1 = bf2f(qp[lane + 64]); sq[w][lane] = q0; sq[w][lane + 64] = q1;
    float s = q0 * q0 + q1 * q1; for (int o = 32; o; o >>= 1) s += __shfl_xor(s, o);
    const float rq = 1.0f / sqrtf(s * (1.0f / 128) + EPS_);
    __syncthreads();
    const bf16_t* Kb = memK + (((size_t)layer * 2 + b) * 4 + hd) * 256 * 128; const bf16_t* Vb = memV + (((size_t)layer * 2 + b) * 4 + hd) * 256 * 128;
    float lgt[4]; float mx = -1e30f;
    for (int j = 0; j < 4; ++j) { const bf16_t* kr = Kb + (size_t)(lane + 64 * j) * 128; float d = 0.f; for (int t = 0; t < 128; ++t) d += sq[w][t] * bf2f(kr[t]); lgt[j] = d * rq; mx = fmaxf(mx, lgt[j]); }
    for (int o = 32; o; o >>= 1) mx = fmaxf(mx, __shfl_xor(mx, o));
    float ps = 0.f; for (int j = 0; j < 4; ++j) { lgt[j] = __expf(lgt[j] - mx); ps += lgt[j]; }
    for (int o = 32; o; o >>= 1) ps += __shfl_xor(ps, o);
    for (int j = 0; j < 4; ++j) sp[w][lane + 64 * j] = lgt[j] / ps;
    __syncthreads();
    float o0 = 0.f, o1 = 0.f;
    for (int m = 0; m < 256; ++m) { const float p = sp[w][m]; o0 += p * bf2f(Vb[(size_t)m * 128 + lane]); o1 += p * bf2f(Vb[(size_t)m * 128 + lane + 64]); }
    const float g0 = bf2f(gp[lane]), g1 = bf2f(gp[lane + 64]);
    qp[lane] = f2bf(o0 * g0); qp[lane + 64] = f2bf(o1 * g1);
}
#ifndef NAIVE_SB_EXIT
#define NAIVE_SB_EXIT 1
#endif
__global__ __launch_bounds__(256) void n7_sb(bf16_t* __restrict__ UB) {
    __shared__ float sq[128]; __shared__ float sa[256]; __shared__ float wtot[4]; __shared__ float wpre[4];
    const int t = blockIdx.x & (S_ - 1), h = (blockIdx.x >> 13) & 7, b = blockIdx.x >> 16, tid = threadIdx.x, lane = tid & 63, w = tid >> 6;
    const size_t rowb = (size_t)b * S_; bf16_t* qp = UB + (rowb + t) * NBW_ + 3072 + h * 128;
    if (tid < 128) sq[tid] = bf2f(qp[tid]);
    __syncthreads();
    float carry = 0.f, od = 0.f;
    for (int s_hi = t - 1; s_hi >= 0; s_hi -= 256) {
        const int s = s_hi - tid; const bool valid = s >= 0;
        float z = 0.f; if (valid) { const bf16_t* kr = UB + (rowb + s) * NBW_ + h * 128; for (int j = 0; j < 128; ++j) z += sq[j] * bf2f(kr[j]); }
        const float spv = softplus_f(z); const float lf = valid ? -spv : 0.f;
        float inc = lf;
        for (int o = 1; o < 64; o <<= 1) { const float v = __shfl_up(inc, o); if (lane >= o) inc += v; }
        if (lane == 63) wtot[w] = inc;
        __syncthreads();
        if (tid == 0) { float a = 0.f; for (int j = 0; j < 4; ++j) { wpre[j] = a; a += wtot[j]; } }
        __syncthreads();
        const float pre = wpre[w] + inc - lf;
        const float tot = wpre[3] + wtot[3];
        sa[tid] = valid ? __expf((z - spv) + pre + carry) : 0.f;
        __syncthreads();
        if (tid < 128) { const int cnt = min(256, s_hi + 1); const bf16_t* vb = UB + rowb * NBW_ + 1024 + h * 128 + tid;
            for (int i = 0; i < cnt; ++i) od += sa[i] * bf2f(vb[(size_t)(s_hi - i) * NBW_]); }
        carry += tot;
        __syncthreads();
        if (NAIVE_SB_EXIT && carry < -104.0f) break;
    }
    if (tid < 128) { const float g = bf2f(UB[(rowb + t) * NBW_ + 2048 + h * 128 + tid]); qp[tid] = f2bf(od * g); }
}


namespace pg8 {
#define PG8_LAS __attribute__((address_space(3)))
typedef unsigned short bf16_t;
typedef short bf16x8 __attribute__((ext_vector_type(8)));
typedef float f32x4 __attribute__((ext_vector_type(4)));
typedef unsigned u32x4 __attribute__((ext_vector_type(4)));
constexpr int BM = 256, BK = 64, HALF = 128, HTB = HALF * BK * 2  , STAGE_BYTES = 8 * HTB, NXCD = 8, WGM = 8;

__host__ __device__ __forceinline__ int lds_byte(int r, int c) { const int st = (r >> 4) * 2 + (c >> 5), rr = r & 15, cc = c & 31, ob = rr * 64 + cc * 2; return st * 1024 + (ob ^ (((ob >> 9) & 1) << 5)); }
__host__ __device__ __forceinline__ void stage_rc(int b, int& R, int& C) { const int st = b / 1024, sb = b % 1024, swz = sb ^ (((sb >> 9) & 1) << 5); R = (st >> 1) * 16 + swz / 64; C = (st & 1) * 32 + (swz % 64) / 2; }
__host__ __device__ __forceinline__ int perm32(int rho) { const int n = rho >> 4, i = rho & 15; return 8 * (i >> 2) + 4 * n + (i & 3); }

struct Unit { int pm, pn; };
struct Gemm { const bf16_t* A; const bf16_t* Bt; int M, N, K, lda; };

struct StaticOrder {
    int nM, nN, nwg, G, c;
    __host__ __device__ void init(int M, int N, int G_, int c_) { nM = M / BM; nN = N / BM; nwg = nM * nN; G = G_; c = c_; }
    __host__ __device__ bool next(int i, Unit& u) const {
        const long L = (long)i * G + c; if (L >= nwg) return false;
        int wgid = (int)L; { const int q = nwg / NXCD, r = nwg % NXCD, xcd = wgid % NXCD, off = wgid / NXCD; wgid = (xcd < r ? xcd * (q + 1) : r * (q + 1) + (xcd - r) * q) + off; }
        const int nig = WGM * nN, gid = wgid / nig, fm = gid * WGM, gsz = (nM - fm) < WGM ? (nM - fm) : WGM;
        u.pm = fm + ((wgid % nig) % gsz); u.pn = (wgid % nig) / gsz; return true;
    }
    __device__ __forceinline__ void a_ready(const Unit&) const {}
    __device__ __forceinline__ void done(const Unit&) const {}
};

__device__ __forceinline__ unsigned cvt_pk_bf16(float lo, float hi) { unsigned r; asm volatile("v_cvt_pk_bf16_f32 %0, %1, %2" : "=v"(r) : "v"(lo), "v"(hi)); return r; }
__device__ __forceinline__ float silu_fast(float v) { return v * __builtin_amdgcn_rcpf(1.0f + __builtin_amdgcn_exp2f(-1.4426950408889634f * v)); }
__device__ __forceinline__ u32x4 pack8(const f32x4 a, const f32x4 b) { u32x4 w; w.x = cvt_pk_bf16(a[0], a[1]); w.y = cvt_pk_bf16(a[2], a[3]); w.z = cvt_pk_bf16(b[0], b[1]); w.w = cvt_pk_bf16(b[2], b[3]); return w; }

struct EpiA {
    static constexpr bool PERM = true, AFTER_DRAIN = false;
    bf16_t* U; const float* rs0; const int* pos;
    __device__ __forceinline__ void operator()(const f32x4 (&acc)[2][2][4][2], const Unit& u, int wr, int wc, int fr, int fq) const {
        const int row0 = u.pm * BM + wr * 64 + fr;
        if (u.pn < 4) {
            const int hit = wc >> 1, i0 = 32 * (wc & 1) + 8 * fq; const float sc = u.pn >= 2 ? QK_SCALE : 1.0f;
            float inv[8];
#pragma unroll
            for (int j = 0; j < 8; ++j) inv[j] = rope_inv_freq(i0 + j);
#pragma unroll
            for (int ai = 0; ai < 2; ++ai)
#pragma unroll
                for (int m = 0; m < 4; ++m) { const int row = row0 + ai * HALF + m * 16; const float rs = rs0[row] * sc, pf = (float)pos[row];
                    bf16_t* up = U + (size_t)row * NA_ + u.pn * BM + hit * 128 + i0;
                    f32x4 o1[2], o2[2];
#pragma unroll
                    for (int n = 0; n < 2; ++n)
#pragma unroll
                        for (int e = 0; e < 4; ++e) { float sn, cs; rot_sincos(pf * inv[4 * n + e], sn, cs); const float x1 = acc[ai][0][m][n][e] * rs, x2 = acc[ai][1][m][n][e] * rs;
                            o1[n][e] = x1 * cs - x2 * sn; o2[n][e] = x1 * sn + x2 * cs; }
                    *(u32x4*)up = pack8(o1[0], o1[1]); *(u32x4*)(up + 64) = pack8(o2[0], o2[1]); }
        } else {
            const bool silu = (u.pn >= 8 && u.pn < 12) || u.pn >= 14;
#pragma unroll
            for (int ai = 0; ai < 2; ++ai)
#pragma unroll
                for (int m = 0; m < 4; ++m) { const int row = row0 + ai * HALF + m * 16; const float rs = rs0[row]; bf16_t* rowp = U + (size_t)row * NA_ + u.pn * BM + wc * 32 + 8 * fq;
#pragma unroll
                    for (int bj = 0; bj < 2; ++bj) { f32x4 v0 = acc[ai][bj][m][0] * rs, v1 = acc[ai][bj][m][1] * rs;
                        if (silu) {
#pragma unroll
                            for (int e = 0; e < 4; ++e) { v0[e] = silu_fast(v0[e]); v1[e] = silu_fast(v1[e]); } }
                        *(u32x4*)(rowp + bj * HALF) = pack8(v0, v1); } }
        }
    }
};
struct EpiOutA {
    static constexpr bool PERM = true, AFTER_DRAIN = false;
    const float* xres; float* out; bf16_t* x1b; float* ss1p;
    __device__ __forceinline__ void operator()(const f32x4 (&acc)[2][2][4][2], const Unit& u, int wr, int wc, int fr, int fq) const {
        const int row0 = u.pm * BM + wr * 64 + fr;
#pragma unroll
        for (int ai = 0; ai < 2; ++ai)
#pragma unroll
            for (int m = 0; m < 4; ++m) { const int row = row0 + ai * HALF + m * 16; const size_t off = (size_t)row * D_ + u.pn * BM + wc * 32 + 8 * fq; float ssq = 0.f;
#pragma unroll
                for (int bj = 0; bj < 2; ++bj) { const f32x4 r0 = *(const f32x4*)(xres + off + bj * HALF), r1 = *(const f32x4*)(xres + off + bj * HALF + 4);
                    const f32x4 v0 = acc[ai][bj][m][0] + r0, v1 = acc[ai][bj][m][1] + r1;
                    *(f32x4*)(out + off + bj * HALF) = v0; *(f32x4*)(out + off + bj * HALF + 4) = v1; *(u32x4*)(x1b + off + bj * HALF) = pack8(v0, v1);
                    ssq += (v0[0] * v0[0] + v0[1] * v0[1]) + (v0[2] * v0[2] + v0[3] * v0[3]) + (v1[0] * v1[0] + v1[1] * v1[1]) + (v1[2] * v1[2] + v1[3] * v1[3]); }
                ssq += __shfl_xor(ssq, 16); ssq += __shfl_xor(ssq, 32);
                if (fq == 0) ss1p[(size_t)row * 16 + u.pn * 4 + wc] = ssq; }
    }
};
struct EpiB {
    static constexpr bool PERM = true, AFTER_DRAIN = false;
    bf16_t* U; const float* ss1p;
    __device__ __forceinline__ void operator()(const f32x4 (&acc)[2][2][4][2], const Unit& u, int wr, int wc, int fr, int fq) const {
        const int row0 = u.pm * BM + wr * 64 + fr; const bool silu = (u.pn >= 8 && u.pn < 12) || u.pn >= 18; const float sc = (u.pn >= 12 && u.pn < 16) ? QK_SCALE : 1.0f;
#pragma unroll
        for (int ai = 0; ai < 2; ++ai)
#pragma unroll
            for (int m = 0; m < 4; ++m) { const int row = row0 + ai * HALF + m * 16; const f32x4 pv = *(const f32x4*)(ss1p + (size_t)row * 16 + 4 * fq);
                float s = (pv[0] + pv[1]) + (pv[2] + pv[3]); s += __shfl_xor(s, 16); s += __shfl_xor(s, 32);
                const float rs = sc / sqrtf(s * (1.0f / D_) + EPS_); bf16_t* rowp = U + (size_t)row * NBW_ + u.pn * BM + wc * 32 + 8 * fq;
#pragma unroll
                for (int bj = 0; bj < 2; ++bj) { f32x4 v0 = acc[ai][bj][m][0] * rs, v1 = acc[ai][bj][m][1] * rs;
                    if (silu) {
#pragma unroll
                        for (int e = 0; e < 4; ++e) { v0[e] = silu_fast(v0[e]); v1[e] = silu_fast(v1[e]); } }
                    *(u32x4*)(rowp + bj * HALF) = pack8(v0, v1); } }
    }
};
struct EpiOutB {
    static constexpr bool PERM = true, AFTER_DRAIN = false;
    float* out;
    __device__ __forceinline__ void operator()(const f32x4 (&acc)[2][2][4][2], const Unit& u, int wr, int wc, int fr, int fq) const {
        const int row0 = u.pm * BM + wr * 64 + fr;
#pragma unroll
        for (int ai = 0; ai < 2; ++ai)
#pragma unroll
            for (int m = 0; m < 4; ++m) { const size_t off = (size_t)(row0 + ai * HALF + m * 16) * D_ + u.pn * BM + wc * 32 + 8 * fq;
#pragma unroll
                for (int bj = 0; bj < 2; ++bj) { const f32x4 r0 = *(const f32x4*)(out + off + bj * HALF), r1 = *(const f32x4*)(out + off + bj * HALF + 4);
                    *(f32x4*)(out + off + bj * HALF) = acc[ai][bj][m][0] + r0; *(f32x4*)(out + off + bj * HALF + 4) = acc[ai][bj][m][1] + r1; } }
    }
};

template <class Epi, class Sched, bool ALIGN_EPI = false, bool SP2 = false>
__device__ __forceinline__ void gemm_phase(PG8_LAS unsigned char* lds, const Gemm g, const Sched& S, const Epi& E) {
    const int tid = threadIdx.x, wid = __builtin_amdgcn_readfirstlane(tid >> 6), lane = tid & 63, wr = wid >> 2, wc = wid & 3, fr = lane & 15, fq = lane >> 4;
    const int K = g.K, nt = K / BK;
    unsigned voffA[2], voffB[2];
#pragma unroll
    for (int i = 0; i < 2; ++i) { int R, C; stage_rc(tid * 16 + i * 8192, R, C); const int Rb = Epi::PERM ? ((R & ~31) + perm32(R & 31)) : R;
        voffA[i] = (unsigned)(R * g.lda + C) * 2u; voffB[i] = (unsigned)(Rb * K + C) * 2u; }
    const size_t kstep = (size_t)(BK * 2);
    const size_t hstepA = (size_t)HALF * g.lda * 2, hstepB = (size_t)HALF * K * 2;
    const size_t tstepA = 2 * hstepA, tstepB = 2 * hstepB;
    const unsigned ldsw = (unsigned)wid * 1024u;
    const int aoff = lds_byte(wr * 64 + fr, fq * 8), boff = lds_byte(wc * 32 + fr, fq * 8);
#define PG8_SA(b, h) (((b) * 2 + (h)) * HTB)
#define PG8_SB(b, h) ((4 + (b) * 2 + (h)) * HTB)
#define PG8_STAGE(bufoff, gbase, voff) do { _Pragma("unroll") for (int _i = 0; _i < 2; ++_i) \
        __builtin_amdgcn_global_load_lds((const unsigned*)((const char*)(gbase) + (voff)[_i]), (PG8_LAS unsigned*)(lds + (bufoff) + ldsw + _i * 8192), 16, 0, 0); } while (0)
#define PG8_LDA(dst, b, h) do { _Pragma("unroll") for (int m = 0; m < 4; ++m) _Pragma("unroll") for (int k = 0; k < 2; ++k) dst[m][k] = *(const PG8_LAS bf16x8*)(lds + PG8_SA(b, h) + aoff + m * 2048 + k * 1024); } while (0)
#define PG8_LDB(dst, b, h) do { _Pragma("unroll") for (int n = 0; n < 2; ++n) _Pragma("unroll") for (int k = 0; k < 2; ++k) dst[n][k] = *(const PG8_LAS bf16x8*)(lds + PG8_SB(b, h) + boff + n * 2048 + k * 1024); } while (0)
#define PG8_MMA(ai, bj, At, Bt) do { __builtin_amdgcn_s_setprio(1); _Pragma("unroll") for (int m = 0; m < 4; ++m) _Pragma("unroll") for (int n = 0; n < 2; ++n) _Pragma("unroll") for (int k = 0; k < 2; ++k) \
        acc[ai][bj][m][n] = __builtin_amdgcn_mfma_f32_16x16x32_bf16(Bt[n][k], At[m][k], acc[ai][bj][m][n], 0, 0, 0); __builtin_amdgcn_s_setprio(0); } while (0)
#define PG8_WAIT_V(n) asm volatile("s_waitcnt vmcnt(" #n ")" ::: "memory")
#define PG8_WAIT_L(n) asm volatile("s_waitcnt lgkmcnt(" #n ")" ::: "memory")
#define PG8_BAR __builtin_amdgcn_s_barrier()
#define PG8_SCHED __builtin_amdgcn_sched_barrier(0)
    Unit cur, nxt; int ui = 0;
    if (!S.next(0, cur)) return;
    f32x4 acc[2][2][4][2];
#pragma unroll
    for (int a = 0; a < 2; ++a)
#pragma unroll
        for (int b = 0; b < 2; ++b)
#pragma unroll
            for (int m = 0; m < 4; ++m)
#pragma unroll
                for (int n = 0; n < 2; ++n) acc[a][b][m][n] = (f32x4){0.f, 0.f, 0.f, 0.f};
    bf16x8 At[4][2], B0[2][2], B1[2][2];
    const char* cA = (const char*)g.A + (size_t)cur.pm * tstepA; const char* cB = (const char*)g.Bt + (size_t)cur.pn * tstepB;
    S.a_ready(cur);
    if constexpr (SP2) {
        PG8_STAGE(PG8_SB(0, 0), cB, voffB); PG8_STAGE(PG8_SB(0, 1), cB + hstepB, voffB); PG8_STAGE(PG8_SA(0, 0), cA, voffA); PG8_STAGE(PG8_SA(0, 1), cA + hstepA, voffA);
        if (wr == 1) PG8_BAR;
        PG8_WAIT_V(2); PG8_BAR;
        PG8_STAGE(PG8_SB(1, 0), cB + kstep, voffB); PG8_STAGE(PG8_SA(1, 0), cA + kstep, voffA); PG8_STAGE(PG8_SB(1, 1), cB + hstepB + kstep, voffB);
        PG8_WAIT_V(6); PG8_BAR;
    } else {
        PG8_STAGE(PG8_SB(0, 0), cB, voffB); PG8_STAGE(PG8_SA(0, 0), cA, voffA); PG8_STAGE(PG8_SB(0, 1), cB + hstepB, voffB); PG8_STAGE(PG8_SA(0, 1), cA + hstepA, voffA);
        if (wr == 1) PG8_BAR;
        PG8_WAIT_V(4); PG8_BAR;
        PG8_STAGE(PG8_SB(1, 0), cB + kstep, voffB); PG8_STAGE(PG8_SA(1, 0), cA + kstep, voffA); PG8_STAGE(PG8_SB(1, 1), cB + hstepB + kstep, voffB);
        PG8_WAIT_V(6); PG8_BAR;
    }
    for (;;) {
        const bool has_next = S.next(ui + 1, nxt);
        const char* nA = has_next ? (const char*)g.A + (size_t)nxt.pm * tstepA : cA; const char* nB = has_next ? (const char*)g.Bt + (size_t)nxt.pn * tstepB : cB;
        for (int t = 0; t < nt; t += 2) {
            const bool last = (t == nt - 2);
            const char* a1 = cA + (size_t)(t + 1) * kstep;
            const char* a2 = last ? nA : cA + (size_t)(t + 2) * kstep; const char* b2 = last ? nB : cB + (size_t)(t + 2) * kstep;
            const char* a3 = a2 + kstep; const char* b3 = b2 + kstep;
            if (last && has_next) S.a_ready(nxt);
            if constexpr (SP2) {
            PG8_LDB(B0, 0, 0); PG8_LDB(B1, 0, 1); PG8_SCHED; PG8_LDA(At, 0, 0); PG8_STAGE(PG8_SA(1, 1), a1 + hstepA, voffA);
            PG8_WAIT_V(8); PG8_WAIT_L(0); PG8_BAR; PG8_MMA(0, 0, At, B0); PG8_MMA(0, 1, At, B1); PG8_BAR; PG8_SCHED;
            PG8_LDA(At, 0, 1); PG8_STAGE(PG8_SB(0, 0), b2, voffB); PG8_STAGE(PG8_SB(0, 1), b2 + hstepB, voffB); PG8_STAGE(PG8_SA(0, 0), a2, voffA);
            PG8_WAIT_V(8); PG8_WAIT_L(0); PG8_BAR; PG8_MMA(1, 0, At, B0); PG8_MMA(1, 1, At, B1); PG8_BAR; PG8_SCHED;
            PG8_LDB(B0, 1, 0); PG8_LDB(B1, 1, 1); PG8_SCHED; PG8_LDA(At, 1, 0); PG8_STAGE(PG8_SA(0, 1), a2 + hstepA, voffA);
            PG8_WAIT_V(8); PG8_WAIT_L(0); PG8_BAR; PG8_MMA(0, 0, At, B0); PG8_MMA(0, 1, At, B1); PG8_BAR; PG8_SCHED;
            PG8_LDA(At, 1, 1); PG8_STAGE(PG8_SB(1, 0), b3, voffB); PG8_STAGE(PG8_SB(1, 1), b3 + hstepB, voffB); PG8_STAGE(PG8_SA(1, 0), a3, voffA);
            PG8_WAIT_V(8); PG8_WAIT_L(0); PG8_BAR; PG8_MMA(1, 0, At, B0); PG8_MMA(1, 1, At, B1); PG8_BAR; PG8_SCHED;
            } else {
            PG8_LDB(B0, 0, 0); PG8_SCHED; PG8_LDA(At, 0, 0); PG8_STAGE(PG8_SA(1, 1), a1 + hstepA, voffA);
            PG8_WAIT_L(8); PG8_BAR; PG8_WAIT_L(0); PG8_MMA(0, 0, At, B0); PG8_BAR; PG8_SCHED;
            PG8_LDB(B1, 0, 1); PG8_STAGE(PG8_SB(0, 0), b2, voffB);
            PG8_BAR; PG8_WAIT_L(0); PG8_MMA(0, 1, At, B1); PG8_BAR;
            PG8_LDA(At, 0, 1); PG8_STAGE(PG8_SA(0, 0), a2, voffA);
            PG8_BAR; PG8_WAIT_L(0); PG8_MMA(1, 0, At, B0); PG8_BAR; PG8_SCHED;
            PG8_STAGE(PG8_SB(0, 1), b2 + hstepB, voffB);
            PG8_WAIT_V(6); PG8_BAR; PG8_MMA(1, 1, At, B1); PG8_BAR;
            PG8_LDB(B0, 1, 0); PG8_SCHED; PG8_LDA(At, 1, 0); PG8_STAGE(PG8_SA(0, 1), a2 + hstepA, voffA);
            PG8_WAIT_L(8); PG8_BAR; PG8_WAIT_L(0); PG8_MMA(0, 0, At, B0); PG8_BAR; PG8_SCHED;
            PG8_LDB(B1, 1, 1); PG8_STAGE(PG8_SB(1, 0), b3, voffB);
            PG8_BAR; PG8_WAIT_L(0); PG8_MMA(0, 1, At, B1); PG8_BAR;
            PG8_LDA(At, 1, 1); PG8_STAGE(PG8_SA(1, 0), a3, voffA);
            PG8_BAR; PG8_WAIT_L(0); PG8_MMA(1, 0, At, B0); PG8_BAR; PG8_SCHED;
            PG8_STAGE(PG8_SB(1, 1), b3 + hstepB, voffB);
            PG8_WAIT_V(6); PG8_BAR; PG8_MMA(1, 1, At, B1); PG8_BAR;
            }
        }
        if constexpr (ALIGN_EPI) { if (wr == 0) PG8_BAR; }
        if constexpr (!Epi::AFTER_DRAIN) { E(acc, cur, wr, wc, fr, fq); S.done(cur); }
        if (!has_next) break;
#pragma unroll
        for (int a = 0; a < 2; ++a)
#pragma unroll
            for (int b = 0; b < 2; ++b)
#pragma unroll
                for (int m = 0; m < 4; ++m)
#pragma unroll
                    for (int n = 0; n < 2; ++n) acc[a][b][m][n] = (f32x4){0.f, 0.f, 0.f, 0.f};
        cur = nxt; cA = nA; cB = nB; ++ui;
        if constexpr (ALIGN_EPI) { if (wr == 1) PG8_BAR; }
    }
    PG8_WAIT_V(0);
    if constexpr (!ALIGN_EPI) { if (wr == 0) PG8_BAR; }
    PG8_BAR;
    if constexpr (Epi::AFTER_DRAIN) { E.fused(acc, cur, wr, wc, fr, fq, lds, wid, lane); S.done(cur); }
#undef PG8_SA
#undef PG8_SB
#undef PG8_STAGE
#undef PG8_LDA
#undef PG8_LDB
#undef PG8_MMA
#undef PG8_WAIT_V
#undef PG8_WAIT_L
#undef PG8_BAR
#undef PG8_SCHED
}
}

#define LAS __attribute__((address_space(3)))
#define XB_TMO      128
#define XB_XCNT(j)  (256  + 64 * (j))
#define XB_XSUB(j)  (1280 + 64 * (j))
#define XB_XGEN(j)  (2304 + 64 * (j))
#define XB_TOP      3328
#define XB_TOPGEN   3392
#define XCD_BAR_WORDS 3456
#define XB_SPIN_CAP (1u << 18)

__device__ __forceinline__ unsigned xb_ld(unsigned* p)              { return __hip_atomic_load(p, __ATOMIC_RELAXED, __HIP_MEMORY_SCOPE_AGENT); }
__device__ __forceinline__ unsigned xb_add(unsigned* p, unsigned v) { return __hip_atomic_fetch_add(p, v, __ATOMIC_RELAXED, __HIP_MEMORY_SCOPE_AGENT); }
__device__ __forceinline__ unsigned xb_xcc_id() { return (unsigned)__builtin_amdgcn_s_getreg((3 << 11) | 20) & 0xFu; }
#define XB_SPIN(cond, bar) do { unsigned _sp = 0; while (cond) { __builtin_amdgcn_s_sleep(1); \
    if ((++_sp & 255u) == 0u) { if (xb_ld(&(bar)[XB_TMO])) break; if (_sp > XB_SPIN_CAP) { atomicAdd(&(bar)[XB_TMO], 1u); break; } } } } while (0)

struct XcdBarrier {
    unsigned* bar; unsigned x;
    volatile LAS unsigned* st;
};

__device__ __forceinline__ XcdBarrier xcd_barrier_post(unsigned* bar, volatile LAS unsigned* st) {
    XcdBarrier b; b.bar = bar; b.x = xb_xcc_id(); b.st = st;
    if (threadIdx.x == 0) (void)xb_add(&bar[XB_XCNT(b.x)], 1u);
    return b;
}
__device__ __forceinline__ void xcd_barrier_complete(unsigned* bar, unsigned x, unsigned& nloc, unsigned& nx) {
    const unsigned G = gridDim.x * gridDim.y * gridDim.z;
    unsigned sum, cnt, mine, sp = 0u;
    for (;;) {
        sum = 0u; cnt = 0u; mine = 0u;
#pragma unroll
        for (unsigned j = 0; j < 16; ++j) { const unsigned c = xb_ld(&bar[XB_XCNT(j)]); sum += c; cnt += (c > 0u) ? 1u : 0u; mine = (j == x) ? c : mine; }
        if (sum == G) break;
        __builtin_amdgcn_s_sleep(1);
        if ((++sp & 255u) == 0u) { if (xb_ld(&bar[XB_TMO])) break; if (sp > XB_SPIN_CAP) { atomicAdd(&bar[XB_TMO], 1u); break; } }
    }
    nloc = mine > 0u ? mine : 1u; nx = cnt > 0u ? cnt : 1u;
}

__device__ __forceinline__ void xcd_barrier(const XcdBarrier& b) {
    asm volatile("s_waitcnt vmcnt(0)" ::: "memory");
    __syncthreads();
    if (threadIdx.x == 0) {
        unsigned* bar = b.bar;
        __builtin_amdgcn_s_waitcnt(0);
        unsigned nloc = b.st[0], nx = b.st[1];
        if (nloc == 0u) { xcd_barrier_complete(bar, b.x, nloc, nx); b.st[0] = nloc; b.st[1] = nx; }
        const unsigned old = xb_add(&bar[XB_XSUB(b.x)], 1u);
        const unsigned gen = old / nloc;
        if (old + 1u == (gen + 1u) * nloc) {
            __builtin_amdgcn_fence(__ATOMIC_RELEASE, "agent");
            asm volatile("s_waitcnt vmcnt(0)" ::: "memory");
            const unsigned og = xb_add(&bar[XB_TOP], 1u);
            const unsigned tg = og / nx;
            if (og + 1u == (tg + 1u) * nx) xb_add(&bar[XB_TOPGEN], 1u);
            else XB_SPIN(xb_ld(&bar[XB_TOPGEN]) == tg, bar);
            __builtin_amdgcn_fence(__ATOMIC_ACQUIRE, "agent");
            xb_add(&bar[XB_XGEN(b.x)], 1u);
            asm volatile("s_waitcnt vmcnt(0)" ::: "memory");
        } else {
            XB_SPIN(xb_ld(&bar[XB_XGEN(b.x)]) == gen, bar);
            __builtin_amdgcn_fence(__ATOMIC_ACQUIRE, "agent");
            asm volatile("s_waitcnt vmcnt(0)" ::: "memory");
        }
    }
    __syncthreads();
}

constexpr int NWAVES = 8;
constexpr int RING_BYTES = 131072;
constexpr int LDSCTL_OFF = RING_BYTES;
constexpr int LDS_BYTES = 147456;
constexpr int CW_BAR = 4096;
constexpr size_t CTL_ZERO_BYTES = 131072;
#ifndef OPT_MASK
#define OPT_MASK 0x1FF
#endif

typedef float f32x4 __attribute__((ext_vector_type(4)));
typedef unsigned u32x4v __attribute__((ext_vector_type(4)));
typedef unsigned u32x2v __attribute__((ext_vector_type(2)));
typedef short bf16x8 __attribute__((ext_vector_type(8)));
#define LDS_WAIT() asm volatile("s_waitcnt lgkmcnt(0)" ::: "memory")

struct MArgs { const float* in[16]; float* out; unsigned char* ws; int ph_lo, ph_hi, li, pad; };
struct Frame { LAS unsigned char* lds; int tid, lane, wave, G, bid; const float* in[16]; float* out; unsigned char* ws; };

__device__ __forceinline__ unsigned pk2(float lo, float hi) { return pg8::cvt_pk_bf16(lo, hi); }
__device__ __forceinline__ float wave_sum(float v) {
#pragma unroll
    for (int o = 1; o < 64; o <<= 1) v += __shfl_xor(v, o);
    return v;
}

__device__ __forceinline__ void p0_x_row(const float* xrow, bf16_t* orow, float* rs, int lane) {
    const f32x4* xr = (const f32x4*)xrow + lane; f32x4 v[4]; float s = 0.f;
#pragma unroll
    for (int j = 0; j < 4; ++j) { v[j] = xr[64 * j]; s += (v[j][0] * v[j][0] + v[j][1] * v[j][1]) + (v[j][2] * v[j][2] + v[j][3] * v[j][3]); }
    s = wave_sum(s);
    u32x2v* o8 = (u32x2v*)orow + lane;
#pragma unroll
    for (int j = 0; j < 4; ++j) { u32x2v w; w.x = pk2(v[j][0], v[j][1]); w.y = pk2(v[j][2], v[j][3]); o8[64 * j] = w; }
    if (lane == 0) *rs = 1.0f / sqrtf(s * (1.0f / D_) + EPS_);
}
__device__ __forceinline__ void p0_transpose_item(const float* W, int ldw, int csrc, const float* gain, int gmask, bf16_t* WT, int K, int nrow, int k0, LAS float* scr, int lane) {
#pragma unroll 8
    for (int i = 0; i < 32; ++i) { const int kk = 2 * i + (lane >> 5); const float g = gain ? gain[(k0 + kk) & gmask] : 1.0f; scr[kk * 33 + (lane & 31)] = W[(size_t)(k0 + kk) * ldw + csrc + (lane & 31)] * g; }
    LDS_WAIT(); asm volatile("" ::: "memory");
    const int c = lane & 7;
#pragma unroll
    for (int j = 0; j < 4; ++j) { const int n = (lane >> 3) + 8 * j; const LAS float* s = scr + (8 * c) * 33 + n;
        u32x4v o; o.x = pk2(s[0 * 33], s[1 * 33]); o.y = pk2(s[2 * 33], s[3 * 33]); o.z = pk2(s[4 * 33], s[5 * 33]); o.w = pk2(s[6 * 33], s[7 * 33]);
        *(u32x4v*)(WT + (size_t)(nrow + n) * K + k0 + 8 * c) = o; }
    LDS_WAIT(); asm volatile("" ::: "memory");
}
__device__ __forceinline__ void p0_memkv(const Frame& F, int unit) {
    const int l = unit >> 7, b = (unit >> 6) & 1, mt = (unit >> 3) & 7, cg = unit & 7, lane = F.lane, w = F.wave, c = lane & 15, g4 = lane >> 4, cgw = w & 1, kq = w >> 1;
    const float* mem = F.in[1] + ((size_t)b * 256 + mt * 32) * D_; const float* W = F.in[13] + (size_t)l * D_ * 1024 + cg * 128 + 64 * cgw + 4 * c; const float* gm = F.in[12] + l * D_;
    f32x4 acc[4][2];
#pragma unroll
    for (int t = 0; t < 4; ++t) { acc[t][0] = (f32x4){0.f, 0.f, 0.f, 0.f}; acc[t][1] = (f32x4){0.f, 0.f, 0.f, 0.f}; }
#pragma unroll 2
    for (int ks = 0; ks < 8; ++ks) { const int kb = kq * 256 + ks * 32 + 8 * g4;
        const f32x4 g0 = *(const f32x4*)(gm + kb), g1 = *(const f32x4*)(gm + kb + 4);
        bf16x8 afr[2], bfr[4];
#pragma unroll
        for (int rb = 0; rb < 2; ++rb) { const float* p = mem + (size_t)(rb * 16 + c) * D_ + kb; const f32x4 a0 = *(const f32x4*)p * g0, a1 = *(const f32x4*)(p + 4) * g1;
            u32x4v t; t.x = pk2(a0[0], a0[1]); t.y = pk2(a0[2], a0[3]); t.z = pk2(a1[0], a1[1]); t.w = pk2(a1[2], a1[3]); afr[rb] = __builtin_bit_cast(bf16x8, t); }
        f32x4 wv[8];
#pragma unroll
        for (int j = 0; j < 8; ++j) wv[j] = *(const f32x4*)(W + (size_t)(kb + j) * 1024);
#pragma unroll
        for (int t = 0; t < 4; ++t) { u32x4v q; q.x = pk2(wv[0][t], wv[1][t]); q.y = pk2(wv[2][t], wv[3][t]); q.z = pk2(wv[4][t], wv[5][t]); q.w = pk2(wv[6][t], wv[7][t]); bfr[t] = __builtin_bit_cast(bf16x8, q); }
#pragma unroll
        for (int t = 0; t < 4; ++t)
#pragma unroll
            for (int rb = 0; rb < 2; ++rb) acc[t][rb] = __builtin_amdgcn_mfma_f32_16x16x32_bf16(afr[rb], bfr[t], acc[t][rb], 0, 0, 0);
    }
    LAS float* P = (LAS float*)F.lds;
#pragma unroll
    for (int rb = 0; rb < 2; ++rb)
#pragma unroll
        for (int r = 0; r < 4; ++r) { const int tok = rb * 16 + 4 * g4 + r; *(LAS f32x4*)(P + ((kq * 32 + tok) * 128 + 64 * cgw + 4 * c)) = (f32x4){acc[0][rb][r], acc[1][rb][r], acc[2][rb][r], acc[3][rb][r]}; }
    __syncthreads();
    const int tok = F.tid >> 4, cb = F.tid & 15;
    f32x4 s0 = (f32x4){0.f, 0.f, 0.f, 0.f}, s1 = s0;
#pragma unroll
    for (int q = 0; q < 4; ++q) { s0 += *(const LAS f32x4*)(P + ((q * 32 + tok) * 128 + cb * 8)); s1 += *(const LAS f32x4*)(P + ((q * 32 + tok) * 128 + cb * 8 + 4)); }
    float ms = 0.f; { const f32x4* mr = (const f32x4*)(mem + (size_t)tok * D_ + cb * 64);
#pragma unroll
        for (int j = 0; j < 16; ++j) { const f32x4 v = mr[j]; ms += (v[0] * v[0] + v[1] * v[1]) + (v[2] * v[2] + v[3] * v[3]); } }
    ms += __shfl_xor(ms, 1); ms += __shfl_xor(ms, 2); ms += __shfl_xor(ms, 4); ms += __shfl_xor(ms, 8);
    const float rm = 1.0f / sqrtf(ms * (1.0f / D_) + EPS_);
    s0 *= rm; s1 *= rm;
    const size_t orow = ((((size_t)l * 2 + b) * 4 + (cg & 3)) * 256 + mt * 32 + tok) * 128 + cb * 8;
    if (cg < 4) {
        float q = (s0[0] * s0[0] + s0[1] * s0[1]) + (s0[2] * s0[2] + s0[3] * s0[3]) + (s1[0] * s1[0] + s1[1] * s1[1]) + (s1[2] * s1[2] + s1[3] * s1[3]);
        q += __shfl_xor(q, 1); q += __shfl_xor(q, 2); q += __shfl_xor(q, 4); q += __shfl_xor(q, 8);
        const float hn = QK_SCALE / sqrtf(q * (1.0f / 128) + EPS_);
        const f32x4 gk0 = *(const f32x4*)(F.in[15] + l * 128 + cb * 8), gk1 = *(const f32x4*)(F.in[15] + l * 128 + cb * 8 + 4);
        const f32x4 gq0 = *(const f32x4*)(F.in[14] + l * 128 + cb * 8), gq1 = *(const f32x4*)(F.in[14] + l * 128 + cb * 8 + 4);
        s0 = s0 * hn * gk0 * gq0; s1 = s1 * hn * gk1 * gq1;
        *(u32x4v*)((bf16_t*)(F.ws + WS_MEMK) + orow) = pg8::pack8(s0, s1);
    } else *(u32x4v*)((bf16_t*)(F.ws + WS_MEMV) + orow) = pg8::pack8(s0, s1);
    __syncthreads();
}
__device__ __forceinline__ void p0_prologue(const Frame& F) {
    const int gw = F.bid * NWAVES + F.wave, NGW = F.G * NWAVES;
    for (int u = F.bid; u < 256; u += F.G) p0_memkv(F, u);
    { bf16_t* XB = (bf16_t*)(F.ws + WS_XB); float* RS0 = (float*)(F.ws + WS_RS0);
      for (int m = gw; m < T_; m += NGW) p0_x_row(F.in[0] + (size_t)m * D_, XB + (size_t)m * D_, RS0 + m, F.lane); }
    LAS float* scr = (LAS float*)(F.lds + F.wave * 16384);
    constexpr int I_A = 16 * 128, I_OA = 24 * 32, I_B = 16 * 160, I_OB = 24 * 32, NITEMS = I_A + I_OA + I_B + I_OB;
    for (int it = gw; it < NITEMS; it += NGW) {
        int r = it;
        if (r < I_A) { const int kb = r / 128, nb = r % 128, n0 = 32 * nb; p0_transpose_item(F.in[4], 4096, permA_src(n0), F.in[3], 0xffff, (bf16_t*)(F.ws + WS_WINA), 1024, n0, 64 * kb, scr, F.lane); continue; } r -= I_A;
        if (r < I_OA) { const int kb = r / 32, nb = r % 32; p0_transpose_item(F.in[6], 1024, 32 * nb, kb < 16 ? F.in[5] : nullptr, 255, (bf16_t*)(F.ws + WS_WOUTA), 1536, 32 * nb, 64 * kb, scr, F.lane); continue; } r -= I_OA;
        if (r < I_B) { const int kb = r / 160, nb = r % 160, n0 = 32 * nb;
            if (n0 < 2048) p0_transpose_item(F.in[8], 2048, n0, F.in[7], 0xffff, (bf16_t*)(F.ws + WS_WB), 1024, n0, 64 * kb, scr, F.lane);
            else { const int c = n0 - 2048, src = c < 1024 ? 1024 + c : (c < 2048 ? c - 1024 : c); p0_transpose_item(F.in[10], 3072, src, F.in[9], 0xffff, (bf16_t*)(F.ws + WS_WB), 1024, n0, 64 * kb, scr, F.lane); }
            continue; } r -= I_B;
        { const int kb = r / 32, nb = r % 32; p0_transpose_item(F.in[11], 1024, 32 * nb, nullptr, 0, (bf16_t*)(F.ws + WS_WOUTB), 1536, 32 * nb, 64 * kb, scr, F.lane); }
    }
}


typedef float f32x16 __attribute__((ext_vector_type(16)));
typedef short s16x4 __attribute__((ext_vector_type(4)));
#define KSWZ(row, colB) ((row) * 256 + ((colB) ^ (((row) & 7) << 4)))
#define SBAR() __builtin_amdgcn_sched_barrier(0)
constexpr float LOG2E = 1.4426950408889634f;
__device__ __forceinline__ int crow(int r, int hi) { return (r & 3) + 8 * (r >> 2) + 4 * hi; }
__device__ __forceinline__ unsigned lds_addr(const LAS void* p) { return (unsigned)(size_t)p; }
__device__ __forceinline__ int v_st(int k, int c) { const int kk = (k & ~0xC) | ((k & 4) << 1) | ((k & 8) >> 1); return ((kk >> 3) * 4 + (c >> 5)) * 512 + ((kk & 7) * 32 + (c & 31)) * 2; }
__device__ __forceinline__ int v_rd_base(int lane) { return ((lane & 3) << 3) | (((lane >> 2) & 3) << 6) | (((lane >> 4) & 1) << 5) | (((lane >> 5) & 1) << 8); }
constexpr int v_rd_off(int d0, int ks, int half) { return d0 * 512 + ks * 4096 + half * 2048; }
template <int OFF> __device__ __forceinline__ s16x4 tr_read(unsigned vb) { s16x4 r; asm volatile("ds_read_b64_tr_b16 %0, %1 offset:%2" : "=&v"(r) : "v"(vb), "i"(OFF) : "memory"); return r; }
#define PKLH(L, H) (bf16x8){L[0], L[1], L[2], L[3], H[0], H[1], H[2], H[3]}
__device__ __forceinline__ float partner32(float x, int hi) { auto rr = __builtin_amdgcn_permlane32_swap(__float_as_uint(x), __float_as_uint(x), false, false); return __uint_as_float(hi ? rr[0] : rr[1]); }

__device__ __forceinline__ void qkt(f32x16& p0, f32x16& p1, const LAS unsigned char* Ks, const bf16x8* qr, int r32, int hi) {
    p0 = f32x16{}; p1 = f32x16{};
#pragma unroll
    for (int d0 = 0; d0 < 8; ++d0) { const int cb = (d0 * 16 + hi * 8) * 2;
        const bf16x8 b0 = *(const LAS bf16x8*)(Ks + KSWZ(r32, cb)), b1 = *(const LAS bf16x8*)(Ks + KSWZ(32 + r32, cb));
        p0 = __builtin_amdgcn_mfma_f32_32x32x16_bf16(b0, qr[d0], p0, 0, 0, 0);
        p1 = __builtin_amdgcn_mfma_f32_32x32x16_bf16(b1, qr[d0], p1, 0, 0, 0); }
}
#define PK4(P, BASE, OUT) do { unsigned a0_ = pg8::cvt_pk_bf16(P[BASE + 0], P[BASE + 1]), a1_ = pg8::cvt_pk_bf16(P[BASE + 2], P[BASE + 3]); \
    unsigned b0_ = pg8::cvt_pk_bf16(P[BASE + 4], P[BASE + 5]), b1_ = pg8::cvt_pk_bf16(P[BASE + 6], P[BASE + 7]); \
    auto r0_ = __builtin_amdgcn_permlane32_swap(a0_, b0_, false, false); auto r1_ = __builtin_amdgcn_permlane32_swap(a1_, b1_, false, false); \
    u32x4v w_ = {r0_[0], r1_[0], r0_[1], r1_[1]}; OUT = __builtin_bit_cast(bf16x8, w_); } while (0)
template <int D0> __device__ __forceinline__ void pv_one(f32x16& od, unsigned vb, bf16x8 pa0, bf16x8 pa1, bf16x8 pa2, bf16x8 pa3) {
    const s16x4 l0 = tr_read<v_rd_off(D0, 0, 0)>(vb), h0 = tr_read<v_rd_off(D0, 0, 1)>(vb), l1 = tr_read<v_rd_off(D0, 1, 0)>(vb), h1 = tr_read<v_rd_off(D0, 1, 1)>(vb);
    const s16x4 l2 = tr_read<v_rd_off(D0, 2, 0)>(vb), h2 = tr_read<v_rd_off(D0, 2, 1)>(vb), l3 = tr_read<v_rd_off(D0, 3, 0)>(vb), h3 = tr_read<v_rd_off(D0, 3, 1)>(vb);
    asm volatile("s_waitcnt lgkmcnt(0)" ::: "memory"); SBAR();
    od = __builtin_amdgcn_mfma_f32_32x32x16_bf16(pa0, PKLH(l0, h0), od, 0, 0, 0);
    od = __builtin_amdgcn_mfma_f32_32x32x16_bf16(pa1, PKLH(l1, h1), od, 0, 0, 0);
    od = __builtin_amdgcn_mfma_f32_32x32x16_bf16(pa2, PKLH(l2, h2), od, 0, 0, 0);
    od = __builtin_amdgcn_mfma_f32_32x32x16_bf16(pa3, PKLH(l3, h3), od, 0, 0, 0);
}
__device__ __forceinline__ void pv_d0(f32x16* o, unsigned vb, bf16x8 pa0, bf16x8 pa1, bf16x8 pa2, bf16x8 pa3) {
    pv_one<0>(o[0], vb, pa0, pa1, pa2, pa3); pv_one<1>(o[1], vb, pa0, pa1, pa2, pa3); pv_one<2>(o[2], vb, pa0, pa1, pa2, pa3); pv_one<3>(o[3], vb, pa0, pa1, pa2, pa3);
}
constexpr int WSCR_OFF = LDSCTL_OFF + 1024, WFLAG_OFF = LDSCTL_OFF + 512;

constexpr float SB_EXIT = -150.1f;
__device__ __forceinline__ void sb_unit(const Frame& F, int b, int h, int qb) {
    int tid = F.tid; asm volatile("" : "+v"(tid));
    const int w = F.wave, lane = tid & 63, r32 = lane & 31, hi = lane >> 5;
    bf16_t* UB = (bf16_t*)(F.ws + WS_UB); const size_t rowb = (size_t)b * S_;
    const int q0 = qb * 256, tq = q0 + 32 * w + r32;
    bf16x8 qr[8];
    { const bf16_t* qp = UB + (rowb + tq) * NBW_ + 3072 + h * 128 + hi * 8;
#pragma unroll
      for (int d0 = 0; d0 < 8; ++d0) qr[d0] = *(const bf16x8*)(qp + d0 * 16); }
    const int sr = tid >> 4, sc = (tid & 15) * 8;
    const bf16_t* kg = UB + rowb * NBW_ + h * 128 + sc; const bf16_t* vg = kg + 1024;
    const int kst0 = KSWZ(sr, sc * 2), kst1 = KSWZ(32 + sr, sc * 2), vst0 = v_st(sr, sc), vst1 = v_st(32 + sr, sc);
    LAS unsigned char* Kb = F.lds; LAS unsigned char* Vb = F.lds + 32768;
    const unsigned vb0 = lds_addr(Vb) + v_rd_base(lane);
    volatile LAS unsigned* flags = (volatile LAS unsigned*)(F.lds + WFLAG_OFF);
    bf16x8 sk0, sk1, sv0, sv1;
#define SB_LOAD(kt_) do { const size_t r0_ = (size_t)((kt_) * 64 + sr) * NBW_; sk0 = *(const bf16x8*)(kg + r0_); sk1 = *(const bf16x8*)(kg + r0_ + 32 * (size_t)NBW_); \
        sv0 = *(const bf16x8*)(vg + r0_); sv1 = *(const bf16x8*)(vg + r0_ + 32 * (size_t)NBW_); } while (0)
#define SB_WRITE(buf_) do { *(LAS bf16x8*)(Kb + (buf_) * 16384 + kst0) = sk0; *(LAS bf16x8*)(Kb + (buf_) * 16384 + kst1) = sk1; \
        *(LAS bf16x8*)(Vb + (buf_) * 16384 + vst0) = sv0; *(LAS bf16x8*)(Vb + (buf_) * 16384 + vst1) = sv1; } while (0)
    f32x16 o[4] = {}; float carry = 0.f; bool wdone = false;
    const int kt_hi = qb * 4 + 3;
    __syncthreads();
    SB_LOAD(kt_hi); SB_WRITE(kt_hi & 1);
    __syncthreads();
    for (int kt = kt_hi; kt >= 0; --kt) {
        const int cur = kt & 1;
        if (kt > 0) SB_LOAD(kt - 1);
        if (!wdone && kt * 64 < q0 + 32 * w + 31) {
            f32x16 p0, p1, l0, l1;
            qkt(p0, p1, Kb + cur * 16384, qr, r32, hi);
            const int lim = tq - kt * 64 - 4 * hi;
#pragma unroll
            for (int r = 0; r < 16; ++r) { const int cr = (r & 3) + 8 * (r >> 2);
                { const float y = p0[r] * LOG2E, e = __builtin_amdgcn_exp2f(y); float sp = __builtin_amdgcn_logf(1.0f + e); sp = y > 30.f ? y : sp; l0[r] = cr < lim ? -sp : 0.f; p0[r] = y - sp; }
                { const float y = p1[r] * LOG2E, e = __builtin_amdgcn_exp2f(y); float sp = __builtin_amdgcn_logf(1.0f + e); sp = y > 30.f ? y : sp; l1[r] = cr + 32 < lim ? -sp : 0.f; p1[r] = y - sp; } }
            float go[8], gp[8], sown[8];
#pragma unroll
            for (int i = 0; i < 4; ++i) { go[i] = (l0[4 * i] + l0[4 * i + 1]) + (l0[4 * i + 2] + l0[4 * i + 3]); go[4 + i] = (l1[4 * i] + l1[4 * i + 1]) + (l1[4 * i + 2] + l1[4 * i + 3]); }
#pragma unroll
            for (int i = 0; i < 8; ++i) gp[i] = partner32(go[i], hi);
            float tail = 0.f;
#pragma unroll
            for (int i = 7; i >= 0; --i) { sown[i] = tail + (hi ? 0.f : gp[i]) + carry; tail += go[i] + gp[i]; }
#pragma unroll
            for (int i = 0; i < 4; ++i) {
                { const float s3 = sown[i], s2 = s3 + l0[4 * i + 3], s1 = s2 + l0[4 * i + 2], s0 = s1 + l0[4 * i + 1]; const int cr = 8 * i;
                  p0[4 * i + 0] = cr + 0 < lim ? __builtin_amdgcn_exp2f(p0[4 * i + 0] + s0) : 0.f; p0[4 * i + 1] = cr + 1 < lim ? __builtin_amdgcn_exp2f(p0[4 * i + 1] + s1) : 0.f;
                  p0[4 * i + 2] = cr + 2 < lim ? __builtin_amdgcn_exp2f(p0[4 * i + 2] + s2) : 0.f; p0[4 * i + 3] = cr + 3 < lim ? __builtin_amdgcn_exp2f(p0[4 * i + 3] + s3) : 0.f; }
                { const float s3 = sown[4 + i], s2 = s3 + l1[4 * i + 3], s1 = s2 + l1[4 * i + 2], s0 = s1 + l1[4 * i + 1]; const int cr = 32 + 8 * i;
                  p1[4 * i + 0] = cr + 0 < lim ? __builtin_amdgcn_exp2f(p1[4 * i + 0] + s0) : 0.f; p1[4 * i + 1] = cr + 1 < lim ? __builtin_amdgcn_exp2f(p1[4 * i + 1] + s1) : 0.f;
                  p1[4 * i + 2] = cr + 2 < lim ? __builtin_amdgcn_exp2f(p1[4 * i + 2] + s2) : 0.f; p1[4 * i + 3] = cr + 3 < lim ? __builtin_amdgcn_exp2f(p1[4 * i + 3] + s3) : 0.f; } }
            carry += tail;
            bf16x8 pa0, pa1, pa2, pa3;
            PK4(p0, 0, pa0); PK4(p0, 8, pa1); PK4(p1, 0, pa2); PK4(p1, 8, pa3);
            pv_d0(o, vb0 + cur * 16384, pa0, pa1, pa2, pa3);
            wdone = __all(carry < SB_EXIT);
        }
        if (kt > 0) SB_WRITE(cur ^ 1);
        if (lane == 0) flags[w] = wdone ? 1u : 0u;
        __syncthreads();
        unsigned alld = 1u;
#pragma unroll
        for (int j = 0; j < 8; ++j) alld &= flags[j];
        if (alld) break;
    }
#undef SB_LOAD
#undef SB_WRITE
    { bf16_t* base = UB + (rowb + q0 + 32 * w) * NBW_ + h * 128 + r32;
#pragma unroll
      for (int r = 0; r < 16; ++r) { bf16_t* rp = base + (size_t)crow(r, hi) * NBW_;
#pragma unroll
          for (int d0 = 0; d0 < 4; ++d0) { const float g = bf2f(rp[2048 + d0 * 32]); rp[3072 + d0 * 32] = f2bf(o[d0][r] * g); } } }
}

__device__ __forceinline__ void memattn_unit(const Frame& F, bf16_t* U, int ld, int qoff, int goff, int layer, int unit) {
    int tid = F.tid; asm volatile("" : "+v"(tid));
    const int w = F.wave, lane = tid & 63, r32 = lane & 31, hi = lane >> 5;
    const int qblk = unit >> 2, hd = unit & 3, row0 = qblk * 256, b = row0 / S_;
    const bf16_t* Kg = (const bf16_t*)(F.ws + WS_MEMK) + (((size_t)layer * 2 + b) * 4 + hd) * 256 * 128; const bf16_t* Vg = (const bf16_t*)(F.ws + WS_MEMV) + (((size_t)layer * 2 + b) * 4 + hd) * 256 * 128;
    LAS unsigned char* Kb = F.lds; LAS unsigned char* Vb = F.lds + 65536;
    __syncthreads();
#pragma unroll
    for (int j = 0; j < 8; ++j) { const int c = tid + 512 * j, row = c >> 4, ch = c & 15;
        *(LAS bf16x8*)(Kb + KSWZ(row, ch * 16)) = *(const bf16x8*)(Kg + (size_t)row * 128 + ch * 8);
        *(LAS bf16x8*)(Vb + (row >> 6) * 16384 + v_st(row & 63, ch * 8)) = *(const bf16x8*)(Vg + (size_t)row * 128 + ch * 8); }
    bf16x8 qr[8]; float ssq = 0.f;
    { const bf16_t* qp = U + (size_t)(row0 + 32 * w + r32) * ld + qoff + hd * 128 + hi * 8;
#pragma unroll
      for (int d0 = 0; d0 < 8; ++d0) { qr[d0] = *(const bf16x8*)(qp + d0 * 16);
#pragma unroll
          for (int j = 0; j < 8; ++j) { const float v = bf2f((bf16_t)qr[d0][j]); ssq += v * v; } } }
    ssq += partner32(ssq, hi);
    const float C = LOG2E / sqrtf(ssq * (1.0f / 128) + EPS_);
    __syncthreads();
    LAS float* wscr = (LAS float*)(F.lds + WSCR_OFF) + w * 64;
    const unsigned vb0 = lds_addr(Vb) + v_rd_base(lane);
    f32x16 o[4] = {}; float m_reg = -1e30f, l_reg = 0.f;
#pragma unroll 1
    for (int t = 0; t < 4; ++t) {
        f32x16 p0, p1;
        qkt(p0, p1, Kb + t * 16384, qr, r32, hi);
        float pmax = p0[0];
#pragma unroll
        for (int r = 1; r < 16; ++r) pmax = fmaxf(pmax, p0[r]);
#pragma unroll
        for (int r = 0; r < 16; ++r) pmax = fmaxf(pmax, p1[r]);
        pmax = fmaxf(pmax, partner32(pmax, hi));
        float alpha = 1.f;
        if (!__all(pmax <= m_reg)) { const float mn = fmaxf(m_reg, pmax); alpha = __builtin_amdgcn_exp2f((m_reg - mn) * C); m_reg = mn;
            if (hi == 0) wscr[r32] = alpha; LDS_WAIT();
#pragma unroll
            for (int d = 0; d < 4; ++d)
#pragma unroll
                for (int r = 0; r < 16; ++r) o[d][r] *= wscr[crow(r, hi)];
            LDS_WAIT(); }
        const float mC = -m_reg * C; float ps = 0.f;
#pragma unroll
        for (int r = 0; r < 16; ++r) { p0[r] = __builtin_amdgcn_exp2f(fmaf(p0[r], C, mC)); p1[r] = __builtin_amdgcn_exp2f(fmaf(p1[r], C, mC)); ps += p0[r] + p1[r]; }
        ps += partner32(ps, hi);
        l_reg = l_reg * alpha + ps;
        bf16x8 pa0, pa1, pa2, pa3;
        PK4(p0, 0, pa0); PK4(p0, 8, pa1); PK4(p1, 0, pa2); PK4(p1, 8, pa3);
        pv_d0(o, vb0 + t * 16384, pa0, pa1, pa2, pa3);
    }
    if (hi == 0) wscr[32 + r32] = l_reg; LDS_WAIT();
    { bf16_t* base = U + (size_t)(row0 + 32 * w) * ld + hd * 128 + r32;
#pragma unroll
      for (int r = 0; r < 16; ++r) { const float rl = 1.0f / wscr[32 + crow(r, hi)]; bf16_t* rp = base + (size_t)crow(r, hi) * ld;
#pragma unroll
          for (int d0 = 0; d0 < 4; ++d0) { const float g = bf2f(rp[goff + d0 * 32]); rp[qoff + d0 * 32] = f2bf(o[d0][r] * rl * g); } } }
    LDS_WAIT();
}

__device__ __forceinline__ float ret_lg2(int h) { return log2f(1.0f - exp2f(-5.0f - (float)h)); }
__device__ __forceinline__ void kvt_unit(const Frame& F, int u) {
    int tid = F.tid; asm volatile("" : "+v"(tid));
    const int w = F.wave, lane = tid & 63, r32 = lane & 31, hi = lane >> 5;
    const int b = u >> 8, h = (u >> 6) & 3, n = u & 63; const size_t row0 = (size_t)b * S_ + n * 128; const float lg2 = ret_lg2(h);
    const bf16_t* UA = (const bf16_t*)(F.ws + WS_UA); bf16_t* KVT = (bf16_t*)(F.ws + WS_KVT);
    LAS unsigned char* Vb = F.lds; LAS unsigned char* Kb = F.lds + 65536;
    __syncthreads();
#pragma unroll
    for (int j = 0; j < 8; ++j) { const int c = tid + 512 * j, row = c >> 5, col = (c & 31) * 8;
        *(LAS bf16x8*)(Vb + ((row >> 6) * 2 + (col >> 7)) * 16384 + v_st(row & 63, col & 127)) = *(const bf16x8*)(UA + (row0 + row) * NA_ + 1024 + h * 256 + col); }
#pragma unroll
    for (int j = 0; j < 4; ++j) { const int c = tid + 512 * j, row = c >> 4, col = (c & 15) * 8; const float z = exp2f((float)(127 - row) * lg2);
        const bf16x8 kv = *(const bf16x8*)(UA + (row0 + row) * NA_ + 512 + h * 128 + col);
        u32x4v t; t.x = pk2(bf2f((bf16_t)kv[0]) * z, bf2f((bf16_t)kv[1]) * z); t.y = pk2(bf2f((bf16_t)kv[2]) * z, bf2f((bf16_t)kv[3]) * z);
        t.z = pk2(bf2f((bf16_t)kv[4]) * z, bf2f((bf16_t)kv[5]) * z); t.w = pk2(bf2f((bf16_t)kv[6]) * z, bf2f((bf16_t)kv[7]) * z);
        *(LAS u32x4v*)(Kb + (row >> 6) * 16384 + v_st(row & 63, col)) = t; }
    __syncthreads();
    f32x16 acc[4] = {};
    const unsigned vbV = lds_addr(Vb) + v_rd_base(lane) + (w >> 2) * 16384 + (w & 3) * 512, vbK = lds_addr(Kb) + v_rd_base(lane);
#define KVT_STEP(TH, KS) do { const unsigned va_ = vbV + (TH) * 32768, vk_ = vbK + (TH) * 16384; \
        const s16x4 al_ = tr_read<v_rd_off(0, KS, 0)>(va_), ah_ = tr_read<v_rd_off(0, KS, 1)>(va_); \
        const s16x4 b0l_ = tr_read<v_rd_off(0, KS, 0)>(vk_), b0h_ = tr_read<v_rd_off(0, KS, 1)>(vk_), b1l_ = tr_read<v_rd_off(1, KS, 0)>(vk_), b1h_ = tr_read<v_rd_off(1, KS, 1)>(vk_); \
        const s16x4 b2l_ = tr_read<v_rd_off(2, KS, 0)>(vk_), b2h_ = tr_read<v_rd_off(2, KS, 1)>(vk_), b3l_ = tr_read<v_rd_off(3, KS, 0)>(vk_), b3h_ = tr_read<v_rd_off(3, KS, 1)>(vk_); \
        asm volatile("s_waitcnt lgkmcnt(0)" ::: "memory"); SBAR(); const bf16x8 a_ = PKLH(al_, ah_); \
        acc[0] = __builtin_amdgcn_mfma_f32_32x32x16_bf16(a_, PKLH(b0l_, b0h_), acc[0], 0, 0, 0); acc[1] = __builtin_amdgcn_mfma_f32_32x32x16_bf16(a_, PKLH(b1l_, b1h_), acc[1], 0, 0, 0); \
        acc[2] = __builtin_amdgcn_mfma_f32_32x32x16_bf16(a_, PKLH(b2l_, b2h_), acc[2], 0, 0, 0); acc[3] = __builtin_amdgcn_mfma_f32_32x32x16_bf16(a_, PKLH(b3l_, b3h_), acc[3], 0, 0, 0); } while (0)
    KVT_STEP(0, 0); KVT_STEP(0, 1); KVT_STEP(0, 2); KVT_STEP(0, 3); KVT_STEP(1, 0); KVT_STEP(1, 1); KVT_STEP(1, 2); KVT_STEP(1, 3);
#undef KVT_STEP
    bf16_t* ob = KVT + ((size_t)u * 256 + 32 * w) * 128 + r32;
#pragma unroll
    for (int r = 0; r < 16; ++r)
#pragma unroll
        for (int db = 0; db < 4; ++db) ob[(size_t)crow(r, hi) * 128 + 32 * db] = f2bf(acc[db][r]);
}
__device__ __forceinline__ void scan_phase(const Frame& F) {
    for (int idx = F.bid * (NWAVES * 64) + F.tid; idx < 8 * 16384; idx += F.G * NWAVES * 64) {
        const int bh = idx >> 14, off = idx & 16383; const float gc = exp2f(128.0f * ret_lg2(bh & 3));
        unsigned* p = (unsigned*)(F.ws + WS_KVT) + (size_t)bh * 64 * 16384 + off; float s0 = 0.f, s1 = 0.f;
#pragma unroll 1
        for (int n0 = 0; n0 < 64; n0 += 16) { unsigned v[16];
#pragma unroll
            for (int j = 0; j < 16; ++j) v[j] = p[(size_t)(n0 + j) * 16384];
#pragma unroll
            for (int j = 0; j < 16; ++j) { p[(size_t)(n0 + j) * 16384] = pk2(s0, s1); s0 = fmaf(gc, s0, __uint_as_float(v[j] << 16)); s1 = fmaf(gc, s1, __uint_as_float(v[j] & 0xffff0000u)); } }
    }
}
__device__ __forceinline__ void ret_unit(const Frame& F, int u) {
    int tid = F.tid; asm volatile("" : "+v"(tid));
    const int w = F.wave, lane = tid & 63, r32 = lane & 31, hi = lane >> 5, wq = w & 3, eh = w >> 2;
    const int b = u >> 8, h = (u >> 6) & 3, n = u & 63; const size_t row0 = (size_t)b * S_ + n * 128; const float lg2 = ret_lg2(h);
    bf16_t* UA = (bf16_t*)(F.ws + WS_UA); const bf16_t* KVT = (const bf16_t*)(F.ws + WS_KVT);
    LAS unsigned char* R1 = F.lds; LAS unsigned char* R2 = F.lds + 65536;
    __syncthreads();
#pragma unroll
    for (int j = 0; j < 8; ++j) { const int c = tid + 512 * j, row = c >> 4, ch = c & 15; *(LAS bf16x8*)(R1 + KSWZ(row, ch * 16)) = *(const bf16x8*)(KVT + ((size_t)u * 256 + row) * 128 + ch * 8); }
#pragma unroll
    for (int j = 0; j < 4; ++j) { const int c = tid + 512 * j, row = c >> 4, ch = c & 15; *(LAS bf16x8*)(R2 + KSWZ(row, ch * 16)) = *(const bf16x8*)(UA + (row0 + row) * NA_ + 512 + h * 128 + ch * 8); }
    bf16x8 qr[8];
    { const bf16_t* qp = UA + (row0 + 32 * wq + r32) * NA_ + h * 128 + hi * 8;
#pragma unroll
      for (int d0 = 0; d0 < 8; ++d0) qr[d0] = *(const bf16x8*)(qp + d0 * 16); }
    __syncthreads();
    f32x16 o[4] = {};
#pragma unroll
    for (int db = 0; db < 4; ++db) {
#pragma unroll
        for (int d0 = 0; d0 < 8; ++d0) { const bf16x8 bs = *(const LAS bf16x8*)(R1 + KSWZ(128 * eh + 32 * db + r32, (d0 * 16 + hi * 8) * 2)); o[db] = __builtin_amdgcn_mfma_f32_32x32x16_bf16(qr[d0], bs, o[db], 0, 0, 0); }
        asm volatile("" ::: "memory"); }
    const float gm1 = exp2f(lg2), gm2 = gm1 * gm1, gm4 = gm2 * gm2, gm8 = gm4 * gm4, gm16 = gm8 * gm8;
    const float gi1 = exp2f(-lg2), gi2 = gi1 * gi1, gi4 = gi2 * gi2, gi8 = gi4 * gi4, gi16 = gi8 * gi8, gi32 = gi16 * gi16;
    const float ga[4] = {1.0f, gm1, gm2, gm2 * gm1}, gb[4] = {1.0f, gm8, gm16, gm16 * gm8};
    const float ia[4] = {1.0f, gi1, gi2, gi2 * gi1}, ib[4] = {1.0f, gi8, gi16, gi16 * gi8};
    { const float xl = exp2f((float)(32 * wq + 4 * hi + 1) * lg2);
#pragma unroll
      for (int r = 0; r < 16; ++r) { const float xi = xl * (ga[r & 3] * gb[r >> 2]);
#pragma unroll
          for (int db = 0; db < 4; ++db) o[db][r] *= xi; } }
    bf16x8 pa[2][4]; const int cq = 32 * wq + r32;
#define RET_P(ST) do { f32x16 p0, p1; qkt(p0, p1, R2 + (ST) * 16384, qr, r32, hi); const int limq_ = cq - 64 * (ST) - 4 * hi; const float al_ = exp2f((float)limq_ * lg2); \
        _Pragma("unroll") for (int r = 0; r < 16; ++r) { const int cr_ = (r & 3) + 8 * (r >> 2); const float f_ = al_ * (ia[r & 3] * ib[r >> 2]); \
            p0[r] = cr_ <= limq_ ? p0[r] * f_ : 0.f; p1[r] = cr_ + 32 <= limq_ ? p1[r] * (f_ * gi32) : 0.f; } \
        PK4(p0, 0, pa[ST][0]); PK4(p0, 8, pa[ST][1]); PK4(p1, 0, pa[ST][2]); PK4(p1, 8, pa[ST][3]); } while (0)
    RET_P(0);
    if (wq >= 2) RET_P(1);
#undef RET_P
    __syncthreads();
#pragma unroll 4
    for (int j = 0; j < 8; ++j) { const int c = tid + 512 * j, row = c >> 5, col = (c & 31) * 8;
        *(LAS bf16x8*)(R1 + ((row >> 6) * 2 + (col >> 7)) * 16384 + v_st(row & 63, col & 127)) = *(const bf16x8*)(UA + (row0 + row) * NA_ + 1024 + h * 256 + col); }
    __syncthreads();
    const unsigned vb = lds_addr(R1) + v_rd_base(lane) + eh * 16384;
    pv_d0(o, vb, pa[0][0], pa[0][1], pa[0][2], pa[0][3]);
    if (wq >= 2) pv_d0(o, vb + 32768, pa[1][0], pa[1][1], pa[1][2], pa[1][3]);
    LAS float* ssq = (LAS float*)(F.lds + WSCR_OFF);
    float qs[16];
#pragma unroll
    for (int r = 0; r < 16; ++r) { float q = (o[0][r] * o[0][r] + o[1][r] * o[1][r]) + (o[2][r] * o[2][r] + o[3][r] * o[3][r]);
        q += __shfl_xor(q, 1); q += __shfl_xor(q, 2); q += __shfl_xor(q, 4); q += __shfl_xor(q, 8); q += __shfl_xor(q, 16); qs[r] = q;
        if (r32 == 0) ssq[w * 32 + crow(r, hi)] = q; }
    __syncthreads();
    { bf16_t* base = UA + (row0 + 32 * wq) * NA_ + 2048 + h * 256 + 128 * eh + r32;
#pragma unroll
      for (int r = 0; r < 16; ++r) { const float rn = 1.0f / sqrtf((qs[r] + ssq[(w ^ 4) * 32 + crow(r, hi)]) * (1.0f / 256) + EPS_); bf16_t* rp = base + (size_t)crow(r, hi) * NA_;
#pragma unroll
          for (int db = 0; db < 4; ++db) { const float g = bf2f(rp[32 * db]); rp[32 * db] = f2bf(o[db][r] * rn * g); } } }
    LDS_WAIT();
}
#ifndef PG8_SP2
#define PG8_SP2 true
#endif
#ifndef PG8_ALIGN
#define PG8_ALIGN true
#endif
__global__ void __launch_bounds__(NWAVES * 64, 2) mega(MArgs args) {
    extern __shared__ __attribute__((aligned(16))) unsigned char lds_raw[];
    Frame F;
    F.lds = (LAS unsigned char*)lds_raw; F.tid = threadIdx.x; F.lane = F.tid & 63; F.wave = __builtin_amdgcn_readfirstlane(F.tid >> 6); F.G = gridDim.x; F.bid = blockIdx.x;
#pragma unroll
    for (int i = 0; i < 16; ++i) F.in[i] = args.in[i];
    F.out = args.out; F.ws = args.ws;
    for (int u = F.tid; u < (LDS_BYTES - LDSCTL_OFF) / 4; u += NWAVES * 64) ((LAS unsigned*)(F.lds + LDSCTL_OFF))[u] = 0u;
    __syncthreads();
    unsigned* ctl = (unsigned*)(F.ws + WS_CTL);
    XcdBarrier bar = xcd_barrier_post(ctl + CW_BAR + args.li * XCD_BAR_WORDS, (volatile LAS unsigned*)(F.lds + LDSCTL_OFF) + 8);
    const int lo = args.ph_lo, hi = args.ph_hi;
#ifndef PH_ENABLE
#define PH_ENABLE 0x1FF
#endif
#define IN(k) (((PH_ENABLE >> (k)) & 1) && lo <= (k) && (k) < hi)
#define BOTH(k) (IN(k) && IN((k) + 1))

    if (IN(0)) { p0_prologue(F); if (BOTH(0)) xcd_barrier(bar); }
    if (IN(1)) {
        pg8::Gemm g{(const bf16_t*)(F.ws + WS_XB), (const bf16_t*)(F.ws + WS_WINA), T_, NA_, D_, D_}; pg8::StaticOrder S; S.init(T_, NA_, F.G, F.bid);
        pg8::EpiA E{(bf16_t*)(F.ws + WS_UA), (const float*)(F.ws + WS_RS0), (const int*)F.in[2]};
        pg8::gemm_phase<pg8::EpiA, pg8::StaticOrder, PG8_ALIGN, PG8_SP2>(F.lds, g, S, E);
        if (BOTH(1)) xcd_barrier(bar);
    }
    if (IN(2)) {
        for (int u = F.bid; u < 512; u += F.G) kvt_unit(F, u);
        for (int u = F.bid; u < 256; u += F.G) memattn_unit(F, (bf16_t*)(F.ws + WS_UA), NA_, 3072, 3584, 0, u);
        if (BOTH(2)) xcd_barrier(bar);
    }
    if (IN(3)) { scan_phase(F); if (BOTH(3)) xcd_barrier(bar); }
    if (IN(4)) { for (int u = F.bid; u < 512; u += F.G) ret_unit(F, u); if (BOTH(4)) xcd_barrier(bar); }
    if (IN(5)) {
        pg8::Gemm g{(const bf16_t*)(F.ws + WS_UA) + 2048, (const bf16_t*)(F.ws + WS_WOUTA), T_, D_, KO_, NA_}; pg8::StaticOrder S; S.init(T_, D_, F.G, F.bid);
        pg8::EpiOutA E{F.in[0], F.out, (bf16_t*)(F.ws + WS_X1B), (float*)(F.ws + WS_SS1P)};
        pg8::gemm_phase<pg8::EpiOutA, pg8::StaticOrder, PG8_ALIGN, PG8_SP2>(F.lds, g, S, E);
        if (BOTH(5)) xcd_barrier(bar);
    }
    if (IN(6)) {
        pg8::Gemm g{(const bf16_t*)(F.ws + WS_X1B), (const bf16_t*)(F.ws + WS_WB), T_, NBW_, D_, D_}; pg8::StaticOrder S; S.init(T_, NBW_, F.G, F.bid);
        pg8::EpiB E{(bf16_t*)(F.ws + WS_UB), (const float*)(F.ws + WS_SS1P)};
        pg8::gemm_phase<pg8::EpiB, pg8::StaticOrder, PG8_ALIGN, PG8_SP2>(F.lds, g, S, E);
        if (BOTH(6)) xcd_barrier(bar);
    }
    if (IN(7)) {
        for (int u = F.bid; u < 512; u += F.G) sb_unit(F, u >> 8, (u >> 5) & 7, u & 31);
        for (int u = F.bid; u < 256; u += F.G) memattn_unit(F, (bf16_t*)(F.ws + WS_UB), NBW_, 4096, 4608, 1, u);
        if (BOTH(7)) xcd_barrier(bar);
    }
    if (IN(8)) {
        pg8::Gemm g{(const bf16_t*)(F.ws + WS_UB) + 3072, (const bf16_t*)(F.ws + WS_WOUTB), T_, D_, KO_, NBW_}; pg8::StaticOrder S; S.init(T_, D_, F.G, F.bid);
        pg8::EpiOutB E{F.out};
        pg8::gemm_phase<pg8::EpiOutB, pg8::StaticOrder, PG8_ALIGN, PG8_SP2>(F.lds, g, S, E);
    }
#undef IN
#undef BOTH
}

static void launch_mega(const MArgs& base, int lo, int hi, int li, int grid, hipStream_t stream) {
    MArgs a = base; a.ph_lo = lo; a.ph_hi = hi; a.li = li; a.pad = 0;
    hipLaunchKernelGGL(mega, dim3(grid), dim3(NWAVES * 64), LDS_BYTES, stream, a);
}
extern "C" void kernel_launch(void* const* d_in, const int* in_sizes, int n_in, void* d_out, int out_size, void* d_ws, size_t ws_size, hipStream_t stream) {
    static int grid = 0;
    if (grid == 0) {
        int dev = 0, cus = 0;
        if (hipGetDevice(&dev) != hipSuccess || hipDeviceGetAttribute(&cus, hipDeviceAttributeMultiprocessorCount, dev) != hipSuccess) { grid = -1; return; }
        if (hipFuncSetAttribute((const void*)mega, hipFuncAttributeMaxDynamicSharedMemorySize, LDS_BYTES) != hipSuccess) { grid = -1; return; }
        (void)hipGetLastError();
        grid = cus;
    }
    if (grid < 0) return;
    const float* x = (const float*)d_in[0]; const int* pos = (const int*)d_in[2];
    unsigned char* ws = (unsigned char*)d_ws; float* out = (float*)d_out;
    bf16_t* MEMK = (bf16_t*)(ws + WS_MEMK); bf16_t* MEMV = (bf16_t*)(ws + WS_MEMV);
    bf16_t* UA = (bf16_t*)(ws + WS_UA); bf16_t* KVT = (bf16_t*)(ws + WS_KVT); bf16_t* UB = (bf16_t*)(ws + WS_UB);
    (void)x; (void)pos; (void)out;
    (void)hipMemsetAsync(ws + WS_CTL, 0, CTL_ZERO_BYTES, stream);
    MArgs a{};
    for (int i = 0; i < 16; ++i) a.in[i] = (const float*)d_in[i];
    a.out = out; a.ws = ws;
    int li = 0;
    for (int p = 0; p < 9;) {
        if ((OPT_MASK >> p) & 1) { int q = p; while (q < 9 && ((OPT_MASK >> q) & 1)) ++q; launch_mega(a, p, q, li++, grid, stream); p = q; continue; }
        switch (p) {
        case 2: n2_kv<<<512 * 4, 256, 0, stream>>>(UA, KVT); n_memattn<<<T_, 256, 0, stream>>>(UA, NA_, 3072, 3584, MEMK, MEMV, 0); break;
        case 3: n3_scan<<<(8 * 32768) / 256, 256, 0, stream>>>(KVT); break;
        case 4: n4_ret<<<512 * 128, 256, 0, stream>>>(UA, KVT); break;
        case 7: n7_sb<<<NB_ * 8 * S_, 256, 0, stream>>>(UB); n_memattn<<<T_, 256, 0, stream>>>(UB, NBW_, 4096, 4608, MEMK, MEMV, 1); break;
        default: break;
        }
        ++p;
    }
}
```

```cpp
#include <hip/hip_runtime.h>
#include <stdint.h>

typedef unsigned short bf16_t;

constexpr int NB_ = 2, S_ = 8192, T_ = NB_ * S_, D_ = 1024;
constexpr int NA_ = 4096, NBW_ = 5120, KO_ = 1536;
constexpr float EPS_ = 1e-6f;
constexpr float QK_SCALE = 0.08838834764831845f;

constexpr size_t MiB = 1u << 20;
constexpr size_t WS_CTL = 0;
constexpr size_t WS_WINA = 1 * MiB;
constexpr size_t WS_WOUTA = 9 * MiB;
constexpr size_t WS_WB = 12 * MiB;
constexpr size_t WS_WOUTB = 22 * MiB;
constexpr size_t WS_MEMK = 25 * MiB;
constexpr size_t WS_MEMV = 26 * MiB;
constexpr size_t WS_RS0 = 27 * MiB;
constexpr size_t WS_SS1P = 28 * MiB;
constexpr size_t WS_UA = 30 * MiB;
constexpr size_t WS_KVT = 158 * MiB;
constexpr size_t WS_XB = 190 * MiB;
constexpr size_t WS_X1B = 190 * MiB;
constexpr size_t WS_UB = 30 * MiB;


__device__ __forceinline__ float bf2f(bf16_t v) { return __uint_as_float(((unsigned)v) << 16); }
__device__ __forceinline__ bf16_t f2bf(float f) { unsigned u = __float_as_uint(f); u += 0x7fffu + ((u >> 16) & 1u); return (bf16_t)(u >> 16); }
__device__ __forceinline__ float silu_f(float v) { return v / (1.0f + __expf(-v)); }
__device__ __forceinline__ float softplus_f(float z) { return fmaxf(z, 0.f) + log1pf(__expf(-fabsf(z))); }
__device__ __forceinline__ float ret_lg(int h) { return logf(1.0f - exp2f(-5.0f - (float)h)); }

__device__ __forceinline__ void rot_sincos(float ang, float& s, float& c) {
    const float n = rintf(ang * 0.15915494309189535f);
    float r = fmaf(-n, 6.28318548202514648f, ang);
    r = fmaf(-n, -1.74845553e-7f, r);
    const float rev = r * 0.15915494309189535f;
    s = __builtin_amdgcn_sinf(rev); c = __builtin_amdgcn_cosf(rev);
}
__device__ __forceinline__ float rope_inv_freq(int i) { return exp2f(-(float)i * 0.20762050593046014f); }

__global__ __launch_bounds__(256) void n0_x(const float* __restrict__ x, bf16_t* __restrict__ xb, float* __restrict__ rs) {
    const int row = blockIdx.x * 4 + (threadIdx.x >> 6), lane = threadIdx.x & 63;
    const float* xr = x + (size_t)row * D_; float s = 0.f;
    for (int j = lane; j < D_; j += 64) { const float v = xr[j]; s += v * v; xb[(size_t)row * D_ + j] = f2bf(v); }
    for (int o = 32; o; o >>= 1) s += __shfl_xor(s, o);
    if (lane == 0) rs[row] = 1.0f / sqrtf(s * (1.0f / D_) + EPS_);
}

struct WArgs { const float* w_in_a; const float* w_out_a; const float* w_kv; const float* w_in_b; const float* w_out_b;
               const float* g_norm_a; const float* g_ret_head; const float* g_kv; const float* g_norm_b; };
__device__ __forceinline__ int permA_src(int n) {
    if (n >= 1024) return n;
    const int tile = n >> 8, c = n & 255, bj = c >> 7, p = c & 127, hit = p >> 6, i = p & 63;
    return tile * 256 + hit * 128 + bj * 64 + i;
}
__global__ __launch_bounds__(256) void n0_w(WArgs a, int mode, bf16_t* __restrict__ out) {
    const int K = (mode == 0 || mode == 2) ? 1024 : 1536;
    const int N = mode == 0 ? 4096 : (mode == 2 ? 5120 : 1024);
    const size_t idx = (size_t)blockIdx.x * 256 + threadIdx.x; if (idx >= (size_t)N * K) return;
    const int k = (int)(idx % K), n = (int)(idx / K);
    float v;
    if (mode == 0) v = a.w_in_a[(size_t)k * 4096 + permA_src(n)] * a.g_norm_a[k];
    else if (mode == 1) v = a.w_out_a[(size_t)k * 1024 + n] * (k < 1024 ? a.g_ret_head[k & 255] : 1.0f);
    else if (mode == 2) {
        if (n < 2048) v = a.w_kv[(size_t)k * 2048 + n] * a.g_kv[k];
        else { const int c = n - 2048; const int src = c < 1024 ? 1024 + c : (c < 2048 ? c - 1024 : c);
               v = a.w_in_b[(size_t)k * 3072 + src] * a.g_norm_b[k]; }
    } else v = a.w_out_b[(size_t)k * 1024 + n];
    out[idx] = f2bf(v);
}

__global__ __launch_bounds__(256) void n0_mem(const float* __restrict__ mem, const float* __restrict__ g_mem, const float* __restrict__ w_mem_kv,
                                              const float* __restrict__ g_mem_q, const float* __restrict__ g_mem_k, bf16_t* __restrict__ memK, bf16_t* __restrict__ memV) {
    __shared__ float sm[1024]; __shared__ float skv[1024]; __shared__ float red[256]; __shared__ float hn[4];
    const int l = blockIdx.x >> 9, b = (blockIdx.x >> 8) & 1, m = blockIdx.x & 255, tid = threadIdx.x;
    const float* mr = mem + ((size_t)b * 256 + m) * D_;
    float s = 0.f; for (int j = tid; j < D_; j += 256) { const float v = mr[j]; s += v * v; }
    red[tid] = s; __syncthreads();
    for (int o = 128; o; o >>= 1) { if (tid < o) red[tid] += red[tid + o]; __syncthreads(); }
    const float r = 1.0f / sqrtf(red[0] * (1.0f / D_) + EPS_);
    for (int j = tid; j < D_; j += 256) sm[j] = mr[j] * r * g_mem[l * D_ + j];
    __syncthreads();
    const float* W = w_mem_kv + (size_t)l * D_ * 1024;
    float acc[4] = {0.f, 0.f, 0.f, 0.f};
    for (int k = 0; k < D_; ++k) { const float a = sm[k];
#pragma unroll
        for (int j = 0; j < 4; ++j) acc[j] += a * W[(size_t)k * 1024 + tid + 256 * j]; }
#pragma unroll
    for (int j = 0; j < 4; ++j) skv[tid + 256 * j] = acc[j];
    __syncthreads();
    if (tid < 4) { float q = 0.f; for (int d = 0; d < 128; ++d) { const float v = skv[tid * 128 + d]; q += v * v; } hn[tid] = 1.0f / sqrtf(q * (1.0f / 128) + EPS_); }
    __syncthreads();
    for (int j = tid; j < 512; j += 256) { const int h = j >> 7, d = j & 127;
        const size_t o = ((((size_t)l * 2 + b) * 4 + h) * 256 + m) * 128 + d;
        memK[o] = f2bf(skv[j] * hn[h] * g_mem_k[l * 128 + d] * g_mem_q[l * 128 + d] * QK_SCALE);
        memV[o] = f2bf(skv[512 + j]); }
}

struct GArgs { const bf16_t* A; int lda; const bf16_t* Bt; int K; int N;
               const float* rs0; const int* pos; bf16_t* U; const float* xres; float* out; bf16_t* x1b; float* ss1p; };
template <int EPI> __global__ __launch_bounds__(256) void n_gemm(GArgs g) {
    __shared__ float sA[16][36]; __shared__ float sC[16][257];
    const int ntn = g.N / 256, pm = blockIdx.x / ntn, pn = blockIdx.x % ntn, row0 = pm * 16, c = threadIdx.x;
    const bf16_t* brow = g.Bt + (size_t)(pn * 256 + c) * g.K;
    float acc[16];
#pragma unroll
    for (int r = 0; r < 16; ++r) acc[r] = 0.f;
    for (int k0 = 0; k0 < g.K; k0 += 32) {
        __syncthreads();
        for (int e = threadIdx.x; e < 512; e += 256) { const int r = e >> 5, kk = e & 31; sA[r][kk] = bf2f(g.A[(size_t)(row0 + r) * g.lda + k0 + kk]); }
        __syncthreads();
#pragma unroll
        for (int j = 0; j < 4; ++j) { const uint4 bv = *(const uint4*)(brow + k0 + 8 * j); const unsigned w[4] = {bv.x, bv.y, bv.z, bv.w};
#pragma unroll
            for (int q = 0; q < 4; ++q) { const float b0 = __uint_as_float(w[q] << 16), b1 = __uint_as_float(w[q] & 0xffff0000u); const int kk = 8 * j + 2 * q;
#pragma unroll
                for (int r = 0; r < 16; ++r) acc[r] += sA[r][kk] * b0 + sA[r][kk + 1] * b1; } }
    }
#pragma unroll
    for (int r = 0; r < 16; ++r) sC[r][c] = acc[r];
    __syncthreads();
    if (EPI == 0) {
        for (int r = 0; r < 16; ++r) { const int row = row0 + r; const float rs = g.rs0[row]; bf16_t* urow = g.U + (size_t)row * NA_;
            if (pn < 4) { if (c < 128) { const int hit = c >> 6, i = c & 63; const float x1 = sC[r][c] * rs, x2 = sC[r][c + 128] * rs;
                    float sn, cs; rot_sincos((float)g.pos[row] * rope_inv_freq(i), sn, cs); const float sc = pn >= 2 ? QK_SCALE : 1.0f;
                    urow[pn * 256 + hit * 128 + i] = f2bf((x1 * cs - x2 * sn) * sc); urow[pn * 256 + hit * 128 + 64 + i] = f2bf((x1 * sn + x2 * cs) * sc); } }
            else { const float v = sC[r][c] * rs; const bool silu = (pn >= 8 && pn < 12) || pn >= 14; urow[pn * 256 + c] = f2bf(silu ? silu_f(v) : v); } }
    } else if (EPI == 1) {
        for (int r = 0; r < 16; ++r) { const size_t o = (size_t)(row0 + r) * D_ + pn * 256 + c; const float v = g.xres[o] + sC[r][c]; g.out[o] = v; g.x1b[o] = f2bf(v); sC[r][c] = v * v; }
        __syncthreads();
        if (c < 16) { float s = 0.f; for (int j = 0; j < 256; ++j) s += sC[c][j]; float* p = g.ss1p + (size_t)(row0 + c) * 16 + pn * 4; p[0] = s; p[1] = 0.f; p[2] = 0.f; p[3] = 0.f; }
    } else if (EPI == 2) {
        for (int r = 0; r < 16; ++r) { const int row = row0 + r; const float* sp = g.ss1p + (size_t)row * 16; float ss = 0.f; for (int j = 0; j < 16; ++j) ss += sp[j];
            const float rs = 1.0f / sqrtf(ss * (1.0f / D_) + EPS_); float v = sC[r][c] * rs;
            if ((pn >= 8 && pn < 12) || pn >= 18) v = silu_f(v); else if (pn >= 12 && pn < 16) v *= QK_SCALE;
            g.U[(size_t)row * NBW_ + pn * 256 + c] = f2bf(v); }
    } else {
        for (int r = 0; r < 16; ++r) { const size_t o = (size_t)(row0 + r) * D_ + pn * 256 + c; g.out[o] = g.out[o] + sC[r][c]; }
    }
}

__global__ __launch_bounds__(256) void n2_kv(const bf16_t* __restrict__ UA, bf16_t* __restrict__ KVT) {
    const int u = blockIdx.x >> 2, eg = blockIdx.x & 3, tid = threadIdx.x, e = eg * 64 + (tid & 63), dq = tid >> 6;
    const int b = u >> 8, h = (u >> 6) & 3, n = u & 63; const size_t row0 = (size_t)b * S_ + n * 128; const float lg = ret_lg(h);
    float acc[32];
#pragma unroll
    for (int j = 0; j < 32; ++j) acc[j] = 0.f;
    for (int m = 0; m < 128; ++m) { const bf16_t* ur = UA + (row0 + m) * NA_; const float vz = bf2f(ur[1024 + h * 256 + e]) * __expf((float)(127 - m) * lg);
#pragma unroll
        for (int j = 0; j < 32; ++j) acc[j] += vz * bf2f(ur[512 + h * 128 + dq * 32 + j]); }
#pragma unroll
    for (int j = 0; j < 32; ++j) KVT[((size_t)u * 256 + e) * 128 + dq * 32 + j] = f2bf(acc[j]);
}
__global__ __launch_bounds__(256) void n3_scan(bf16_t* __restrict__ KVT) {
    const int idx = blockIdx.x * 256 + threadIdx.x; const int bh = idx >> 15, off = idx & 32767; const float gc = __expf(128.0f * ret_lg(bh & 3));
    float s = 0.f;
    for (int n = 0; n < 64; ++n) { bf16_t* p = KVT + ((size_t)(bh * 64 + n) << 15) + off; const float t = bf2f(*p); *p = f2bf(s); s = gc * s + t; }
}
__global__ __launch_bounds__(256) void n4_ret(bf16_t* __restrict__ UA, const bf16_t* __restrict__ KVT) {
    __shared__ float sq[128], ss[128], red[256];
    const int u = blockIdx.x >> 7, c = blockIdx.x & 127, tid = threadIdx.x; const int b = u >> 8, h = (u >> 6) & 3, n = u & 63;
    const size_t row0 = (size_t)b * S_ + n * 128, row = row0 + c; const float lg = ret_lg(h);
    if (tid < 128) sq[tid] = bf2f(UA[row * NA_ + h * 128 + tid]);
    __syncthreads();
    if (tid < 128) { float d = 0.f; if (tid <= c) { const bf16_t* kr = UA + (row0 + tid) * NA_ + 512 + h * 128; for (int j = 0; j < 128; ++j) d += sq[j] * bf2f(kr[j]); d *= __expf((float)(c - tid) * lg); } ss[tid] = d; }
    __syncthreads();
    const int e = tid; float o = 0.f;
    for (int m = 0; m <= c; ++m) o += ss[m] * bf2f(UA[(row0 + m) * NA_ + 1024 + h * 256 + e]);
    float cr = 0.f; const bf16_t* st = KVT + ((size_t)u * 256 + e) * 128; for (int j = 0; j < 128; ++j) cr += sq[j] * bf2f(st[j]);
    o += __expf((float)(c + 1) * lg) * cr;
    red[tid] = o * o; __syncthreads();
    for (int w = 128; w; w >>= 1) { if (tid < w) red[tid] += red[tid + w]; __syncthreads(); }
    const float r = 1.0f / sqrtf(red[0] * (1.0f / 256) + EPS_);
    bf16_t* gp = UA + row * NA_ + 2048 + h * 256 + e; *gp = f2bf(o * r * bf2f(*gp));
}
__global__ __launch_bounds__(256) void n_memattn(bf16_t* __restrict__ U, int ld, int qoff, int goff, const bf16_t* __restrict__ memK, const bf16_t* __restrict__ memV, int layer) {
    __shared__ float sq[4][128]; __shared__ float sp[4][256];
    const int w = threadIdx.x >> 6, lane = threadIdx.x & 63; const int gw = blockIdx.x * 4 + w, row = gw >> 2, hd = gw & 3, b = row / S_;
    bf16_t* qp = U + (size_t)row * ld + qoff + hd * 128; const bf16_t* gp = U + (size_t)row * ld + goff + hd * 128;
    const float q0 = bf2f(qp[lane]), q1 = bf2f(qp[lane + 64]); sq[w][lane] = q0; sq[w][lane + 64] = q1;
    float s = q0 * q0 + q1 * q1; for (int o = 32; o; o >>= 1) s += __shfl_xor(s, o);
    const float rq = 1.0f / sqrtf(s * (1.0f / 128) + EPS_);
    __syncthreads();
    const bf16_t* Kb = memK + (((size_t)layer * 2 + b) * 4 + hd) * 256 * 128; const bf16_t* Vb = memV + (((size_t)layer * 2 + b) * 4 + hd) * 256 * 128;
    float lgt[4]; float mx = -1e30f;
    for (int j = 0; j < 4; ++j) { const bf16_t* kr = Kb + (size_t)(lane + 64 * j) * 128; float d = 0.f; for (int t = 0; t < 128; ++t) d += sq[w][t] * bf2f(kr[t]); lgt[j] = d * rq; mx = fmaxf(mx, lgt[j]); }
    for (int o = 32; o; o >>= 1) mx = fmaxf(mx, __shfl_xor(mx, o));
    float ps = 0.f; for (int j = 0; j < 4; ++j) { lgt[j] = __expf(lgt[j] - mx); ps += lgt[j]; }
    for (int o = 32; o; o >>= 1) ps += __shfl_xor(ps, o);
    for (int j = 0; j < 4; ++j) sp[w][lane + 64 * j] = lgt[j] / ps;
    __syncthreads();
    float o0 = 0.f, o1 = 0.f;
    for (int m = 0; m < 256; ++m) { const float p = sp[w][m]; o0 += p * bf2f(Vb[(size_t)m * 128 + lane]); o1 += p * bf2f(Vb[(size_t)m * 128 + lane + 64]); }
    const float g0 = bf2f(gp[lane]), g1 = bf2f(gp[lane + 64]);
    qp[lane] = f2bf(o0 * g0); qp[lane + 64] = f2bf(o1 * g1);
}
#ifndef NAIVE_SB_EXIT
#define NAIVE_SB_EXIT 1
#endif
__global__ __launch_bounds__(256) void n7_sb(bf16_t* __restrict__ UB) {
    __shared__ float sq[128]; __shared__ float sa[256]; __shared__ float wtot[4]; __shared__ float wpre[4];
    const int t = blockIdx.x & (S_ - 1), h = (blockIdx.x >> 13) & 7, b = blockIdx.x >> 16, tid = threadIdx.x, lane = tid & 63, w = tid >> 6;
    const size_t rowb = (size_t)b * S_; bf16_t* qp = UB + (rowb + t) * NBW_ + 3072 + h * 128;
    if (tid < 128) sq[tid] = bf2f(qp[tid]);
    __syncthreads();
    float carry = 0.f, od = 0.f;
    for (int s_hi = t - 1; s_hi >= 0; s_hi -= 256) {
        const int s = s_hi - tid; const bool valid = s >= 0;
        float z = 0.f; if (valid) { const bf16_t* kr = UB + (rowb + s) * NBW_ + h * 128; for (int j = 0; j < 128; ++j) z += sq[j] * bf2f(kr[j]); }
        const float spv = softplus_f(z); const float lf = valid ? -spv : 0.f;
        float inc = lf;
        for (int o = 1; o < 64; o <<= 1) { const float v = __shfl_up(inc, o); if (lane >= o) inc += v; }
        if (lane == 63) wtot[w] = inc;
        __syncthreads();
        if (tid == 0) { float a = 0.f; for (int j = 0; j < 4; ++j) { wpre[j] = a; a += wtot[j]; } }
        __syncthreads();
        const float pre = wpre[w] + inc - lf;
        const float tot = wpre[3] + wtot[3];
        sa[tid] = valid ? __expf((z - spv) + pre + carry) : 0.f;
        __syncthreads();
        if (tid < 128) { const int cnt = min(256, s_hi + 1); const bf16_t* vb = UB + rowb * NBW_ + 1024 + h * 128 + tid;
            for (int i = 0; i < cnt; ++i) od += sa[i] * bf2f(vb[(size_t)(s_hi - i) * NBW_]); }
        carry += tot;
        __syncthreads();
        if (NAIVE_SB_EXIT && carry < -104.0f) break;
    }
    if (tid < 128) { const float g = bf2f(UB[(rowb + t) * NBW_ + 2048 + h * 128 + tid]); qp[tid] = f2bf(od * g); }
}


namespace pg8 {
#define PG8_LAS __attribute__((address_space(3)))
typedef unsigned short bf16_t;
typedef short bf16x8 __attribute__((ext_vector_type(8)));
typedef float f32x4 __attribute__((ext_vector_type(4)));
typedef unsigned u32x4 __attribute__((ext_vector_type(4)));
constexpr int BM = 256, BK = 64, HALF = 128, HTB = HALF * BK * 2  , STAGE_BYTES = 8 * HTB, NXCD = 8, WGM = 8;

__host__ __device__ __forceinline__ int lds_byte(int r, int c) { const int st = (r >> 4) * 2 + (c >> 5), rr = r & 15, cc = c & 31, ob = rr * 64 + cc * 2; return st * 1024 + (ob ^ (((ob >> 9) & 1) << 5)); }
__host__ __device__ __forceinline__ void stage_rc(int b, int& R, int& C) { const int st = b / 1024, sb = b % 1024, swz = sb ^ (((sb >> 9) & 1) << 5); R = (st >> 1) * 16 + swz / 64; C = (st & 1) * 32 + (swz % 64) / 2; }
__host__ __device__ __forceinline__ int perm32(int rho) { const int n = rho >> 4, i = rho & 15; return 8 * (i >> 2) + 4 * n + (i & 3); }

struct Unit { int pm, pn; };
struct Gemm { const bf16_t* A; const bf16_t* Bt; int M, N, K, lda; };

struct StaticOrder {
    int nM, nN, nwg, G, c;
    __host__ __device__ void init(int M, int N, int G_, int c_) { nM = M / BM; nN = N / BM; nwg = nM * nN; G = G_; c = c_; }
    __host__ __device__ bool next(int i, Unit& u) const {
        const long L = (long)i * G + c; if (L >= nwg) return false;
        int wgid = (int)L; { const int q = nwg / NXCD, r = nwg % NXCD, xcd = wgid % NXCD, off = wgid / NXCD; wgid = (xcd < r ? xcd * (q + 1) : r * (q + 1) + (xcd - r) * q) + off; }
        const int nig = WGM * nN, gid = wgid / nig, fm = gid * WGM, gsz = (nM - fm) < WGM ? (nM - fm) : WGM;
        u.pm = fm + ((wgid % nig) % gsz); u.pn = (wgid % nig) / gsz; return true;
    }
    __device__ __forceinline__ void a_ready(const Unit&) const {}
    __device__ __forceinline__ void done(const Unit&) const {}
};

__device__ __forceinline__ unsigned cvt_pk_bf16(float lo, float hi) { unsigned r; asm volatile("v_cvt_pk_bf16_f32 %0, %1, %2" : "=v"(r) : "v"(lo), "v"(hi)); return r; }
__device__ __forceinline__ float silu_fast(float v) { return v * __builtin_amdgcn_rcpf(1.0f + __builtin_amdgcn_exp2f(-1.4426950408889634f * v)); }
__device__ __forceinline__ u32x4 pack8(const f32x4 a, const f32x4 b) { u32x4 w; w.x = cvt_pk_bf16(a[0], a[1]); w.y = cvt_pk_bf16(a[2], a[3]); w.z = cvt_pk_bf16(b[0], b[1]); w.w = cvt_pk_bf16(b[2], b[3]); return w; }

struct EpiA {
    static constexpr bool PERM = true, AFTER_DRAIN = false, ACC_INIT = false;
    bf16_t* U; const float* rs0; const int* pos;
    __device__ __forceinline__ void operator()(const f32x4 (&acc)[2][2][4][2], const Unit& u, int wr, int wc, int fr, int fq) const {
        const int row0 = u.pm * BM + wr * 64 + fr;
        if (u.pn < 4) {
            const int hit = wc >> 1, i0 = 32 * (wc & 1) + 8 * fq; const float sc = u.pn >= 2 ? QK_SCALE : 1.0f;
            float inv[8];
#pragma unroll
            for (int j = 0; j < 8; ++j) inv[j] = rope_inv_freq(i0 + j);
#pragma unroll
            for (int ai = 0; ai < 2; ++ai)
#pragma unroll
                for (int m = 0; m < 4; ++m) { const int row = row0 + ai * HALF + m * 16; const float rs = rs0[row] * sc, pf = (float)pos[row];
                    bf16_t* up = U + (size_t)row * NA_ + u.pn * BM + hit * 128 + i0;
                    f32x4 o1[2], o2[2];
#pragma unroll
                    for (int n = 0; n < 2; ++n)
#pragma unroll
                        for (int e = 0; e < 4; ++e) { float sn, cs; rot_sincos(pf * inv[4 * n + e], sn, cs); const float x1 = acc[ai][0][m][n][e] * rs, x2 = acc[ai][1][m][n][e] * rs;
                            o1[n][e] = x1 * cs - x2 * sn; o2[n][e] = x1 * sn + x2 * cs; }
                    *(u32x4*)up = pack8(o1[0], o1[1]); *(u32x4*)(up + 64) = pack8(o2[0], o2[1]); }
        } else {
            const bool silu = (u.pn >= 8 && u.pn < 12) || u.pn >= 14;
#pragma unroll
            for (int ai = 0; ai < 2; ++ai)
#pragma unroll
                for (int m = 0; m < 4; ++m) { const int row = row0 + ai * HALF + m * 16; const float rs = rs0[row]; bf16_t* rowp = U + (size_t)row * NA_ + u.pn * BM + wc * 32 + 8 * fq;
#pragma unroll
                    for (int bj = 0; bj < 2; ++bj) { f32x4 v0 = acc[ai][bj][m][0] * rs, v1 = acc[ai][bj][m][1] * rs;
                        if (silu) {
#pragma unroll
                            for (int e = 0; e < 4; ++e) { v0[e] = silu_fast(v0[e]); v1[e] = silu_fast(v1[e]); } }
                        *(u32x4*)(rowp + bj * HALF) = pack8(v0, v1); } }
        }
    }
};
struct EpiOutA {
    static constexpr bool PERM = true, AFTER_DRAIN = false, ACC_INIT = true;
    const float* xres; float* out; bf16_t* x1b; float* ss1p;
    __device__ __forceinline__ void init(f32x4 (&acc)[2][2][4][2], const Unit& u, int wr, int wc, int fr, int fq) const {
        const int row0 = u.pm * BM + wr * 64 + fr;
#pragma unroll
        for (int ai = 0; ai < 2; ++ai)
#pragma unroll
            for (int m = 0; m < 4; ++m) { const size_t off = (size_t)(row0 + ai * HALF + m * 16) * D_ + u.pn * BM + wc * 32 + 8 * fq;
#pragma unroll
                for (int bj = 0; bj < 2; ++bj) { acc[ai][bj][m][0] = *(const f32x4*)(xres + off + bj * HALF); acc[ai][bj][m][1] = *(const f32x4*)(xres + off + bj * HALF + 4); } }
    }
    __device__ __forceinline__ void operator()(const f32x4 (&acc)[2][2][4][2], const Unit& u, int wr, int wc, int fr, int fq) const {
        const int row0 = u.pm * BM + wr * 64 + fr;
#pragma unroll
        for (int ai = 0; ai < 2; ++ai)
#pragma unroll
            for (int m = 0; m < 4; ++m) { const int row = row0 + ai * HALF + m * 16; const size_t off = (size_t)row * D_ + u.pn * BM + wc * 32 + 8 * fq; float ssq = 0.f;
#pragma unroll
                for (int bj = 0; bj < 2; ++bj) { const f32x4 v0 = acc[ai][bj][m][0], v1 = acc[ai][bj][m][1];
                    *(f32x4*)(out + off + bj * HALF) = v0; *(f32x4*)(out + off + bj * HALF + 4) = v1; *(u32x4*)(x1b + off + bj * HALF) = pack8(v0, v1);
                    ssq += (v0[0] * v0[0] + v0[1] * v0[1]) + (v0[2] * v0[2] + v0[3] * v0[3]) + (v1[0] * v1[0] + v1[1] * v1[1]) + (v1[2] * v1[2] + v1[3] * v1[3]); }
                ssq += __shfl_xor(ssq, 16); ssq += __shfl_xor(ssq, 32);
                if (fq == 0) ss1p[(size_t)row * 16 + u.pn * 4 + wc] = ssq; }
    }
};
struct EpiB {
    static constexpr bool PERM = true, AFTER_DRAIN = false, ACC_INIT = false;
    bf16_t* U; const float* ss1p;
    __device__ __forceinline__ void operator()(const f32x4 (&acc)[2][2][4][2], const Unit& u, int wr, int wc, int fr, int fq) const {
        const int row0 = u.pm * BM + wr * 64 + fr; const bool silu = (u.pn >= 8 && u.pn < 12) || u.pn >= 18; const float sc = (u.pn >= 12 && u.pn < 16) ? QK_SCALE : 1.0f;
#pragma unroll
        for (int ai = 0; ai < 2; ++ai)
#pragma unroll
            for (int m = 0; m < 4; ++m) { const int row = row0 + ai * HALF + m * 16; const f32x4 pv = *(const f32x4*)(ss1p + (size_t)row * 16 + 4 * fq);
                float s = (pv[0] + pv[1]) + (pv[2] + pv[3]); s += __shfl_xor(s, 16); s += __shfl_xor(s, 32);
                const float rs = sc / sqrtf(s * (1.0f / D_) + EPS_); bf16_t* rowp = U + (size_t)row * NBW_ + u.pn * BM + wc * 32 + 8 * fq;
#pragma unroll
                for (int bj = 0; bj < 2; ++bj) { f32x4 v0 = acc[ai][bj][m][0] * rs, v1 = acc[ai][bj][m][1] * rs;
                    if (silu) {
#pragma unroll
                        for (int e = 0; e < 4; ++e) { v0[e] = silu_fast(v0[e]); v1[e] = silu_fast(v1[e]); } }
                    *(u32x4*)(rowp + bj * HALF) = pack8(v0, v1); } }
    }
};
struct EpiOutB {
    static constexpr bool PERM = true, AFTER_DRAIN = false, ACC_INIT = true;
    float* out;
    __device__ __forceinline__ void init(f32x4 (&acc)[2][2][4][2], const Unit& u, int wr, int wc, int fr, int fq) const {
        const int row0 = u.pm * BM + wr * 64 + fr;
#pragma unroll
        for (int ai = 0; ai < 2; ++ai)
#pragma unroll
            for (int m = 0; m < 4; ++m) { const size_t off = (size_t)(row0 + ai * HALF + m * 16) * D_ + u.pn * BM + wc * 32 + 8 * fq;
#pragma unroll
                for (int bj = 0; bj < 2; ++bj) { acc[ai][bj][m][0] = *(const f32x4*)(out + off + bj * HALF); acc[ai][bj][m][1] = *(const f32x4*)(out + off + bj * HALF + 4); } }
    }
    __device__ __forceinline__ void operator()(const f32x4 (&acc)[2][2][4][2], const Unit& u, int wr, int wc, int fr, int fq) const {
        const int row0 = u.pm * BM + wr * 64 + fr;
#pragma unroll
        for (int ai = 0; ai < 2; ++ai)
#pragma unroll
            for (int m = 0; m < 4; ++m) { const size_t off = (size_t)(row0 + ai * HALF + m * 16) * D_ + u.pn * BM + wc * 32 + 8 * fq;
#pragma unroll
                for (int bj = 0; bj < 2; ++bj) { *(f32x4*)(out + off + bj * HALF) = acc[ai][bj][m][0]; *(f32x4*)(out + off + bj * HALF + 4) = acc[ai][bj][m][1]; } }
    }
};

template <class Epi, class Sched, bool ALIGN_EPI = false, bool SP2 = false>
__device__ __forceinline__ void gemm_phase(PG8_LAS unsigned char* lds, const Gemm g, const Sched& S, const Epi& E) {
    const int tid = threadIdx.x, wid = __builtin_amdgcn_readfirstlane(tid >> 6), lane = tid & 63, wr = wid >> 2, wc = wid & 3, fr = lane & 15, fq = lane >> 4;
    const int K = g.K, nt = K / BK;
    unsigned voffA[2], voffB[2];
#pragma unroll
    for (int i = 0; i < 2; ++i) { int R, C; stage_rc(tid * 16 + i * 8192, R, C); const int Rb = Epi::PERM ? ((R & ~31) + perm32(R & 31)) : R;
        voffA[i] = (unsigned)(R * g.lda + C) * 2u; voffB[i] = (unsigned)(Rb * K + C) * 2u; }
    const size_t kstep = (size_t)(BK * 2);
    const size_t hstepA = (size_t)HALF * g.lda * 2, hstepB = (size_t)HALF * K * 2;
    const size_t tstepA = 2 * hstepA, tstepB = 2 * hstepB;
    const unsigned ldsw = (unsigned)wid * 1024u;
    const int aoff = lds_byte(wr * 64 + fr, fq * 8), boff = lds_byte(wc * 32 + fr, fq * 8);
#define PG8_SA(b, h) (((b) * 2 + (h)) * HTB)
#define PG8_SB(b, h) ((4 + (b) * 2 + (h)) * HTB)
#define PG8_STAGE(bufoff, gbase, voff) do { _Pragma("unroll") for (int _i = 0; _i < 2; ++_i) \
        __builtin_amdgcn_global_load_lds((const unsigned*)((const char*)(gbase) + (voff)[_i]), (PG8_LAS unsigned*)(lds + (bufoff) + ldsw + _i * 8192), 16, 0, 0); } while (0)
#define PG8_LDA(dst, b, h) do { _Pragma("unroll") for (int m = 0; m < 4; ++m) _Pragma("unroll") for (int k = 0; k < 2; ++k) dst[m][k] = *(const PG8_LAS bf16x8*)(lds + PG8_SA(b, h) + aoff + m * 2048 + k * 1024); } while (0)
#define PG8_LDB(dst, b, h) do { _Pragma("unroll") for (int n = 0; n < 2; ++n) _Pragma("unroll") for (int k = 0; k < 2; ++k) dst[n][k] = *(const PG8_LAS bf16x8*)(lds + PG8_SB(b, h) + boff + n * 2048 + k * 1024); } while (0)
#define PG8_MMA(ai, bj, At, Bt) do { __builtin_amdgcn_s_setprio(1); _Pragma("unroll") for (int m = 0; m < 4; ++m) _Pragma("unroll") for (int n = 0; n < 2; ++n) _Pragma("unroll") for (int k = 0; k < 2; ++k) \
        acc[ai][bj][m][n] = __builtin_amdgcn_mfma_f32_16x16x32_bf16(Bt[n][k], At[m][k], acc[ai][bj][m][n], 0, 0, 0); __builtin_amdgcn_s_setprio(0); } while (0)
#define PG8_WAIT_V(n) asm volatile("s_waitcnt vmcnt(" #n ")" ::: "memory")
#define PG8_WAIT_L(n) asm volatile("s_waitcnt lgkmcnt(" #n ")" ::: "memory")
#define PG8_BAR __builtin_amdgcn_s_barrier()
#define PG8_SCHED __builtin_amdgcn_sched_barrier(0)
    Unit cur, nxt; int ui = 0;
    if (!S.next(0, cur)) return;
    f32x4 acc[2][2][4][2];
#pragma unroll
    for (int a = 0; a < 2; ++a)
#pragma unroll
        for (int b = 0; b < 2; ++b)
#pragma unroll
            for (int m = 0; m < 4; ++m)
#pragma unroll
                for (int n = 0; n < 2; ++n) acc[a][b][m][n] = (f32x4){0.f, 0.f, 0.f, 0.f};
    if constexpr (Epi::ACC_INIT) E.init(acc, cur, wr, wc, fr, fq);
    bf16x8 At[4][2], B0[2][2], B1[2][2];
    const char* cA = (const char*)g.A + (size_t)cur.pm * tstepA; const char* cB = (const char*)g.Bt + (size_t)cur.pn * tstepB;
    S.a_ready(cur);
    if constexpr (SP2) {
        PG8_STAGE(PG8_SB(0, 0), cB, voffB); PG8_STAGE(PG8_SB(0, 1), cB + hstepB, voffB); PG8_STAGE(PG8_SA(0, 0), cA, voffA); PG8_STAGE(PG8_SA(0, 1), cA + hstepA, voffA);
        if (wr == 1) PG8_BAR;
        PG8_WAIT_V(2); PG8_BAR;
        PG8_STAGE(PG8_SB(1, 0), cB + kstep, voffB); PG8_STAGE(PG8_SA(1, 0), cA + kstep, voffA); PG8_STAGE(PG8_SB(1, 1), cB + hstepB + kstep, voffB);
        PG8_WAIT_V(6); PG8_BAR;
    } else {
        PG8_STAGE(PG8_SB(0, 0), cB, voffB); PG8_STAGE(PG8_SA(0, 0), cA, voffA); PG8_STAGE(PG8_SB(0, 1), cB + hstepB, voffB); PG8_STAGE(PG8_SA(0, 1), cA + hstepA, voffA);
        if (wr == 1) PG8_BAR;
        PG8_WAIT_V(4); PG8_BAR;
        PG8_STAGE(PG8_SB(1, 0), cB + kstep, voffB); PG8_STAGE(PG8_SA(1, 0), cA + kstep, voffA); PG8_STAGE(PG8_SB(1, 1), cB + hstepB + kstep, voffB);
        PG8_WAIT_V(6); PG8_BAR;
    }
    for (;;) {
        const bool has_next = S.next(ui + 1, nxt);
        const char* nA = has_next ? (const char*)g.A + (size_t)nxt.pm * tstepA : cA; const char* nB = has_next ? (const char*)g.Bt + (size_t)nxt.pn * tstepB : cB;
        for (int t = 0; t < nt; t += 2) {
            const bool last = (t == nt - 2);
            const char* a1 = cA + (size_t)(t + 1) * kstep;
            const char* a2 = last ? nA : cA + (size_t)(t + 2) * kstep; const char* b2 = last ? nB : cB + (size_t)(t + 2) * kstep;
            const char* a3 = a2 + kstep; const char* b3 = b2 + kstep;
            if (last && has_next) S.a_ready(nxt);
            if constexpr (SP2) {
            PG8_LDB(B0, 0, 0); PG8_LDB(B1, 0, 1); PG8_SCHED; PG8_LDA(At, 0, 0); PG8_STAGE(PG8_SA(1, 1), a1 + hstepA, voffA);
            PG8_WAIT_V(8); PG8_WAIT_L(0); PG8_BAR; PG8_MMA(0, 0, At, B0); PG8_MMA(0, 1, At, B1); PG8_BAR; PG8_SCHED;
            PG8_LDA(At, 0, 1); PG8_STAGE(PG8_SB(0, 0), b2, voffB); PG8_STAGE(PG8_SB(0, 1), b2 + hstepB, voffB); PG8_STAGE(PG8_SA(0, 0), a2, voffA);
            PG8_WAIT_V(8); PG8_WAIT_L(0); PG8_BAR; PG8_MMA(1, 0, At, B0); PG8_MMA(1, 1, At, B1); PG8_BAR; PG8_SCHED;
            PG8_LDB(B0, 1, 0); PG8_LDB(B1, 1, 1); PG8_SCHED; PG8_LDA(At, 1, 0); PG8_STAGE(PG8_SA(0, 1), a2 + hstepA, voffA);
            PG8_WAIT_V(8); PG8_WAIT_L(0); PG8_BAR; PG8_MMA(0, 0, At, B0); PG8_MMA(0, 1, At, B1); PG8_BAR; PG8_SCHED;
            PG8_LDA(At, 1, 1); PG8_STAGE(PG8_SB(1, 0), b3, voffB); PG8_STAGE(PG8_SB(1, 1), b3 + hstepB, voffB); PG8_STAGE(PG8_SA(1, 0), a3, voffA);
            PG8_WAIT_V(8); PG8_WAIT_L(0); PG8_BAR; PG8_MMA(1, 0, At, B0); PG8_MMA(1, 1, At, B1); PG8_BAR; PG8_SCHED;
            } else {
            PG8_LDB(B0, 0, 0); PG8_SCHED; PG8_LDA(At, 0, 0); PG8_STAGE(PG8_SA(1, 1), a1 + hstepA, voffA);
            PG8_WAIT_L(8); PG8_BAR; PG8_WAIT_L(0); PG8_MMA(0, 0, At, B0); PG8_BAR; PG8_SCHED;
            PG8_LDB(B1, 0, 1); PG8_STAGE(PG8_SB(0, 0), b2, voffB);
            PG8_BAR; PG8_WAIT_L(0); PG8_MMA(0, 1, At, B1); PG8_BAR;
            PG8_LDA(At, 0, 1); PG8_STAGE(PG8_SA(0, 0), a2, voffA);
            PG8_BAR; PG8_WAIT_L(0); PG8_MMA(1, 0, At, B0); PG8_BAR; PG8_SCHED;
            PG8_STAGE(PG8_SB(0, 1), b2 + hstepB, voffB);
            PG8_WAIT_V(6); PG8_BAR; PG8_MMA(1, 1, At, B1); PG8_BAR;
            PG8_LDB(B0, 1, 0); PG8_SCHED; PG8_LDA(At, 1, 0); PG8_STAGE(PG8_SA(0, 1), a2 + hstepA, voffA);
            PG8_WAIT_L(8); PG8_BAR; PG8_WAIT_L(0); PG8_MMA(0, 0, At, B0); PG8_BAR; PG8_SCHED;
            PG8_LDB(B1, 1, 1); PG8_STAGE(PG8_SB(1, 0), b3, voffB);
            PG8_BAR; PG8_WAIT_L(0); PG8_MMA(0, 1, At, B1); PG8_BAR;
            PG8_LDA(At, 1, 1); PG8_STAGE(PG8_SA(1, 0), a3, voffA);
            PG8_BAR; PG8_WAIT_L(0); PG8_MMA(1, 0, At, B0); PG8_BAR; PG8_SCHED;
            PG8_STAGE(PG8_SB(1, 1), b3 + hstepB, voffB);
            PG8_WAIT_V(6); PG8_BAR; PG8_MMA(1, 1, At, B1); PG8_BAR;
            }
        }
        if constexpr (ALIGN_EPI) { if (wr == 0) PG8_BAR; }
        if constexpr (!Epi::AFTER_DRAIN) { E(acc, cur, wr, wc, fr, fq); S.done(cur); }
        if (!has_next) break;
#pragma unroll
        for (int a = 0; a < 2; ++a)
#pragma unroll
            for (int b = 0; b < 2; ++b)
#pragma unroll
                for (int m = 0; m < 4; ++m)
#pragma unroll
                    for (int n = 0; n < 2; ++n) acc[a][b][m][n] = (f32x4){0.f, 0.f, 0.f, 0.f};
        cur = nxt; cA = nA; cB = nB; ++ui;
        if constexpr (Epi::ACC_INIT) E.init(acc, cur, wr, wc, fr, fq);
        if constexpr (ALIGN_EPI) { if (wr == 1) PG8_BAR; }
    }
    PG8_WAIT_V(0);
    if constexpr (!ALIGN_EPI) { if (wr == 0) PG8_BAR; }
    PG8_BAR;
    if constexpr (Epi::AFTER_DRAIN) { E.fused(acc, cur, wr, wc, fr, fq, lds, wid, lane); S.done(cur); }
#undef PG8_SA
#undef PG8_SB
#undef PG8_STAGE
#undef PG8_LDA
#undef PG8_LDB
#undef PG8_MMA
#undef PG8_WAIT_V
#undef PG8_WAIT_L
#undef PG8_BAR
#undef PG8_SCHED
}
}

#define LAS __attribute__((address_space(3)))
#define XB_TMO      128
#define XB_XCNT(j)  (256  + 64 * (j))
#define XB_XSUB(j)  (1280 + 64 * (j))
#define XB_XGEN(j)  (2304 + 64 * (j))
#define XB_TOP      3328
#define XB_TOPGEN   3392
#define XCD_BAR_WORDS 3456
#define XB_SPIN_CAP (1u << 18)

__device__ __forceinline__ unsigned xb_ld(unsigned* p)              { return __hip_atomic_load(p, __ATOMIC_RELAXED, __HIP_MEMORY_SCOPE_AGENT); }
__device__ __forceinline__ unsigned xb_add(unsigned* p, unsigned v) { return __hip_atomic_fetch_add(p, v, __ATOMIC_RELAXED, __HIP_MEMORY_SCOPE_AGENT); }
__device__ __forceinline__ unsigned xb_xcc_id() { return (unsigned)__builtin_amdgcn_s_getreg((3 << 11) | 20) & 0xFu; }
#define XB_SPIN(cond, bar) do { unsigned _sp = 0; while (cond) { __builtin_amdgcn_s_sleep(1); \
    if ((++_sp & 255u) == 0u) { if (xb_ld(&(bar)[XB_TMO])) break; if (_sp > XB_SPIN_CAP) { atomicAdd(&(bar)[XB_TMO], 1u); break; } } } } while (0)

struct XcdBarrier {
    unsigned* bar; unsigned x;
    volatile LAS unsigned* st;
};

__device__ __forceinline__ XcdBarrier xcd_barrier_post(unsigned* bar, volatile LAS unsigned* st) {
    XcdBarrier b; b.bar = bar; b.x = xb_xcc_id(); b.st = st;
    if (threadIdx.x == 0) (void)xb_add(&bar[XB_XCNT(b.x)], 1u);
    return b;
}
__device__ __forceinline__ void xcd_barrier_complete(unsigned* bar, unsigned x, unsigned& nloc, unsigned& nx) {
    const unsigned G = gridDim.x * gridDim.y * gridDim.z;
    unsigned sum, cnt, mine, sp = 0u;
    for (;;) {
        sum = 0u; cnt = 0u; mine = 0u;
#pragma unroll
        for (unsigned j = 0; j < 16; ++j) { const unsigned c = xb_ld(&bar[XB_XCNT(j)]); sum += c; cnt += (c > 0u) ? 1u : 0u; mine = (j == x) ? c : mine; }
        if (sum == G) break;
        __builtin_amdgcn_s_sleep(1);
        if ((++sp & 255u) == 0u) { if (xb_ld(&bar[XB_TMO])) break; if (sp > XB_SPIN_CAP) { atomicAdd(&bar[XB_TMO], 1u); break; } }
    }
    nloc = mine > 0u ? mine : 1u; nx = cnt > 0u ? cnt : 1u;
}

__device__ __forceinline__ void xcd_barrier(const XcdBarrier& b) {
    asm volatile("s_waitcnt vmcnt(0)" ::: "memory");
    __syncthreads();
    if (threadIdx.x == 0) {
        unsigned* bar = b.bar;
        __builtin_amdgcn_s_waitcnt(0);
        unsigned nloc = b.st[0], nx = b.st[1];
        if (nloc == 0u) { xcd_barrier_complete(bar, b.x, nloc, nx); b.st[0] = nloc; b.st[1] = nx; }
        const unsigned old = xb_add(&bar[XB_XSUB(b.x)], 1u);
        const unsigned gen = old / nloc;
        if (old + 1u == (gen + 1u) * nloc) {
            __builtin_amdgcn_fence(__ATOMIC_RELEASE, "agent");
            asm volatile("s_waitcnt vmcnt(0)" ::: "memory");
            const unsigned og = xb_add(&bar[XB_TOP], 1u);
            const unsigned tg = og / nx;
            if (og + 1u == (tg + 1u) * nx) xb_add(&bar[XB_TOPGEN], 1u);
            else XB_SPIN(xb_ld(&bar[XB_TOPGEN]) == tg, bar);
            __builtin_amdgcn_fence(__ATOMIC_ACQUIRE, "agent");
            xb_add(&bar[XB_XGEN(b.x)], 1u);
            asm volatile("s_waitcnt vmcnt(0)" ::: "memory");
        } else {
            XB_SPIN(xb_ld(&bar[XB_XGEN(b.x)]) == gen, bar);
            __builtin_amdgcn_fence(__ATOMIC_ACQUIRE, "agent");
            asm volatile("s_waitcnt vmcnt(0)" ::: "memory");
        }
    }
    __syncthreads();
}

constexpr int NWAVES = 8;
constexpr int RING_BYTES = 131072;
constexpr int LDSCTL_OFF = 139264;
constexpr int LDS_BYTES = 147456;
constexpr int CW_BAR = 4096;
constexpr size_t CTL_ZERO_BYTES = 131072;
#ifndef OPT_MASK
#define OPT_MASK 0x1FF
#endif

typedef float f32x4 __attribute__((ext_vector_type(4)));
typedef unsigned u32x4v __attribute__((ext_vector_type(4)));
typedef unsigned u32x2v __attribute__((ext_vector_type(2)));
typedef short bf16x8 __attribute__((ext_vector_type(8)));
#define LDS_WAIT() asm volatile("s_waitcnt lgkmcnt(0)" ::: "memory")

struct MArgs { const float* in[16]; float* out; unsigned char* ws; int ph_lo, ph_hi, li, pad; };
struct Frame { LAS unsigned char* lds; int tid, lane, wave, G, bid; const float* in[16]; float* out; unsigned char* ws; };

__device__ __forceinline__ unsigned pk2(float lo, float hi) { return pg8::cvt_pk_bf16(lo, hi); }
__device__ __forceinline__ float wave_sum(float v) {
#pragma unroll
    for (int o = 1; o < 64; o <<= 1) v += __shfl_xor(v, o);
    return v;
}

template <int NR> __device__ __forceinline__ void p0_x_rows(const float* x, bf16_t* xb, float* rs, int row, int lane) {
    f32x4 v[NR][4]; float s[NR];
#pragma unroll
    for (int r = 0; r < NR; ++r) { const f32x4* xr = (const f32x4*)(x + (size_t)(row + r) * D_) + lane;
#pragma unroll
        for (int j = 0; j < 4; ++j) v[r][j] = xr[64 * j]; }
#pragma unroll
    for (int r = 0; r < NR; ++r) { s[r] = 0.f;
#pragma unroll
        for (int j = 0; j < 4; ++j) s[r] += (v[r][j][0] * v[r][j][0] + v[r][j][1] * v[r][j][1]) + (v[r][j][2] * v[r][j][2] + v[r][j][3] * v[r][j][3]); }
#pragma unroll
    for (int o = 1; o < 64; o <<= 1)
#pragma unroll
        for (int r = 0; r < NR; ++r) s[r] += __shfl_xor(s[r], o);
#pragma unroll
    for (int r = 0; r < NR; ++r) { u32x2v* o8 = (u32x2v*)(xb + (size_t)(row + r) * D_) + lane;
#pragma unroll
        for (int j = 0; j < 4; ++j) { u32x2v w; w.x = pk2(v[r][j][0], v[r][j][1]); w.y = pk2(v[r][j][2], v[r][j][3]); o8[64 * j] = w; }
        if (lane == 0) rs[row + r] = 1.0f / sqrtf(s[r] * (1.0f / D_) + EPS_); }
}
constexpr int TSCR_BYTES = 64 * 65 * 4;
__device__ __forceinline__ void p0_transpose_item(const float* W, int ldw, int csrc, const float* gain, int gmask, bf16_t* WT, int K, int nrow, int k0, LAS float* scr, int lane) {
    const int kk = lane >> 4, nq = lane & 15;
    f32x4 v[16];
#pragma unroll
    for (int j = 0; j < 16; ++j) v[j] = *(const f32x4*)(W + (size_t)(k0 + 4 * j + kk) * ldw + csrc + 4 * nq);
#pragma unroll
    for (int j = 0; j < 16; ++j) { const int k = 4 * j + kk; LAS float* d = scr + k * 65 + ((4 * nq + 4 * (j >> 3)) & 63);
        d[0] = v[j][0]; d[1] = v[j][1]; d[2] = v[j][2]; d[3] = v[j][3]; }
    const int c = lane & 7, nr = lane >> 3;
    f32x4 g0 = (f32x4){1.f, 1.f, 1.f, 1.f}, g1 = g0;
    if (gain) { g0 = *(const f32x4*)(gain + ((k0 + 8 * c) & gmask)); g1 = *(const f32x4*)(gain + ((k0 + 8 * c + 4) & gmask)); }
    LDS_WAIT(); asm volatile("" ::: "memory");
#pragma unroll
    for (int jj = 0; jj < 8; ++jj) { const int n = nr + 8 * jj; const LAS float* s = scr + (8 * c) * 65 + ((n + 4 * (c >> 2)) & 63);
        u32x4v o; o.x = pk2(s[0 * 65] * g0[0], s[1 * 65] * g0[1]); o.y = pk2(s[2 * 65] * g0[2], s[3 * 65] * g0[3]); o.z = pk2(s[4 * 65] * g1[0], s[5 * 65] * g1[1]); o.w = pk2(s[6 * 65] * g1[2], s[7 * 65] * g1[3]);
        *(u32x4v*)(WT + (size_t)(nrow + n) * K + k0 + 8 * c) = o; }
    LDS_WAIT(); asm volatile("" ::: "memory");
}
__device__ __forceinline__ void p0_memkv(const Frame& F, int unit) {
    const int l = unit >> 7, b = (unit >> 6) & 1, mt = (unit >> 3) & 7, cg = unit & 7, lane = F.lane, w = F.wave, c = lane & 15, g4 = lane >> 4, cgw = w & 1, kq = w >> 1;
    const float* mem = F.in[1] + ((size_t)b * 256 + mt * 32) * D_; const float* W = F.in[13] + (size_t)l * D_ * 1024 + cg * 128 + 64 * cgw + 4 * c; const float* gm = F.in[12] + l * D_;
    f32x4 acc[4][2];
#pragma unroll
    for (int t = 0; t < 4; ++t) { acc[t][0] = (f32x4){0.f, 0.f, 0.f, 0.f}; acc[t][1] = (f32x4){0.f, 0.f, 0.f, 0.f}; }
#pragma unroll 4
    for (int ks = 0; ks < 8; ++ks) { const int kb = kq * 256 + ks * 32 + 8 * g4;
        const f32x4 g0 = *(const f32x4*)(gm + kb), g1 = *(const f32x4*)(gm + kb + 4);
        bf16x8 afr[2], bfr[4];
#pragma unroll
        for (int rb = 0; rb < 2; ++rb) { const float* p = mem + (size_t)(rb * 16 + c) * D_ + kb; const f32x4 a0 = *(const f32x4*)p * g0, a1 = *(const f32x4*)(p + 4) * g1;
            u32x4v t; t.x = pk2(a0[0], a0[1]); t.y = pk2(a0[2], a0[3]); t.z = pk2(a1[0], a1[1]); t.w = pk2(a1[2], a1[3]); afr[rb] = __builtin_bit_cast(bf16x8, t); }
        f32x4 wv[8];
#pragma unroll
        for (int j = 0; j < 8; ++j) wv[j] = *(const f32x4*)(W + (size_t)(kb + j) * 1024);
#pragma unroll
        for (int t = 0; t < 4; ++t) { u32x4v q; q.x = pk2(wv[0][t], wv[1][t]); q.y = pk2(wv[2][t], wv[3][t]); q.z = pk2(wv[4][t], wv[5][t]); q.w = pk2(wv[6][t], wv[7][t]); bfr[t] = __builtin_bit_cast(bf16x8, q); }
#pragma unroll
        for (int t = 0; t < 4; ++t)
#pragma unroll
            for (int rb = 0; rb < 2; ++rb) acc[t][rb] = __builtin_amdgcn_mfma_f32_16x16x32_bf16(afr[rb], bfr[t], acc[t][rb], 0, 0, 0);
    }
    LAS float* P = (LAS float*)F.lds;
#pragma unroll
    for (int rb = 0; rb < 2; ++rb)
#pragma unroll
        for (int r = 0; r < 4; ++r) { const int tok = rb * 16 + 4 * g4 + r; *(LAS f32x4*)(P + ((kq * 32 + tok) * 128 + 64 * cgw + 4 * c)) = (f32x4){acc[0][rb][r], acc[1][rb][r], acc[2][rb][r], acc[3][rb][r]}; }
    __syncthreads();
    const int tok = F.tid >> 4, cb = F.tid & 15;
    f32x4 s0 = (f32x4){0.f, 0.f, 0.f, 0.f}, s1 = s0;
#pragma unroll
    for (int q = 0; q < 4; ++q) { s0 += *(const LAS f32x4*)(P + ((q * 32 + tok) * 128 + cb * 8)); s1 += *(const LAS f32x4*)(P + ((q * 32 + tok) * 128 + cb * 8 + 4)); }
    float ms = 0.f; { const f32x4* mr = (const f32x4*)(mem + (size_t)tok * D_ + cb * 64);
#pragma unroll
        for (int j = 0; j < 16; ++j) { const f32x4 v = mr[j]; ms += (v[0] * v[0] + v[1] * v[1]) + (v[2] * v[2] + v[3] * v[3]); } }
    ms += __shfl_xor(ms, 1); ms += __shfl_xor(ms, 2); ms += __shfl_xor(ms, 4); ms += __shfl_xor(ms, 8);
    const float rm = 1.0f / sqrtf(ms * (1.0f / D_) + EPS_);
    s0 *= rm; s1 *= rm;
    const size_t orow = ((((size_t)l * 2 + b) * 4 + (cg & 3)) * 256 + mt * 32 + tok) * 128 + cb * 8;
    if (cg < 4) {
        float q = (s0[0] * s0[0] + s0[1] * s0[1]) + (s0[2] * s0[2] + s0[3] * s0[3]) + (s1[0] * s1[0] + s1[1] * s1[1]) + (s1[2] * s1[2] + s1[3] * s1[3]);
        q += __shfl_xor(q, 1); q += __shfl_xor(q, 2); q += __shfl_xor(q, 4); q += __shfl_xor(q, 8);
        const float hn = QK_SCALE / sqrtf(q * (1.0f / 128) + EPS_);
        const f32x4 gk0 = *(const f32x4*)(F.in[15] + l * 128 + cb * 8), gk1 = *(const f32x4*)(F.in[15] + l * 128 + cb * 8 + 4);
        const f32x4 gq0 = *(const f32x4*)(F.in[14] + l * 128 + cb * 8), gq1 = *(const f32x4*)(F.in[14] + l * 128 + cb * 8 + 4);
        s0 = s0 * hn * gk0 * gq0; s1 = s1 * hn * gk1 * gq1;
        *(u32x4v*)((bf16_t*)(F.ws + WS_MEMK) + orow) = pg8::pack8(s0, s1);
    } else *(u32x4v*)((bf16_t*)(F.ws + WS_MEMV) + orow) = pg8::pack8(s0, s1);
    __syncthreads();
}
__device__ __forceinline__ void p0_weight_item(const Frame& F, int r, LAS float* scr) {
    constexpr int I_A = 16 * 64, I_OA = 24 * 16, I_B = 16 * 80;
    if (r < I_A) { const int kb = r / 64, n0 = 64 * (r % 64); p0_transpose_item(F.in[4], 4096, permA_src(n0), F.in[3], 0xffff, (bf16_t*)(F.ws + WS_WINA), 1024, n0, 64 * kb, scr, F.lane); return; } r -= I_A;
    if (r < I_OA) { const int kb = r / 16, n0 = 64 * (r % 16); p0_transpose_item(F.in[6], 1024, n0, kb < 16 ? F.in[5] : nullptr, 255, (bf16_t*)(F.ws + WS_WOUTA), 1536, n0, 64 * kb, scr, F.lane); return; } r -= I_OA;
    if (r < I_B) { const int kb = r / 80, n0 = 64 * (r % 80);
        if (n0 < 2048) p0_transpose_item(F.in[8], 2048, n0, F.in[7], 0xffff, (bf16_t*)(F.ws + WS_WB), 1024, n0, 64 * kb, scr, F.lane);
        else { const int c = n0 - 2048, src = c < 1024 ? 1024 + c : (c < 2048 ? c - 1024 : c); p0_transpose_item(F.in[10], 3072, src, F.in[9], 0xffff, (bf16_t*)(F.ws + WS_WB), 1024, n0, 64 * kb, scr, F.lane); }
        return; } r -= I_B;
    { const int kb = r / 16, n0 = 64 * (r % 16); p0_transpose_item(F.in[11], 1024, n0, nullptr, 0, (bf16_t*)(F.ws + WS_WOUTB), 1536, n0, 64 * kb, scr, F.lane); }
}
__device__ __forceinline__ void p0_prologue(const Frame& F) {
    for (int u = F.bid; u < 256; u += F.G) p0_memkv(F, u);
    const int gw = F.bid * NWAVES + F.wave, NGW = F.G * NWAVES;
    LAS float* scr = (LAS float*)(F.lds + F.wave * TSCR_BYTES);
    bf16_t* XB = (bf16_t*)(F.ws + WS_XB); float* RS0 = (float*)(F.ws + WS_RS0); const float* x = F.in[0];
    if (NGW == 2048) {
        if (gw < 1024) { p0_weight_item(F, gw, scr); p0_x_rows<4>(x, XB, RS0, 6 * gw, F.lane); p0_weight_item(F, gw + 2048, scr); p0_x_rows<2>(x, XB, RS0, 6 * gw + 4, F.lane); }
        else { const int r0 = 6144 + 10 * (gw - 1024); p0_x_rows<4>(x, XB, RS0, r0, F.lane); p0_weight_item(F, gw, scr); p0_x_rows<4>(x, XB, RS0, r0 + 4, F.lane); p0_x_rows<2>(x, XB, RS0, r0 + 8, F.lane); }
    } else {
        for (int it = gw; it < 3072; it += NGW) p0_weight_item(F, it, scr);
        for (int m = 4 * gw; m < T_; m += 4 * NGW) p0_x_rows<4>(x, XB, RS0, m, F.lane);
    }
}

typedef float f32x16 __attribute__((ext_vector_type(16)));
typedef short s16x4 __attribute__((ext_vector_type(4)));
#define KSWZ(row, colB) ((row) * 256 + ((colB) ^ (((row) & 7) << 4)))
#define SBAR() __builtin_amdgcn_sched_barrier(0)
constexpr float LOG2E = 1.4426950408889634f;
__device__ __forceinline__ int crow(int r, int hi) { return (r & 3) + 8 * (r >> 2) + 4 * hi; }
__device__ __forceinline__ unsigned lds_addr(const LAS void* p) { return (unsigned)(size_t)p; }
__device__ __forceinline__ int v_st(int k, int c) { const int kk = (k & ~0xC) | ((k & 4) << 1) | ((k & 8) >> 1); return ((kk >> 3) * 4 + (c >> 5)) * 512 + ((kk & 7) * 32 + (c & 31)) * 2; }
__device__ __forceinline__ int v_rd_base(int lane) { return ((lane & 3) << 3) | (((lane >> 2) & 3) << 6) | (((lane >> 4) & 1) << 5) | (((lane >> 5) & 1) << 8); }
constexpr int v_rd_off(int d0, int ks, int half) { return d0 * 512 + ks * 4096 + half * 2048; }
template <int OFF> __device__ __forceinline__ s16x4 tr_read(unsigned vb) { s16x4 r; asm volatile("ds_read_b64_tr_b16 %0, %1 offset:%2" : "=&v"(r) : "v"(vb), "i"(OFF) : "memory"); return r; }
#define PKLH(L, H) (bf16x8){L[0], L[1], L[2], L[3], H[0], H[1], H[2], H[3]}
__device__ __forceinline__ float partner32(float x, int hi) { auto rr = __builtin_amdgcn_permlane32_swap(__float_as_uint(x), __float_as_uint(x), false, false); return __uint_as_float(hi ? rr[0] : rr[1]); }

__device__ __forceinline__ void qkt(f32x16& p0, f32x16& p1, const LAS unsigned char* Ks, const bf16x8* qr, int r32, int hi) {
    p0 = f32x16{}; p1 = f32x16{};
#pragma unroll
    for (int d0 = 0; d0 < 8; ++d0) { const int cb = (d0 * 16 + hi * 8) * 2;
        const bf16x8 b0 = *(const LAS bf16x8*)(Ks + KSWZ(r32, cb)), b1 = *(const LAS bf16x8*)(Ks + KSWZ(32 + r32, cb));
        p0 = __builtin_amdgcn_mfma_f32_32x32x16_bf16(b0, qr[d0], p0, 0, 0, 0);
        p1 = __builtin_amdgcn_mfma_f32_32x32x16_bf16(b1, qr[d0], p1, 0, 0, 0); }
}
#define PK4(P, BASE, OUT) do { unsigned a0_ = pg8::cvt_pk_bf16(P[BASE + 0], P[BASE + 1]), a1_ = pg8::cvt_pk_bf16(P[BASE + 2], P[BASE + 3]); \
    unsigned b0_ = pg8::cvt_pk_bf16(P[BASE + 4], P[BASE + 5]), b1_ = pg8::cvt_pk_bf16(P[BASE + 6], P[BASE + 7]); \
    auto r0_ = __builtin_amdgcn_permlane32_swap(a0_, b0_, false, false); auto r1_ = __builtin_amdgcn_permlane32_swap(a1_, b1_, false, false); \
    u32x4v w_ = {r0_[0], r1_[0], r0_[1], r1_[1]}; OUT = __builtin_bit_cast(bf16x8, w_); } while (0)
template <int D0> __device__ __forceinline__ void pv_one(f32x16& od, unsigned vb, bf16x8 pa0, bf16x8 pa1, bf16x8 pa2, bf16x8 pa3) {
    const s16x4 l0 = tr_read<v_rd_off(D0, 0, 0)>(vb), h0 = tr_read<v_rd_off(D0, 0, 1)>(vb), l1 = tr_read<v_rd_off(D0, 1, 0)>(vb), h1 = tr_read<v_rd_off(D0, 1, 1)>(vb);
    const s16x4 l2 = tr_read<v_rd_off(D0, 2, 0)>(vb), h2 = tr_read<v_rd_off(D0, 2, 1)>(vb), l3 = tr_read<v_rd_off(D0, 3, 0)>(vb), h3 = tr_read<v_rd_off(D0, 3, 1)>(vb);
    asm volatile("s_waitcnt lgkmcnt(0)" ::: "memory"); SBAR();
    od = __builtin_amdgcn_mfma_f32_32x32x16_bf16(pa0, PKLH(l0, h0), od, 0, 0, 0);
    od = __builtin_amdgcn_mfma_f32_32x32x16_bf16(pa1, PKLH(l1, h1), od, 0, 0, 0);
    od = __builtin_amdgcn_mfma_f32_32x32x16_bf16(pa2, PKLH(l2, h2), od, 0, 0, 0);
    od = __builtin_amdgcn_mfma_f32_32x32x16_bf16(pa3, PKLH(l3, h3), od, 0, 0, 0);
}
__device__ __forceinline__ void pv_d0(f32x16* o, unsigned vb, bf16x8 pa0, bf16x8 pa1, bf16x8 pa2, bf16x8 pa3) {
    pv_one<0>(o[0], vb, pa0, pa1, pa2, pa3); pv_one<1>(o[1], vb, pa0, pa1, pa2, pa3); pv_one<2>(o[2], vb, pa0, pa1, pa2, pa3); pv_one<3>(o[3], vb, pa0, pa1, pa2, pa3);
}
constexpr int WSCR_OFF = LDSCTL_OFF + 1024, WFLAG_OFF = LDSCTL_OFF + 512;

constexpr float SB_EXIT = -150.1f;
__device__ __forceinline__ void sb_unit(const Frame& F, int b, int h, int qb) {
    int tid = F.tid; asm volatile("" : "+v"(tid));
    const int w = F.wave, lane = tid & 63, r32 = lane & 31, hi = lane >> 5;
    bf16_t* UB = (bf16_t*)(F.ws + WS_UB); const size_t rowb = (size_t)b * S_;
    const int q0 = qb * 256, tq = q0 + 32 * w + r32;
    bf16x8 qr[8];
    { const bf16_t* qp = UB + (rowb + tq) * NBW_ + 3072 + h * 128 + hi * 8;
#pragma unroll
      for (int d0 = 0; d0 < 8; ++d0) qr[d0] = *(const bf16x8*)(qp + d0 * 16); }
    const int sr = tid >> 4, sc = (tid & 15) * 8;
    const bf16_t* kg = UB + rowb * NBW_ + h * 128 + sc; const bf16_t* vg = kg + 1024;
    const int kst0 = KSWZ(sr, sc * 2), kst1 = KSWZ(32 + sr, sc * 2), vst0 = v_st(sr, sc), vst1 = v_st(32 + sr, sc);
    LAS unsigned char* Kb = F.lds; LAS unsigned char* Vb = F.lds + 32768;
    const unsigned vb0 = lds_addr(Vb) + v_rd_base(lane);
    volatile LAS unsigned* flags = (volatile LAS unsigned*)(F.lds + WFLAG_OFF);
    bf16x8 sk0, sk1, sv0, sv1;
#define SB_LOAD(kt_) do { const size_t r0_ = (size_t)((kt_) * 64 + sr) * NBW_; sk0 = *(const bf16x8*)(kg + r0_); sk1 = *(const bf16x8*)(kg + r0_ + 32 * (size_t)NBW_); \
        sv0 = *(const bf16x8*)(vg + r0_); sv1 = *(const bf16x8*)(vg + r0_ + 32 * (size_t)NBW_); } while (0)
#define SB_WRITE(buf_) do { *(LAS bf16x8*)(Kb + (buf_) * 16384 + kst0) = sk0; *(LAS bf16x8*)(Kb + (buf_) * 16384 + kst1) = sk1; \
        *(LAS bf16x8*)(Vb + (buf_) * 16384 + vst0) = sv0; *(LAS bf16x8*)(Vb + (buf_) * 16384 + vst1) = sv1; } while (0)
    f32x16 o[4] = {}; float carry = 0.f; bool wdone = false;
    const int kt_hi = qb * 4 + 3;
    __syncthreads();
    SB_LOAD(kt_hi); SB_WRITE(kt_hi & 1);
    __syncthreads();
    for (int kt = kt_hi; kt >= 0; --kt) {
        const int cur = kt & 1;
        if (kt > 0) SB_LOAD(kt - 1);
        if (!wdone && kt * 64 < q0 + 32 * w + 31) {
            f32x16 p0, p1, l0, l1;
            qkt(p0, p1, Kb + cur * 16384, qr, r32, hi);
            const int lim = tq - kt * 64 - 4 * hi;
#pragma unroll
            for (int r = 0; r < 16; ++r) { const int cr = (r & 3) + 8 * (r >> 2);
                { const float y = p0[r] * LOG2E, e = __builtin_amdgcn_exp2f(y); float sp = __builtin_amdgcn_logf(1.0f + e); sp = y > 30.f ? y : sp; l0[r] = cr < lim ? -sp : 0.f; p0[r] = y - sp; }
                { const float y = p1[r] * LOG2E, e = __builtin_amdgcn_exp2f(y); float sp = __builtin_amdgcn_logf(1.0f + e); sp = y > 30.f ? y : sp; l1[r] = cr + 32 < lim ? -sp : 0.f; p1[r] = y - sp; } }
            float go[8], gp[8], sown[8];
#pragma unroll
            for (int i = 0; i < 4; ++i) { go[i] = (l0[4 * i] + l0[4 * i + 1]) + (l0[4 * i + 2] + l0[4 * i + 3]); go[4 + i] = (l1[4 * i] + l1[4 * i + 1]) + (l1[4 * i + 2] + l1[4 * i + 3]); }
#pragma unroll
            for (int i = 0; i < 8; ++i) gp[i] = partner32(go[i], hi);
            float tail = 0.f;
#pragma unroll
            for (int i = 7; i >= 0; --i) { sown[i] = tail + (hi ? 0.f : gp[i]) + carry; tail += go[i] + gp[i]; }
#pragma unroll
            for (int i = 0; i < 4; ++i) {
                { const float s3 = sown[i], s2 = s3 + l0[4 * i + 3], s1 = s2 + l0[4 * i + 2], s0 = s1 + l0[4 * i + 1]; const int cr = 8 * i;
                  p0[4 * i + 0] = cr + 0 < lim ? __builtin_amdgcn_exp2f(p0[4 * i + 0] + s0) : 0.f; p0[4 * i + 1] = cr + 1 < lim ? __builtin_amdgcn_exp2f(p0[4 * i + 1] + s1) : 0.f;
                  p0[4 * i + 2] = cr + 2 < lim ? __builtin_amdgcn_exp2f(p0[4 * i + 2] + s2) : 0.f; p0[4 * i + 3] = cr + 3 < lim ? __builtin_amdgcn_exp2f(p0[4 * i + 3] + s3) : 0.f; }
                { const float s3 = sown[4 + i], s2 = s3 + l1[4 * i + 3], s1 = s2 + l1[4 * i + 2], s0 = s1 + l1[4 * i + 1]; const int cr = 32 + 8 * i;
                  p1[4 * i + 0] = cr + 0 < lim ? __builtin_amdgcn_exp2f(p1[4 * i + 0] + s0) : 0.f; p1[4 * i + 1] = cr + 1 < lim ? __builtin_amdgcn_exp2f(p1[4 * i + 1] + s1) : 0.f;
                  p1[4 * i + 2] = cr + 2 < lim ? __builtin_amdgcn_exp2f(p1[4 * i + 2] + s2) : 0.f; p1[4 * i + 3] = cr + 3 < lim ? __builtin_amdgcn_exp2f(p1[4 * i + 3] + s3) : 0.f; } }
            carry += tail;
            bf16x8 pa0, pa1, pa2, pa3;
            PK4(p0, 0, pa0); PK4(p0, 8, pa1); PK4(p1, 0, pa2); PK4(p1, 8, pa3);
            pv_d0(o, vb0 + cur * 16384, pa0, pa1, pa2, pa3);
            wdone = __all(carry < SB_EXIT);
        }
        if (kt > 0) SB_WRITE(cur ^ 1);
        if (lane == 0) flags[w] = wdone ? 1u : 0u;
        __syncthreads();
        unsigned alld = 1u;
#pragma unroll
        for (int j = 0; j < 8; ++j) alld &= flags[j];
        if (alld) break;
    }
#undef SB_LOAD
#undef SB_WRITE
    { bf16_t* base = UB + (rowb + q0 + 32 * w) * NBW_ + h * 128 + r32;
#pragma unroll
      for (int r = 0; r < 16; ++r) { bf16_t* rp = base + (size_t)crow(r, hi) * NBW_;
#pragma unroll
          for (int d0 = 0; d0 < 4; ++d0) { const float g = bf2f(rp[2048 + d0 * 32]); rp[3072 + d0 * 32] = f2bf(o[d0][r] * g); } } }
}

__device__ __forceinline__ void memattn_unit(const Frame& F, bf16_t* U, int ld, int qoff, int goff, int layer, int unit) {
    int tid = F.tid; asm volatile("" : "+v"(tid));
    const int w = F.wave, lane = tid & 63, r32 = lane & 31, hi = lane >> 5;
    const int qblk = unit >> 2, hd = unit & 3, row0 = qblk * 256, b = row0 / S_;
    const bf16_t* Kg = (const bf16_t*)(F.ws + WS_MEMK) + (((size_t)layer * 2 + b) * 4 + hd) * 256 * 128; const bf16_t* Vg = (const bf16_t*)(F.ws + WS_MEMV) + (((size_t)layer * 2 + b) * 4 + hd) * 256 * 128;
    LAS unsigned char* Kb = F.lds; LAS unsigned char* Vb = F.lds + 65536;
    __syncthreads();
#pragma unroll
    for (int j = 0; j < 8; ++j) { const int c = tid + 512 * j, row = c >> 4, ch = c & 15;
        *(LAS bf16x8*)(Kb + KSWZ(row, ch * 16)) = *(const bf16x8*)(Kg + (size_t)row * 128 + ch * 8);
        *(LAS bf16x8*)(Vb + (row >> 6) * 16384 + v_st(row & 63, ch * 8)) = *(const bf16x8*)(Vg + (size_t)row * 128 + ch * 8); }
    bf16x8 qr[8]; float ssq = 0.f;
    { const bf16_t* qp = U + (size_t)(row0 + 32 * w + r32) * ld + qoff + hd * 128 + hi * 8;
#pragma unroll
      for (int d0 = 0; d0 < 8; ++d0) { qr[d0] = *(const bf16x8*)(qp + d0 * 16);
#pragma unroll
          for (int j = 0; j < 8; ++j) { const float v = bf2f((bf16_t)qr[d0][j]); ssq += v * v; } } }
    ssq += partner32(ssq, hi);
    const float C = LOG2E / sqrtf(ssq * (1.0f / 128) + EPS_);
    __syncthreads();
    LAS float* wscr = (LAS float*)(F.lds + WSCR_OFF) + w * 64;
    const unsigned vb0 = lds_addr(Vb) + v_rd_base(lane);
    f32x16 o[4] = {}; float m_reg = -1e30f, l_reg = 0.f;
#pragma unroll 1
    for (int t = 0; t < 4; ++t) {
        f32x16 p0, p1;
        qkt(p0, p1, Kb + t * 16384, qr, r32, hi);
        float pmax = p0[0];
#pragma unroll
        for (int r = 1; r < 16; ++r) pmax = fmaxf(pmax, p0[r]);
#pragma unroll
        for (int r = 0; r < 16; ++r) pmax = fmaxf(pmax, p1[r]);
        pmax = fmaxf(pmax, partner32(pmax, hi));
        float alpha = 1.f;
        if (!__all(pmax <= m_reg)) { const float mn = fmaxf(m_reg, pmax); alpha = __builtin_amdgcn_exp2f((m_reg - mn) * C); m_reg = mn;
            if (hi == 0) wscr[r32] = alpha; LDS_WAIT();
#pragma unroll
            for (int d = 0; d < 4; ++d)
#pragma unroll
                for (int r = 0; r < 16; ++r) o[d][r] *= wscr[crow(r, hi)];
            LDS_WAIT(); }
        const float mC = -m_reg * C; float ps = 0.f;
#pragma unroll
        for (int r = 0; r < 16; ++r) { p0[r] = __builtin_amdgcn_exp2f(fmaf(p0[r], C, mC)); p1[r] = __builtin_amdgcn_exp2f(fmaf(p1[r], C, mC)); ps += p0[r] + p1[r]; }
        ps += partner32(ps, hi);
        l_reg = l_reg * alpha + ps;
        bf16x8 pa0, pa1, pa2, pa3;
        PK4(p0, 0, pa0); PK4(p0, 8, pa1); PK4(p1, 0, pa2); PK4(p1, 8, pa3);
        pv_d0(o, vb0 + t * 16384, pa0, pa1, pa2, pa3);
    }
    if (hi == 0) wscr[32 + r32] = l_reg; LDS_WAIT();
    { bf16_t* base = U + (size_t)(row0 + 32 * w) * ld + hd * 128 + r32;
#pragma unroll
      for (int r = 0; r < 16; ++r) { const float rl = 1.0f / wscr[32 + crow(r, hi)]; bf16_t* rp = base + (size_t)crow(r, hi) * ld;
#pragma unroll
          for (int d0 = 0; d0 < 4; ++d0) { const float g = bf2f(rp[goff + d0 * 32]); rp[qoff + d0 * 32] = f2bf(o[d0][r] * rl * g); } } }
    LDS_WAIT();
}

__device__ __forceinline__ float ret_lg2(int h) { return log2f(1.0f - exp2f(-5.0f - (float)h)); }
__device__ __forceinline__ void kvt_unit(const Frame& F, int u) {
    int tid = F.tid; asm volatile("" : "+v"(tid));
    const int w = F.wave, lane = tid & 63, r32 = lane & 31, hi = lane >> 5;
    const int b = u >> 8, h = (u >> 6) & 3, n = u & 63; const size_t row0 = (size_t)b * S_ + n * 128; const float lg2 = ret_lg2(h);
    const bf16_t* UA = (const bf16_t*)(F.ws + WS_UA); bf16_t* KVT = (bf16_t*)(F.ws + WS_KVT);
    LAS unsigned char* Vb = F.lds; LAS unsigned char* Kb = F.lds + 65536;
    __syncthreads();
#pragma unroll
    for (int j = 0; j < 8; ++j) { const int c = tid + 512 * j, row = c >> 5, col = (c & 31) * 8;
        *(LAS bf16x8*)(Vb + ((row >> 6) * 2 + (col >> 7)) * 16384 + v_st(row & 63, col & 127)) = *(const bf16x8*)(UA + (row0 + row) * NA_ + 1024 + h * 256 + col); }
#pragma unroll
    for (int j = 0; j < 4; ++j) { const int c = tid + 512 * j, row = c >> 4, col = (c & 15) * 8; const float z = exp2f((float)(127 - row) * lg2);
        const bf16x8 kv = *(const bf16x8*)(UA + (row0 + row) * NA_ + 512 + h * 128 + col);
        u32x4v t; t.x = pk2(bf2f((bf16_t)kv[0]) * z, bf2f((bf16_t)kv[1]) * z); t.y = pk2(bf2f((bf16_t)kv[2]) * z, bf2f((bf16_t)kv[3]) * z);
        t.z = pk2(bf2f((bf16_t)kv[4]) * z, bf2f((bf16_t)kv[5]) * z); t.w = pk2(bf2f((bf16_t)kv[6]) * z, bf2f((bf16_t)kv[7]) * z);
        *(LAS u32x4v*)(Kb + (row >> 6) * 16384 + v_st(row & 63, col)) = t; }
    __syncthreads();
    f32x16 acc[4] = {};
    const unsigned vbV = lds_addr(Vb) + v_rd_base(lane) + (w >> 2) * 16384 + (w & 3) * 512, vbK = lds_addr(Kb) + v_rd_base(lane);
#define KVT_STEP(TH, KS) do { const unsigned va_ = vbV + (TH) * 32768, vk_ = vbK + (TH) * 16384; \
        const s16x4 al_ = tr_read<v_rd_off(0, KS, 0)>(va_), ah_ = tr_read<v_rd_off(0, KS, 1)>(va_); \
        const s16x4 b0l_ = tr_read<v_rd_off(0, KS, 0)>(vk_), b0h_ = tr_read<v_rd_off(0, KS, 1)>(vk_), b1l_ = tr_read<v_rd_off(1, KS, 0)>(vk_), b1h_ = tr_read<v_rd_off(1, KS, 1)>(vk_); \
        const s16x4 b2l_ = tr_read<v_rd_off(2, KS, 0)>(vk_), b2h_ = tr_read<v_rd_off(2, KS, 1)>(vk_), b3l_ = tr_read<v_rd_off(3, KS, 0)>(vk_), b3h_ = tr_read<v_rd_off(3, KS, 1)>(vk_); \
        asm volatile("s_waitcnt lgkmcnt(0)" ::: "memory"); SBAR(); const bf16x8 a_ = PKLH(al_, ah_); \
        acc[0] = __builtin_amdgcn_mfma_f32_32x32x16_bf16(a_, PKLH(b0l_, b0h_), acc[0], 0, 0, 0); acc[1] = __builtin_amdgcn_mfma_f32_32x32x16_bf16(a_, PKLH(b1l_, b1h_), acc[1], 0, 0, 0); \
        acc[2] = __builtin_amdgcn_mfma_f32_32x32x16_bf16(a_, PKLH(b2l_, b2h_), acc[2], 0, 0, 0); acc[3] = __builtin_amdgcn_mfma_f32_32x32x16_bf16(a_, PKLH(b3l_, b3h_), acc[3], 0, 0, 0); } while (0)
    KVT_STEP(0, 0); KVT_STEP(0, 1); KVT_STEP(0, 2); KVT_STEP(0, 3); KVT_STEP(1, 0); KVT_STEP(1, 1); KVT_STEP(1, 2); KVT_STEP(1, 3);
#undef KVT_STEP
    bf16_t* ob = KVT + ((size_t)u * 256 + 32 * w) * 128 + r32;
#pragma unroll
    for (int r = 0; r < 16; ++r)
#pragma unroll
        for (int db = 0; db < 4; ++db) ob[(size_t)crow(r, hi) * 128 + 32 * db] = f2bf(acc[db][r]);
}
__device__ __forceinline__ void scan_phase(const Frame& F) {
    for (int idx = F.bid * (NWAVES * 64) + F.tid; idx < 8 * 16384; idx += F.G * NWAVES * 64) {
        const int bh = idx >> 14, off = idx & 16383; const float gc = exp2f(128.0f * ret_lg2(bh & 3));
        unsigned* p = (unsigned*)(F.ws + WS_KVT) + (size_t)bh * 64 * 16384 + off; float s0 = 0.f, s1 = 0.f;
#pragma unroll 1
        for (int n0 = 0; n0 < 64; n0 += 16) { unsigned v[16];
#pragma unroll
            for (int j = 0; j < 16; ++j) v[j] = p[(size_t)(n0 + j) * 16384];
#pragma unroll
            for (int j = 0; j < 16; ++j) { p[(size_t)(n0 + j) * 16384] = pk2(s0, s1); s0 = fmaf(gc, s0, __uint_as_float(v[j] << 16)); s1 = fmaf(gc, s1, __uint_as_float(v[j] & 0xffff0000u)); } }
    }
}
__device__ __forceinline__ void ret_unit(const Frame& F, int u) {
    int tid = F.tid; asm volatile("" : "+v"(tid));
    const int w = F.wave, lane = tid & 63, r32 = lane & 31, hi = lane >> 5, wq = w & 3, eh = w >> 2;
    const int b = u >> 8, h = (u >> 6) & 3, n = u & 63; const size_t row0 = (size_t)b * S_ + n * 128; const float lg2 = ret_lg2(h);
    bf16_t* UA = (bf16_t*)(F.ws + WS_UA); const bf16_t* KVT = (const bf16_t*)(F.ws + WS_KVT);
    LAS unsigned char* R1 = F.lds; LAS unsigned char* R2 = F.lds + 65536;
    __syncthreads();
#pragma unroll
    for (int j = 0; j < 8; ++j) { const int c = tid + 512 * j, row = c >> 4, ch = c & 15; *(LAS bf16x8*)(R1 + KSWZ(row, ch * 16)) = *(const bf16x8*)(KVT + ((size_t)u * 256 + row) * 128 + ch * 8); }
#pragma unroll
    for (int j = 0; j < 4; ++j) { const int c = tid + 512 * j, row = c >> 4, ch = c & 15; *(LAS bf16x8*)(R2 + KSWZ(row, ch * 16)) = *(const bf16x8*)(UA + (row0 + row) * NA_ + 512 + h * 128 + ch * 8); }
    bf16x8 qr[8];
    { const bf16_t* qp = UA + (row0 + 32 * wq + r32) * NA_ + h * 128 + hi * 8;
#pragma unroll
      for (int d0 = 0; d0 < 8; ++d0) qr[d0] = *(const bf16x8*)(qp + d0 * 16); }
    __syncthreads();
    f32x16 o[4] = {};
#pragma unroll
    for (int db = 0; db < 4; ++db) {
#pragma unroll
        for (int d0 = 0; d0 < 8; ++d0) { const bf16x8 bs = *(const LAS bf16x8*)(R1 + KSWZ(128 * eh + 32 * db + r32, (d0 * 16 + hi * 8) * 2)); o[db] = __builtin_amdgcn_mfma_f32_32x32x16_bf16(qr[d0], bs, o[db], 0, 0, 0); }
        asm volatile("" ::: "memory"); }
    const float gm1 = exp2f(lg2), gm2 = gm1 * gm1, gm4 = gm2 * gm2, gm8 = gm4 * gm4, gm16 = gm8 * gm8;
    const float gi1 = exp2f(-lg2), gi2 = gi1 * gi1, gi4 = gi2 * gi2, gi8 = gi4 * gi4, gi16 = gi8 * gi8, gi32 = gi16 * gi16;
    const float ga[4] = {1.0f, gm1, gm2, gm2 * gm1}, gb[4] = {1.0f, gm8, gm16, gm16 * gm8};
    const float ia[4] = {1.0f, gi1, gi2, gi2 * gi1}, ib[4] = {1.0f, gi8, gi16, gi16 * gi8};
    { const float xl = exp2f((float)(32 * wq + 4 * hi + 1) * lg2);
#pragma unroll
      for (int r = 0; r < 16; ++r) { const float xi = xl * (ga[r & 3] * gb[r >> 2]);
#pragma unroll
          for (int db = 0; db < 4; ++db) o[db][r] *= xi; } }
    bf16x8 pa[2][4]; const int cq = 32 * wq + r32;
#define RET_P(ST) do { f32x16 p0, p1; qkt(p0, p1, R2 + (ST) * 16384, qr, r32, hi); const int limq_ = cq - 64 * (ST) - 4 * hi; const float al_ = exp2f((float)limq_ * lg2); \
        _Pragma("unroll") for (int r = 0; r < 16; ++r) { const int cr_ = (r & 3) + 8 * (r >> 2); const float f_ = al_ * (ia[r & 3] * ib[r >> 2]); \
            p0[r] = cr_ <= limq_ ? p0[r] * f_ : 0.f; p1[r] = cr_ + 32 <= limq_ ? p1[r] * (f_ * gi32) : 0.f; } \
        PK4(p0, 0, pa[ST][0]); PK4(p0, 8, pa[ST][1]); PK4(p1, 0, pa[ST][2]); PK4(p1, 8, pa[ST][3]); } while (0)
    RET_P(0);
    if (wq >= 2) RET_P(1);
#undef RET_P
    __syncthreads();
#pragma unroll 4
    for (int j = 0; j < 8; ++j) { const int c = tid + 512 * j, row = c >> 5, col = (c & 31) * 8;
        *(LAS bf16x8*)(R1 + ((row >> 6) * 2 + (col >> 7)) * 16384 + v_st(row & 63, col & 127)) = *(const bf16x8*)(UA + (row0 + row) * NA_ + 1024 + h * 256 + col); }
    __syncthreads();
    const unsigned vb = lds_addr(R1) + v_rd_base(lane) + eh * 16384;
    pv_d0(o, vb, pa[0][0], pa[0][1], pa[0][2], pa[0][3]);
    if (wq >= 2) pv_d0(o, vb + 32768, pa[1][0], pa[1][1], pa[1][2], pa[1][3]);
    LAS float* ssq = (LAS float*)(F.lds + WSCR_OFF);
    float qs[16];
#pragma unroll
    for (int r = 0; r < 16; ++r) { float q = (o[0][r] * o[0][r] + o[1][r] * o[1][r]) + (o[2][r] * o[2][r] + o[3][r] * o[3][r]);
        q += __shfl_xor(q, 1); q += __shfl_xor(q, 2); q += __shfl_xor(q, 4); q += __shfl_xor(q, 8); q += __shfl_xor(q, 16); qs[r] = q;
        if (r32 == 0) ssq[w * 32 + crow(r, hi)] = q; }
    __syncthreads();
    { bf16_t* base = UA + (row0 + 32 * wq) * NA_ + 2048 + h * 256 + 128 * eh + r32;
#pragma unroll
      for (int r = 0; r < 16; ++r) { const float rn = 1.0f / sqrtf((qs[r] + ssq[(w ^ 4) * 32 + crow(r, hi)]) * (1.0f / 256) + EPS_); bf16_t* rp = base + (size_t)crow(r, hi) * NA_;
#pragma unroll
          for (int db = 0; db < 4; ++db) { const float g = bf2f(rp[32 * db]); rp[32 * db] = f2bf(o[db][r] * rn * g); } } }
    LDS_WAIT();
}
#ifndef PG8_SP2
#define PG8_SP2 true
#endif
#ifndef PG8_ALIGN
#define PG8_ALIGN true
#endif

__device__ __forceinline__ void phase1(const Frame& F) {
    pg8::Gemm g{(const bf16_t*)(F.ws + WS_XB), (const bf16_t*)(F.ws + WS_WINA), T_, NA_, D_, D_}; pg8::StaticOrder S; S.init(T_, NA_, F.G, F.bid);
    pg8::EpiA E{(bf16_t*)(F.ws + WS_UA), (const float*)(F.ws + WS_RS0), (const int*)F.in[2]};
    pg8::gemm_phase<pg8::EpiA, pg8::StaticOrder, PG8_ALIGN, PG8_SP2>(F.lds, g, S, E);
}
__device__ __forceinline__ void phase2(const Frame& F) {
    for (int u = F.bid; u < 512; u += F.G) kvt_unit(F, u);
    for (int u = F.bid; u < 256; u += F.G) memattn_unit(F, (bf16_t*)(F.ws + WS_UA), NA_, 3072, 3584, 0, u);
}
__device__ __forceinline__ void phase4(const Frame& F) { for (int u = F.bid; u < 512; u += F.G) ret_unit(F, u); }
__device__ __forceinline__ void phase5(const Frame& F) {
    pg8::Gemm g{(const bf16_t*)(F.ws + WS_UA) + 2048, (const bf16_t*)(F.ws + WS_WOUTA), T_, D_, KO_, NA_}; pg8::StaticOrder S; S.init(T_, D_, F.G, F.bid);
    pg8::EpiOutA E{F.in[0], F.out, (bf16_t*)(F.ws + WS_X1B), (float*)(F.ws + WS_SS1P)};
    pg8::gemm_phase<pg8::EpiOutA, pg8::StaticOrder, PG8_ALIGN, PG8_SP2>(F.lds, g, S, E);
}
__device__ __forceinline__ void phase6(const Frame& F) {
    pg8::Gemm g{(const bf16_t*)(F.ws + WS_X1B), (const bf16_t*)(F.ws + WS_WB), T_, NBW_, D_, D_}; pg8::StaticOrder S; S.init(T_, NBW_, F.G, F.bid);
    pg8::EpiB E{(bf16_t*)(F.ws + WS_UB), (const float*)(F.ws + WS_SS1P)};
    pg8::gemm_phase<pg8::EpiB, pg8::StaticOrder, PG8_ALIGN, PG8_SP2>(F.lds, g, S, E);
}
__device__ __forceinline__ void phase7(const Frame& F) {
    for (int u = F.bid; u < 512; u += F.G) sb_unit(F, u >> 8, (u >> 5) & 7, u & 31);
    for (int u = F.bid; u < 256; u += F.G) memattn_unit(F, (bf16_t*)(F.ws + WS_UB), NBW_, 4096, 4608, 1, u);
}
__device__ __forceinline__ void phase8(const Frame& F) {
    pg8::Gemm g{(const bf16_t*)(F.ws + WS_UB) + 3072, (const bf16_t*)(F.ws + WS_WOUTB), T_, D_, KO_, NBW_}; pg8::StaticOrder S; S.init(T_, D_, F.G, F.bid);
    pg8::EpiOutB E{F.out};
    pg8::gemm_phase<pg8::EpiOutB, pg8::StaticOrder, PG8_ALIGN, PG8_SP2>(F.lds, g, S, E);
}
__global__ void __launch_bounds__(NWAVES * 64, 2) mega(MArgs args) {
    extern __shared__ __attribute__((aligned(16))) unsigned char lds_raw[];
    Frame F;
    F.lds = (LAS unsigned char*)lds_raw; F.tid = threadIdx.x; F.lane = F.tid & 63; F.wave = __builtin_amdgcn_readfirstlane(F.tid >> 6); F.G = gridDim.x; F.bid = blockIdx.x;
#pragma unroll
    for (int i = 0; i < 16; ++i) F.in[i] = args.in[i];
    F.out = args.out; F.ws = args.ws;
    for (int u = F.tid; u < (LDS_BYTES - LDSCTL_OFF) / 4; u += NWAVES * 64) ((LAS unsigned*)(F.lds + LDSCTL_OFF))[u] = 0u;
    __syncthreads();
    unsigned* ctl = (unsigned*)(F.ws + WS_CTL);
    XcdBarrier bar = xcd_barrier_post(ctl + CW_BAR + args.li * XCD_BAR_WORDS, (volatile LAS unsigned*)(F.lds + LDSCTL_OFF) + 8);
    const int lo = args.ph_lo, hi = args.ph_hi;
#ifndef PH_ENABLE
#define PH_ENABLE 0x1FF
#endif
#define IN(k) (((PH_ENABLE >> (k)) & 1) && lo <= (k) && (k) < hi)
#define BOTH(k) (IN(k) && IN((k) + 1))

#ifndef PROBE
#define PROBE 0
#endif
#define PH(k, call) do { if (IN(k)) { call; if (BOTH(k)) xcd_barrier(bar); } } while (0)
#define PHB(call) do { call; xcd_barrier(bar); } while (0)
    PH(0, p0_prologue(F));
#if PROBE == 2
    PHB(p0_prologue(F));
#endif
#if PROBE == 5
    xcd_barrier(bar); xcd_barrier(bar); xcd_barrier(bar); xcd_barrier(bar);
#endif
    PH(1, phase1(F));
#if PROBE == 1
    PHB(phase1(F));
#endif
    PH(2, phase2(F));
#if PROBE == 8
    PHB(phase1(F)); PHB(phase2(F));
#endif
#if PROBE == 10
    PHB(for (int u = F.bid; u < 512; u += F.G) kvt_unit(F, u));
#endif
    PH(3, scan_phase(F));
#if PROBE == 11
    PHB(for (int u = F.bid; u < 512; u += F.G) kvt_unit(F, u)); PHB(scan_phase(F));
#endif
#if PROBE == 9
    PHB(phase1(F)); PHB(phase2(F)); PHB(scan_phase(F));
#endif
    PH(4, phase4(F));
#if PROBE == 3
    PHB(phase1(F)); PHB(phase2(F)); PHB(scan_phase(F)); PHB(phase4(F));
#endif
    PH(5, phase5(F));
#if PROBE == 6
    PHB(phase5(F));
#endif
    PH(6, phase6(F));
#if PROBE == 7
    PHB(phase6(F));
#endif
#if PROBE == 12
    PHB(for (int u = F.bid; u < 512; u += F.G) sb_unit(F, u >> 8, (u >> 5) & 7, u & 31)); PHB(phase6(F));
#endif
    PH(7, phase7(F));
#if PROBE == 4
    PHB(phase6(F)); PHB(phase7(F));
#endif
    PH(8, phase8(F));
#undef PH
#undef PHB
#undef IN
#undef BOTH
}

static void launch_mega(const MArgs& base, int lo, int hi, int li, int grid, hipStream_t stream) {
    MArgs a = base; a.ph_lo = lo; a.ph_hi = hi; a.li = li; a.pad = 0;
    hipLaunchKernelGGL(mega, dim3(grid), dim3(NWAVES * 64), LDS_BYTES, stream, a);
}
extern "C" void kernel_launch(void* const* d_in, const int* in_sizes, int n_in, void* d_out, int out_size, void* d_ws, size_t ws_size, hipStream_t stream) {
    static int grid = 0;
    if (grid == 0) {
        int dev = 0, cus = 0;
        if (hipGetDevice(&dev) != hipSuccess || hipDeviceGetAttribute(&cus, hipDeviceAttributeMultiprocessorCount, dev) != hipSuccess) { grid = -1; return; }
        if (hipFuncSetAttribute((const void*)mega, hipFuncAttributeMaxDynamicSharedMemorySize, LDS_BYTES) != hipSuccess) { grid = -1; return; }
        (void)hipGetLastError();
        grid = cus;
    }
    if (grid < 0) return;
    const float* x = (const float*)d_in[0]; const int* pos = (const int*)d_in[2];
    unsigned char* ws = (unsigned char*)d_ws; float* out = (float*)d_out;
    bf16_t* MEMK = (bf16_t*)(ws + WS_MEMK); bf16_t* MEMV = (bf16_t*)(ws + WS_MEMV);
    bf16_t* UA = (bf16_t*)(ws + WS_UA); bf16_t* KVT = (bf16_t*)(ws + WS_KVT); bf16_t* UB = (bf16_t*)(ws + WS_UB);
    (void)x; (void)pos; (void)out;
    (void)hipMemsetAsync(ws + WS_CTL, 0, CTL_ZERO_BYTES, stream);
    MArgs a{};
    for (int i = 0; i < 16; ++i) a.in[i] = (const float*)d_in[i];
    a.out = out; a.ws = ws;
    int li = 0;
    for (int p = 0; p < 9;) {
        if ((OPT_MASK >> p) & 1) { int q = p; while (q < 9 && ((OPT_MASK >> q) & 1)) ++q; launch_mega(a, p, q, li++, grid, stream); p = q; continue; }
        switch (p) {
        case 2: n2_kv<<<512 * 4, 256, 0, stream>>>(UA, KVT); n_memattn<<<T_, 256, 0, stream>>>(UA, NA_, 3072, 3584, MEMK, MEMV, 0); break;
        case 3: n3_scan<<<(8 * 32768) / 256, 256, 0, stream>>>(KVT); break;
        case 4: n4_ret<<<512 * 128, 256, 0, stream>>>(UA, KVT); break;
        case 7: n7_sb<<<NB_ * 8 * S_, 256, 0, stream>>>(UB); n_memattn<<<T_, 256, 0, stream>>>(UB, NBW_, 4096, 4608, MEMK, MEMV, 1); break;
        default: break;
        }
        ++p;
    }
}
```

```cpp
#include <hip/hip_runtime.h>
#include <stdint.h>

typedef unsigned short bf16_t;

constexpr int NB_ = 2, S_ = 8192, T_ = NB_ * S_, D_ = 1024;
constexpr int NA_ = 4096, NBW_ = 5120, KO_ = 1536;
constexpr float EPS_ = 1e-6f;
constexpr float QK_SCALE = 0.08838834764831845f;

constexpr size_t MiB = 1u << 20;
constexpr size_t WS_CTL = 0;
constexpr size_t WS_WINA = 1 * MiB;
constexpr size_t WS_WOUTA = 9 * MiB;
constexpr size_t WS_WB = 12 * MiB;
constexpr size_t WS_WOUTB = 22 * MiB;
constexpr size_t WS_MEMK = 25 * MiB;
constexpr size_t WS_MEMV = 26 * MiB;
constexpr size_t WS_RS0 = 27 * MiB;
constexpr size_t WS_SS1P = 28 * MiB;
constexpr size_t WS_UA = 30 * MiB;
constexpr size_t WS_KVT = 158 * MiB;
constexpr size_t WS_XB = 190 * MiB;
constexpr size_t WS_X1B = 190 * MiB;
constexpr size_t WS_UB = 30 * MiB;


__device__ __forceinline__ float bf2f(bf16_t v) { return __uint_as_float(((unsigned)v) << 16); }
__device__ __forceinline__ bf16_t f2bf(float f) { unsigned u = __float_as_uint(f); u += 0x7fffu + ((u >> 16) & 1u); return (bf16_t)(u >> 16); }
__device__ __forceinline__ float silu_f(float v) { return v / (1.0f + __expf(-v)); }
__device__ __forceinline__ float softplus_f(float z) { return fmaxf(z, 0.f) + log1pf(__expf(-fabsf(z))); }
__device__ __forceinline__ float ret_lg(int h) { return logf(1.0f - exp2f(-5.0f - (float)h)); }

__device__ __forceinline__ void rot_sincos(float ang, float& s, float& c) {
    const float n = rintf(ang * 0.15915494309189535f);
    float r = fmaf(-n, 6.28318548202514648f, ang);
    r = fmaf(-n, -1.74845553e-7f, r);
    const float rev = r * 0.15915494309189535f;
    s = __builtin_amdgcn_sinf(rev); c = __builtin_amdgcn_cosf(rev);
}
__device__ __forceinline__ float rope_inv_freq(int i) { return exp2f(-(float)i * 0.20762050593046014f); }

__global__ __launch_bounds__(256) void n0_x(const float* __restrict__ x, bf16_t* __restrict__ xb, float* __restrict__ rs) {
    const int row = blockIdx.x * 4 + (threadIdx.x >> 6), lane = threadIdx.x & 63;
    const float* xr = x + (size_t)row * D_; float s = 0.f;
    for (int j = lane; j < D_; j += 64) { const float v = xr[j]; s += v * v; xb[(size_t)row * D_ + j] = f2bf(v); }
    for (int o = 32; o; o >>= 1) s += __shfl_xor(s, o);
    if (lane == 0) rs[row] = 1.0f / sqrtf(s * (1.0f / D_) + EPS_);
}

struct WArgs { const float* w_in_a; const float* w_out_a; const float* w_kv; const float* w_in_b; const float* w_out_b;
               const float* g_norm_a; const float* g_ret_head; const float* g_kv; const float* g_norm_b; };
__device__ __forceinline__ int permA_src(int n) {
    if (n >= 1024) return n;
    const int tile = n >> 8, c = n & 255, bj = c >> 7, p = c & 127, hit = p >> 6, i = p & 63;
    return tile * 256 + hit * 128 + bj * 64 + i;
}
__global__ __launch_bounds__(256) void n0_w(WArgs a, int mode, bf16_t* __restrict__ out) {
    const int K = (mode == 0 || mode == 2) ? 1024 : 1536;
    const int N = mode == 0 ? 4096 : (mode == 2 ? 5120 : 1024);
    const size_t idx = (size_t)blockIdx.x * 256 + threadIdx.x; if (idx >= (size_t)N * K) return;
    const int k = (int)(idx % K), n = (int)(idx / K);
    float v;
    if (mode == 0) v = a.w_in_a[(size_t)k * 4096 + permA_src(n)] * a.g_norm_a[k];
    else if (mode == 1) v = a.w_out_a[(size_t)k * 1024 + n] * (k < 1024 ? a.g_ret_head[k & 255] : 1.0f);
    else if (mode == 2) {
        if (n < 2048) v = a.w_kv[(size_t)k * 2048 + n] * a.g_kv[k];
        else { const int c = n - 2048; const int src = c < 1024 ? 1024 + c : (c < 2048 ? c - 1024 : c);
               v = a.w_in_b[(size_t)k * 3072 + src] * a.g_norm_b[k]; }
    } else v = a.w_out_b[(size_t)k * 1024 + n];
    out[idx] = f2bf(v);
}

__global__ __launch_bounds__(256) void n0_mem(const float* __restrict__ mem, const float* __restrict__ g_mem, const float* __restrict__ w_mem_kv,
                                              const float* __restrict__ g_mem_q, const float* __restrict__ g_mem_k, bf16_t* __restrict__ memK, bf16_t* __restrict__ memV) {
    __shared__ float sm[1024]; __shared__ float skv[1024]; __shared__ float red[256]; __shared__ float hn[4];
    const int l = blockIdx.x >> 9, b = (blockIdx.x >> 8) & 1, m = blockIdx.x & 255, tid = threadIdx.x;
    const float* mr = mem + ((size_t)b * 256 + m) * D_;
    float s = 0.f; for (int j = tid; j < D_; j += 256) { const float v = mr[j]; s += v * v; }
    red[tid] = s; __syncthreads();
    for (int o = 128; o; o >>= 1) { if (tid < o) red[tid] += red[tid + o]; __syncthreads(); }
    const float r = 1.0f / sqrtf(red[0] * (1.0f / D_) + EPS_);
    for (int j = tid; j < D_; j += 256) sm[j] = mr[j] * r * g_mem[l * D_ + j];
    __syncthreads();
    const float* W = w_mem_kv + (size_t)l * D_ * 1024;
    float acc[4] = {0.f, 0.f, 0.f, 0.f};
    for (int k = 0; k < D_; ++k) { const float a = sm[k];
#pragma unroll
        for (int j = 0; j < 4; ++j) acc[j] += a * W[(size_t)k * 1024 + tid + 256 * j]; }
#pragma unroll
    for (int j = 0; j < 4; ++j) skv[tid + 256 * j] = acc[j];
    __syncthreads();
    if (tid < 4) { float q = 0.f; for (int d = 0; d < 128; ++d) { const float v = skv[tid * 128 + d]; q += v * v; } hn[tid] = 1.0f / sqrtf(q * (1.0f / 128) + EPS_); }
    __syncthreads();
    for (int j = tid; j < 512; j += 256) { const int h = j >> 7, d = j & 127;
        const size_t o = ((((size_t)l * 2 + b) * 4 + h) * 256 + m) * 128 + d;
        memK[o] = f2bf(skv[j] * hn[h] * g_mem_k[l * 128 + d] * g_mem_q[l * 128 + d] * QK_SCALE);
        memV[o] = f2bf(skv[512 + j]); }
}

struct GArgs { const bf16_t* A; int lda; const bf16_t* Bt; int K; int N;
               const float* rs0; const int* pos; bf16_t* U; const float* xres; float* out; bf16_t* x1b; float* ss1p; };
template <int EPI> __global__ __launch_bounds__(256) void n_gemm(GArgs g) {
    __shared__ float sA[16][36]; __shared__ float sC[16][257];
    const int ntn = g.N / 256, pm = blockIdx.x / ntn, pn = blockIdx.x % ntn, row0 = pm * 16, c = threadIdx.x;
    const bf16_t* brow = g.Bt + (size_t)(pn * 256 + c) * g.K;
    float acc[16];
#pragma unroll
    for (int r = 0; r < 16; ++r) acc[r] = 0.f;
    for (int k0 = 0; k0 < g.K; k0 += 32) {
        __syncthreads();
        for (int e = threadIdx.x; e < 512; e += 256) { const int r = e >> 5, kk = e & 31; sA[r][kk] = bf2f(g.A[(size_t)(row0 + r) * g.lda + k0 + kk]); }
        __syncthreads();
#pragma unroll
        for (int j = 0; j < 4; ++j) { const uint4 bv = *(const uint4*)(brow + k0 + 8 * j); const unsigned w[4] = {bv.x, bv.y, bv.z, bv.w};
#pragma unroll
            for (int q = 0; q < 4; ++q) { const float b0 = __uint_as_float(w[q] << 16), b1 = __uint_as_float(w[q] & 0xffff0000u); const int kk = 8 * j + 2 * q;
#pragma unroll
                for (int r = 0; r < 16; ++r) acc[r] += sA[r][kk] * b0 + sA[r][kk + 1] * b1; } }
    }
#pragma unroll
    for (int r = 0; r < 16; ++r) sC[r][c] = acc[r];
    __syncthreads();
    if (EPI == 0) {
        for (int r = 0; r < 16; ++r) { const int row = row0 + r; const float rs = g.rs0[row]; bf16_t* urow = g.U + (size_t)row * NA_;
            if (pn < 4) { if (c < 128) { const int hit = c >> 6, i = c & 63; const float x1 = sC[r][c] * rs, x2 = sC[r][c + 128] * rs;
                    float sn, cs; rot_sincos((float)g.pos[row] * rope_inv_freq(i), sn, cs); const float sc = pn >= 2 ? QK_SCALE : 1.0f;
                    urow[pn * 256 + hit * 128 + i] = f2bf((x1 * cs - x2 * sn) * sc); urow[pn * 256 + hit * 128 + 64 + i] = f2bf((x1 * sn + x2 * cs) * sc); } }
            else { const float v = sC[r][c] * rs; const bool silu = (pn >= 8 && pn < 12) || pn >= 14; urow[pn * 256 + c] = f2bf(silu ? silu_f(v) : v); } }
    } else if (EPI == 1) {
        for (int r = 0; r < 16; ++r) { const size_t o = (size_t)(row0 + r) * D_ + pn * 256 + c; const float v = g.xres[o] + sC[r][c]; g.out[o] = v; g.x1b[o] = f2bf(v); sC[r][c] = v * v; }
        __syncthreads();
        if (c < 16) { float s = 0.f; for (int j = 0; j < 256; ++j) s += sC[c][j]; float* p = g.ss1p + (size_t)(row0 + c) * 16 + pn * 4; p[0] = s; p[1] = 0.f; p[2] = 0.f; p[3] = 0.f; }
    } else if (EPI == 2) {
        for (int r = 0; r < 16; ++r) { const int row = row0 + r; const float* sp = g.ss1p + (size_t)row * 16; float ss = 0.f; for (int j = 0; j < 16; ++j) ss += sp[j];
            const float rs = 1.0f / sqrtf(ss * (1.0f / D_) + EPS_); float v = sC[r][c] * rs;
            if ((pn >= 8 && pn < 12) || pn >= 18) v = silu_f(v); else if (pn >= 12 && pn < 16) v *= QK_SCALE * 1.4426950408889634f;
            g.U[(size_t)row * NBW_ + pn * 256 + c] = f2bf(v); }
    } else {
        for (int r = 0; r < 16; ++r) { const size_t o = (size_t)(row0 + r) * D_ + pn * 256 + c; g.out[o] = bf2f(g.x1b[o]) + sC[r][c]; }
    }
}

__global__ __launch_bounds__(256) void n2_kv(const bf16_t* __restrict__ UA, bf16_t* __restrict__ KVT) {
    const int u = blockIdx.x >> 2, eg = blockIdx.x & 3, tid = threadIdx.x, e = eg * 64 + (tid & 63), dq = tid >> 6;
    const int b = u >> 8, h = (u >> 6) & 3, n = u & 63; const size_t row0 = (size_t)b * S_ + n * 128; const float lg = ret_lg(h);
    float acc[32];
#pragma unroll
    for (int j = 0; j < 32; ++j) acc[j] = 0.f;
    for (int m = 0; m < 128; ++m) { const bf16_t* ur = UA + (row0 + m) * NA_; const float vz = bf2f(ur[1024 + h * 256 + e]) * __expf((float)(127 - m) * lg);
#pragma unroll
        for (int j = 0; j < 32; ++j) acc[j] += vz * bf2f(ur[512 + h * 128 + dq * 32 + j]); }
#pragma unroll
    for (int j = 0; j < 32; ++j) KVT[((size_t)u * 256 + e) * 128 + dq * 32 + j] = f2bf(acc[j]);
}
__global__ __launch_bounds__(256) void n3_scan(bf16_t* __restrict__ KVT) {
    const int idx = blockIdx.x * 256 + threadIdx.x; const int bh = idx >> 15, off = idx & 32767; const float gc = __expf(128.0f * ret_lg(bh & 3));
    float s = 0.f;
    for (int n = 0; n < 64; ++n) { bf16_t* p = KVT + ((size_t)(bh * 64 + n) << 15) + off; const float t = bf2f(*p); *p = f2bf(s); s = gc * s + t; }
}
__global__ __launch_bounds__(256) void n4_ret(bf16_t* __restrict__ UA, const bf16_t* __restrict__ KVT) {
    __shared__ float sq[128], ss[128], red[256];
    const int u = blockIdx.x >> 7, c = blockIdx.x & 127, tid = threadIdx.x; const int b = u >> 8, h = (u >> 6) & 3, n = u & 63;
    const size_t row0 = (size_t)b * S_ + n * 128, row = row0 + c; const float lg = ret_lg(h);
    if (tid < 128) sq[tid] = bf2f(UA[row * NA_ + h * 128 + tid]);
    __syncthreads();
    if (tid < 128) { float d = 0.f; if (tid <= c) { const bf16_t* kr = UA + (row0 + tid) * NA_ + 512 + h * 128; for (int j = 0; j < 128; ++j) d += sq[j] * bf2f(kr[j]); d *= __expf((float)(c - tid) * lg); } ss[tid] = d; }
    __syncthreads();
    const int e = tid; float o = 0.f;
    for (int m = 0; m <= c; ++m) o += ss[m] * bf2f(UA[(row0 + m) * NA_ + 1024 + h * 256 + e]);
    float cr = 0.f; const bf16_t* st = KVT + ((size_t)u * 256 + e) * 128; for (int j = 0; j < 128; ++j) cr += sq[j] * bf2f(st[j]);
    o += __expf((float)(c + 1) * lg) * cr;
    red[tid] = o * o; __syncthreads();
    for (int w = 128; w; w >>= 1) { if (tid < w) red[tid] += red[tid + w]; __syncthreads(); }
    const float r = 1.0f / sqrtf(red[0] * (1.0f / 256) + EPS_);
    bf16_t* gp = UA + row * NA_ + 2048 + h * 256 + e; *gp = f2bf(o * r * bf2f(*gp));
}
__global__ __launch_bounds__(256) void n_memattn(bf16_t* __restrict__ U, int ld, int qoff, int goff, const bf16_t* __restrict__ memK, const bf16_t* __restrict__ memV, int layer) {
    __shared__ float sq[4][128]; __shared__ float sp[4][256];
    const int w = threadIdx.x >> 6, lane = threadIdx.x & 63; const int gw = blockIdx.x * 4 + w, row = gw >> 2, hd = gw & 3, b = row / S_;
    bf16_t* qp = U + (size_t)row * ld + qoff + hd * 128; const bf16_t* gp = U + (size_t)row * ld + goff + hd * 128;
    const float q0 = bf2f(qp[lane]), q1 = bf2f(qp[lane + 64]); sq[w][lane] = q0; sq[w][lane + 64] = q1;
    float s = q0 * q0 + q1 * q1; for (int o = 32; o; o >>= 1) s += __shfl_xor(s, o);
    const float rq = 1.0f / sqrtf(s * (1.0f / 128) + EPS_);
    __syncthreads();
    const bf16_t* Kb = memK + (((size_t)layer * 2 + b) * 4 + hd) * 256 * 128; const bf16_t* Vb = memV + (((size_t)layer * 2 + b) * 4 + hd) * 256 * 128;
    float lgt[4]; float mx = -1e30f;
    for (int j = 0; j < 4; ++j) { const bf16_t* kr = Kb + (size_t)(lane + 64 * j) * 128; float d = 0.f; for (int t = 0; t < 128; ++t) d += sq[w][t] * bf2f(kr[t]); lgt[j] = d * rq; mx = fmaxf(mx, lgt[j]); }
    for (int o = 32; o; o >>= 1) mx = fmaxf(mx, __shfl_xor(mx, o));
    float ps = 0.f; for (int j = 0; j < 4; ++j) { lgt[j] = __expf(lgt[j] - mx); ps += lgt[j]; }
    for (int o = 32; o; o >>= 1) ps += __shfl_xor(ps, o);
    for (int j = 0; j < 4; ++j) sp[w][lane + 64 * j] = lgt[j] / ps;
    __syncthreads();
    float o0 = 0.f, o1 = 0.f;
    for (int m = 0; m < 256; ++m) { const float p = sp[w][m]; o0 += p * bf2f(Vb[(size_t)m * 128 + lane]); o1 += p * bf2f(Vb[(size_t)m * 128 + lane + 64]); }
    const float g0 = bf2f(gp[lane]), g1 = bf2f(gp[lane + 64]);
    qp[lane] = f2bf(o0 * g0); qp[lane + 64] = f2bf(o1 * g1);
}
#ifndef NAIVE_SB_EXIT
#define NAIVE_SB_EXIT 1
#endif
__global__ __launch_bounds__(256) void n7_sb(bf16_t* __restrict__ UB) {
    __shared__ float sq[128]; __shared__ float sa[256]; __shared__ float wtot[4]; __shared__ float wpre[4];
    const int t = blockIdx.x & (S_ - 1), h = (blockIdx.x >> 13) & 7, b = blockIdx.x >> 16, tid = threadIdx.x, lane = tid & 63, w = tid >> 6;
    const size_t rowb = (size_t)b * S_; bf16_t* qp = UB + (rowb + t) * NBW_ + 3072 + h * 128;
    if (tid < 128) sq[tid] = bf2f(qp[tid]);
    __syncthreads();
    float carry = 0.f, od = 0.f;
    for (int s_hi = t - 1; s_hi >= 0; s_hi -= 256) {
        const int s = s_hi - tid; const bool valid = s >= 0;
        float z = 0.f; if (valid) { const bf16_t* kr = UB + (rowb + s) * NBW_ + h * 128; for (int j = 0; j < 128; ++j) z += sq[j] * bf2f(kr[j]); z *= 0.6931471805599453f; }
        const float spv = softplus_f(z); const float lf = valid ? -spv : 0.f;
        float inc = lf;
        for (int o = 1; o < 64; o <<= 1) { const float v = __shfl_up(inc, o); if (lane >= o) inc += v; }
        if (lane == 63) wtot[w] = inc;
        __syncthreads();
        if (tid == 0) { float a = 0.f; for (int j = 0; j < 4; ++j) { wpre[j] = a; a += wtot[j]; } }
        __syncthreads();
        const float pre = wpre[w] + inc - lf;
        const float tot = wpre[3] + wtot[3];
        sa[tid] = valid ? __expf((z - spv) + pre + carry) : 0.f;
        __syncthreads();
        if (tid < 128) { const int cnt = min(256, s_hi + 1); const bf16_t* vb = UB + rowb * NBW_ + 1024 + h * 128 + tid;
            for (int i = 0; i < cnt; ++i) od += sa[i] * bf2f(vb[(size_t)(s_hi - i) * NBW_]); }
        carry += tot;
        __syncthreads();
        if (NAIVE_SB_EXIT && carry < -104.0f) break;
    }
    if (tid < 128) { const float g = bf2f(UB[(rowb + t) * NBW_ + 2048 + h * 128 + tid]); qp[tid] = f2bf(od * g); }
}


namespace pg8 {
#define PG8_LAS __attribute__((address_space(3)))
typedef unsigned short bf16_t;
typedef short bf16x8 __attribute__((ext_vector_type(8)));
typedef float f32x4 __attribute__((ext_vector_type(4)));
typedef unsigned u32x4 __attribute__((ext_vector_type(4)));
constexpr int BM = 256, BK = 64, HALF = 128, HTB = HALF * BK * 2  , STAGE_BYTES = 8 * HTB, NXCD = 8, WGM = 8;

__host__ __device__ __forceinline__ int lds_byte(int r, int c) { const int st = (r >> 4) * 2 + (c >> 5), rr = r & 15, cc = c & 31, ob = rr * 64 + cc * 2; return st * 1024 + (ob ^ (((ob >> 9) & 1) << 5)); }
__host__ __device__ __forceinline__ void stage_rc(int b, int& R, int& C) { const int st = b / 1024, sb = b % 1024, swz = sb ^ (((sb >> 9) & 1) << 5); R = (st >> 1) * 16 + swz / 64; C = (st & 1) * 32 + (swz % 64) / 2; }
__host__ __device__ __forceinline__ int perm32(int rho) { const int n = rho >> 4, i = rho & 15; return 8 * (i >> 2) + 4 * n + (i & 3); }

struct Unit { int pm, pn; };
struct Gemm { const bf16_t* A; const bf16_t* Bt; int M, N, K, lda; };

struct StaticOrder {
    int nM, nN, nwg, G, c;
    __host__ __device__ void init(int M, int N, int G_, int c_) { nM = M / BM; nN = N / BM; nwg = nM * nN; G = G_; c = c_; }
    __host__ __device__ bool next(int i, Unit& u) const {
        const long L = (long)i * G + c; if (L >= nwg) return false;
        int wgid = (int)L; { const int q = nwg / NXCD, r = nwg % NXCD, xcd = wgid % NXCD, off = wgid / NXCD; wgid = (xcd < r ? xcd * (q + 1) : r * (q + 1) + (xcd - r) * q) + off; }
        const int nig = WGM * nN, gid = wgid / nig, fm = gid * WGM, gsz = (nM - fm) < WGM ? (nM - fm) : WGM;
        u.pm = fm + ((wgid % nig) % gsz); u.pn = (wgid % nig) / gsz; return true;
    }
    __device__ __forceinline__ void a_ready(const Unit&) const {}
    __device__ __forceinline__ void done(const Unit&) const {}
};

__device__ __forceinline__ unsigned cvt_pk_bf16(float lo, float hi) { unsigned r; asm volatile("v_cvt_pk_bf16_f32 %0, %1, %2" : "=v"(r) : "v"(lo), "v"(hi)); return r; }
__device__ __forceinline__ float silu_fast(float v) { return v * __builtin_amdgcn_rcpf(1.0f + __builtin_amdgcn_exp2f(-1.4426950408889634f * v)); }
__device__ __forceinline__ u32x4 pack8(const f32x4 a, const f32x4 b) { u32x4 w; w.x = cvt_pk_bf16(a[0], a[1]); w.y = cvt_pk_bf16(a[2], a[3]); w.z = cvt_pk_bf16(b[0], b[1]); w.w = cvt_pk_bf16(b[2], b[3]); return w; }

struct EpiA {
    static constexpr bool PERM = true, AFTER_DRAIN = false, ACC_INIT = false;
    bf16_t* U; const float* rs0; const int* pos;
    __device__ __forceinline__ void operator()(const f32x4 (&acc)[2][2][4][2], const Unit& u, int wr, int wc, int fr, int fq) const {
        const int row0 = u.pm * BM + wr * 64 + fr;
        if (u.pn < 4) {
            const int hit = wc >> 1, i0 = 32 * (wc & 1) + 8 * fq; const float sc = u.pn >= 2 ? QK_SCALE : 1.0f;
            float inv[8];
#pragma unroll
            for (int j = 0; j < 8; ++j) inv[j] = rope_inv_freq(i0 + j);
#pragma unroll
            for (int ai = 0; ai < 2; ++ai)
#pragma unroll
                for (int m = 0; m < 4; ++m) { const int row = row0 + ai * HALF + m * 16; const float rs = rs0[row] * sc, pf = (float)pos[row];
                    bf16_t* up = U + (size_t)row * NA_ + u.pn * BM + hit * 128 + i0;
                    f32x4 o1[2], o2[2];
#pragma unroll
                    for (int n = 0; n < 2; ++n)
#pragma unroll
                        for (int e = 0; e < 4; ++e) { float sn, cs; rot_sincos(pf * inv[4 * n + e], sn, cs); const float x1 = acc[ai][0][m][n][e] * rs, x2 = acc[ai][1][m][n][e] * rs;
                            o1[n][e] = x1 * cs - x2 * sn; o2[n][e] = x1 * sn + x2 * cs; }
                    *(u32x4*)up = pack8(o1[0], o1[1]); *(u32x4*)(up + 64) = pack8(o2[0], o2[1]); }
        } else {
            const bool silu = (u.pn >= 8 && u.pn < 12) || u.pn >= 14;
#pragma unroll
            for (int ai = 0; ai < 2; ++ai)
#pragma unroll
                for (int m = 0; m < 4; ++m) { const int row = row0 + ai * HALF + m * 16; const float rs = rs0[row]; bf16_t* rowp = U + (size_t)row * NA_ + u.pn * BM + wc * 32 + 8 * fq;
#pragma unroll
                    for (int bj = 0; bj < 2; ++bj) { f32x4 v0 = acc[ai][bj][m][0] * rs, v1 = acc[ai][bj][m][1] * rs;
                        if (silu) {
#pragma unroll
                            for (int e = 0; e < 4; ++e) { v0[e] = silu_fast(v0[e]); v1[e] = silu_fast(v1[e]); } }
                        *(u32x4*)(rowp + bj * HALF) = pack8(v0, v1); } }
        }
    }
};
struct EpiOutA {
    static constexpr bool PERM = true, AFTER_DRAIN = false, ACC_INIT = true;
    const float* xres; float* out; bf16_t* x1b; float* ss1p;
    __device__ __forceinline__ void init(f32x4 (&acc)[2][2][4][2], const Unit& u, int wr, int wc, int fr, int fq) const {
        const int row0 = u.pm * BM + wr * 64 + fr;
#pragma unroll
        for (int ai = 0; ai < 2; ++ai)
#pragma unroll
            for (int m = 0; m < 4; ++m) { const size_t off = (size_t)(row0 + ai * HALF + m * 16) * D_ + u.pn * BM + wc * 32 + 8 * fq;
#pragma unroll
                for (int bj = 0; bj < 2; ++bj) { acc[ai][bj][m][0] = *(const f32x4*)(xres + off + bj * HALF); acc[ai][bj][m][1] = *(const f32x4*)(xres + off + bj * HALF + 4); } }
    }
    __device__ __forceinline__ void operator()(const f32x4 (&acc)[2][2][4][2], const Unit& u, int wr, int wc, int fr, int fq) const {
        const int row0 = u.pm * BM + wr * 64 + fr;
#pragma unroll
        for (int ai = 0; ai < 2; ++ai)
#pragma unroll
            for (int m = 0; m < 4; ++m) { const int row = row0 + ai * HALF + m * 16; const size_t off = (size_t)row * D_ + u.pn * BM + wc * 32 + 8 * fq; float ssq = 0.f;
#pragma unroll
                for (int bj = 0; bj < 2; ++bj) { const f32x4 v0 = acc[ai][bj][m][0], v1 = acc[ai][bj][m][1];
                    *(u32x4*)(x1b + off + bj * HALF) = pack8(v0, v1);
                    ssq += (v0[0] * v0[0] + v0[1] * v0[1]) + (v0[2] * v0[2] + v0[3] * v0[3]) + (v1[0] * v1[0] + v1[1] * v1[1]) + (v1[2] * v1[2] + v1[3] * v1[3]); }
                ssq += __shfl_xor(ssq, 16); ssq += __shfl_xor(ssq, 32);
                if (fq == 0) ss1p[(size_t)row * 16 + u.pn * 4 + wc] = ssq; }
    }
};
struct EpiB {
    static constexpr bool PERM = true, AFTER_DRAIN = false, ACC_INIT = false;
    bf16_t* U; const float* ss1p;
    __device__ __forceinline__ void operator()(const f32x4 (&acc)[2][2][4][2], const Unit& u, int wr, int wc, int fr, int fq) const {
        const int row0 = u.pm * BM + wr * 64 + fr; const bool silu = (u.pn >= 8 && u.pn < 12) || u.pn >= 18; const float sc = (u.pn >= 12 && u.pn < 16) ? QK_SCALE * 1.4426950408889634f : 1.0f;
#pragma unroll
        for (int ai = 0; ai < 2; ++ai)
#pragma unroll
            for (int m = 0; m < 4; ++m) { const int row = row0 + ai * HALF + m * 16; const f32x4 pv = *(const f32x4*)(ss1p + (size_t)row * 16 + 4 * fq);
                float s = (pv[0] + pv[1]) + (pv[2] + pv[3]); s += __shfl_xor(s, 16); s += __shfl_xor(s, 32);
                const float rs = sc / sqrtf(s * (1.0f / D_) + EPS_); bf16_t* rowp = U + (size_t)row * NBW_ + u.pn * BM + wc * 32 + 8 * fq;
#pragma unroll
                for (int bj = 0; bj < 2; ++bj) { f32x4 v0 = acc[ai][bj][m][0] * rs, v1 = acc[ai][bj][m][1] * rs;
                    if (silu) {
#pragma unroll
                        for (int e = 0; e < 4; ++e) { v0[e] = silu_fast(v0[e]); v1[e] = silu_fast(v1[e]); } }
                    *(u32x4*)(rowp + bj * HALF) = pack8(v0, v1); } }
    }
};
struct EpiOutB {
    static constexpr bool PERM = true, AFTER_DRAIN = false, ACC_INIT = true;
    float* out; const bf16_t* x1b;
    __device__ __forceinline__ void init(f32x4 (&acc)[2][2][4][2], const Unit& u, int wr, int wc, int fr, int fq) const {
        const int row0 = u.pm * BM + wr * 64 + fr;
#pragma unroll
        for (int ai = 0; ai < 2; ++ai)
#pragma unroll
            for (int m = 0; m < 4; ++m) { const size_t off = (size_t)(row0 + ai * HALF + m * 16) * D_ + u.pn * BM + wc * 32 + 8 * fq;
#pragma unroll
                for (int bj = 0; bj < 2; ++bj) { const u32x4 w = *(const u32x4*)(x1b + off + bj * HALF);
                    acc[ai][bj][m][0] = (f32x4){__uint_as_float(w.x << 16), __uint_as_float(w.x & 0xffff0000u), __uint_as_float(w.y << 16), __uint_as_float(w.y & 0xffff0000u)};
                    acc[ai][bj][m][1] = (f32x4){__uint_as_float(w.z << 16), __uint_as_float(w.z & 0xffff0000u), __uint_as_float(w.w << 16), __uint_as_float(w.w & 0xffff0000u)}; } }
    }
    __device__ __forceinline__ void operator()(const f32x4 (&acc)[2][2][4][2], const Unit& u, int wr, int wc, int fr, int fq) const {
        const int row0 = u.pm * BM + wr * 64 + fr;
#pragma unroll
        for (int ai = 0; ai < 2; ++ai)
#pragma unroll
            for (int m = 0; m < 4; ++m) { const size_t off = (size_t)(row0 + ai * HALF + m * 16) * D_ + u.pn * BM + wc * 32 + 8 * fq;
#pragma unroll
                for (int bj = 0; bj < 2; ++bj) { *(f32x4*)(out + off + bj * HALF) = acc[ai][bj][m][0]; *(f32x4*)(out + off + bj * HALF + 4) = acc[ai][bj][m][1]; } }
    }
};

template <class Epi, class Sched, bool ALIGN_EPI = false, bool SP2 = false>
__device__ __forceinline__ void gemm_phase(PG8_LAS unsigned char* lds, const Gemm g, const Sched& S, const Epi& E) {
    const int tid = threadIdx.x, wid = __builtin_amdgcn_readfirstlane(tid >> 6), lane = tid & 63, wr = wid >> 2, wc = wid & 3, fr = lane & 15, fq = lane >> 4;
    const int K = g.K, nt = K / BK;
    unsigned voffA[2], voffB[2];
#pragma unroll
    for (int i = 0; i < 2; ++i) { int R, C; stage_rc(tid * 16 + i * 8192, R, C); const int Rb = Epi::PERM ? ((R & ~31) + perm32(R & 31)) : R;
        voffA[i] = (unsigned)(R * g.lda + C) * 2u; voffB[i] = (unsigned)(Rb * K + C) * 2u; }
    const size_t kstep = (size_t)(BK * 2);
    const size_t hstepA = (size_t)HALF * g.lda * 2, hstepB = (size_t)HALF * K * 2;
    const size_t tstepA = 2 * hstepA, tstepB = 2 * hstepB;
    const unsigned ldsw = (unsigned)wid * 1024u;
    const int aoff = lds_byte(wr * 64 + fr, fq * 8), boff = lds_byte(wc * 32 + fr, fq * 8);
#define PG8_SA(b, h) (((b) * 2 + (h)) * HTB)
#define PG8_SB(b, h) ((4 + (b) * 2 + (h)) * HTB)
#define PG8_STAGE(bufoff, gbase, voff) do { _Pragma("unroll") for (int _i = 0; _i < 2; ++_i) \
        __builtin_amdgcn_global_load_lds((const unsigned*)((const char*)(gbase) + (voff)[_i]), (PG8_LAS unsigned*)(lds + (bufoff) + ldsw + _i * 8192), 16, 0, 0); } while (0)
#define PG8_LDA(dst, b, h) do { _Pragma("unroll") for (int m = 0; m < 4; ++m) _Pragma("unroll") for (int k = 0; k < 2; ++k) dst[m][k] = *(const PG8_LAS bf16x8*)(lds + PG8_SA(b, h) + aoff + m * 2048 + k * 1024); } while (0)
#define PG8_LDB(dst, b, h) do { _Pragma("unroll") for (int n = 0; n < 2; ++n) _Pragma("unroll") for (int k = 0; k < 2; ++k) dst[n][k] = *(const PG8_LAS bf16x8*)(lds + PG8_SB(b, h) + boff + n * 2048 + k * 1024); } while (0)
#define PG8_MMA(ai, bj, At, Bt) do { __builtin_amdgcn_s_setprio(1); _Pragma("unroll") for (int m = 0; m < 4; ++m) _Pragma("unroll") for (int n = 0; n < 2; ++n) _Pragma("unroll") for (int k = 0; k < 2; ++k) \
        acc[ai][bj][m][n] = __builtin_amdgcn_mfma_f32_16x16x32_bf16(Bt[n][k], At[m][k], acc[ai][bj][m][n], 0, 0, 0); __builtin_amdgcn_s_setprio(0); } while (0)
#define PG8_WAIT_V(n) asm volatile("s_waitcnt vmcnt(" #n ")" ::: "memory")
#define PG8_WAIT_L(n) asm volatile("s_waitcnt lgkmcnt(" #n ")" ::: "memory")
#define PG8_BAR __builtin_amdgcn_s_barrier()
#define PG8_SCHED __builtin_amdgcn_sched_barrier(0)
    Unit cur, nxt; int ui = 0;
    if (!S.next(0, cur)) return;
    f32x4 acc[2][2][4][2];
#pragma unroll
    for (int a = 0; a < 2; ++a)
#pragma unroll
        for (int b = 0; b < 2; ++b)
#pragma unroll
            for (int m = 0; m < 4; ++m)
#pragma unroll
                for (int n = 0; n < 2; ++n) acc[a][b][m][n] = (f32x4){0.f, 0.f, 0.f, 0.f};
    if constexpr (Epi::ACC_INIT) E.init(acc, cur, wr, wc, fr, fq);
    bf16x8 At[4][2], B0[2][2], B1[2][2];
    const char* cA = (const char*)g.A + (size_t)cur.pm * tstepA; const char* cB = (const char*)g.Bt + (size_t)cur.pn * tstepB;
    S.a_ready(cur);
    if constexpr (SP2) {
        PG8_STAGE(PG8_SB(0, 0), cB, voffB); PG8_STAGE(PG8_SB(0, 1), cB + hstepB, voffB); PG8_STAGE(PG8_SA(0, 0), cA, voffA); PG8_STAGE(PG8_SA(0, 1), cA + hstepA, voffA);
        if (wr == 1) PG8_BAR;
        PG8_WAIT_V(2); PG8_BAR;
        PG8_STAGE(PG8_SB(1, 0), cB + kstep, voffB); PG8_STAGE(PG8_SA(1, 0), cA + kstep, voffA); PG8_STAGE(PG8_SB(1, 1), cB + hstepB + kstep, voffB);
        PG8_WAIT_V(6); PG8_BAR;
    } else {
        PG8_STAGE(PG8_SB(0, 0), cB, voffB); PG8_STAGE(PG8_SA(0, 0), cA, voffA); PG8_STAGE(PG8_SB(0, 1), cB + hstepB, voffB); PG8_STAGE(PG8_SA(0, 1), cA + hstepA, voffA);
        if (wr == 1) PG8_BAR;
        PG8_WAIT_V(4); PG8_BAR;
        PG8_STAGE(PG8_SB(1, 0), cB + kstep, voffB); PG8_STAGE(PG8_SA(1, 0), cA + kstep, voffA); PG8_STAGE(PG8_SB(1, 1), cB + hstepB + kstep, voffB);
        PG8_WAIT_V(6); PG8_BAR;
    }
    for (;;) {
        const bool has_next = S.next(ui + 1, nxt);
        const char* nA = has_next ? (const char*)g.A + (size_t)nxt.pm * tstepA : cA; const char* nB = has_next ? (const char*)g.Bt + (size_t)nxt.pn * tstepB : cB;
        for (int t = 0; t < nt; t += 2) {
            const bool last = (t == nt - 2);
            const char* a1 = cA + (size_t)(t + 1) * kstep;
            const char* a2 = last ? nA : cA + (size_t)(t + 2) * kstep; const char* b2 = last ? nB : cB + (size_t)(t + 2) * kstep;
            const char* a3 = a2 + kstep; const char* b3 = b2 + kstep;
            if (last && has_next) S.a_ready(nxt);
            if constexpr (SP2) {
            PG8_LDB(B0, 0, 0); PG8_LDB(B1, 0, 1); PG8_SCHED; PG8_LDA(At, 0, 0); PG8_STAGE(PG8_SA(1, 1), a1 + hstepA, voffA);
            PG8_WAIT_V(8); PG8_WAIT_L(0); PG8_BAR; PG8_MMA(0, 0, At, B0); PG8_MMA(0, 1, At, B1); PG8_BAR; PG8_SCHED;
            PG8_LDA(At, 0, 1); PG8_STAGE(PG8_SB(0, 0), b2, voffB); PG8_STAGE(PG8_SB(0, 1), b2 + hstepB, voffB); PG8_STAGE(PG8_SA(0, 0), a2, voffA);
            PG8_WAIT_V(8); PG8_WAIT_L(0); PG8_BAR; PG8_MMA(1, 0, At, B0); PG8_MMA(1, 1, At, B1); PG8_BAR; PG8_SCHED;
            PG8_LDB(B0, 1, 0); PG8_LDB(B1, 1, 1); PG8_SCHED; PG8_LDA(At, 1, 0); PG8_STAGE(PG8_SA(0, 1), a2 + hstepA, voffA);
            PG8_WAIT_V(8); PG8_WAIT_L(0); PG8_BAR; PG8_MMA(0, 0, At, B0); PG8_MMA(0, 1, At, B1); PG8_BAR; PG8_SCHED;
            PG8_LDA(At, 1, 1); PG8_STAGE(PG8_SB(1, 0), b3, voffB); PG8_STAGE(PG8_SB(1, 1), b3 + hstepB, voffB); PG8_STAGE(PG8_SA(1, 0), a3, voffA);
            PG8_WAIT_V(8); PG8_WAIT_L(0); PG8_BAR; PG8_MMA(1, 0, At, B0); PG8_MMA(1, 1, At, B1); PG8_BAR; PG8_SCHED;
            } else {
            PG8_LDB(B0, 0, 0); PG8_SCHED; PG8_LDA(At, 0, 0); PG8_STAGE(PG8_SA(1, 1), a1 + hstepA, voffA);
            PG8_WAIT_L(8); PG8_BAR; PG8_WAIT_L(0); PG8_MMA(0, 0, At, B0); PG8_BAR; PG8_SCHED;
            PG8_LDB(B1, 0, 1); PG8_STAGE(PG8_SB(0, 0), b2, voffB);
            PG8_BAR; PG8_WAIT_L(0); PG8_MMA(0, 1, At, B1); PG8_BAR;
            PG8_LDA(At, 0, 1); PG8_STAGE(PG8_SA(0, 0), a2, voffA);
            PG8_BAR; PG8_WAIT_L(0); PG8_MMA(1, 0, At, B0); PG8_BAR; PG8_SCHED;
            PG8_STAGE(PG8_SB(0, 1), b2 + hstepB, voffB);
            PG8_WAIT_V(6); PG8_BAR; PG8_MMA(1, 1, At, B1); PG8_BAR;
            PG8_LDB(B0, 1, 0); PG8_SCHED; PG8_LDA(At, 1, 0); PG8_STAGE(PG8_SA(0, 1), a2 + hstepA, voffA);
            PG8_WAIT_L(8); PG8_BAR; PG8_WAIT_L(0); PG8_MMA(0, 0, At, B0); PG8_BAR; PG8_SCHED;
            PG8_LDB(B1, 1, 1); PG8_STAGE(PG8_SB(1, 0), b3, voffB);
            PG8_BAR; PG8_WAIT_L(0); PG8_MMA(0, 1, At, B1); PG8_BAR;
            PG8_LDA(At, 1, 1); PG8_STAGE(PG8_SA(1, 0), a3, voffA);
            PG8_BAR; PG8_WAIT_L(0); PG8_MMA(1, 0, At, B0); PG8_BAR; PG8_SCHED;
            PG8_STAGE(PG8_SB(1, 1), b3 + hstepB, voffB);
            PG8_WAIT_V(6); PG8_BAR; PG8_MMA(1, 1, At, B1); PG8_BAR;
            }
        }
        if constexpr (ALIGN_EPI) { if (wr == 0) PG8_BAR; }
        if constexpr (!Epi::AFTER_DRAIN) { E(acc, cur, wr, wc, fr, fq); S.done(cur); }
        if (!has_next) break;
#pragma unroll
        for (int a = 0; a < 2; ++a)
#pragma unroll
            for (int b = 0; b < 2; ++b)
#pragma unroll
                for (int m = 0; m < 4; ++m)
#pragma unroll
                    for (int n = 0; n < 2; ++n) acc[a][b][m][n] = (f32x4){0.f, 0.f, 0.f, 0.f};
        cur = nxt; cA = nA; cB = nB; ++ui;
        if constexpr (Epi::ACC_INIT) E.init(acc, cur, wr, wc, fr, fq);
        if constexpr (ALIGN_EPI) { if (wr == 1) PG8_BAR; }
    }
    PG8_WAIT_V(0);
    if constexpr (!ALIGN_EPI) { if (wr == 0) PG8_BAR; }
    PG8_BAR;
    if constexpr (Epi::AFTER_DRAIN) { E.fused(acc, cur, wr, wc, fr, fq, lds, wid, lane); S.done(cur); }
#undef PG8_SA
#undef PG8_SB
#undef PG8_STAGE
#undef PG8_LDA
#undef PG8_LDB
#undef PG8_MMA
#undef PG8_WAIT_V
#undef PG8_WAIT_L
#undef PG8_BAR
#undef PG8_SCHED
}
}

#define LAS __attribute__((address_space(3)))
#define XB_TMO      128
#define XB_XCNT(j)  (256  + 64 * (j))
#define XB_XSUB(j)  (1280 + 64 * (j))
#define XB_XGEN(j)  (2304 + 64 * (j))
#define XB_TOP      3328
#define XB_TOPGEN   3392
#define XCD_BAR_WORDS 3456
#define XB_SPIN_CAP (1u << 18)

__device__ __forceinline__ unsigned xb_ld(unsigned* p)              { return __hip_atomic_load(p, __ATOMIC_RELAXED, __HIP_MEMORY_SCOPE_AGENT); }
__device__ __forceinline__ unsigned xb_add(unsigned* p, unsigned v) { return __hip_atomic_fetch_add(p, v, __ATOMIC_RELAXED, __HIP_MEMORY_SCOPE_AGENT); }
__device__ __forceinline__ unsigned xb_xcc_id() { return (unsigned)__builtin_amdgcn_s_getreg((3 << 11) | 20) & 0xFu; }
#define XB_SPIN(cond, bar) do { unsigned _sp = 0; while (cond) { __builtin_amdgcn_s_sleep(1); \
    if ((++_sp & 255u) == 0u) { if (xb_ld(&(bar)[XB_TMO])) break; if (_sp > XB_SPIN_CAP) { atomicAdd(&(bar)[XB_TMO], 1u); break; } } } } while (0)

struct XcdBarrier {
    unsigned* bar; unsigned x;
    volatile LAS unsigned* st;
};

__device__ __forceinline__ XcdBarrier xcd_barrier_post(unsigned* bar, volatile LAS unsigned* st) {
    XcdBarrier b; b.bar = bar; b.x = xb_xcc_id(); b.st = st;
    if (threadIdx.x == 0) (void)xb_add(&bar[XB_XCNT(b.x)], 1u);
    return b;
}
__device__ __forceinline__ void xcd_barrier_complete(unsigned* bar, unsigned x, unsigned& nloc, unsigned& nx) {
    const unsigned G = gridDim.x * gridDim.y * gridDim.z;
    unsigned sum, cnt, mine, sp = 0u;
    for (;;) {
        sum = 0u; cnt = 0u; mine = 0u;
#pragma unroll
        for (unsigned j = 0; j < 16; ++j) { const unsigned c = xb_ld(&bar[XB_XCNT(j)]); sum += c; cnt += (c > 0u) ? 1u : 0u; mine = (j == x) ? c : mine; }
        if (sum == G) break;
        __builtin_amdgcn_s_sleep(1);
        if ((++sp & 255u) == 0u) { if (xb_ld(&bar[XB_TMO])) break; if (sp > XB_SPIN_CAP) { atomicAdd(&bar[XB_TMO], 1u); break; } }
    }
    nloc = mine > 0u ? mine : 1u; nx = cnt > 0u ? cnt : 1u;
}

__device__ __forceinline__ void xcd_barrier(const XcdBarrier& b) {
    asm volatile("s_waitcnt vmcnt(0)" ::: "memory");
    __syncthreads();
    if (threadIdx.x == 0) {
        unsigned* bar = b.bar;
        __builtin_amdgcn_s_waitcnt(0);
        unsigned nloc = b.st[0], nx = b.st[1];
        if (nloc == 0u) { xcd_barrier_complete(bar, b.x, nloc, nx); b.st[0] = nloc; b.st[1] = nx; }
        const unsigned old = xb_add(&bar[XB_XSUB(b.x)], 1u);
        const unsigned gen = old / nloc;
        if (old + 1u == (gen + 1u) * nloc) {
            __builtin_amdgcn_fence(__ATOMIC_RELEASE, "agent");
            asm volatile("s_waitcnt vmcnt(0)" ::: "memory");
            const unsigned og = xb_add(&bar[XB_TOP], 1u);
            const unsigned tg = og / nx;
            if (og + 1u == (tg + 1u) * nx) xb_add(&bar[XB_TOPGEN], 1u);
            else XB_SPIN(xb_ld(&bar[XB_TOPGEN]) == tg, bar);
            __builtin_amdgcn_fence(__ATOMIC_ACQUIRE, "agent");
            xb_add(&bar[XB_XGEN(b.x)], 1u);
            asm volatile("s_waitcnt vmcnt(0)" ::: "memory");
        } else {
            XB_SPIN(xb_ld(&bar[XB_XGEN(b.x)]) == gen, bar);
            __builtin_amdgcn_fence(__ATOMIC_ACQUIRE, "agent");
            asm volatile("s_waitcnt vmcnt(0)" ::: "memory");
        }
    }
    __syncthreads();
}

constexpr int NWAVES = 8;
constexpr int RING_BYTES = 131072;
constexpr int LDSCTL_OFF = 139264;
constexpr int LDS_BYTES = 147456;
constexpr int CW_BAR = 4096;
constexpr size_t CTL_ZERO_BYTES = 131072;
#ifndef OPT_MASK
#define OPT_MASK 0x1FF
#endif

typedef float f32x4 __attribute__((ext_vector_type(4)));
typedef unsigned u32x4v __attribute__((ext_vector_type(4)));
typedef unsigned u32x2v __attribute__((ext_vector_type(2)));
typedef short bf16x8 __attribute__((ext_vector_type(8)));
#define LDS_WAIT() asm volatile("s_waitcnt lgkmcnt(0)" ::: "memory")

struct MArgs { const float* in[16]; float* out; unsigned char* ws; int ph_lo, ph_hi, li, pad; };
struct Frame { LAS unsigned char* lds; int tid, lane, wave, G, bid; const float* in[16]; float* out; unsigned char* ws; };

__device__ __forceinline__ unsigned pk2(float lo, float hi) { return pg8::cvt_pk_bf16(lo, hi); }
__device__ __forceinline__ float wave_sum(float v) {
#pragma unroll
    for (int o = 1; o < 64; o <<= 1) v += __shfl_xor(v, o);
    return v;
}

template <int NR> __device__ __forceinline__ void p0_x_rows(const float* x, bf16_t* xb, float* rs, int row, int lane) {
    f32x4 v[NR][4]; float s[NR];
#pragma unroll
    for (int r = 0; r < NR; ++r) { const f32x4* xr = (const f32x4*)(x + (size_t)(row + r) * D_) + lane;
#pragma unroll
        for (int j = 0; j < 4; ++j) v[r][j] = xr[64 * j]; }
#pragma unroll
    for (int r = 0; r < NR; ++r) { s[r] = 0.f;
#pragma unroll
        for (int j = 0; j < 4; ++j) s[r] += (v[r][j][0] * v[r][j][0] + v[r][j][1] * v[r][j][1]) + (v[r][j][2] * v[r][j][2] + v[r][j][3] * v[r][j][3]); }
#pragma unroll
    for (int o = 1; o < 64; o <<= 1)
#pragma unroll
        for (int r = 0; r < NR; ++r) s[r] += __shfl_xor(s[r], o);
#pragma unroll
    for (int r = 0; r < NR; ++r) { u32x2v* o8 = (u32x2v*)(xb + (size_t)(row + r) * D_) + lane;
#pragma unroll
        for (int j = 0; j < 4; ++j) { u32x2v w; w.x = pk2(v[r][j][0], v[r][j][1]); w.y = pk2(v[r][j][2], v[r][j][3]); o8[64 * j] = w; }
        if (lane == 0) rs[row + r] = 1.0f / sqrtf(s[r] * (1.0f / D_) + EPS_); }
}
constexpr int TSCR_BYTES = 64 * 65 * 4;
__device__ __forceinline__ void p0_transpose_item(const float* W, int ldw, int csrc, const float* gain, int gmask, bf16_t* WT, int K, int nrow, int k0, LAS float* scr, int lane) {
    const int kk = lane >> 4, nq = lane & 15;
    f32x4 v[16];
#pragma unroll
    for (int j = 0; j < 16; ++j) v[j] = *(const f32x4*)(W + (size_t)(k0 + 4 * j + kk) * ldw + csrc + 4 * nq);
#pragma unroll
    for (int j = 0; j < 16; ++j) { const int k = 4 * j + kk; LAS float* d = scr + k * 65 + ((4 * nq + 4 * (j >> 3)) & 63);
        d[0] = v[j][0]; d[1] = v[j][1]; d[2] = v[j][2]; d[3] = v[j][3]; }
    const int c = lane & 7, nr = lane >> 3;
    f32x4 g0 = (f32x4){1.f, 1.f, 1.f, 1.f}, g1 = g0;
    if (gain) { g0 = *(const f32x4*)(gain + ((k0 + 8 * c) & gmask)); g1 = *(const f32x4*)(gain + ((k0 + 8 * c + 4) & gmask)); }
    LDS_WAIT(); asm volatile("" ::: "memory");
#pragma unroll
    for (int jj = 0; jj < 8; ++jj) { const int n = nr + 8 * jj; const LAS float* s = scr + (8 * c) * 65 + ((n + 4 * (c >> 2)) & 63);
        u32x4v o; o.x = pk2(s[0 * 65] * g0[0], s[1 * 65] * g0[1]); o.y = pk2(s[2 * 65] * g0[2], s[3 * 65] * g0[3]); o.z = pk2(s[4 * 65] * g1[0], s[5 * 65] * g1[1]); o.w = pk2(s[6 * 65] * g1[2], s[7 * 65] * g1[3]);
        *(u32x4v*)(WT + (size_t)(nrow + n) * K + k0 + 8 * c) = o; }
    LDS_WAIT(); asm volatile("" ::: "memory");
}
__device__ __forceinline__ void p0_memkv(const Frame& F, int unit) {
    const int l = unit >> 7, b = (unit >> 6) & 1, mt = (unit >> 3) & 7, cg = unit & 7, lane = F.lane, w = F.wave, c = lane & 15, g4 = lane >> 4, cgw = w & 1, kq = w >> 1;
    const float* mem = F.in[1] + ((size_t)b * 256 + mt * 32) * D_; const float* W = F.in[13] + (size_t)l * D_ * 1024 + cg * 128 + 64 * cgw + 4 * c; const float* gm = F.in[12] + l * D_;
    f32x4 acc[4][2];
#pragma unroll
    for (int t = 0; t < 4; ++t) { acc[t][0] = (f32x4){0.f, 0.f, 0.f, 0.f}; acc[t][1] = (f32x4){0.f, 0.f, 0.f, 0.f}; }
#pragma unroll 4
    for (int ks = 0; ks < 8; ++ks) { const int kb = kq * 256 + ks * 32 + 8 * g4;
        const f32x4 g0 = *(const f32x4*)(gm + kb), g1 = *(const f32x4*)(gm + kb + 4);
        bf16x8 afr[2], bfr[4];
#pragma unroll
        for (int rb = 0; rb < 2; ++rb) { const float* p = mem + (size_t)(rb * 16 + c) * D_ + kb; const f32x4 a0 = *(const f32x4*)p * g0, a1 = *(const f32x4*)(p + 4) * g1;
            u32x4v t; t.x = pk2(a0[0], a0[1]); t.y = pk2(a0[2], a0[3]); t.z = pk2(a1[0], a1[1]); t.w = pk2(a1[2], a1[3]); afr[rb] = __builtin_bit_cast(bf16x8, t); }
        f32x4 wv[8];
#pragma unroll
        for (int j = 0; j < 8; ++j) wv[j] = *(const f32x4*)(W + (size_t)(kb + j) * 1024);
#pragma unroll
        for (int t = 0; t < 4; ++t) { u32x4v q; q.x = pk2(wv[0][t], wv[1][t]); q.y = pk2(wv[2][t], wv[3][t]); q.z = pk2(wv[4][t], wv[5][t]); q.w = pk2(wv[6][t], wv[7][t]); bfr[t] = __builtin_bit_cast(bf16x8, q); }
#pragma unroll
        for (int t = 0; t < 4; ++t)
#pragma unroll
            for (int rb = 0; rb < 2; ++rb) acc[t][rb] = __builtin_amdgcn_mfma_f32_16x16x32_bf16(afr[rb], bfr[t], acc[t][rb], 0, 0, 0);
    }
    LAS float* P = (LAS float*)F.lds;
#pragma unroll
    for (int rb = 0; rb < 2; ++rb)
#pragma unroll
        for (int r = 0; r < 4; ++r) { const int tok = rb * 16 + 4 * g4 + r; *(LAS f32x4*)(P + ((kq * 32 + tok) * 128 + 64 * cgw + 4 * c)) = (f32x4){acc[0][rb][r], acc[1][rb][r], acc[2][rb][r], acc[3][rb][r]}; }
    __syncthreads();
    const int tok = F.tid >> 4, cb = F.tid & 15;
    f32x4 s0 = (f32x4){0.f, 0.f, 0.f, 0.f}, s1 = s0;
#pragma unroll
    for (int q = 0; q < 4; ++q) { s0 += *(const LAS f32x4*)(P + ((q * 32 + tok) * 128 + cb * 8)); s1 += *(const LAS f32x4*)(P + ((q * 32 + tok) * 128 + cb * 8 + 4)); }
    float ms = 0.f; { const f32x4* mr = (const f32x4*)(mem + (size_t)tok * D_ + cb * 64);
#pragma unroll
        for (int j = 0; j < 16; ++j) { const f32x4 v = mr[j]; ms += (v[0] * v[0] + v[1] * v[1]) + (v[2] * v[2] + v[3] * v[3]); } }
    ms += __shfl_xor(ms, 1); ms += __shfl_xor(ms, 2); ms += __shfl_xor(ms, 4); ms += __shfl_xor(ms, 8);
    const float rm = 1.0f / sqrtf(ms * (1.0f / D_) + EPS_);
    s0 *= rm; s1 *= rm;
    const size_t orow = ((((size_t)l * 2 + b) * 4 + (cg & 3)) * 256 + mt * 32 + tok) * 128 + cb * 8;
    if (cg < 4) {
        float q = (s0[0] * s0[0] + s0[1] * s0[1]) + (s0[2] * s0[2] + s0[3] * s0[3]) + (s1[0] * s1[0] + s1[1] * s1[1]) + (s1[2] * s1[2] + s1[3] * s1[3]);
        q += __shfl_xor(q, 1); q += __shfl_xor(q, 2); q += __shfl_xor(q, 4); q += __shfl_xor(q, 8);
        const float hn = QK_SCALE / sqrtf(q * (1.0f / 128) + EPS_);
        const f32x4 gk0 = *(const f32x4*)(F.in[15] + l * 128 + cb * 8), gk1 = *(const f32x4*)(F.in[15] + l * 128 + cb * 8 + 4);
        const f32x4 gq0 = *(const f32x4*)(F.in[14] + l * 128 + cb * 8), gq1 = *(const f32x4*)(F.in[14] + l * 128 + cb * 8 + 4);
        s0 = s0 * hn * gk0 * gq0; s1 = s1 * hn * gk1 * gq1;
        *(u32x4v*)((bf16_t*)(F.ws + WS_MEMK) + orow) = pg8::pack8(s0, s1);
    } else *(u32x4v*)((bf16_t*)(F.ws + WS_MEMV) + orow) = pg8::pack8(s0, s1);
    __syncthreads();
}
__device__ __forceinline__ void p0_weight_item(const Frame& F, int r, LAS float* scr) {
    constexpr int I_A = 16 * 64, I_OA = 24 * 16, I_B = 16 * 80;
    if (r < I_A) { const int kb = r / 64, n0 = 64 * (r % 64); p0_transpose_item(F.in[4], 4096, permA_src(n0), F.in[3], 0xffff, (bf16_t*)(F.ws + WS_WINA), 1024, n0, 64 * kb, scr, F.lane); return; } r -= I_A;
    if (r < I_OA) { const int kb = r / 16, n0 = 64 * (r % 16); p0_transpose_item(F.in[6], 1024, n0, kb < 16 ? F.in[5] : nullptr, 255, (bf16_t*)(F.ws + WS_WOUTA), 1536, n0, 64 * kb, scr, F.lane); return; } r -= I_OA;
    if (r < I_B) { const int kb = r / 80, n0 = 64 * (r % 80);
        if (n0 < 2048) p0_transpose_item(F.in[8], 2048, n0, F.in[7], 0xffff, (bf16_t*)(F.ws + WS_WB), 1024, n0, 64 * kb, scr, F.lane);
        else { const int c = n0 - 2048, src = c < 1024 ? 1024 + c : (c < 2048 ? c - 1024 : c); p0_transpose_item(F.in[10], 3072, src, F.in[9], 0xffff, (bf16_t*)(F.ws + WS_WB), 1024, n0, 64 * kb, scr, F.lane); }
        return; } r -= I_B;
    { const int kb = r / 16, n0 = 64 * (r % 16); p0_transpose_item(F.in[11], 1024, n0, nullptr, 0, (bf16_t*)(F.ws + WS_WOUTB), 1536, n0, 64 * kb, scr, F.lane); }
}
__device__ __forceinline__ void p0_prologue(const Frame& F) {
    for (int u = F.bid; u < 256; u += F.G) p0_memkv(F, u);
    const int gw = F.bid * NWAVES + F.wave, NGW = F.G * NWAVES;
    LAS float* scr = (LAS float*)(F.lds + F.wave * TSCR_BYTES);
    bf16_t* XB = (bf16_t*)(F.ws + WS_XB); float* RS0 = (float*)(F.ws + WS_RS0); const float* x = F.in[0];
    if (NGW == 2048) {
        if (gw < 1024) { p0_weight_item(F, gw, scr); p0_x_rows<4>(x, XB, RS0, 6 * gw, F.lane); p0_weight_item(F, gw + 2048, scr); p0_x_rows<2>(x, XB, RS0, 6 * gw + 4, F.lane); }
        else { const int r0 = 6144 + 10 * (gw - 1024); p0_x_rows<4>(x, XB, RS0, r0, F.lane); p0_weight_item(F, gw, scr); p0_x_rows<4>(x, XB, RS0, r0 + 4, F.lane); p0_x_rows<2>(x, XB, RS0, r0 + 8, F.lane); }
    } else {
        for (int it = gw; it < 3072; it += NGW) p0_weight_item(F, it, scr);
        for (int m = 4 * gw; m < T_; m += 4 * NGW) p0_x_rows<4>(x, XB, RS0, m, F.lane);
    }
}

typedef float f32x16 __attribute__((ext_vector_type(16)));
typedef short s16x4 __attribute__((ext_vector_type(4)));
#define KSWZ(row, colB) ((row) * 256 + ((colB) ^ (((row) & 7) << 4)))
#define SBAR() __builtin_amdgcn_sched_barrier(0)
constexpr float LOG2E = 1.4426950408889634f;
__device__ __forceinline__ int crow(int r, int hi) { return (r & 3) + 8 * (r >> 2) + 4 * hi; }
__device__ __forceinline__ unsigned lds_addr(const LAS void* p) { return (unsigned)(size_t)p; }
__device__ __forceinline__ int v_st(int k, int c) { const int kk = (k & ~0xC) | ((k & 4) << 1) | ((k & 8) >> 1); return ((kk >> 3) * 4 + (c >> 5)) * 512 + ((kk & 7) * 32 + (c & 31)) * 2; }
__device__ __forceinline__ int v_rd_base(int lane) { return ((lane & 3) << 3) | (((lane >> 2) & 3) << 6) | (((lane >> 4) & 1) << 5) | (((lane >> 5) & 1) << 8); }
constexpr int v_rd_off(int d0, int ks, int half) { return d0 * 512 + ks * 4096 + half * 2048; }
template <int OFF> __device__ __forceinline__ s16x4 tr_read(unsigned vb) { s16x4 r; asm volatile("ds_read_b64_tr_b16 %0, %1 offset:%2" : "=&v"(r) : "v"(vb), "i"(OFF) : "memory"); return r; }
#define PKLH(L, H) (bf16x8){L[0], L[1], L[2], L[3], H[0], H[1], H[2], H[3]}
__device__ __forceinline__ float partner32(float x, int hi) { auto rr = __builtin_amdgcn_permlane32_swap(__float_as_uint(x), __float_as_uint(x), false, false); return __uint_as_float(hi ? rr[0] : rr[1]); }

__device__ __forceinline__ void qkt(f32x16& p0, f32x16& p1, const LAS unsigned char* Ks, const bf16x8* qr, int r32, int hi) {
    p0 = f32x16{}; p1 = f32x16{};
#pragma unroll
    for (int d0 = 0; d0 < 8; ++d0) { const int cb = (d0 * 16 + hi * 8) * 2;
        const bf16x8 b0 = *(const LAS bf16x8*)(Ks + KSWZ(r32, cb)), b1 = *(const LAS bf16x8*)(Ks + KSWZ(32 + r32, cb));
        p0 = __builtin_amdgcn_mfma_f32_32x32x16_bf16(b0, qr[d0], p0, 0, 0, 0);
        p1 = __builtin_amdgcn_mfma_f32_32x32x16_bf16(b1, qr[d0], p1, 0, 0, 0); }
}
#define PK4(P, BASE, OUT) do { unsigned a0_ = pg8::cvt_pk_bf16(P[BASE + 0], P[BASE + 1]), a1_ = pg8::cvt_pk_bf16(P[BASE + 2], P[BASE + 3]); \
    unsigned b0_ = pg8::cvt_pk_bf16(P[BASE + 4], P[BASE + 5]), b1_ = pg8::cvt_pk_bf16(P[BASE + 6], P[BASE + 7]); \
    auto r0_ = __builtin_amdgcn_permlane32_swap(a0_, b0_, false, false); auto r1_ = __builtin_amdgcn_permlane32_swap(a1_, b1_, false, false); \
    u32x4v w_ = {r0_[0], r1_[0], r0_[1], r1_[1]}; OUT = __builtin_bit_cast(bf16x8, w_); } while (0)
template <int D0> __device__ __forceinline__ void pv_one(f32x16& od, unsigned vb, bf16x8 pa0, bf16x8 pa1, bf16x8 pa2, bf16x8 pa3) {
    const s16x4 l0 = tr_read<v_rd_off(D0, 0, 0)>(vb), h0 = tr_read<v_rd_off(D0, 0, 1)>(vb), l1 = tr_read<v_rd_off(D0, 1, 0)>(vb), h1 = tr_read<v_rd_off(D0, 1, 1)>(vb);
    const s16x4 l2 = tr_read<v_rd_off(D0, 2, 0)>(vb), h2 = tr_read<v_rd_off(D0, 2, 1)>(vb), l3 = tr_read<v_rd_off(D0, 3, 0)>(vb), h3 = tr_read<v_rd_off(D0, 3, 1)>(vb);
    asm volatile("s_waitcnt lgkmcnt(0)" ::: "memory"); SBAR();
    od = __builtin_amdgcn_mfma_f32_32x32x16_bf16(pa0, PKLH(l0, h0), od, 0, 0, 0);
    od = __builtin_amdgcn_mfma_f32_32x32x16_bf16(pa1, PKLH(l1, h1), od, 0, 0, 0);
    od = __builtin_amdgcn_mfma_f32_32x32x16_bf16(pa2, PKLH(l2, h2), od, 0, 0, 0);
    od = __builtin_amdgcn_mfma_f32_32x32x16_bf16(pa3, PKLH(l3, h3), od, 0, 0, 0);
}
__device__ __forceinline__ void pv_d0(f32x16* o, unsigned vb, bf16x8 pa0, bf16x8 pa1, bf16x8 pa2, bf16x8 pa3) {
    pv_one<0>(o[0], vb, pa0, pa1, pa2, pa3); pv_one<1>(o[1], vb, pa0, pa1, pa2, pa3); pv_one<2>(o[2], vb, pa0, pa1, pa2, pa3); pv_one<3>(o[3], vb, pa0, pa1, pa2, pa3);
}
constexpr int WSCR_OFF = LDSCTL_OFF + 1024, WFLAG_OFF = LDSCTL_OFF + 512;


__device__ __forceinline__ void o_tile_stage(const f32x16* o, const float* rsc, LAS unsigned char* stg, int r32, int hi) {
#pragma unroll
    for (int r = 0; r < 16; ++r) { LAS bf16_t* sp = (LAS bf16_t*)(stg + crow(r, hi) * 256) + r32;
#pragma unroll
        for (int db = 0; db < 4; ++db) sp[32 * db] = (bf16_t)(pg8::cvt_pk_bf16(o[db][r] * rsc[r], 0.f) & 0xffffu); }
}
__device__ __forceinline__ void o_tile_out(const LAS unsigned char* stg, const bf16_t* gate, bf16_t* out, size_t ld, int lane) {
    const int rr = lane >> 4, ch = lane & 15;
#pragma unroll
    for (int ps = 0; ps < 8; ++ps) { const int row = 4 * ps + rr; const bf16x8 v = *(const LAS bf16x8*)(stg + row * 256 + ch * 16); const bf16x8 g = *(const bf16x8*)(gate + (size_t)row * ld + ch * 8);
        u32x4v w; w.x = pk2(bf2f((bf16_t)v[0]) * bf2f((bf16_t)g[0]), bf2f((bf16_t)v[1]) * bf2f((bf16_t)g[1])); w.y = pk2(bf2f((bf16_t)v[2]) * bf2f((bf16_t)g[2]), bf2f((bf16_t)v[3]) * bf2f((bf16_t)g[3]));
        w.z = pk2(bf2f((bf16_t)v[4]) * bf2f((bf16_t)g[4]), bf2f((bf16_t)v[5]) * bf2f((bf16_t)g[5])); w.w = pk2(bf2f((bf16_t)v[6]) * bf2f((bf16_t)g[6]), bf2f((bf16_t)v[7]) * bf2f((bf16_t)g[7]));
        *(u32x4v*)(out + (size_t)row * ld + ch * 8) = w; }
}


template <bool MASK, int KOFF> __device__ __forceinline__ void sb_half_a(f32x16& p, float* go, int lim) {
#pragma unroll
    for (int i = 0; i < 4; ++i) { float l[4];
#pragma unroll
        for (int e = 0; e < 4; ++e) { const float y = fminf(p[4 * i + e], 60.f), sp = __builtin_amdgcn_logf(1.0f + __builtin_amdgcn_exp2f(y));
            l[e] = -sp; p[4 * i + e] = y - sp; if (MASK) l[e] = KOFF + 8 * i + e < lim ? l[e] : 0.f; }
        go[i] = (l[0] + l[1]) + (l[2] + l[3]);
        const float s2 = l[3], s1 = s2 + l[2], s0 = s1 + l[1]; p[4 * i + 2] += s2; p[4 * i + 1] += s1; p[4 * i] += s0; }
}
template <bool MASK, int KOFF> __device__ __forceinline__ void sb_half_b(f32x16& p, const float* go, int lim, float carry, float& tail, int hi) {
#pragma unroll
    for (int i = 3; i >= 0; --i) { const float gpi = partner32(go[i], hi); const float so = tail + (hi ? 0.f : gpi) + carry; tail += go[i] + gpi;
#pragma unroll
        for (int e = 0; e < 4; ++e) { float a = __builtin_amdgcn_exp2f(p[4 * i + e] + so); if (MASK) a = KOFF + 8 * i + e < lim ? a : 0.f; p[4 * i + e] = a; } }
}
template <bool MASK> __device__ __forceinline__ float sb_weights(f32x16& p0, f32x16& p1, int lim, float carry, int hi) {
    float go[8], tail = 0.f;
    sb_half_a<MASK, 0>(p0, go, lim); sb_half_a<MASK, 32>(p1, go + 4, lim);
    sb_half_b<MASK, 32>(p1, go + 4, lim, carry, tail, hi); sb_half_b<MASK, 0>(p0, go, lim, carry, tail, hi);
    return tail;
}

constexpr float SB_EXIT = -150.1f;
__device__ __forceinline__ int swap23(int k) { return (k & ~0xC) | ((k & 4) << 1) | ((k & 8) >> 1); }
__device__ __forceinline__ void sb_unit(const Frame& F, int b, int h, int qb) {
    int tid = F.tid; asm volatile("" : "+v"(tid));
    const int w = F.wave, lane = tid & 63, r32 = lane & 31, hi = lane >> 5;
    bf16_t* UB = (bf16_t*)(F.ws + WS_UB); const size_t rowb = (size_t)b * S_;
    const int q0 = qb * 256, tq = q0 + 32 * w + r32;
    unsigned offK[2], offV[2];
#pragma unroll
    for (int i = 0; i < 2; ++i) { const int pc = w + 8 * i;
        { const int row = pc * 4 + (lane >> 4), colB = ((lane & 15) * 16) ^ ((row & 7) << 4); offK[i] = (unsigned)(row * NBW_ + colB / 2); }
        { const int d = pc * 1024 + lane * 16, st = d >> 9, o = d & 511, kk = ((st >> 2) << 3) | (o >> 6), k = swap23(kk), c = (st & 3) * 32 + (o & 63) / 2; offV[i] = (unsigned)(k * NBW_ + c); } }
    const bf16_t* kg = UB + rowb * NBW_ + h * 128; const bf16_t* vg = kg + 1024;
#define SB_DMA(kt_) do { const int bo_ = ((kt_) % 3) * 32768; const bf16_t* kt0_ = kg + (size_t)(kt_) * 64 * NBW_; const bf16_t* vt0_ = vg + (size_t)(kt_) * 64 * NBW_; \
        _Pragma("unroll") for (int i_ = 0; i_ < 2; ++i_) { \
            __builtin_amdgcn_global_load_lds((const unsigned*)(kt0_ + offK[i_]), (LAS unsigned*)(F.lds + bo_ + (w + 8 * i_) * 1024), 16, 0, 0); \
            __builtin_amdgcn_global_load_lds((const unsigned*)(vt0_ + offV[i_]), (LAS unsigned*)(F.lds + bo_ + 16384 + (w + 8 * i_) * 1024), 16, 0, 0); } } while (0)
    volatile LAS unsigned* flags = (volatile LAS unsigned*)(F.lds + WFLAG_OFF);
    f32x16 o[4] = {}; float carry = 0.f; bool wdone = false;
    const int kt_hi = qb * 4 + 3;
    __syncthreads();
    if (lane == 0) { flags[w] = 0u; flags[8 + w] = 0u; }
    SB_DMA(kt_hi); SB_DMA(kt_hi - 1);
    bf16x8 qr[8];
    { const bf16_t* qp = UB + (rowb + tq) * NBW_ + 3072 + h * 128 + hi * 8;
#pragma unroll
      for (int d0 = 0; d0 < 8; ++d0) qr[d0] = *(const bf16x8*)(qp + d0 * 16); }
    asm volatile("s_waitcnt vmcnt(0)" ::: "memory");
    const unsigned vbase = lds_addr(F.lds) + 16384 + v_rd_base(lane);
    for (int kt = kt_hi; kt >= 0; --kt) {
        if (kt >= 1) asm volatile("s_waitcnt vmcnt(4)" ::: "memory"); else asm volatile("s_waitcnt vmcnt(0)" ::: "memory");
        asm volatile("s_waitcnt lgkmcnt(0)" ::: "memory"); __builtin_amdgcn_s_barrier(); asm volatile("" ::: "memory");
        unsigned alld = 1u;
#pragma unroll
        for (int j = 0; j < 8; ++j) alld &= flags[8 * (kt & 1) + j];
        if (alld) break;
        if (kt >= 2) SB_DMA(kt - 2);
        const int bo = (kt % 3) * 32768;
        if (!wdone && kt * 64 < q0 + 32 * w + 31) {
            f32x16 p0, p1;
            qkt(p0, p1, F.lds + bo, qr, r32, hi);
            const int lim = tq - kt * 64 - 4 * hi;
            const bool need_mask = kt * 64 + 63 >= q0 + 32 * w;
            carry += need_mask ? sb_weights<true>(p0, p1, lim, carry, hi) : sb_weights<false>(p0, p1, lim, carry, hi);
            bf16x8 pa0, pa1, pa2, pa3;
            PK4(p0, 0, pa0); PK4(p0, 8, pa1); PK4(p1, 0, pa2); PK4(p1, 8, pa3);
            pv_d0(o, vbase + bo, pa0, pa1, pa2, pa3);
            wdone = __all(carry < SB_EXIT);
        }
        if (lane == 0) flags[8 * ((kt & 1) ^ 1) + w] = wdone ? 1u : 0u;
    }
#undef SB_DMA
    asm volatile("s_waitcnt vmcnt(0) lgkmcnt(0)" ::: "memory"); __builtin_amdgcn_s_barrier(); asm volatile("" ::: "memory");
    { float one[16];
#pragma unroll
      for (int r = 0; r < 16; ++r) one[r] = 1.0f;
      LAS unsigned char* stg = F.lds + w * 8192; bf16_t* base = UB + (rowb + q0 + 32 * w) * NBW_ + h * 128;
      o_tile_stage(o, one, stg, r32, hi); LDS_WAIT();
      o_tile_out(stg, base + 2048, base + 3072, NBW_, lane); LDS_WAIT(); }
}

__device__ __forceinline__ void memattn_unit(const Frame& F, bf16_t* U, int ld, int qoff, int goff, int layer, int unit) {
    int tid = F.tid; asm volatile("" : "+v"(tid));
    const int w = F.wave, lane = tid & 63, r32 = lane & 31, hi = lane >> 5;
    const int qblk = unit >> 2, hd = unit & 3, row0 = qblk * 256, b = row0 / S_;
    const bf16_t* Kg = (const bf16_t*)(F.ws + WS_MEMK) + (((size_t)layer * 2 + b) * 4 + hd) * 256 * 128; const bf16_t* Vg = (const bf16_t*)(F.ws + WS_MEMV) + (((size_t)layer * 2 + b) * 4 + hd) * 256 * 128;
    LAS unsigned char* Kb = F.lds; LAS unsigned char* Vb = F.lds + 65536;
    __syncthreads();
#pragma unroll
    for (int j = 0; j < 8; ++j) { const int c = tid + 512 * j, row = c >> 4, ch = c & 15;
        *(LAS bf16x8*)(Kb + KSWZ(row, ch * 16)) = *(const bf16x8*)(Kg + (size_t)row * 128 + ch * 8);
        *(LAS bf16x8*)(Vb + (row >> 6) * 16384 + v_st(row & 63, ch * 8)) = *(const bf16x8*)(Vg + (size_t)row * 128 + ch * 8); }
    bf16x8 qr[8]; float ssq = 0.f;
    { const bf16_t* qp = U + (size_t)(row0 + 32 * w + r32) * ld + qoff + hd * 128 + hi * 8;
#pragma unroll
      for (int d0 = 0; d0 < 8; ++d0) { qr[d0] = *(const bf16x8*)(qp + d0 * 16);
#pragma unroll
          for (int j = 0; j < 8; ++j) { const float v = bf2f((bf16_t)qr[d0][j]); ssq += v * v; } } }
    ssq += partner32(ssq, hi);
    const float C = LOG2E / sqrtf(ssq * (1.0f / 128) + EPS_);
    __syncthreads();
    LAS float* wscr = (LAS float*)(F.lds + WSCR_OFF) + w * 64;
    const unsigned vb0 = lds_addr(Vb) + v_rd_base(lane);
    f32x16 o[4] = {}; float m_reg = -1e30f, l_reg = 0.f;
#pragma unroll 1
    for (int t = 0; t < 4; ++t) {
        f32x16 p0, p1;
        qkt(p0, p1, Kb + t * 16384, qr, r32, hi);
        float pmax = p0[0];
#pragma unroll
        for (int r = 1; r < 16; ++r) pmax = fmaxf(pmax, p0[r]);
#pragma unroll
        for (int r = 0; r < 16; ++r) pmax = fmaxf(pmax, p1[r]);
        pmax = fmaxf(pmax, partner32(pmax, hi));
        float alpha = 1.f;
        if (!__all(pmax <= m_reg)) { const float mn = fmaxf(m_reg, pmax); alpha = __builtin_amdgcn_exp2f((m_reg - mn) * C); m_reg = mn;
            if (hi == 0) wscr[r32] = alpha; LDS_WAIT();
#pragma unroll
            for (int d = 0; d < 4; ++d)
#pragma unroll
                for (int r = 0; r < 16; ++r) o[d][r] *= wscr[crow(r, hi)];
            LDS_WAIT(); }
        const float mC = -m_reg * C; float ps = 0.f;
#pragma unroll
        for (int r = 0; r < 16; ++r) { p0[r] = __builtin_amdgcn_exp2f(fmaf(p0[r], C, mC)); p1[r] = __builtin_amdgcn_exp2f(fmaf(p1[r], C, mC)); ps += p0[r] + p1[r]; }
        ps += partner32(ps, hi);
        l_reg = l_reg * alpha + ps;
        bf16x8 pa0, pa1, pa2, pa3;
        PK4(p0, 0, pa0); PK4(p0, 8, pa1); PK4(p1, 0, pa2); PK4(p1, 8, pa3);
        pv_d0(o, vb0 + t * 16384, pa0, pa1, pa2, pa3);
    }
    if (hi == 0) wscr[32 + r32] = l_reg; LDS_WAIT();
    { float rl[16];
#pragma unroll
      for (int r = 0; r < 16; ++r) rl[r] = 1.0f / wscr[32 + crow(r, hi)];
      __syncthreads();
      LAS unsigned char* stg = F.lds + w * 8192; bf16_t* base = U + (size_t)(row0 + 32 * w) * ld + hd * 128;
      o_tile_stage(o, rl, stg, r32, hi); LDS_WAIT();
      o_tile_out(stg, base + goff, base + qoff, ld, lane); LDS_WAIT(); }
}

__device__ __forceinline__ float ret_lg2(int h) { return log2f(1.0f - exp2f(-5.0f - (float)h)); }
__device__ __forceinline__ void kvt_unit(const Frame& F, int u) {
    int tid = F.tid; asm volatile("" : "+v"(tid));
    const int w = F.wave, lane = tid & 63, r32 = lane & 31, hi = lane >> 5;
    const int b = u >> 8, h = (u >> 6) & 3, n = u & 63; const size_t row0 = (size_t)b * S_ + n * 128; const float lg2 = ret_lg2(h);
    const bf16_t* UA = (const bf16_t*)(F.ws + WS_UA); bf16_t* KVT = (bf16_t*)(F.ws + WS_KVT);
    LAS unsigned char* Vb = F.lds; LAS unsigned char* Kb = F.lds + 65536;
    __syncthreads();
#pragma unroll
    for (int j = 0; j < 8; ++j) { const int c = tid + 512 * j, row = c >> 5, col = (c & 31) * 8;
        *(LAS bf16x8*)(Vb + ((row >> 6) * 2 + (col >> 7)) * 16384 + v_st(row & 63, col & 127)) = *(const bf16x8*)(UA + (row0 + row) * NA_ + 1024 + h * 256 + col); }
#pragma unroll
    for (int j = 0; j < 4; ++j) { const int c = tid + 512 * j, row = c >> 4, col = (c & 15) * 8; const float z = exp2f((float)(127 - row) * lg2);
        const bf16x8 kv = *(const bf16x8*)(UA + (row0 + row) * NA_ + 512 + h * 128 + col);
        u32x4v t; t.x = pk2(bf2f((bf16_t)kv[0]) * z, bf2f((bf16_t)kv[1]) * z); t.y = pk2(bf2f((bf16_t)kv[2]) * z, bf2f((bf16_t)kv[3]) * z);
        t.z = pk2(bf2f((bf16_t)kv[4]) * z, bf2f((bf16_t)kv[5]) * z); t.w = pk2(bf2f((bf16_t)kv[6]) * z, bf2f((bf16_t)kv[7]) * z);
        *(LAS u32x4v*)(Kb + (row >> 6) * 16384 + v_st(row & 63, col)) = t; }
    __syncthreads();
    f32x16 acc[4] = {};
    const unsigned vbV = lds_addr(Vb) + v_rd_base(lane) + (w >> 2) * 16384 + (w & 3) * 512, vbK = lds_addr(Kb) + v_rd_base(lane);
#define KVT_STEP(TH, KS) do { const unsigned va_ = vbV + (TH) * 32768, vk_ = vbK + (TH) * 16384; \
        const s16x4 al_ = tr_read<v_rd_off(0, KS, 0)>(va_), ah_ = tr_read<v_rd_off(0, KS, 1)>(va_); \
        const s16x4 b0l_ = tr_read<v_rd_off(0, KS, 0)>(vk_), b0h_ = tr_read<v_rd_off(0, KS, 1)>(vk_), b1l_ = tr_read<v_rd_off(1, KS, 0)>(vk_), b1h_ = tr_read<v_rd_off(1, KS, 1)>(vk_); \
        const s16x4 b2l_ = tr_read<v_rd_off(2, KS, 0)>(vk_), b2h_ = tr_read<v_rd_off(2, KS, 1)>(vk_), b3l_ = tr_read<v_rd_off(3, KS, 0)>(vk_), b3h_ = tr_read<v_rd_off(3, KS, 1)>(vk_); \
        asm volatile("s_waitcnt lgkmcnt(0)" ::: "memory"); SBAR(); const bf16x8 a_ = PKLH(al_, ah_); \
        acc[0] = __builtin_amdgcn_mfma_f32_32x32x16_bf16(a_, PKLH(b0l_, b0h_), acc[0], 0, 0, 0); acc[1] = __builtin_amdgcn_mfma_f32_32x32x16_bf16(a_, PKLH(b1l_, b1h_), acc[1], 0, 0, 0); \
        acc[2] = __builtin_amdgcn_mfma_f32_32x32x16_bf16(a_, PKLH(b2l_, b2h_), acc[2], 0, 0, 0); acc[3] = __builtin_amdgcn_mfma_f32_32x32x16_bf16(a_, PKLH(b3l_, b3h_), acc[3], 0, 0, 0); } while (0)
    KVT_STEP(0, 0); KVT_STEP(0, 1); KVT_STEP(0, 2); KVT_STEP(0, 3); KVT_STEP(1, 0); KVT_STEP(1, 1); KVT_STEP(1, 2); KVT_STEP(1, 3);
#undef KVT_STEP
    bf16_t* ob = KVT + ((size_t)u * 256 + 32 * w) * 128 + r32;
#pragma unroll
    for (int r = 0; r < 16; ++r)
#pragma unroll
        for (int db = 0; db < 4; ++db) ob[(size_t)crow(r, hi) * 128 + 32 * db] = f2bf(acc[db][r]);
}
__device__ __forceinline__ void scan_phase(const Frame& F) {
    for (int idx = F.bid * (NWAVES * 64) + F.tid; idx < 8 * 16384; idx += F.G * NWAVES * 64) {
        const int bh = idx >> 14, off = idx & 16383; const float gc = exp2f(128.0f * ret_lg2(bh & 3));
        unsigned* p = (unsigned*)(F.ws + WS_KVT) + (size_t)bh * 64 * 16384 + off; float s0 = 0.f, s1 = 0.f;
#pragma unroll 1
        for (int n0 = 0; n0 < 64; n0 += 16) { unsigned v[16];
#pragma unroll
            for (int j = 0; j < 16; ++j) v[j] = p[(size_t)(n0 + j) * 16384];
#pragma unroll
            for (int j = 0; j < 16; ++j) { p[(size_t)(n0 + j) * 16384] = pk2(s0, s1); s0 = fmaf(gc, s0, __uint_as_float(v[j] << 16)); s1 = fmaf(gc, s1, __uint_as_float(v[j] & 0xffff0000u)); } }
    }
}
__device__ __forceinline__ void ret_unit(const Frame& F, int u) {
    int tid = F.tid; asm volatile("" : "+v"(tid));
    const int w = F.wave, lane = tid & 63, r32 = lane & 31, hi = lane >> 5, wq = w & 3, eh = w >> 2;
    const int b = u >> 8, h = (u >> 6) & 3, n = u & 63; const size_t row0 = (size_t)b * S_ + n * 128; const float lg2 = ret_lg2(h);
    bf16_t* UA = (bf16_t*)(F.ws + WS_UA); const bf16_t* KVT = (const bf16_t*)(F.ws + WS_KVT);
    LAS unsigned char* R1 = F.lds; LAS unsigned char* R2 = F.lds + 65536;
    __syncthreads();
#pragma unroll
    for (int j = 0; j < 8; ++j) { const int c = tid + 512 * j, row = c >> 4, ch = c & 15; *(LAS bf16x8*)(R1 + KSWZ(row, ch * 16)) = *(const bf16x8*)(KVT + ((size_t)u * 256 + row) * 128 + ch * 8); }
#pragma unroll
    for (int j = 0; j < 4; ++j) { const int c = tid + 512 * j, row = c >> 4, ch = c & 15; *(LAS bf16x8*)(R2 + KSWZ(row, ch * 16)) = *(const bf16x8*)(UA + (row0 + row) * NA_ + 512 + h * 128 + ch * 8); }
    bf16x8 qr[8];
    { const bf16_t* qp = UA + (row0 + 32 * wq + r32) * NA_ + h * 128 + hi * 8;
#pragma unroll
      for (int d0 = 0; d0 < 8; ++d0) qr[d0] = *(const bf16x8*)(qp + d0 * 16); }
    __syncthreads();
    f32x16 o[4] = {};
#pragma unroll
    for (int db = 0; db < 4; ++db) {
#pragma unroll
        for (int d0 = 0; d0 < 8; ++d0) { const bf16x8 bs = *(const LAS bf16x8*)(R1 + KSWZ(128 * eh + 32 * db + r32, (d0 * 16 + hi * 8) * 2)); o[db] = __builtin_amdgcn_mfma_f32_32x32x16_bf16(qr[d0], bs, o[db], 0, 0, 0); }
        asm volatile("" ::: "memory"); }
    const float gm1 = exp2f(lg2), gm2 = gm1 * gm1, gm4 = gm2 * gm2, gm8 = gm4 * gm4, gm16 = gm8 * gm8;
    const float gi1 = exp2f(-lg2), gi2 = gi1 * gi1, gi4 = gi2 * gi2, gi8 = gi4 * gi4, gi16 = gi8 * gi8, gi32 = gi16 * gi16;
    const float ga[4] = {1.0f, gm1, gm2, gm2 * gm1}, gb[4] = {1.0f, gm8, gm16, gm16 * gm8};
    const float ia[4] = {1.0f, gi1, gi2, gi2 * gi1}, ib[4] = {1.0f, gi8, gi16, gi16 * gi8};
    { const float xl = exp2f((float)(32 * wq + 4 * hi + 1) * lg2);
#pragma unroll
      for (int r = 0; r < 16; ++r) { const float xi = xl * (ga[r & 3] * gb[r >> 2]);
#pragma unroll
          for (int db = 0; db < 4; ++db) o[db][r] *= xi; } }
    bf16x8 pa[2][4]; const int cq = 32 * wq + r32;
#define RET_P(ST) do { f32x16 p0, p1; qkt(p0, p1, R2 + (ST) * 16384, qr, r32, hi); const int limq_ = cq - 64 * (ST) - 4 * hi; const float al_ = exp2f((float)limq_ * lg2); \
        _Pragma("unroll") for (int r = 0; r < 16; ++r) { const int cr_ = (r & 3) + 8 * (r >> 2); const float f_ = al_ * (ia[r & 3] * ib[r >> 2]); \
            p0[r] = cr_ <= limq_ ? p0[r] * f_ : 0.f; p1[r] = cr_ + 32 <= limq_ ? p1[r] * (f_ * gi32) : 0.f; } \
        PK4(p0, 0, pa[ST][0]); PK4(p0, 8, pa[ST][1]); PK4(p1, 0, pa[ST][2]); PK4(p1, 8, pa[ST][3]); } while (0)
    RET_P(0);
    if (wq >= 2) RET_P(1);
#undef RET_P
    __syncthreads();
#pragma unroll 4
    for (int j = 0; j < 8; ++j) { const int c = tid + 512 * j, row = c >> 5, col = (c & 31) * 8;
        *(LAS bf16x8*)(R1 + ((row >> 6) * 2 + (col >> 7)) * 16384 + v_st(row & 63, col & 127)) = *(const bf16x8*)(UA + (row0 + row) * NA_ + 1024 + h * 256 + col); }
    __syncthreads();
    const unsigned vb = lds_addr(R1) + v_rd_base(lane) + eh * 16384;
    pv_d0(o, vb, pa[0][0], pa[0][1], pa[0][2], pa[0][3]);
    if (wq >= 2) pv_d0(o, vb + 32768, pa[1][0], pa[1][1], pa[1][2], pa[1][3]);
    LAS float* ssq = (LAS float*)(F.lds + WSCR_OFF);
    float qs[16];
#pragma unroll
    for (int r = 0; r < 16; ++r) { float q = (o[0][r] * o[0][r] + o[1][r] * o[1][r]) + (o[2][r] * o[2][r] + o[3][r] * o[3][r]);
        q += __shfl_xor(q, 1); q += __shfl_xor(q, 2); q += __shfl_xor(q, 4); q += __shfl_xor(q, 8); q += __shfl_xor(q, 16); qs[r] = q;
        if (r32 == 0) ssq[w * 32 + crow(r, hi)] = q; }
    __syncthreads();
    { bf16_t* base = UA + (row0 + 32 * wq) * NA_ + 2048 + h * 256 + 128 * eh + r32;
#pragma unroll
      for (int r = 0; r < 16; ++r) { const float rn = 1.0f / sqrtf((qs[r] + ssq[(w ^ 4) * 32 + crow(r, hi)]) * (1.0f / 256) + EPS_); bf16_t* rp = base + (size_t)crow(r, hi) * NA_;
#pragma unroll
          for (int db = 0; db < 4; ++db) { const float g = bf2f(rp[32 * db]); rp[32 * db] = f2bf(o[db][r] * rn * g); } } }
    LDS_WAIT();
}
#ifndef PG8_SP2
#define PG8_SP2 true
#endif
#ifndef PG8_ALIGN
#define PG8_ALIGN true
#endif

__device__ __forceinline__ void phase1(const Frame& F) {
    pg8::Gemm g{(const bf16_t*)(F.ws + WS_XB), (const bf16_t*)(F.ws + WS_WINA), T_, NA_, D_, D_}; pg8::StaticOrder S; S.init(T_, NA_, F.G, F.bid);
    pg8::EpiA E{(bf16_t*)(F.ws + WS_UA), (const float*)(F.ws + WS_RS0), (const int*)F.in[2]};
    pg8::gemm_phase<pg8::EpiA, pg8::StaticOrder, PG8_ALIGN, PG8_SP2>(F.lds, g, S, E);
}
__device__ __forceinline__ void phase2(const Frame& F) {
    for (int u = F.bid; u < 512; u += F.G) kvt_unit(F, u);
    for (int u = F.bid; u < 256; u += F.G) memattn_unit(F, (bf16_t*)(F.ws + WS_UA), NA_, 3072, 3584, 0, u);
}
__device__ __forceinline__ void phase4(const Frame& F) { for (int u = F.bid; u < 512; u += F.G) ret_unit(F, u); }
__device__ __forceinline__ void phase5(const Frame& F) {
    pg8::Gemm g{(const bf16_t*)(F.ws + WS_UA) + 2048, (const bf16_t*)(F.ws + WS_WOUTA), T_, D_, KO_, NA_}; pg8::StaticOrder S; S.init(T_, D_, F.G, F.bid);
    pg8::EpiOutA E{F.in[0], F.out, (bf16_t*)(F.ws + WS_X1B), (float*)(F.ws + WS_SS1P)};
    pg8::gemm_phase<pg8::EpiOutA, pg8::StaticOrder, PG8_ALIGN, PG8_SP2>(F.lds, g, S, E);
}
__device__ __forceinline__ void phase6(const Frame& F) {
    pg8::Gemm g{(const bf16_t*)(F.ws + WS_X1B), (const bf16_t*)(F.ws + WS_WB), T_, NBW_, D_, D_}; pg8::StaticOrder S; S.init(T_, NBW_, F.G, F.bid);
    pg8::EpiB E{(bf16_t*)(F.ws + WS_UB), (const float*)(F.ws + WS_SS1P)};
    pg8::gemm_phase<pg8::EpiB, pg8::StaticOrder, PG8_ALIGN, PG8_SP2>(F.lds, g, S, E);
}
__device__ __forceinline__ void phase7(const Frame& F) {
    for (int u = F.bid; u < 512; u += F.G) sb_unit(F, u >> 8, (u >> 5) & 7, u & 31);
    for (int u = F.bid; u < 256; u += F.G) memattn_unit(F, (bf16_t*)(F.ws + WS_UB), NBW_, 4096, 4608, 1, u);
}
__device__ __forceinline__ void phase8(const Frame& F) {
    pg8::Gemm g{(const bf16_t*)(F.ws + WS_UB) + 3072, (const bf16_t*)(F.ws + WS_WOUTB), T_, D_, KO_, NBW_}; pg8::StaticOrder S; S.init(T_, D_, F.G, F.bid);
    pg8::EpiOutB E{F.out, (const bf16_t*)(F.ws + WS_X1B)};
    pg8::gemm_phase<pg8::EpiOutB, pg8::StaticOrder, PG8_ALIGN, PG8_SP2>(F.lds, g, S, E);
}
__global__ void __launch_bounds__(NWAVES * 64, 2) mega(MArgs args) {
    extern __shared__ __attribute__((aligned(16))) unsigned char lds_raw[];
    Frame F;
    F.lds = (LAS unsigned char*)lds_raw; F.tid = threadIdx.x; F.lane = F.tid & 63; F.wave = __builtin_amdgcn_readfirstlane(F.tid >> 6); F.G = gridDim.x; F.bid = blockIdx.x;
#pragma unroll
    for (int i = 0; i < 16; ++i) F.in[i] = args.in[i];
    F.out = args.out; F.ws = args.ws;
    for (int u = F.tid; u < (LDS_BYTES - LDSCTL_OFF) / 4; u += NWAVES * 64) ((LAS unsigned*)(F.lds + LDSCTL_OFF))[u] = 0u;
    __syncthreads();
    unsigned* ctl = (unsigned*)(F.ws + WS_CTL);
    XcdBarrier bar = xcd_barrier_post(ctl + CW_BAR + args.li * XCD_BAR_WORDS, (volatile LAS unsigned*)(F.lds + LDSCTL_OFF) + 8);
    const int lo = args.ph_lo, hi = args.ph_hi;
#ifndef PH_ENABLE
#define PH_ENABLE 0x1FF
#endif
#define IN(k) (((PH_ENABLE >> (k)) & 1) && lo <= (k) && (k) < hi)
#define BOTH(k) (IN(k) && IN((k) + 1))

#ifndef PROBE
#define PROBE 0
#endif
#define PH(k, call) do { if (IN(k)) { call; if (BOTH(k)) xcd_barrier(bar); } } while (0)
#define PHB(call) do { call; xcd_barrier(bar); } while (0)
    PH(0, p0_prologue(F));
#if PROBE == 2
    PHB(p0_prologue(F));
#endif
#if PROBE == 5
    xcd_barrier(bar); xcd_barrier(bar); xcd_barrier(bar); xcd_barrier(bar);
#endif
    PH(1, phase1(F));
#if PROBE == 1
    PHB(phase1(F));
#endif
    PH(2, phase2(F));
#if PROBE == 8
    PHB(phase1(F)); PHB(phase2(F));
#endif
#if PROBE == 10
    PHB(for (int u = F.bid; u < 512; u += F.G) kvt_unit(F, u));
#endif
    PH(3, scan_phase(F));
#if PROBE == 11
    PHB(for (int u = F.bid; u < 512; u += F.G) kvt_unit(F, u)); PHB(scan_phase(F));
#endif
#if PROBE == 9
    PHB(phase1(F)); PHB(phase2(F)); PHB(scan_phase(F));
#endif
    PH(4, phase4(F));
#if PROBE == 3
    PHB(phase1(F)); PHB(phase2(F)); PHB(scan_phase(F)); PHB(phase4(F));
#endif
    PH(5, phase5(F));
#if PROBE == 6
    PHB(phase5(F));
#endif
    PH(6, phase6(F));
#if PROBE == 7
    PHB(phase6(F));
#endif
#if PROBE == 12
    PHB(for (int u = F.bid; u < 512; u += F.G) sb_unit(F, u >> 8, (u >> 5) & 7, u & 31)); PHB(phase6(F));
#endif
    PH(7, phase7(F));
#if PROBE == 4
    PHB(phase6(F)); PHB(phase7(F));
#endif
    PH(8, phase8(F));
#undef PH
#undef PHB
#undef IN
#undef BOTH
}

static void launch_mega(const MArgs& base, int lo, int hi, int li, int grid, hipStream_t stream) {
    MArgs a = base; a.ph_lo = lo; a.ph_hi = hi; a.li = li; a.pad = 0;
    hipLaunchKernelGGL(mega, dim3(grid), dim3(NWAVES * 64), LDS_BYTES, stream, a);
}
extern "C" void kernel_launch(void* const* d_in, const int* in_sizes, int n_in, void* d_out, int out_size, void* d_ws, size_t ws_size, hipStream_t stream) {
    static int grid = 0;
    if (grid == 0) {
        int dev = 0, cus = 0;
        if (hipGetDevice(&dev) != hipSuccess || hipDeviceGetAttribute(&cus, hipDeviceAttributeMultiprocessorCount, dev) != hipSuccess) { grid = -1; return; }
        if (hipFuncSetAttribute((const void*)mega, hipFuncAttributeMaxDynamicSharedMemorySize, LDS_BYTES) != hipSuccess) { grid = -1; return; }
        (void)hipGetLastError();
        grid = cus;
    }
    if (grid < 0) return;
    const float* x = (const float*)d_in[0]; const int* pos = (const int*)d_in[2];
    unsigned char* ws = (unsigned char*)d_ws; float* out = (float*)d_out;
    bf16_t* MEMK = (bf16_t*)(ws + WS_MEMK); bf16_t* MEMV = (bf16_t*)(ws + WS_MEMV);
    bf16_t* UA = (bf16_t*)(ws + WS_UA); bf16_t* KVT = (bf16_t*)(ws + WS_KVT); bf16_t* UB = (bf16_t*)(ws + WS_UB);
    (void)x; (void)pos; (void)out;
    (void)hipMemsetAsync(ws + WS_CTL, 0, CTL_ZERO_BYTES, stream);
    MArgs a{};
    for (int i = 0; i < 16; ++i) a.in[i] = (const float*)d_in[i];
    a.out = out; a.ws = ws;
    int li = 0;
    for (int p = 0; p < 9;) {
        if ((OPT_MASK >> p) & 1) { int q = p; while (q < 9 && ((OPT_MASK >> q) & 1)) ++q; launch_mega(a, p, q, li++, grid, stream); p = q; continue; }
        switch (p) {
        case 2: n2_kv<<<512 * 4, 256, 0, stream>>>(UA, KVT); n_memattn<<<T_, 256, 0, stream>>>(UA, NA_, 3072, 3584, MEMK, MEMV, 0); break;
        case 3: n3_scan<<<(8 * 32768) / 256, 256, 0, stream>>>(KVT); break;
        case 4: n4_ret<<<512 * 128, 256, 0, stream>>>(UA, KVT); break;
        case 7: n7_sb<<<NB_ * 8 * S_, 256, 0, stream>>>(UB); n_memattn<<<T_, 256, 0, stream>>>(UB, NBW_, 4096, 4608, MEMK, MEMV, 1); break;
        default: break;
        }
        ++p;
    }
}
```

```cpp
#include <hip/hip_runtime.h>
#include <stdint.h>

typedef unsigned short bf16_t;

constexpr int NB_ = 2, S_ = 8192, T_ = NB_ * S_, D_ = 1024;
constexpr int NA_ = 4096, NBW_ = 5120, KO_ = 1536;
constexpr float EPS_ = 1e-6f;
constexpr float QK_SCALE = 0.08838834764831845f;

constexpr size_t MiB = 1u << 20;
constexpr size_t WS_CTL = 0;
constexpr size_t WS_WINA = 1 * MiB;
constexpr size_t WS_WOUTA = 9 * MiB;
constexpr size_t WS_WB = 12 * MiB;
constexpr size_t WS_WOUTB = 22 * MiB;
constexpr size_t WS_MEMK = 25 * MiB;
constexpr size_t WS_MEMV = 26 * MiB;
constexpr size_t WS_RS0 = 27 * MiB;
constexpr size_t WS_SS1P = 28 * MiB;
#ifndef NGRP
#define NGRP 2
#endif
#if NGRP == 2
constexpr size_t WS_BSTRIDE = 96 * MiB;
constexpr size_t WS_UA = 30 * MiB, WS_UA_STRIDE = WS_BSTRIDE, WS_UB = 30 * MiB, WS_UB_STRIDE = WS_BSTRIDE, WS_KVT = 94 * MiB, WS_KVT_STRIDE = WS_BSTRIDE, WS_X1B = 110 * MiB, WS_X1B_STRIDE = WS_BSTRIDE;
#else
constexpr size_t WS_UA = 30 * MiB, WS_UA_STRIDE = 64 * MiB, WS_UB = 30 * MiB, WS_UB_STRIDE = 80 * MiB, WS_KVT = 158 * MiB, WS_KVT_STRIDE = 16 * MiB, WS_X1B = 190 * MiB, WS_X1B_STRIDE = 16 * MiB;
#endif
__device__ __forceinline__ bf16_t* ua_ptr(unsigned char* ws, int b) { return (bf16_t*)(ws + WS_UA + (size_t)b * WS_UA_STRIDE) - (size_t)b * S_ * NA_; }
__device__ __forceinline__ bf16_t* ub_ptr(unsigned char* ws, int b) { return (bf16_t*)(ws + WS_UB + (size_t)b * WS_UB_STRIDE) - (size_t)b * S_ * NBW_; }
__device__ __forceinline__ bf16_t* kvt_ptr(unsigned char* ws, int b) { return (bf16_t*)(ws + WS_KVT + (size_t)b * WS_KVT_STRIDE) - (size_t)b * 256 * 32768; }
__device__ __forceinline__ bf16_t* x1b_ptr(unsigned char* ws, int b) { return (bf16_t*)(ws + WS_X1B + (size_t)b * WS_X1B_STRIDE) - (size_t)b * S_ * D_; }


__device__ __forceinline__ float bf2f(bf16_t v) { return __uint_as_float(((unsigned)v) << 16); }
__device__ __forceinline__ bf16_t f2bf(float f) { unsigned u = __float_as_uint(f); u += 0x7fffu + ((u >> 16) & 1u); return (bf16_t)(u >> 16); }
__device__ __forceinline__ float silu_f(float v) { return v / (1.0f + __expf(-v)); }
__device__ __forceinline__ float softplus_f(float z) { return fmaxf(z, 0.f) + log1pf(__expf(-fabsf(z))); }
__device__ __forceinline__ float ret_lg(int h) { return logf(1.0f - exp2f(-5.0f - (float)h)); }

__device__ __forceinline__ void rot_sincos(float ang, float& s, float& c) {
    const float n = rintf(ang * 0.15915494309189535f);
    float r = fmaf(-n, 6.28318548202514648f, ang);
    r = fmaf(-n, -1.74845553e-7f, r);
    const float rev = r * 0.15915494309189535f;
    s = __builtin_amdgcn_sinf(rev); c = __builtin_amdgcn_cosf(rev);
}
__device__ __forceinline__ float rope_inv_freq(int i) { return exp2f(-(float)i * 0.20762050593046014f); }

__global__ __launch_bounds__(256) void n0_x(const float* __restrict__ x, bf16_t* __restrict__ xb, float* __restrict__ rs) {
    const int row = blockIdx.x * 4 + (threadIdx.x >> 6), lane = threadIdx.x & 63;
    const float* xr = x + (size_t)row * D_; float s = 0.f;
    for (int j = lane; j < D_; j += 64) { const float v = xr[j]; s += v * v; xb[(size_t)row * D_ + j] = f2bf(v); }
    for (int o = 32; o; o >>= 1) s += __shfl_xor(s, o);
    if (lane == 0) rs[row] = 1.0f / sqrtf(s * (1.0f / D_) + EPS_);
}

struct WArgs { const float* w_in_a; const float* w_out_a; const float* w_kv; const float* w_in_b; const float* w_out_b;
               const float* g_norm_a; const float* g_ret_head; const float* g_kv; const float* g_norm_b; };
__device__ __forceinline__ int permA_src(int n) {
    if (n >= 1024) return n;
    const int tile = n >> 8, c = n & 255, bj = c >> 7, p = c & 127, hit = p >> 6, i = p & 63;
    return tile * 256 + hit * 128 + bj * 64 + i;
}
__global__ __launch_bounds__(256) void n0_w(WArgs a, int mode, bf16_t* __restrict__ out) {
    const int K = (mode == 0 || mode == 2) ? 1024 : 1536;
    const int N = mode == 0 ? 4096 : (mode == 2 ? 5120 : 1024);
    const size_t idx = (size_t)blockIdx.x * 256 + threadIdx.x; if (idx >= (size_t)N * K) return;
    const int k = (int)(idx % K), n = (int)(idx / K);
    float v;
    if (mode == 0) v = a.w_in_a[(size_t)k * 4096 + permA_src(n)] * a.g_norm_a[k];
    else if (mode == 1) v = a.w_out_a[(size_t)k * 1024 + n] * (k < 1024 ? a.g_ret_head[k & 255] : 1.0f);
    else if (mode == 2) {
        if (n < 2048) v = a.w_kv[(size_t)k * 2048 + n] * a.g_kv[k];
        else { const int c = n - 2048; const int src = c < 1024 ? 1024 + c : (c < 2048 ? c - 1024 : c);
               v = a.w_in_b[(size_t)k * 3072 + src] * a.g_norm_b[k]; }
    } else v = a.w_out_b[(size_t)k * 1024 + n];
    out[idx] = f2bf(v);
}

__global__ __launch_bounds__(256) void n0_mem(const float* __restrict__ mem, const float* __restrict__ g_mem, const float* __restrict__ w_mem_kv,
                                              const float* __restrict__ g_mem_q, const float* __restrict__ g_mem_k, bf16_t* __restrict__ memK, bf16_t* __restrict__ memV) {
    __shared__ float sm[1024]; __shared__ float skv[1024]; __shared__ float red[256]; __shared__ float hn[4];
    const int l = blockIdx.x >> 9, b = (blockIdx.x >> 8) & 1, m = blockIdx.x & 255, tid = threadIdx.x;
    const float* mr = mem + ((size_t)b * 256 + m) * D_;
    float s = 0.f; for (int j = tid; j < D_; j += 256) { const float v = mr[j]; s += v * v; }
    red[tid] = s; __syncthreads();
    for (int o = 128; o; o >>= 1) { if (tid < o) red[tid] += red[tid + o]; __syncthreads(); }
    const float r = 1.0f / sqrtf(red[0] * (1.0f / D_) + EPS_);
    for (int j = tid; j < D_; j += 256) sm[j] = mr[j] * r * g_mem[l * D_ + j];
    __syncthreads();
    const float* W = w_mem_kv + (size_t)l * D_ * 1024;
    float acc[4] = {0.f, 0.f, 0.f, 0.f};
    for (int k = 0; k < D_; ++k) { const float a = sm[k];
#pragma unroll
        for (int j = 0; j < 4; ++j) acc[j] += a * W[(size_t)k * 1024 + tid + 256 * j]; }
#pragma unroll
    for (int j = 0; j < 4; ++j) skv[tid + 256 * j] = acc[j];
    __syncthreads();
    if (tid < 4) { float q = 0.f; for (int d = 0; d < 128; ++d) { const float v = skv[tid * 128 + d]; q += v * v; } hn[tid] = 1.0f / sqrtf(q * (1.0f / 128) + EPS_); }
    __syncthreads();
    for (int j = tid; j < 512; j += 256) { const int h = j >> 7, d = j & 127;
        const size_t o = ((((size_t)l * 2 + b) * 4 + h) * 256 + m) * 128 + d;
        memK[o] = f2bf(skv[j] * hn[h] * g_mem_k[l * 128 + d] * g_mem_q[l * 128 + d] * QK_SCALE);
        memV[o] = f2bf(skv[512 + j]); }
}

struct GArgs { const bf16_t* A; int lda; const bf16_t* Bt; int K; int N;
               const float* rs0; const int* pos; bf16_t* U; const float* xres; float* out; bf16_t* x1b; float* ss1p; };
template <int EPI> __global__ __launch_bounds__(256) void n_gemm(GArgs g) {
    __shared__ float sA[16][36]; __shared__ float sC[16][257];
    const int ntn = g.N / 256, pm = blockIdx.x / ntn, pn = blockIdx.x % ntn, row0 = pm * 16, c = threadIdx.x;
    const bf16_t* brow = g.Bt + (size_t)(pn * 256 + c) * g.K;
    float acc[16];
#pragma unroll
    for (int r = 0; r < 16; ++r) acc[r] = 0.f;
    for (int k0 = 0; k0 < g.K; k0 += 32) {
        __syncthreads();
        for (int e = threadIdx.x; e < 512; e += 256) { const int r = e >> 5, kk = e & 31; sA[r][kk] = bf2f(g.A[(size_t)(row0 + r) * g.lda + k0 + kk]); }
        __syncthreads();
#pragma unroll
        for (int j = 0; j < 4; ++j) { const uint4 bv = *(const uint4*)(brow + k0 + 8 * j); const unsigned w[4] = {bv.x, bv.y, bv.z, bv.w};
#pragma unroll
            for (int q = 0; q < 4; ++q) { const float b0 = __uint_as_float(w[q] << 16), b1 = __uint_as_float(w[q] & 0xffff0000u); const int kk = 8 * j + 2 * q;
#pragma unroll
                for (int r = 0; r < 16; ++r) acc[r] += sA[r][kk] * b0 + sA[r][kk + 1] * b1; } }
    }
#pragma unroll
    for (int r = 0; r < 16; ++r) sC[r][c] = acc[r];
    __syncthreads();
    if (EPI == 0) {
        for (int r = 0; r < 16; ++r) { const int row = row0 + r; const float rs = g.rs0[row]; bf16_t* urow = g.U + (size_t)row * NA_;
            if (pn < 4) { if (c < 128) { const int hit = c >> 6, i = c & 63; const float x1 = sC[r][c] * rs, x2 = sC[r][c + 128] * rs;
                    float sn, cs; rot_sincos((float)g.pos[row] * rope_inv_freq(i), sn, cs); const float sc = pn >= 2 ? QK_SCALE : 1.0f;
                    urow[pn * 256 + hit * 128 + i] = f2bf((x1 * cs - x2 * sn) * sc); urow[pn * 256 + hit * 128 + 64 + i] = f2bf((x1 * sn + x2 * cs) * sc); } }
            else { const float v = sC[r][c] * rs; const bool silu = (pn >= 8 && pn < 12) || pn >= 14; urow[pn * 256 + c] = f2bf(silu ? silu_f(v) : v); } }
    } else if (EPI == 1) {
        for (int r = 0; r < 16; ++r) { const size_t o = (size_t)(row0 + r) * D_ + pn * 256 + c; const float v = g.xres[o] + sC[r][c]; g.out[o] = v; g.x1b[o] = f2bf(v); sC[r][c] = v * v; }
        __syncthreads();
        if (c < 16) { float s = 0.f; for (int j = 0; j < 256; ++j) s += sC[c][j]; float* p = g.ss1p + (size_t)(row0 + c) * 16 + pn * 4; p[0] = s; p[1] = 0.f; p[2] = 0.f; p[3] = 0.f; }
    } else if (EPI == 2) {
        for (int r = 0; r < 16; ++r) { const int row = row0 + r; const float* sp = g.ss1p + (size_t)row * 16; float ss = 0.f; for (int j = 0; j < 16; ++j) ss += sp[j];
            const float rs = 1.0f / sqrtf(ss * (1.0f / D_) + EPS_); float v = sC[r][c] * rs;
            if ((pn >= 8 && pn < 12) || pn >= 18) v = silu_f(v); else if (pn >= 12 && pn < 16) v *= QK_SCALE * 1.4426950408889634f;
            g.U[(size_t)row * NBW_ + pn * 256 + c] = f2bf(v); }
    } else {
        for (int r = 0; r < 16; ++r) { const size_t o = (size_t)(row0 + r) * D_ + pn * 256 + c; g.out[o] = bf2f(g.x1b[o]) + sC[r][c]; }
    }
}

__global__ __launch_bounds__(256) void n2_kv(const bf16_t* __restrict__ UA, bf16_t* __restrict__ KVT) {
    const int u = blockIdx.x >> 2, eg = blockIdx.x & 3, tid = threadIdx.x, e = eg * 64 + (tid & 63), dq = tid >> 6;
    const int b = u >> 8, h = (u >> 6) & 3, n = u & 63; const size_t row0 = (size_t)b * S_ + n * 128; const float lg = ret_lg(h);
    float acc[32];
#pragma unroll
    for (int j = 0; j < 32; ++j) acc[j] = 0.f;
    for (int m = 0; m < 128; ++m) { const bf16_t* ur = UA + (row0 + m) * NA_; const float vz = bf2f(ur[1024 + h * 256 + e]) * __expf((float)(127 - m) * lg);
#pragma unroll
        for (int j = 0; j < 32; ++j) acc[j] += vz * bf2f(ur[512 + h * 128 + dq * 32 + j]); }
#pragma unroll
    for (int j = 0; j < 32; ++j) KVT[((size_t)u * 256 + e) * 128 + dq * 32 + j] = f2bf(acc[j]);
}
__global__ __launch_bounds__(256) void n3_scan(bf16_t* __restrict__ KVT) {
    const int idx = blockIdx.x * 256 + threadIdx.x; const int bh = idx >> 15, off = idx & 32767; const float gc = __expf(128.0f * ret_lg(bh & 3));
    float s = 0.f;
    for (int n = 0; n < 64; ++n) { bf16_t* p = KVT + ((size_t)(bh * 64 + n) << 15) + off; const float t = bf2f(*p); *p = f2bf(s); s = gc * s + t; }
}
__global__ __launch_bounds__(256) void n4_ret(bf16_t* __restrict__ UA, const bf16_t* __restrict__ KVT) {
    __shared__ float sq[128], ss[128], red[256];
    const int u = blockIdx.x >> 7, c = blockIdx.x & 127, tid = threadIdx.x; const int b = u >> 8, h = (u >> 6) & 3, n = u & 63;
    const size_t row0 = (size_t)b * S_ + n * 128, row = row0 + c; const float lg = ret_lg(h);
    if (tid < 128) sq[tid] = bf2f(UA[row * NA_ + h * 128 + tid]);
    __syncthreads();
    if (tid < 128) { float d = 0.f; if (tid <= c) { const bf16_t* kr = UA + (row0 + tid) * NA_ + 512 + h * 128; for (int j = 0; j < 128; ++j) d += sq[j] * bf2f(kr[j]); d *= __expf((float)(c - tid) * lg); } ss[tid] = d; }
    __syncthreads();
    const int e = tid; float o = 0.f;
    for (int m = 0; m <= c; ++m) o += ss[m] * bf2f(UA[(row0 + m) * NA_ + 1024 + h * 256 + e]);
    float cr = 0.f; const bf16_t* st = KVT + ((size_t)u * 256 + e) * 128; for (int j = 0; j < 128; ++j) cr += sq[j] * bf2f(st[j]);
    o += __expf((float)(c + 1) * lg) * cr;
    red[tid] = o * o; __syncthreads();
    for (int w = 128; w; w >>= 1) { if (tid < w) red[tid] += red[tid + w]; __syncthreads(); }
    const float r = 1.0f / sqrtf(red[0] * (1.0f / 256) + EPS_);
    bf16_t* gp = UA + row * NA_ + 2048 + h * 256 + e; *gp = f2bf(o * r * bf2f(*gp));
}
__global__ __launch_bounds__(256) void n_memattn(bf16_t* __restrict__ U, int ld, int qoff, int goff, const bf16_t* __restrict__ memK, const bf16_t* __restrict__ memV, int layer) {
    __shared__ float sq[4][128]; __shared__ float sp[4][256];
    const int w = threadIdx.x >> 6, lane = threadIdx.x & 63; const int gw = blockIdx.x * 4 + w, row = gw >> 2, hd = gw & 3, b = row / S_;
    bf16_t* qp = U + (size_t)row * ld + qoff + hd * 128; const bf16_t* gp = U + (size_t)row * ld + goff + hd * 128;
    const float q0 = bf2f(qp[lane]), q1 = bf2f(qp[lane + 64]); sq[w][lane] = q0; sq[w][lane + 64] = q1;
    float s = q0 * q0 + q1 * q1; for (int o = 32; o; o >>= 1) s += __shfl_xor(s, o);
    const float rq = 1.0f / sqrtf(s * (1.0f / 128) + EPS_);
    __syncthreads();
    const bf16_t* Kb = memK + (((size_t)layer * 2 + b) * 4 + hd) * 256 * 128; const bf16_t* Vb = memV + (((size_t)layer * 2 + b) * 4 + hd) * 256 * 128;
    float lgt[4]; float mx = -1e30f;
    for (int j = 0; j < 4; ++j) { const bf16_t* kr = Kb + (size_t)(lane + 64 * j) * 128; float d = 0.f; for (int t = 0; t < 128; ++t) d += sq[w][t] * bf2f(kr[t]); lgt[j] = d * rq; mx = fmaxf(mx, lgt[j]); }
    for (int o = 32; o; o >>= 1) mx = fmaxf(mx, __shfl_xor(mx, o));
    float ps = 0.f; for (int j = 0; j < 4; ++j) { lgt[j] = __expf(lgt[j] - mx); ps += lgt[j]; }
    for (int o = 32; o; o >>= 1) ps += __shfl_xor(ps, o);
    for (int j = 0; j < 4; ++j) sp[w][lane + 64 * j] = lgt[j] / ps;
    __syncthreads();
    float o0 = 0.f, o1 = 0.f;
    for (int m = 0; m < 256; ++m) { const float p = sp[w][m]; o0 += p * bf2f(Vb[(size_t)m * 128 + lane]); o1 += p * bf2f(Vb[(size_t)m * 128 + lane + 64]); }
    const float g0 = bf2f(gp[lane]), g1 = bf2f(gp[lane + 64]);
    qp[lane] = f2bf(o0 * g0); qp[lane + 64] = f2bf(o1 * g1);
}
#ifndef NAIVE_SB_EXIT
#define NAIVE_SB_EXIT 1
#endif
__global__ __launch_bounds__(256) void n7_sb(bf16_t* __restrict__ UB) {
    __shared__ float sq[128]; __shared__ float sa[256]; __shared__ float wtot[4]; __shared__ float wpre[4];
    const int t = blockIdx.x & (S_ - 1), h = (blockIdx.x >> 13) & 7, b = blockIdx.x >> 16, tid = threadIdx.x, lane = tid & 63, w = tid >> 6;
    const size_t rowb = (size_t)b * S_; bf16_t* qp = UB + (rowb + t) * NBW_ + 3072 + h * 128;
    if (tid < 128) sq[tid] = bf2f(qp[tid]);
    __syncthreads();
    float carry = 0.f, od = 0.f;
    for (int s_hi = t - 1; s_hi >= 0; s_hi -= 256) {
        const int s = s_hi - tid; const bool valid = s >= 0;
        float z = 0.f; if (valid) { const bf16_t* kr = UB + (rowb + s) * NBW_ + h * 128; for (int j = 0; j < 128; ++j) z += sq[j] * bf2f(kr[j]); z *= 0.6931471805599453f; }
        const float spv = softplus_f(z); const float lf = valid ? -spv : 0.f;
        float inc = lf;
        for (int o = 1; o < 64; o <<= 1) { const float v = __shfl_up(inc, o); if (lane >= o) inc += v; }
        if (lane == 63) wtot[w] = inc;
        __syncthreads();
        if (tid == 0) { float a = 0.f; for (int j = 0; j < 4; ++j) { wpre[j] = a; a += wtot[j]; } }
        __syncthreads();
        const float pre = wpre[w] + inc - lf;
        const float tot = wpre[3] + wtot[3];
        sa[tid] = valid ? __expf((z - spv) + pre + carry) : 0.f;
        __syncthreads();
        if (tid < 128) { const int cnt = min(256, s_hi + 1); const bf16_t* vb = UB + rowb * NBW_ + 1024 + h * 128 + tid;
            for (int i = 0; i < cnt; ++i) od += sa[i] * bf2f(vb[(size_t)(s_hi - i) * NBW_]); }
        carry += tot;
        __syncthreads();
        if (NAIVE_SB_EXIT && carry < -104.0f) break;
    }
    if (tid < 128) { const float g = bf2f(UB[(rowb + t) * NBW_ + 2048 + h * 128 + tid]); qp[tid] = f2bf(od * g); }
}


namespace pg8 {
#define PG8_LAS __attribute__((address_space(3)))
typedef unsigned short bf16_t;
typedef short bf16x8 __attribute__((ext_vector_type(8)));
typedef float f32x4 __attribute__((ext_vector_type(4)));
typedef unsigned u32x4 __attribute__((ext_vector_type(4)));
constexpr int BM = 256, BK = 64, HALF = 128, HTB = HALF * BK * 2  , STAGE_BYTES = 8 * HTB, NXCD = 8, WGM = 4;

__host__ __device__ __forceinline__ int lds_byte(int r, int c) { const int st = (r >> 4) * 2 + (c >> 5), rr = r & 15, cc = c & 31, ob = rr * 64 + cc * 2; return st * 1024 + (ob ^ (((ob >> 9) & 1) << 5)); }
__host__ __device__ __forceinline__ void stage_rc(int b, int& R, int& C) { const int st = b / 1024, sb = b % 1024, swz = sb ^ (((sb >> 9) & 1) << 5); R = (st >> 1) * 16 + swz / 64; C = (st & 1) * 32 + (swz % 64) / 2; }
__host__ __device__ __forceinline__ int perm32(int rho) { const int n = rho >> 4, i = rho & 15; return 8 * (i >> 2) + 4 * n + (i & 3); }

struct Unit { int pm, pn; };
struct Gemm { const bf16_t* A; const bf16_t* Bt; int M, N, K, lda; };

struct StaticOrder {
    int nM, nN, nwg, G, c;
    __host__ __device__ void init(int M, int N, int G_, int c_) { nM = M / BM; nN = N / BM; nwg = nM * nN; G = G_; c = c_; }
    __host__ __device__ bool next(int i, Unit& u) const {
        const long L = (long)i * G + c; if (L >= nwg) return false;
        int wgid = (int)L; { const int q = nwg / NXCD, r = nwg % NXCD, xcd = wgid % NXCD, off = wgid / NXCD; wgid = (xcd < r ? xcd * (q + 1) : r * (q + 1) + (xcd - r) * q) + off; }
        const int nig = WGM * nN, gid = wgid / nig, fm = gid * WGM, gsz = (nM - fm) < WGM ? (nM - fm) : WGM;
        u.pm = fm + ((wgid % nig) % gsz); u.pn = (wgid % nig) / gsz; return true;
    }
    __device__ __forceinline__ void a_ready(const Unit&) const {}
    __device__ __forceinline__ void done(const Unit&) const {}
};

typedef __bf16 bf16x2_hw __attribute__((ext_vector_type(2)));
typedef float f32x2_hw __attribute__((ext_vector_type(2)));
__device__ __forceinline__ unsigned cvt_pk_bf16_safe(float lo, float hi) { const f32x2_hw v = {lo, hi}; return __builtin_bit_cast(unsigned, __builtin_convertvector(v, bf16x2_hw)); }
__device__ __forceinline__ unsigned cvt_pk_bf16(float lo, float hi) { unsigned r; asm volatile("v_cvt_pk_bf16_f32 %0, %1, %2" : "=v"(r) : "v"(lo), "v"(hi)); return r; }
__device__ __forceinline__ float silu_fast(float v) { return v * __builtin_amdgcn_rcpf(1.0f + __builtin_amdgcn_exp2f(-1.4426950408889634f * v)); }
__device__ __forceinline__ u32x4 pack8_safe(const f32x4 a, const f32x4 b) { u32x4 w; w.x = cvt_pk_bf16_safe(a[0], a[1]); w.y = cvt_pk_bf16_safe(a[2], a[3]); w.z = cvt_pk_bf16_safe(b[0], b[1]); w.w = cvt_pk_bf16_safe(b[2], b[3]); return w; }
__device__ __forceinline__ u32x4 pack8(const f32x4 a, const f32x4 b) { u32x4 w; w.x = cvt_pk_bf16(a[0], a[1]); w.y = cvt_pk_bf16(a[2], a[3]); w.z = cvt_pk_bf16(b[0], b[1]); w.w = cvt_pk_bf16(b[2], b[3]); return w; }

struct EpiA {
    static constexpr bool PERM = true, AFTER_DRAIN = false, ACC_INIT = false;
    bf16_t* U; const float* rs0; const int* pos;
    __device__ __forceinline__ void operator()(const f32x4 (&acc)[2][2][4][2], const Unit& u, int wr, int wc, int fr, int fq) const {
        const int row0 = u.pm * BM + wr * 64 + fr;
        if (u.pn < 4) {
            const int hit = wc >> 1, i0 = 32 * (wc & 1) + 8 * fq; const float sc = u.pn >= 2 ? QK_SCALE : 1.0f;
            float inv[8];
#pragma unroll
            for (int j = 0; j < 8; ++j) inv[j] = rope_inv_freq(i0 + j);
#pragma unroll
            for (int ai = 0; ai < 2; ++ai)
#pragma unroll
                for (int m = 0; m < 4; ++m) { const int row = row0 + ai * HALF + m * 16; const float rs = rs0[row] * sc, pf = (float)pos[row];
                    bf16_t* up = U + (size_t)row * NA_ + u.pn * BM + hit * 128 + i0;
                    f32x4 o1[2], o2[2];
#pragma unroll
                    for (int n = 0; n < 2; ++n)
#pragma unroll
                        for (int e = 0; e < 4; ++e) { float sn, cs; rot_sincos(pf * inv[4 * n + e], sn, cs); const float x1 = acc[ai][0][m][n][e] * rs, x2 = acc[ai][1][m][n][e] * rs;
                            o1[n][e] = x1 * cs - x2 * sn; o2[n][e] = x1 * sn + x2 * cs; }
                    *(u32x4*)up = pack8(o1[0], o1[1]); *(u32x4*)(up + 64) = pack8(o2[0], o2[1]); }
        } else {
            const bool silu = (u.pn >= 8 && u.pn < 12) || u.pn >= 14;
#pragma unroll
            for (int ai = 0; ai < 2; ++ai)
#pragma unroll
                for (int m = 0; m < 4; ++m) { const int row = row0 + ai * HALF + m * 16; const float rs = rs0[row]; bf16_t* rowp = U + (size_t)row * NA_ + u.pn * BM + wc * 32 + 8 * fq;
#pragma unroll
                    for (int bj = 0; bj < 2; ++bj) { f32x4 v0 = acc[ai][bj][m][0] * rs, v1 = acc[ai][bj][m][1] * rs;
                        if (silu) {
#pragma unroll
                            for (int e = 0; e < 4; ++e) { v0[e] = silu_fast(v0[e]); v1[e] = silu_fast(v1[e]); } }
                        *(u32x4*)(rowp + bj * HALF) = pack8(v0, v1); } }
        }
    }
};
struct EpiOutA {
    static constexpr bool PERM = true, AFTER_DRAIN = false, ACC_INIT = true;
    const float* xres; float* out; bf16_t* x1b; float* ss1p;
    __device__ __forceinline__ void init(f32x4 (&acc)[2][2][4][2], const Unit& u, int wr, int wc, int fr, int fq) const {
        const int row0 = u.pm * BM + wr * 64 + fr;
#pragma unroll
        for (int ai = 0; ai < 2; ++ai)
#pragma unroll
            for (int m = 0; m < 4; ++m) { const size_t off = (size_t)(row0 + ai * HALF + m * 16) * D_ + u.pn * BM + wc * 32 + 8 * fq;
#pragma unroll
                for (int bj = 0; bj < 2; ++bj) { acc[ai][bj][m][0] = *(const f32x4*)(xres + off + bj * HALF); acc[ai][bj][m][1] = *(const f32x4*)(xres + off + bj * HALF + 4); } }
    }
    __device__ __forceinline__ void operator()(const f32x4 (&acc)[2][2][4][2], const Unit& u, int wr, int wc, int fr, int fq) const {
        const int row0 = u.pm * BM + wr * 64 + fr;
#pragma unroll
        for (int ai = 0; ai < 2; ++ai)
#pragma unroll
            for (int m = 0; m < 4; ++m) { const int row = row0 + ai * HALF + m * 16; const size_t off = (size_t)row * D_ + u.pn * BM + wc * 32 + 8 * fq; float ssq = 0.f;
#pragma unroll
                for (int bj = 0; bj < 2; ++bj) { const f32x4 v0 = acc[ai][bj][m][0], v1 = acc[ai][bj][m][1];
                    *(u32x4*)(x1b + off + bj * HALF) = pack8_safe(v0, v1);
                    ssq += (v0[0] * v0[0] + v0[1] * v0[1]) + (v0[2] * v0[2] + v0[3] * v0[3]) + (v1[0] * v1[0] + v1[1] * v1[1]) + (v1[2] * v1[2] + v1[3] * v1[3]); }
                ssq += __shfl_xor(ssq, 16); ssq += __shfl_xor(ssq, 32);
                if (fq == 0) ss1p[(size_t)row * 16 + u.pn * 4 + wc] = ssq; }
    }
};
struct EpiB {
    static constexpr bool PERM = true, AFTER_DRAIN = false, ACC_INIT = false;
    bf16_t* U; const float* ss1p;
    __device__ __forceinline__ void operator()(const f32x4 (&acc)[2][2][4][2], const Unit& u, int wr, int wc, int fr, int fq) const {
        const int row0 = u.pm * BM + wr * 64 + fr; const bool silu = (u.pn >= 8 && u.pn < 12) || u.pn >= 18; const float sc = (u.pn >= 12 && u.pn < 16) ? QK_SCALE * 1.4426950408889634f : 1.0f;
#pragma unroll
        for (int ai = 0; ai < 2; ++ai)
#pragma unroll
            for (int m = 0; m < 4; ++m) { const int row = row0 + ai * HALF + m * 16; const f32x4 pv = *(const f32x4*)(ss1p + (size_t)row * 16 + 4 * fq);
                float s = (pv[0] + pv[1]) + (pv[2] + pv[3]); s += __shfl_xor(s, 16); s += __shfl_xor(s, 32);
                const float rs = sc / sqrtf(s * (1.0f / D_) + EPS_); bf16_t* rowp = U + (size_t)row * NBW_ + u.pn * BM + wc * 32 + 8 * fq;
#pragma unroll
                for (int bj = 0; bj < 2; ++bj) { f32x4 v0 = acc[ai][bj][m][0] * rs, v1 = acc[ai][bj][m][1] * rs;
                    if (silu) {
#pragma unroll
                        for (int e = 0; e < 4; ++e) { v0[e] = silu_fast(v0[e]); v1[e] = silu_fast(v1[e]); } }
                    *(u32x4*)(rowp + bj * HALF) = pack8(v0, v1); } }
    }
};
struct EpiOutB {
    static constexpr bool PERM = false, AFTER_DRAIN = false, ACC_INIT = true;
    float* out; const bf16_t* x1b;
    __device__ __forceinline__ void init(f32x4 (&acc)[2][2][4][2], const Unit& u, int wr, int wc, int fr, int fq) const {
        const int row0 = u.pm * BM + wr * 64 + fr;
#pragma unroll
        for (int ai = 0; ai < 2; ++ai)
#pragma unroll
            for (int m = 0; m < 4; ++m) { const size_t off = (size_t)(row0 + ai * HALF + m * 16) * D_ + u.pn * BM + wc * 32 + 4 * fq;
#pragma unroll
                for (int bj = 0; bj < 2; ++bj)
#pragma unroll
                    for (int n = 0; n < 2; ++n) { const unsigned long long w = *(const unsigned long long*)(x1b + off + bj * HALF + n * 16); const unsigned lo = (unsigned)w, hi = (unsigned)(w >> 32);
                        acc[ai][bj][m][n] = (f32x4){__uint_as_float(lo << 16), __uint_as_float(lo & 0xffff0000u), __uint_as_float(hi << 16), __uint_as_float(hi & 0xffff0000u)}; } }
    }
    __device__ __forceinline__ void operator()(const f32x4 (&acc)[2][2][4][2], const Unit& u, int wr, int wc, int fr, int fq) const {
        const int row0 = u.pm * BM + wr * 64 + fr;
#pragma unroll
        for (int ai = 0; ai < 2; ++ai)
#pragma unroll
            for (int m = 0; m < 4; ++m) { const size_t off = (size_t)(row0 + ai * HALF + m * 16) * D_ + u.pn * BM + wc * 32 + 4 * fq;
#pragma unroll
                for (int bj = 0; bj < 2; ++bj)
#pragma unroll
                    for (int n = 0; n < 2; ++n) *(f32x4*)(out + off + bj * HALF + n * 16) = acc[ai][bj][m][n]; }
    }
};

struct EpiNull {
    static constexpr bool PERM = true, AFTER_DRAIN = false, ACC_INIT = false;
    float* sink;
    __device__ __forceinline__ void operator()(const f32x4 (&acc)[2][2][4][2], const Unit& u, int wr, int wc, int fr, int fq) const {
        f32x4 s = (f32x4){0.f, 0.f, 0.f, 0.f};
#pragma unroll
        for (int ai = 0; ai < 2; ++ai)
#pragma unroll
            for (int bj = 0; bj < 2; ++bj)
#pragma unroll
                for (int m = 0; m < 4; ++m) s += acc[ai][bj][m][0] + acc[ai][bj][m][1];
        const float t = (s[0] + s[1]) + (s[2] + s[3]);
        if (t == 1.2345678e33f) sink[0] = t;
    }
};
template <class Epi, class Sched, bool ALIGN_EPI = false, bool SP2 = false>
__device__ __forceinline__ void gemm_phase(PG8_LAS unsigned char* lds, const Gemm g, const Sched& S, const Epi& E) {
    const int tid = threadIdx.x, wid = __builtin_amdgcn_readfirstlane(tid >> 6), lane = tid & 63, wr = wid >> 2, wc = wid & 3, fr = lane & 15, fq = lane >> 4;
    const int K = g.K, nt = K / BK;
    unsigned voffA[2], voffB[2];
#pragma unroll
    for (int i = 0; i < 2; ++i) { int R, C; stage_rc(tid * 16 + i * 8192, R, C); const int Rb = Epi::PERM ? ((R & ~31) + perm32(R & 31)) : R;
        voffA[i] = (unsigned)(R * g.lda + C) * 2u; voffB[i] = (unsigned)(Rb * K + C) * 2u; }
    const size_t kstep = (size_t)(BK * 2);
    const size_t hstepA = (size_t)HALF * g.lda * 2, hstepB = (size_t)HALF * K * 2;
    const size_t tstepA = 2 * hstepA, tstepB = 2 * hstepB;
    const unsigned ldsw = (unsigned)wid * 1024u;
    const int aoff = lds_byte(wr * 64 + fr, fq * 8), boff = lds_byte(wc * 32 + fr, fq * 8);
#define PG8_SA(b, h) (((b) * 2 + (h)) * HTB)
#define PG8_SB(b, h) ((4 + (b) * 2 + (h)) * HTB)
#define PG8_STAGE(bufoff, gbase, voff) do { _Pragma("unroll") for (int _i = 0; _i < 2; ++_i) \
        __builtin_amdgcn_global_load_lds((const unsigned*)((const char*)(gbase) + (voff)[_i]), (PG8_LAS unsigned*)(lds + (bufoff) + ldsw + _i * 8192), 16, 0, 0); } while (0)
#define PG8_LDA(dst, b, h) do { _Pragma("unroll") for (int m = 0; m < 4; ++m) _Pragma("unroll") for (int k = 0; k < 2; ++k) dst[m][k] = *(const PG8_LAS bf16x8*)(lds + PG8_SA(b, h) + aoff + m * 2048 + k * 1024); } while (0)
#define PG8_LDB(dst, b, h) do { _Pragma("unroll") for (int n = 0; n < 2; ++n) _Pragma("unroll") for (int k = 0; k < 2; ++k) dst[n][k] = *(const PG8_LAS bf16x8*)(lds + PG8_SB(b, h) + boff + n * 2048 + k * 1024); } while (0)
#define PG8_MMA(ai, bj, At, Bt) do { __builtin_amdgcn_s_setprio(1); _Pragma("unroll") for (int m = 0; m < 4; ++m) _Pragma("unroll") for (int n = 0; n < 2; ++n) _Pragma("unroll") for (int k = 0; k < 2; ++k) \
        acc[ai][bj][m][n] = __builtin_amdgcn_mfma_f32_16x16x32_bf16(Bt[n][k], At[m][k], acc[ai][bj][m][n], 0, 0, 0); __builtin_amdgcn_s_setprio(0); } while (0)
#define PG8_WAIT_V(n) asm volatile("s_waitcnt vmcnt(" #n ")" ::: "memory")
#define PG8_WAIT_L(n) asm volatile("s_waitcnt lgkmcnt(" #n ")" ::: "memory")
#define PG8_BAR __builtin_amdgcn_s_barrier()
#define PG8_SCHED __builtin_amdgcn_sched_barrier(0)
    Unit cur, nxt; int ui = 0;
    if (!S.next(0, cur)) return;
    f32x4 acc[2][2][4][2];
#pragma unroll
    for (int a = 0; a < 2; ++a)
#pragma unroll
        for (int b = 0; b < 2; ++b)
#pragma unroll
            for (int m = 0; m < 4; ++m)
#pragma unroll
                for (int n = 0; n < 2; ++n) acc[a][b][m][n] = (f32x4){0.f, 0.f, 0.f, 0.f};
    if constexpr (Epi::ACC_INIT) E.init(acc, cur, wr, wc, fr, fq);
    bf16x8 At[4][2], B0[2][2], B1[2][2];
    const char* cA = (const char*)g.A + (size_t)cur.pm * tstepA; const char* cB = (const char*)g.Bt + (size_t)cur.pn * tstepB;
    S.a_ready(cur);
    if constexpr (SP2) {
        PG8_STAGE(PG8_SB(0, 0), cB, voffB); PG8_STAGE(PG8_SB(0, 1), cB + hstepB, voffB); PG8_STAGE(PG8_SA(0, 0), cA, voffA); PG8_STAGE(PG8_SA(0, 1), cA + hstepA, voffA);
        if (wr == 1) PG8_BAR;
        PG8_WAIT_V(2); PG8_BAR;
        PG8_STAGE(PG8_SB(1, 0), cB + kstep, voffB); PG8_STAGE(PG8_SA(1, 0), cA + kstep, voffA); PG8_STAGE(PG8_SB(1, 1), cB + hstepB + kstep, voffB);
        PG8_WAIT_V(6); PG8_BAR;
    } else {
        PG8_STAGE(PG8_SB(0, 0), cB, voffB); PG8_STAGE(PG8_SA(0, 0), cA, voffA); PG8_STAGE(PG8_SB(0, 1), cB + hstepB, voffB); PG8_STAGE(PG8_SA(0, 1), cA + hstepA, voffA);
        if (wr == 1) PG8_BAR;
        PG8_WAIT_V(4); PG8_BAR;
        PG8_STAGE(PG8_SB(1, 0), cB + kstep, voffB); PG8_STAGE(PG8_SA(1, 0), cA + kstep, voffA); PG8_STAGE(PG8_SB(1, 1), cB + hstepB + kstep, voffB);
        PG8_WAIT_V(6); PG8_BAR;
    }
    for (;;) {
        const bool has_next = S.next(ui + 1, nxt);
        const char* nA = has_next ? (const char*)g.A + (size_t)nxt.pm * tstepA : cA; const char* nB = has_next ? (const char*)g.Bt + (size_t)nxt.pn * tstepB : cB;
        for (int t = 0; t < nt; t += 2) {
            const bool last = (t == nt - 2);
            const char* a1 = cA + (size_t)(t + 1) * kstep;
            const char* a2 = last ? nA : cA + (size_t)(t + 2) * kstep; const char* b2 = last ? nB : cB + (size_t)(t + 2) * kstep;
            const char* a3 = a2 + kstep; const char* b3 = b2 + kstep;
            if (last && has_next) S.a_ready(nxt);
            if constexpr (SP2) {
            PG8_LDB(B0, 0, 0); PG8_LDB(B1, 0, 1); PG8_SCHED; PG8_LDA(At, 0, 0); PG8_STAGE(PG8_SA(1, 1), a1 + hstepA, voffA);
            PG8_WAIT_V(8); PG8_WAIT_L(0); PG8_BAR; PG8_MMA(0, 0, At, B0); PG8_MMA(0, 1, At, B1); PG8_BAR; PG8_SCHED;
            PG8_LDA(At, 0, 1); PG8_STAGE(PG8_SB(0, 0), b2, voffB); PG8_STAGE(PG8_SB(0, 1), b2 + hstepB, voffB); PG8_STAGE(PG8_SA(0, 0), a2, voffA);
            PG8_WAIT_V(8); PG8_WAIT_L(0); PG8_BAR; PG8_MMA(1, 0, At, B0); PG8_MMA(1, 1, At, B1); PG8_BAR; PG8_SCHED;
            PG8_LDB(B0, 1, 0); PG8_LDB(B1, 1, 1); PG8_SCHED; PG8_LDA(At, 1, 0); PG8_STAGE(PG8_SA(0, 1), a2 + hstepA, voffA);
            PG8_WAIT_V(8); PG8_WAIT_L(0); PG8_BAR; PG8_MMA(0, 0, At, B0); PG8_MMA(0, 1, At, B1); PG8_BAR; PG8_SCHED;
            PG8_LDA(At, 1, 1); PG8_STAGE(PG8_SB(1, 0), b3, voffB); PG8_STAGE(PG8_SB(1, 1), b3 + hstepB, voffB); PG8_STAGE(PG8_SA(1, 0), a3, voffA);
            PG8_WAIT_V(8); PG8_WAIT_L(0); PG8_BAR; PG8_MMA(1, 0, At, B0); PG8_MMA(1, 1, At, B1); PG8_BAR; PG8_SCHED;
            } else {
            PG8_LDB(B0, 0, 0); PG8_SCHED; PG8_LDA(At, 0, 0); PG8_STAGE(PG8_SA(1, 1), a1 + hstepA, voffA);
            PG8_WAIT_L(8); PG8_BAR; PG8_WAIT_L(0); PG8_MMA(0, 0, At, B0); PG8_BAR; PG8_SCHED;
            PG8_LDB(B1, 0, 1); PG8_STAGE(PG8_SB(0, 0), b2, voffB);
            PG8_BAR; PG8_WAIT_L(0); PG8_MMA(0, 1, At, B1); PG8_BAR;
            PG8_LDA(At, 0, 1); PG8_STAGE(PG8_SA(0, 0), a2, voffA);
            PG8_BAR; PG8_WAIT_L(0); PG8_MMA(1, 0, At, B0); PG8_BAR; PG8_SCHED;
            PG8_STAGE(PG8_SB(0, 1), b2 + hstepB, voffB);
            PG8_WAIT_V(6); PG8_BAR; PG8_MMA(1, 1, At, B1); PG8_BAR;
            PG8_LDB(B0, 1, 0); PG8_SCHED; PG8_LDA(At, 1, 0); PG8_STAGE(PG8_SA(0, 1), a2 + hstepA, voffA);
            PG8_WAIT_L(8); PG8_BAR; PG8_WAIT_L(0); PG8_MMA(0, 0, At, B0); PG8_BAR; PG8_SCHED;
            PG8_LDB(B1, 1, 1); PG8_STAGE(PG8_SB(1, 0), b3, voffB);
            PG8_BAR; PG8_WAIT_L(0); PG8_MMA(0, 1, At, B1); PG8_BAR;
            PG8_LDA(At, 1, 1); PG8_STAGE(PG8_SA(1, 0), a3, voffA);
            PG8_BAR; PG8_WAIT_L(0); PG8_MMA(1, 0, At, B0); PG8_BAR; PG8_SCHED;
            PG8_STAGE(PG8_SB(1, 1), b3 + hstepB, voffB);
            PG8_WAIT_V(6); PG8_BAR; PG8_MMA(1, 1, At, B1); PG8_BAR;
            }
        }
        if constexpr (ALIGN_EPI) { if (wr == 0) PG8_BAR; }
        if constexpr (!Epi::AFTER_DRAIN) { E(acc, cur, wr, wc, fr, fq); S.done(cur); }
        if (!has_next) break;
#pragma unroll
        for (int a = 0; a < 2; ++a)
#pragma unroll
            for (int b = 0; b < 2; ++b)
#pragma unroll
                for (int m = 0; m < 4; ++m)
#pragma unroll
                    for (int n = 0; n < 2; ++n) acc[a][b][m][n] = (f32x4){0.f, 0.f, 0.f, 0.f};
        cur = nxt; cA = nA; cB = nB; ++ui;
        if constexpr (Epi::ACC_INIT) E.init(acc, cur, wr, wc, fr, fq);
        if constexpr (ALIGN_EPI) { if (wr == 1) PG8_BAR; }
    }
    PG8_WAIT_V(0);
    if constexpr (!ALIGN_EPI) { if (wr == 0) PG8_BAR; }
    PG8_BAR;
    if constexpr (Epi::AFTER_DRAIN) { E.fused(acc, cur, wr, wc, fr, fq, lds, wid, lane); S.done(cur); }
#undef PG8_SA
#undef PG8_SB
#undef PG8_STAGE
#undef PG8_LDA
#undef PG8_LDB
#undef PG8_MMA
#undef PG8_WAIT_V
#undef PG8_WAIT_L
#undef PG8_BAR
#undef PG8_SCHED
}
}

#define LAS __attribute__((address_space(3)))
#define XB_TMO      128
#define XB_XCNT(j)  (256  + 64 * (j))
#define XB_XSUB(j)  (1280 + 64 * (j))
#define XB_XGEN(j)  (2304 + 64 * (j))
#define XB_TOP      3328
#define XB_TOPGEN   3392
#define XCD_BAR_WORDS 3456
#define XB_SPIN_CAP (1u << 18)

__device__ __forceinline__ unsigned xb_ld(unsigned* p)              { return __hip_atomic_load(p, __ATOMIC_RELAXED, __HIP_MEMORY_SCOPE_AGENT); }
__device__ __forceinline__ unsigned xb_add(unsigned* p, unsigned v) { return __hip_atomic_fetch_add(p, v, __ATOMIC_RELAXED, __HIP_MEMORY_SCOPE_AGENT); }
__device__ __forceinline__ unsigned xb_xcc_id() { return (unsigned)__builtin_amdgcn_s_getreg((3 << 11) | 20) & 0xFu; }
#define XB_SPIN(cond, bar) do { unsigned _sp = 0; while (cond) { __builtin_amdgcn_s_sleep(1); \
    if ((++_sp & 255u) == 0u) { if (xb_ld(&(bar)[XB_TMO])) break; if (_sp > XB_SPIN_CAP) { atomicAdd(&(bar)[XB_TMO], 1u); break; } } } } while (0)

struct XcdBarrier {
    unsigned* bar; unsigned x; unsigned G;
    volatile LAS unsigned* st;
};

__device__ __forceinline__ XcdBarrier xcd_barrier_post(unsigned* bar, volatile LAS unsigned* st, unsigned G) {
    XcdBarrier b; b.bar = bar; b.x = xb_xcc_id(); b.st = st; b.G = G;
    if (threadIdx.x == 0) (void)xb_add(&bar[XB_XCNT(b.x)], 1u);
    return b;
}
__device__ __forceinline__ void xcd_barrier_complete(unsigned* bar, unsigned x, unsigned G, unsigned& nloc, unsigned& nx) {
    unsigned sum, cnt, mine, sp = 0u;
    for (;;) {
        sum = 0u; cnt = 0u; mine = 0u;
#pragma unroll
        for (unsigned j = 0; j < 16; ++j) { const unsigned c = xb_ld(&bar[XB_XCNT(j)]); sum += c; cnt += (c > 0u) ? 1u : 0u; mine = (j == x) ? c : mine; }
        if (sum == G) break;
        __builtin_amdgcn_s_sleep(1);
        if ((++sp & 255u) == 0u) { if (xb_ld(&bar[XB_TMO])) break; if (sp > XB_SPIN_CAP) { atomicAdd(&bar[XB_TMO], 1u); break; } }
    }
    nloc = mine > 0u ? mine : 1u; nx = cnt > 0u ? cnt : 1u;
}

__device__ __forceinline__ void xcd_barrier(const XcdBarrier& b) {
    asm volatile("s_waitcnt vmcnt(0)" ::: "memory");
    __syncthreads();
    if (threadIdx.x == 0) {
        unsigned* bar = b.bar;
        __builtin_amdgcn_s_waitcnt(0);
        unsigned nloc = b.st[0], nx = b.st[1];
        if (nloc == 0u) { xcd_barrier_complete(bar, b.x, b.G, nloc, nx); b.st[0] = nloc; b.st[1] = nx; }
        const unsigned old = xb_add(&bar[XB_XSUB(b.x)], 1u);
        const unsigned gen = old / nloc;
        if (old + 1u == (gen + 1u) * nloc) {
            __builtin_amdgcn_fence(__ATOMIC_RELEASE, "agent");
            asm volatile("s_waitcnt vmcnt(0)" ::: "memory");
            const unsigned og = xb_add(&bar[XB_TOP], 1u);
            const unsigned tg = og / nx;
            if (og + 1u == (tg + 1u) * nx) xb_add(&bar[XB_TOPGEN], 1u);
            else XB_SPIN(xb_ld(&bar[XB_TOPGEN]) == tg, bar);
            __builtin_amdgcn_fence(__ATOMIC_ACQUIRE, "agent");
            xb_add(&bar[XB_XGEN(b.x)], 1u);
            asm volatile("s_waitcnt vmcnt(0)" ::: "memory");
        } else {
            XB_SPIN(xb_ld(&bar[XB_XGEN(b.x)]) == gen, bar);
            __builtin_amdgcn_fence(__ATOMIC_ACQUIRE, "agent");
            asm volatile("s_waitcnt vmcnt(0)" ::: "memory");
        }
    }
    __syncthreads();
}

constexpr int NWAVES = 8;
constexpr int RING_BYTES = 131072;
constexpr int LDSCTL_OFF = 139264;
constexpr int LDS_BYTES = 147456;
constexpr int CW_BAR = 4096;
constexpr size_t CTL_ZERO_BYTES = 131072;
#ifndef OPT_MASK
#define OPT_MASK 0x1FF
#endif

typedef float f32x4 __attribute__((ext_vector_type(4)));
typedef unsigned u32x4v __attribute__((ext_vector_type(4)));
typedef unsigned u32x2v __attribute__((ext_vector_type(2)));
typedef short bf16x8 __attribute__((ext_vector_type(8)));
#define LDS_WAIT() asm volatile("s_waitcnt lgkmcnt(0)" ::: "memory")

struct MArgs { const float* in[16]; float* out; unsigned char* ws; int ph_lo, ph_hi, li, pad; };
struct Frame { LAS unsigned char* lds; int tid, lane, wave, G, bid, grp, gi, gs, b0, nb; const float* in[16]; float* out; unsigned char* ws; };
#ifndef NGRP
#define NGRP 2
#endif
constexpr int CW_MEMKV = 64;

__device__ __forceinline__ unsigned pk2(float lo, float hi) { return pg8::cvt_pk_bf16(lo, hi); }
__device__ __forceinline__ float wave_sum(float v) {
#pragma unroll
    for (int o = 1; o < 64; o <<= 1) v += __shfl_xor(v, o);
    return v;
}

template <int NR> __device__ __forceinline__ void p0_x_rows(const float* x, bf16_t* xb, float* rs, int row, int lane) {
    f32x4 v[NR][4]; float s[NR];
#pragma unroll
    for (int r = 0; r < NR; ++r) { const f32x4* xr = (const f32x4*)(x + (size_t)(row + r) * D_) + lane;
#pragma unroll
        for (int j = 0; j < 4; ++j) v[r][j] = xr[64 * j]; }
#pragma unroll
    for (int r = 0; r < NR; ++r) { s[r] = 0.f;
#pragma unroll
        for (int j = 0; j < 4; ++j) s[r] += (v[r][j][0] * v[r][j][0] + v[r][j][1] * v[r][j][1]) + (v[r][j][2] * v[r][j][2] + v[r][j][3] * v[r][j][3]); }
#pragma unroll
    for (int o = 1; o < 64; o <<= 1)
#pragma unroll
        for (int r = 0; r < NR; ++r) s[r] += __shfl_xor(s[r], o);
#pragma unroll
    for (int r = 0; r < NR; ++r) { u32x2v* o8 = (u32x2v*)(xb + (size_t)(row + r) * D_) + lane;
#pragma unroll
        for (int j = 0; j < 4; ++j) { u32x2v w; w.x = pk2(v[r][j][0], v[r][j][1]); w.y = pk2(v[r][j][2], v[r][j][3]); o8[64 * j] = w; }
        if (lane == 0) rs[row + r] = 1.0f / sqrtf(s[r] * (1.0f / D_) + EPS_); }
}
constexpr int TSCR_BYTES = 64 * 65 * 4;
__device__ __forceinline__ void p0_transpose_item(const float* W, int ldw, int csrc, const float* gain, int gmask, bf16_t* WT, int K, int nrow, int k0, LAS float* scr, int lane) {
    const int kk = lane >> 4, nq = lane & 15;
    f32x4 v[16];
#pragma unroll
    for (int j = 0; j < 16; ++j) v[j] = *(const f32x4*)(W + (size_t)(k0 + 4 * j + kk) * ldw + csrc + 4 * nq);
#pragma unroll
    for (int j = 0; j < 16; ++j) { const int k = 4 * j + kk; LAS float* d = scr + k * 65 + ((4 * nq + 4 * (j >> 3)) & 63);
        d[0] = v[j][0]; d[1] = v[j][1]; d[2] = v[j][2]; d[3] = v[j][3]; }
    const int c = lane & 7, nr = lane >> 3;
    f32x4 g0 = (f32x4){1.f, 1.f, 1.f, 1.f}, g1 = g0;
    if (gain) { g0 = *(const f32x4*)(gain + ((k0 + 8 * c) & gmask)); g1 = *(const f32x4*)(gain + ((k0 + 8 * c + 4) & gmask)); }
    LDS_WAIT(); asm volatile("" ::: "memory");
#pragma unroll
    for (int jj = 0; jj < 8; ++jj) { const int n = nr + 8 * jj; const LAS float* s = scr + (8 * c) * 65 + ((n + 4 * (c >> 2)) & 63);
        u32x4v o; o.x = pk2(s[0 * 65] * g0[0], s[1 * 65] * g0[1]); o.y = pk2(s[2 * 65] * g0[2], s[3 * 65] * g0[3]); o.z = pk2(s[4 * 65] * g1[0], s[5 * 65] * g1[1]); o.w = pk2(s[6 * 65] * g1[2], s[7 * 65] * g1[3]);
        *(u32x4v*)(WT + (size_t)(nrow + n) * K + k0 + 8 * c) = o; }
    LDS_WAIT(); asm volatile("" ::: "memory");
}
__device__ __forceinline__ void p0_memkv(const Frame& F, int unit) {
    const int l = unit >> 7, b = (unit >> 6) & 1, mt = (unit >> 3) & 7, cg = unit & 7, lane = F.lane, w = F.wave, c = lane & 15, g4 = lane >> 4, cgw = w & 1, kq = w >> 1;
    const float* mem = F.in[1] + ((size_t)b * 256 + mt * 32) * D_; const float* W = F.in[13] + (size_t)l * D_ * 1024 + cg * 128 + 64 * cgw + 4 * c; const float* gm = F.in[12] + l * D_;
    f32x4 acc[4][2];
#pragma unroll
    for (int t = 0; t < 4; ++t) { acc[t][0] = (f32x4){0.f, 0.f, 0.f, 0.f}; acc[t][1] = (f32x4){0.f, 0.f, 0.f, 0.f}; }
#pragma unroll 4
    for (int ks = 0; ks < 8; ++ks) { const int kb = kq * 256 + ks * 32 + 8 * g4;
        const f32x4 g0 = *(const f32x4*)(gm + kb), g1 = *(const f32x4*)(gm + kb + 4);
        bf16x8 afr[2], bfr[4];
#pragma unroll
        for (int rb = 0; rb < 2; ++rb) { const float* p = mem + (size_t)(rb * 16 + c) * D_ + kb; const f32x4 a0 = *(const f32x4*)p * g0, a1 = *(const f32x4*)(p + 4) * g1;
            u32x4v t; t.x = pk2(a0[0], a0[1]); t.y = pk2(a0[2], a0[3]); t.z = pk2(a1[0], a1[1]); t.w = pk2(a1[2], a1[3]); afr[rb] = __builtin_bit_cast(bf16x8, t); }
        f32x4 wv[8];
#pragma unroll
        for (int j = 0; j < 8; ++j) wv[j] = *(const f32x4*)(W + (size_t)(kb + j) * 1024);
#pragma unroll
        for (int t = 0; t < 4; ++t) { u32x4v q; q.x = pk2(wv[0][t], wv[1][t]); q.y = pk2(wv[2][t], wv[3][t]); q.z = pk2(wv[4][t], wv[5][t]); q.w = pk2(wv[6][t], wv[7][t]); bfr[t] = __builtin_bit_cast(bf16x8, q); }
#pragma unroll
        for (int t = 0; t < 4; ++t)
#pragma unroll
            for (int rb = 0; rb < 2; ++rb) acc[t][rb] = __builtin_amdgcn_mfma_f32_16x16x32_bf16(afr[rb], bfr[t], acc[t][rb], 0, 0, 0);
    }
    LAS float* P = (LAS float*)F.lds;
#pragma unroll
    for (int rb = 0; rb < 2; ++rb)
#pragma unroll
        for (int r = 0; r < 4; ++r) { const int tok = rb * 16 + 4 * g4 + r; *(LAS f32x4*)(P + ((kq * 32 + tok) * 128 + 64 * cgw + 4 * c)) = (f32x4){acc[0][rb][r], acc[1][rb][r], acc[2][rb][r], acc[3][rb][r]}; }
    __syncthreads();
    const int tok = F.tid >> 4, cb = F.tid & 15;
    f32x4 s0 = (f32x4){0.f, 0.f, 0.f, 0.f}, s1 = s0;
#pragma unroll
    for (int q = 0; q < 4; ++q) { s0 += *(const LAS f32x4*)(P + ((q * 32 + tok) * 128 + cb * 8)); s1 += *(const LAS f32x4*)(P + ((q * 32 + tok) * 128 + cb * 8 + 4)); }
    float ms = 0.f; { const f32x4* mr = (const f32x4*)(mem + (size_t)tok * D_ + cb * 64);
#pragma unroll
        for (int j = 0; j < 16; ++j) { const f32x4 v = mr[j]; ms += (v[0] * v[0] + v[1] * v[1]) + (v[2] * v[2] + v[3] * v[3]); } }
    ms += __shfl_xor(ms, 1); ms += __shfl_xor(ms, 2); ms += __shfl_xor(ms, 4); ms += __shfl_xor(ms, 8);
    const float rm = 1.0f / sqrtf(ms * (1.0f / D_) + EPS_);
    s0 *= rm; s1 *= rm;
    const size_t orow = ((((size_t)l * 2 + b) * 4 + (cg & 3)) * 256 + mt * 32 + tok) * 128 + cb * 8;
    if (cg < 4) {
        float q = (s0[0] * s0[0] + s0[1] * s0[1]) + (s0[2] * s0[2] + s0[3] * s0[3]) + (s1[0] * s1[0] + s1[1] * s1[1]) + (s1[2] * s1[2] + s1[3] * s1[3]);
        q += __shfl_xor(q, 1); q += __shfl_xor(q, 2); q += __shfl_xor(q, 4); q += __shfl_xor(q, 8);
        const float hn = QK_SCALE / sqrtf(q * (1.0f / 128) + EPS_);
        const f32x4 gk0 = *(const f32x4*)(F.in[15] + l * 128 + cb * 8), gk1 = *(const f32x4*)(F.in[15] + l * 128 + cb * 8 + 4);
        const f32x4 gq0 = *(const f32x4*)(F.in[14] + l * 128 + cb * 8), gq1 = *(const f32x4*)(F.in[14] + l * 128 + cb * 8 + 4);
        s0 = s0 * hn * gk0 * gq0; s1 = s1 * hn * gk1 * gq1;
        *(u32x4v*)((bf16_t*)(F.ws + WS_MEMK) + orow) = pg8::pack8(s0, s1);
    } else *(u32x4v*)((bf16_t*)(F.ws + WS_MEMV) + orow) = pg8::pack8(s0, s1);
    __syncthreads();
}
__device__ __forceinline__ void p0_weight_item(const Frame& F, int r, LAS float* scr) {
    constexpr int I_A = 16 * 64, I_OA = 24 * 16, I_B = 16 * 80;
    if (r < I_A) { const int kb = r / 64, n0 = 64 * (r % 64); p0_transpose_item(F.in[4], 4096, permA_src(n0), F.in[3], 0xffff, (bf16_t*)(F.ws + WS_WINA), 1024, n0, 64 * kb, scr, F.lane); return; } r -= I_A;
    if (r < I_OA) { const int kb = r / 16, n0 = 64 * (r % 16); p0_transpose_item(F.in[6], 1024, n0, kb < 16 ? F.in[5] : nullptr, 255, (bf16_t*)(F.ws + WS_WOUTA), 1536, n0, 64 * kb, scr, F.lane); return; } r -= I_OA;
    if (r < I_B) { const int kb = r / 80, n0 = 64 * (r % 80);
        if (n0 < 2048) p0_transpose_item(F.in[8], 2048, n0, F.in[7], 0xffff, (bf16_t*)(F.ws + WS_WB), 1024, n0, 64 * kb, scr, F.lane);
        else { const int c = n0 - 2048, src = c < 1024 ? 1024 + c : (c < 2048 ? c - 1024 : c); p0_transpose_item(F.in[10], 3072, src, F.in[9], 0xffff, (bf16_t*)(F.ws + WS_WB), 1024, n0, 64 * kb, scr, F.lane); }
        return; } r -= I_B;
    { const int kb = r / 16, n0 = 64 * (r % 16); p0_transpose_item(F.in[11], 1024, n0, nullptr, 0, (bf16_t*)(F.ws + WS_WOUTB), 1536, n0, 64 * kb, scr, F.lane); }
}
__device__ __forceinline__ void p0_prologue(const Frame& F) {
    if (NGRP == 1) for (int u = F.bid; u < 256; u += F.G) p0_memkv(F, u);
    const int gw = F.bid * NWAVES + F.wave, NGW = F.G * NWAVES;
    LAS float* scr = (LAS float*)(F.lds + F.wave * TSCR_BYTES);
    float* RS0 = (float*)(F.ws + WS_RS0); const float* x = F.in[0];
    if (NGW == 2048) {
        if (gw < 1024) { p0_weight_item(F, gw, scr); p0_x_rows<4>(x, x1b_ptr(F.ws, (6 * gw) >> 13), RS0, 6 * gw, F.lane); p0_weight_item(F, gw + 2048, scr); p0_x_rows<2>(x, x1b_ptr(F.ws, (6 * gw + 4) >> 13), RS0, 6 * gw + 4, F.lane); }
        else { const int r0 = 6144 + 10 * (gw - 1024); p0_x_rows<4>(x, x1b_ptr(F.ws, r0 >> 13), RS0, r0, F.lane); p0_weight_item(F, gw, scr); p0_x_rows<4>(x, x1b_ptr(F.ws, (r0 + 4) >> 13), RS0, r0 + 4, F.lane); p0_x_rows<2>(x, x1b_ptr(F.ws, (r0 + 8) >> 13), RS0, r0 + 8, F.lane); }
    } else {
        for (int it = gw; it < 3072; it += NGW) p0_weight_item(F, it, scr);
        for (int m = 4 * gw; m < T_; m += 4 * NGW) p0_x_rows<4>(x, x1b_ptr(F.ws, m >> 13), RS0, m, F.lane);
    }
}

typedef float f32x16 __attribute__((ext_vector_type(16)));
typedef short s16x4 __attribute__((ext_vector_type(4)));
#define KSWZ(row, colB) ((row) * 256 + ((colB) ^ (((row) & 7) << 4)))
#define SBAR() __builtin_amdgcn_sched_barrier(0)
constexpr float LOG2E = 1.4426950408889634f;
__device__ __forceinline__ int crow(int r, int hi) { return (r & 3) + 8 * (r >> 2) + 4 * hi; }
__device__ __forceinline__ unsigned lds_addr(const LAS void* p) { return (unsigned)(size_t)p; }
__device__ __forceinline__ int v_st(int k, int c) { const int kk = (k & ~0xC) | ((k & 4) << 1) | ((k & 8) >> 1); return ((kk >> 3) * 4 + (c >> 5)) * 512 + ((kk & 7) * 32 + (c & 31)) * 2; }
__device__ __forceinline__ int v_rd_base(int lane) { return ((lane & 3) << 3) | (((lane >> 2) & 3) << 6) | (((lane >> 4) & 1) << 5) | (((lane >> 5) & 1) << 8); }
constexpr int v_rd_off(int d0, int ks, int half) { return d0 * 512 + ks * 4096 + half * 2048; }
template <int OFF> __device__ __forceinline__ s16x4 tr_read(unsigned vb) { s16x4 r; asm volatile("ds_read_b64_tr_b16 %0, %1 offset:%2" : "=&v"(r) : "v"(vb), "i"(OFF) : "memory"); return r; }
#define PKLH(L, H) (bf16x8){L[0], L[1], L[2], L[3], H[0], H[1], H[2], H[3]}
__device__ __forceinline__ float partner32(float x, int hi) { auto rr = __builtin_amdgcn_permlane32_swap(__float_as_uint(x), __float_as_uint(x), false, false); return __uint_as_float(hi ? rr[0] : rr[1]); }

__device__ __forceinline__ void qkt(f32x16& p0, f32x16& p1, const LAS unsigned char* Ks, const bf16x8* qr, int r32, int hi) {
    p0 = f32x16{}; p1 = f32x16{};
#pragma unroll
    for (int d0 = 0; d0 < 8; ++d0) { const int cb = (d0 * 16 + hi * 8) * 2;
        const bf16x8 b0 = *(const LAS bf16x8*)(Ks + KSWZ(r32, cb)), b1 = *(const LAS bf16x8*)(Ks + KSWZ(32 + r32, cb));
        p0 = __builtin_amdgcn_mfma_f32_32x32x16_bf16(b0, qr[d0], p0, 0, 0, 0);
        p1 = __builtin_amdgcn_mfma_f32_32x32x16_bf16(b1, qr[d0], p1, 0, 0, 0); }
}
#define PK4(P, BASE, OUT) do { unsigned a0_ = pg8::cvt_pk_bf16(P[BASE + 0], P[BASE + 1]), a1_ = pg8::cvt_pk_bf16(P[BASE + 2], P[BASE + 3]); \
    unsigned b0_ = pg8::cvt_pk_bf16(P[BASE + 4], P[BASE + 5]), b1_ = pg8::cvt_pk_bf16(P[BASE + 6], P[BASE + 7]); \
    auto r0_ = __builtin_amdgcn_permlane32_swap(a0_, b0_, false, false); auto r1_ = __builtin_amdgcn_permlane32_swap(a1_, b1_, false, false); \
    u32x4v w_ = {r0_[0], r1_[0], r0_[1], r1_[1]}; OUT = __builtin_bit_cast(bf16x8, w_); } while (0)
template <int D0> __device__ __forceinline__ void pv_one(f32x16& od, unsigned vb, bf16x8 pa0, bf16x8 pa1, bf16x8 pa2, bf16x8 pa3) {
    const s16x4 l0 = tr_read<v_rd_off(D0, 0, 0)>(vb), h0 = tr_read<v_rd_off(D0, 0, 1)>(vb), l1 = tr_read<v_rd_off(D0, 1, 0)>(vb), h1 = tr_read<v_rd_off(D0, 1, 1)>(vb);
    const s16x4 l2 = tr_read<v_rd_off(D0, 2, 0)>(vb), h2 = tr_read<v_rd_off(D0, 2, 1)>(vb), l3 = tr_read<v_rd_off(D0, 3, 0)>(vb), h3 = tr_read<v_rd_off(D0, 3, 1)>(vb);
    asm volatile("s_waitcnt lgkmcnt(0)" ::: "memory"); SBAR();
    od = __builtin_amdgcn_mfma_f32_32x32x16_bf16(pa0, PKLH(l0, h0), od, 0, 0, 0);
    od = __builtin_amdgcn_mfma_f32_32x32x16_bf16(pa1, PKLH(l1, h1), od, 0, 0, 0);
    od = __builtin_amdgcn_mfma_f32_32x32x16_bf16(pa2, PKLH(l2, h2), od, 0, 0, 0);
    od = __builtin_amdgcn_mfma_f32_32x32x16_bf16(pa3, PKLH(l3, h3), od, 0, 0, 0);
}
__device__ __forceinline__ void pv_d0(f32x16* o, unsigned vb, bf16x8 pa0, bf16x8 pa1, bf16x8 pa2, bf16x8 pa3) {
    pv_one<0>(o[0], vb, pa0, pa1, pa2, pa3); pv_one<1>(o[1], vb, pa0, pa1, pa2, pa3); pv_one<2>(o[2], vb, pa0, pa1, pa2, pa3); pv_one<3>(o[3], vb, pa0, pa1, pa2, pa3);
}
constexpr int WSCR_OFF = LDSCTL_OFF + 1024, WFLAG_OFF = LDSCTL_OFF + 512;


__device__ __forceinline__ void o_tile_stage(const f32x16* o, const float* rsc, LAS unsigned char* stg, int r32, int hi) {
#pragma unroll
    for (int r = 0; r < 16; ++r) { LAS bf16_t* sp = (LAS bf16_t*)(stg + crow(r, hi) * 256) + r32;
#pragma unroll
        for (int db = 0; db < 4; ++db) sp[32 * db] = (bf16_t)(pg8::cvt_pk_bf16_safe(o[db][r] * rsc[r], 0.f) & 0xffffu); }
}
__device__ __forceinline__ void o_tile_out(const LAS unsigned char* stg, const bf16_t* gate, bf16_t* out, size_t ld, int lane) {
    const int rr = lane >> 4, ch = lane & 15;
#pragma unroll
    for (int ps = 0; ps < 8; ++ps) { const int row = 4 * ps + rr; const bf16x8 v = *(const LAS bf16x8*)(stg + row * 256 + ch * 16); const bf16x8 g = *(const bf16x8*)(gate + (size_t)row * ld + ch * 8);
        u32x4v w; w.x = pk2(bf2f((bf16_t)v[0]) * bf2f((bf16_t)g[0]), bf2f((bf16_t)v[1]) * bf2f((bf16_t)g[1])); w.y = pk2(bf2f((bf16_t)v[2]) * bf2f((bf16_t)g[2]), bf2f((bf16_t)v[3]) * bf2f((bf16_t)g[3]));
        w.z = pk2(bf2f((bf16_t)v[4]) * bf2f((bf16_t)g[4]), bf2f((bf16_t)v[5]) * bf2f((bf16_t)g[5])); w.w = pk2(bf2f((bf16_t)v[6]) * bf2f((bf16_t)g[6]), bf2f((bf16_t)v[7]) * bf2f((bf16_t)g[7]));
        *(u32x4v*)(out + (size_t)row * ld + ch * 8) = w; }
}


template <bool MASK, int KOFF> __device__ __forceinline__ void sb_half_a(f32x16& p, float* go, int lim) {
#pragma unroll
    for (int i = 0; i < 4; ++i) { float l[4];
#pragma unroll
        for (int e = 0; e < 4; ++e) { const float y = fminf(p[4 * i + e], 60.f), sp = __builtin_amdgcn_logf(1.0f + __builtin_amdgcn_exp2f(y));
            l[e] = -sp; p[4 * i + e] = y - sp; if (MASK) l[e] = KOFF + 8 * i + e < lim ? l[e] : 0.f; }
        go[i] = (l[0] + l[1]) + (l[2] + l[3]);
        const float s2 = l[3], s1 = s2 + l[2], s0 = s1 + l[1]; p[4 * i + 2] += s2; p[4 * i + 1] += s1; p[4 * i] += s0; }
}
template <bool MASK, int KOFF> __device__ __forceinline__ void sb_half_b(f32x16& p, const float* go, int lim, float carry, float& tail, int hi) {
#pragma unroll
    for (int i = 3; i >= 0; --i) { const float gpi = partner32(go[i], hi); const float so = tail + (hi ? 0.f : gpi) + carry; tail += go[i] + gpi;
#pragma unroll
        for (int e = 0; e < 4; ++e) { float a = __builtin_amdgcn_exp2f(p[4 * i + e] + so); if (MASK) a = KOFF + 8 * i + e < lim ? a : 0.f; p[4 * i + e] = a; } }
}
template <bool MASK> __device__ __forceinline__ float sb_weights(f32x16& p0, f32x16& p1, int lim, float carry, int hi) {
    float go[8], tail = 0.f;
    sb_half_a<MASK, 0>(p0, go, lim); sb_half_a<MASK, 32>(p1, go + 4, lim);
    sb_half_b<MASK, 32>(p1, go + 4, lim, carry, tail, hi); sb_half_b<MASK, 0>(p0, go, lim, carry, tail, hi);
    return tail;
}

constexpr float SB_EXIT = -150.1f;
__device__ __forceinline__ int swap23(int k) { return (k & ~0xC) | ((k & 4) << 1) | ((k & 8) >> 1); }
__device__ __forceinline__ void sb_unit(const Frame& F, int b, int h, int qb) {
    int tid = F.tid; asm volatile("" : "+v"(tid));
    const int w = F.wave, lane = tid & 63, r32 = lane & 31, hi = lane >> 5;
    bf16_t* UB = ub_ptr(F.ws, b); const size_t rowb = (size_t)b * S_;
    const int q0 = qb * 256, tq = q0 + 32 * w + r32;
    unsigned offK[2], offV[2];
#pragma unroll
    for (int i = 0; i < 2; ++i) { const int pc = w + 8 * i;
        { const int row = pc * 4 + (lane >> 4), colB = ((lane & 15) * 16) ^ ((row & 7) << 4); offK[i] = (unsigned)(row * NBW_ + colB / 2); }
        { const int d = pc * 1024 + lane * 16, st = d >> 9, o = d & 511, kk = ((st >> 2) << 3) | (o >> 6), k = swap23(kk), c = (st & 3) * 32 + (o & 63) / 2; offV[i] = (unsigned)(k * NBW_ + c); } }
    const bf16_t* kg = UB + rowb * NBW_ + h * 128; const bf16_t* vg = kg + 1024;
#define SB_DMA(kt_) do { const int bo_ = ((kt_) % 3) * 32768; const bf16_t* kt0_ = kg + (size_t)(kt_) * 64 * NBW_; const bf16_t* vt0_ = vg + (size_t)(kt_) * 64 * NBW_; \
        _Pragma("unroll") for (int i_ = 0; i_ < 2; ++i_) { \
            __builtin_amdgcn_global_load_lds((const unsigned*)(kt0_ + offK[i_]), (LAS unsigned*)(F.lds + bo_ + (w + 8 * i_) * 1024), 16, 0, 0); \
            __builtin_amdgcn_global_load_lds((const unsigned*)(vt0_ + offV[i_]), (LAS unsigned*)(F.lds + bo_ + 16384 + (w + 8 * i_) * 1024), 16, 0, 0); } } while (0)
    volatile LAS unsigned* flags = (volatile LAS unsigned*)(F.lds + WFLAG_OFF);
    f32x16 o[4] = {}; float carry = 0.f; bool wdone = false;
    const int kt_hi = qb * 4 + 3;
    __syncthreads();
    if (lane == 0) { flags[w] = 0u; flags[8 + w] = 0u; }
    SB_DMA(kt_hi); SB_DMA(kt_hi - 1);
    bf16x8 qr[8];
    { const bf16_t* qp = UB + (rowb + tq) * NBW_ + 3072 + h * 128 + hi * 8;
#pragma unroll
      for (int d0 = 0; d0 < 8; ++d0) qr[d0] = *(const bf16x8*)(qp + d0 * 16); }
    asm volatile("s_waitcnt vmcnt(0)" ::: "memory");
    const unsigned vbase = lds_addr(F.lds) + 16384 + v_rd_base(lane);
    for (int kt = kt_hi; kt >= 0; --kt) {
        if (kt >= 1) asm volatile("s_waitcnt vmcnt(4)" ::: "memory"); else asm volatile("s_waitcnt vmcnt(0)" ::: "memory");
        asm volatile("s_waitcnt lgkmcnt(0)" ::: "memory"); __builtin_amdgcn_s_barrier(); asm volatile("" ::: "memory");
        unsigned alld = 1u;
#pragma unroll
        for (int j = 0; j < 8; ++j) alld &= flags[8 * (kt & 1) + j];
        if (alld) break;
        if (kt >= 2) SB_DMA(kt - 2);
        const int bo = (kt % 3) * 32768;
        if (!wdone && kt * 64 < q0 + 32 * w + 31) {
            f32x16 p0, p1;
            qkt(p0, p1, F.lds + bo, qr, r32, hi);
            const int lim = tq - kt * 64 - 4 * hi;
            const bool need_mask = kt * 64 + 63 >= q0 + 32 * w;
            carry += need_mask ? sb_weights<true>(p0, p1, lim, carry, hi) : sb_weights<false>(p0, p1, lim, carry, hi);
            bf16x8 pa0, pa1, pa2, pa3;
            PK4(p0, 0, pa0); PK4(p0, 8, pa1); PK4(p1, 0, pa2); PK4(p1, 8, pa3);
            pv_d0(o, vbase + bo, pa0, pa1, pa2, pa3);
            wdone = __all(carry < SB_EXIT);
        }
        if (lane == 0) flags[8 * ((kt & 1) ^ 1) + w] = wdone ? 1u : 0u;
    }
#undef SB_DMA
    asm volatile("s_waitcnt vmcnt(0) lgkmcnt(0)" ::: "memory"); __builtin_amdgcn_s_barrier(); asm volatile("" ::: "memory");
    { float one[16];
#pragma unroll
      for (int r = 0; r < 16; ++r) one[r] = 1.0f;
      LAS unsigned char* stg = F.lds + w * 8192; bf16_t* base = UB + (rowb + q0 + 32 * w) * NBW_ + h * 128;
      o_tile_stage(o, one, stg, r32, hi); LDS_WAIT();
      o_tile_out(stg, base + 2048, base + 3072, NBW_, lane); LDS_WAIT(); }
}

__device__ __forceinline__ void memattn_unit(const Frame& F, bf16_t* U, int ld, int qoff, int goff, int layer, int unit) {
    int tid = F.tid; asm volatile("" : "+v"(tid));
    const int w = F.wave, lane = tid & 63, r32 = lane & 31, hi = lane >> 5;
    const int qblk = unit >> 2, hd = unit & 3, row0 = qblk * 256, b = row0 / S_;
    const bf16_t* Kg = (const bf16_t*)(F.ws + WS_MEMK) + (((size_t)layer * 2 + b) * 4 + hd) * 256 * 128; const bf16_t* Vg = (const bf16_t*)(F.ws + WS_MEMV) + (((size_t)layer * 2 + b) * 4 + hd) * 256 * 128;
    LAS unsigned char* Kb = F.lds; LAS unsigned char* Vb = F.lds + 65536;
    __syncthreads();
#pragma unroll
    for (int j = 0; j < 8; ++j) { const int c = tid + 512 * j, row = c >> 4, ch = c & 15;
        *(LAS bf16x8*)(Kb + KSWZ(row, ch * 16)) = *(const bf16x8*)(Kg + (size_t)row * 128 + ch * 8);
        *(LAS bf16x8*)(Vb + (row >> 6) * 16384 + v_st(row & 63, ch * 8)) = *(const bf16x8*)(Vg + (size_t)row * 128 + ch * 8); }
    bf16x8 qr[8]; float ssq = 0.f;
    { const bf16_t* qp = U + (size_t)(row0 + 32 * w + r32) * ld + qoff + hd * 128 + hi * 8;
#pragma unroll
      for (int d0 = 0; d0 < 8; ++d0) { qr[d0] = *(const bf16x8*)(qp + d0 * 16);
#pragma unroll
          for (int j = 0; j < 8; ++j) { const float v = bf2f((bf16_t)qr[d0][j]); ssq += v * v; } } }
    ssq += partner32(ssq, hi);
    const float C = LOG2E / sqrtf(ssq * (1.0f / 128) + EPS_);
    __syncthreads();
    LAS float* wscr = (LAS float*)(F.lds + WSCR_OFF) + w * 64;
    const unsigned vb0 = lds_addr(Vb) + v_rd_base(lane);
    f32x16 o[4] = {}; float m_reg = -1e30f, l_reg = 0.f;
#pragma unroll 1
    for (int t = 0; t < 4; ++t) {
        f32x16 p0, p1;
        qkt(p0, p1, Kb + t * 16384, qr, r32, hi);
        float pmax = p0[0];
#pragma unroll
        for (int r = 1; r < 16; ++r) pmax = fmaxf(pmax, p0[r]);
#pragma unroll
        for (int r = 0; r < 16; ++r) pmax = fmaxf(pmax, p1[r]);
        pmax = fmaxf(pmax, partner32(pmax, hi));
        float alpha = 1.f;
        if (!__all(pmax <= m_reg)) { const float mn = fmaxf(m_reg, pmax); alpha = __builtin_amdgcn_exp2f((m_reg - mn) * C); m_reg = mn;
            if (hi == 0) wscr[r32] = alpha; LDS_WAIT();
#pragma unroll
            for (int d = 0; d < 4; ++d)
#pragma unroll
                for (int r = 0; r < 16; ++r) o[d][r] *= wscr[crow(r, hi)];
            LDS_WAIT(); }
        const float mC = -m_reg * C; float ps = 0.f;
#pragma unroll
        for (int r = 0; r < 16; ++r) { p0[r] = __builtin_amdgcn_exp2f(fmaf(p0[r], C, mC)); p1[r] = __builtin_amdgcn_exp2f(fmaf(p1[r], C, mC)); ps += p0[r] + p1[r]; }
        ps += partner32(ps, hi);
        l_reg = l_reg * alpha + ps;
        bf16x8 pa0, pa1, pa2, pa3;
        PK4(p0, 0, pa0); PK4(p0, 8, pa1); PK4(p1, 0, pa2); PK4(p1, 8, pa3);
        pv_d0(o, vb0 + t * 16384, pa0, pa1, pa2, pa3);
    }
    if (hi == 0) wscr[32 + r32] = l_reg; LDS_WAIT();
    { float rl[16];
#pragma unroll
      for (int r = 0; r < 16; ++r) rl[r] = 1.0f / wscr[32 + crow(r, hi)];
      __syncthreads();
      LAS unsigned char* stg = F.lds + w * 8192; bf16_t* base = U + (size_t)(row0 + 32 * w) * ld + hd * 128;
      o_tile_stage(o, rl, stg, r32, hi); LDS_WAIT();
      o_tile_out(stg, base + goff, base + qoff, ld, lane); LDS_WAIT(); }
}

__device__ __forceinline__ float ret_lg2(int h) { return log2f(1.0f - exp2f(-5.0f - (float)h)); }
template <int H2> __device__ __forceinline__ void o_half_stage(const f32x16* o, const float* rsc, LAS unsigned char* stg, int r32, int hi) {
#pragma unroll
    for (int r = 8 * H2; r < 8 * H2 + 8; ++r) { LAS bf16_t* sp = (LAS bf16_t*)(stg + ((r & 3) + 8 * ((r >> 2) & 1) + 4 * hi) * 256) + r32;
#pragma unroll
        for (int db = 0; db < 4; ++db) sp[32 * db] = (bf16_t)(pg8::cvt_pk_bf16_safe(o[db][r] * rsc[r], 0.f) & 0xffffu); }
}
__device__ __forceinline__ bf16x8 mul8_bf16(bf16x8 v, bf16x8 g) {
    u32x4v w; w.x = pk2(bf2f((bf16_t)v[0]) * bf2f((bf16_t)g[0]), bf2f((bf16_t)v[1]) * bf2f((bf16_t)g[1])); w.y = pk2(bf2f((bf16_t)v[2]) * bf2f((bf16_t)g[2]), bf2f((bf16_t)v[3]) * bf2f((bf16_t)g[3]));
    w.z = pk2(bf2f((bf16_t)v[4]) * bf2f((bf16_t)g[4]), bf2f((bf16_t)v[5]) * bf2f((bf16_t)g[5])); w.w = pk2(bf2f((bf16_t)v[6]) * bf2f((bf16_t)g[6]), bf2f((bf16_t)v[7]) * bf2f((bf16_t)g[7]));
    return __builtin_bit_cast(bf16x8, w);
}
__device__ __forceinline__ void kvt_unit(const Frame& F, int u) {
    int tid = F.tid; asm volatile("" : "+v"(tid));
    const int w = F.wave, lane = tid & 63, r32 = lane & 31, hi = lane >> 5;
    const int b = u >> 8, h = (u >> 6) & 3, n = u & 63; const size_t row0 = (size_t)b * S_ + n * 128; const float lg2 = ret_lg2(h);
    const bf16_t* UA = ua_ptr(F.ws, b); bf16_t* KVT = kvt_ptr(F.ws, b);
    LAS unsigned char* Vb = F.lds; LAS unsigned char* Kb = F.lds + 65536;
    __syncthreads();
#pragma unroll
    for (int j = 0; j < 8; ++j) { const int c = tid + 512 * j, row = c >> 5, col = (c & 31) * 8;
        *(LAS bf16x8*)(Vb + ((row >> 6) * 2 + (col >> 7)) * 16384 + v_st(row & 63, col & 127)) = *(const bf16x8*)(UA + (row0 + row) * NA_ + 1024 + h * 256 + col); }
#pragma unroll
    for (int j = 0; j < 4; ++j) { const int c = tid + 512 * j, row = c >> 4, col = (c & 15) * 8; const float z = exp2f((float)(127 - row) * lg2);
        const bf16x8 kv = *(const bf16x8*)(UA + (row0 + row) * NA_ + 512 + h * 128 + col);
        u32x4v t; t.x = pk2(bf2f((bf16_t)kv[0]) * z, bf2f((bf16_t)kv[1]) * z); t.y = pk2(bf2f((bf16_t)kv[2]) * z, bf2f((bf16_t)kv[3]) * z);
        t.z = pk2(bf2f((bf16_t)kv[4]) * z, bf2f((bf16_t)kv[5]) * z); t.w = pk2(bf2f((bf16_t)kv[6]) * z, bf2f((bf16_t)kv[7]) * z);
        *(LAS u32x4v*)(Kb + (row >> 6) * 16384 + v_st(row & 63, col)) = t; }
    __syncthreads();
    f32x16 acc[4] = {};
    const unsigned vbV = lds_addr(Vb) + v_rd_base(lane) + (w >> 2) * 16384 + (w & 3) * 512, vbK = lds_addr(Kb) + v_rd_base(lane);
#define KVT_STEP(TH, KS) do { const unsigned va_ = vbV + (TH) * 32768, vk_ = vbK + (TH) * 16384; \
        const s16x4 al_ = tr_read<v_rd_off(0, KS, 0)>(va_), ah_ = tr_read<v_rd_off(0, KS, 1)>(va_); \
        const s16x4 b0l_ = tr_read<v_rd_off(0, KS, 0)>(vk_), b0h_ = tr_read<v_rd_off(0, KS, 1)>(vk_), b1l_ = tr_read<v_rd_off(1, KS, 0)>(vk_), b1h_ = tr_read<v_rd_off(1, KS, 1)>(vk_); \
        const s16x4 b2l_ = tr_read<v_rd_off(2, KS, 0)>(vk_), b2h_ = tr_read<v_rd_off(2, KS, 1)>(vk_), b3l_ = tr_read<v_rd_off(3, KS, 0)>(vk_), b3h_ = tr_read<v_rd_off(3, KS, 1)>(vk_); \
        asm volatile("s_waitcnt lgkmcnt(0)" ::: "memory"); SBAR(); const bf16x8 a_ = PKLH(al_, ah_); \
        acc[0] = __builtin_amdgcn_mfma_f32_32x32x16_bf16(a_, PKLH(b0l_, b0h_), acc[0], 0, 0, 0); acc[1] = __builtin_amdgcn_mfma_f32_32x32x16_bf16(a_, PKLH(b1l_, b1h_), acc[1], 0, 0, 0); \
        acc[2] = __builtin_amdgcn_mfma_f32_32x32x16_bf16(a_, PKLH(b2l_, b2h_), acc[2], 0, 0, 0); acc[3] = __builtin_amdgcn_mfma_f32_32x32x16_bf16(a_, PKLH(b3l_, b3h_), acc[3], 0, 0, 0); } while (0)
    KVT_STEP(0, 0); KVT_STEP(0, 1); KVT_STEP(0, 2); KVT_STEP(0, 3); KVT_STEP(1, 0); KVT_STEP(1, 1); KVT_STEP(1, 2); KVT_STEP(1, 3);
#undef KVT_STEP
    bf16_t* ob = KVT + ((size_t)u * 256 + 32 * w) * 128 + r32;
#pragma unroll
    for (int r = 0; r < 16; ++r)
#pragma unroll
        for (int db = 0; db < 4; ++db) ob[(size_t)crow(r, hi) * 128 + 32 * db] = f2bf(acc[db][r]);
}
__device__ __forceinline__ void scan_phase(const Frame& F) {
    for (int idx = F.gi * (NWAVES * 64) + F.tid; idx < F.nb * 4 * 16384; idx += F.gs * NWAVES * 64) {
        const int bh = F.b0 * 4 + (idx >> 14), off = idx & 16383; const float gc = exp2f(128.0f * ret_lg2(bh & 3));
        unsigned* p = (unsigned*)kvt_ptr(F.ws, bh >> 2) + (size_t)bh * 64 * 16384 + off; float s0 = 0.f, s1 = 0.f;
#pragma unroll 1
        for (int n0 = 0; n0 < 64; n0 += 16) { unsigned v[16];
#pragma unroll
            for (int j = 0; j < 16; ++j) v[j] = p[(size_t)(n0 + j) * 16384];
#pragma unroll
            for (int j = 0; j < 16; ++j) { p[(size_t)(n0 + j) * 16384] = pk2(s0, s1); s0 = fmaf(gc, s0, __uint_as_float(v[j] << 16)); s1 = fmaf(gc, s1, __uint_as_float(v[j] & 0xffff0000u)); } }
    }
}
__device__ __forceinline__ void ret_unit(const Frame& F, int u) {
    int tid = F.tid; asm volatile("" : "+v"(tid));
    const int w = F.wave, lane = tid & 63, r32 = lane & 31, hi = lane >> 5, wq = w & 3, eh = w >> 2;
    const int b = u >> 8, h = (u >> 6) & 3, n = u & 63; const size_t row0 = (size_t)b * S_ + n * 128; const float lg2 = ret_lg2(h);
    bf16_t* UA = ua_ptr(F.ws, b); const bf16_t* KVT = kvt_ptr(F.ws, b);
    LAS unsigned char* R1 = F.lds; LAS unsigned char* R2 = F.lds + 65536;
    __syncthreads();
#pragma unroll
    for (int j = 0; j < 8; ++j) { const int c = tid + 512 * j, row = c >> 4, ch = c & 15; *(LAS bf16x8*)(R1 + KSWZ(row, ch * 16)) = *(const bf16x8*)(KVT + ((size_t)u * 256 + row) * 128 + ch * 8); }
#pragma unroll
    for (int j = 0; j < 4; ++j) { const int c = tid + 512 * j, row = c >> 4, ch = c & 15; *(LAS bf16x8*)(R2 + KSWZ(row, ch * 16)) = *(const bf16x8*)(UA + (row0 + row) * NA_ + 512 + h * 128 + ch * 8); }
    bf16x8 qr[8];
    { const bf16_t* qp = UA + (row0 + 32 * wq + r32) * NA_ + h * 128 + hi * 8;
#pragma unroll
      for (int d0 = 0; d0 < 8; ++d0) qr[d0] = *(const bf16x8*)(qp + d0 * 16); }
    __syncthreads();
    f32x16 o[4] = {};
#pragma unroll
    for (int db = 0; db < 4; ++db) {
#pragma unroll
        for (int d0 = 0; d0 < 8; ++d0) { const bf16x8 bs = *(const LAS bf16x8*)(R1 + KSWZ(128 * eh + 32 * db + r32, (d0 * 16 + hi * 8) * 2)); o[db] = __builtin_amdgcn_mfma_f32_32x32x16_bf16(qr[d0], bs, o[db], 0, 0, 0); }
        asm volatile("" ::: "memory"); }
    const float gm1 = exp2f(lg2), gm2 = gm1 * gm1, gm4 = gm2 * gm2, gm8 = gm4 * gm4, gm16 = gm8 * gm8;
    const float gi1 = exp2f(-lg2), gi2 = gi1 * gi1, gi4 = gi2 * gi2, gi8 = gi4 * gi4, gi16 = gi8 * gi8, gi32 = gi16 * gi16;
    const float ga[4] = {1.0f, gm1, gm2, gm2 * gm1}, gb[4] = {1.0f, gm8, gm16, gm16 * gm8};
    const float ia[4] = {1.0f, gi1, gi2, gi2 * gi1}, ib[4] = {1.0f, gi8, gi16, gi16 * gi8};
    { const float xl = exp2f((float)(32 * wq + 4 * hi + 1) * lg2);
#pragma unroll
      for (int r = 0; r < 16; ++r) { const float xi = xl * (ga[r & 3] * gb[r >> 2]);
#pragma unroll
          for (int db = 0; db < 4; ++db) o[db][r] *= xi; } }
    bf16x8 pa[2][4]; const int cq = 32 * wq + r32;
#define RET_P(ST) do { f32x16 p0, p1; qkt(p0, p1, R2 + (ST) * 16384, qr, r32, hi); const int limq_ = cq - 64 * (ST) - 4 * hi; const float al_ = exp2f((float)limq_ * lg2); \
        _Pragma("unroll") for (int r = 0; r < 16; ++r) { const int cr_ = (r & 3) + 8 * (r >> 2); const float f_ = al_ * (ia[r & 3] * ib[r >> 2]); \
            p0[r] = cr_ <= limq_ ? p0[r] * f_ : 0.f; p1[r] = cr_ + 32 <= limq_ ? p1[r] * (f_ * gi32) : 0.f; } \
        PK4(p0, 0, pa[ST][0]); PK4(p0, 8, pa[ST][1]); PK4(p1, 0, pa[ST][2]); PK4(p1, 8, pa[ST][3]); } while (0)
    RET_P(0);
    if (wq >= 2) RET_P(1);
#undef RET_P
    __syncthreads();
#pragma unroll 4
    for (int j = 0; j < 8; ++j) { const int c = tid + 512 * j, row = c >> 5, col = (c & 31) * 8;
        *(LAS bf16x8*)(R1 + ((row >> 6) * 2 + (col >> 7)) * 16384 + v_st(row & 63, col & 127)) = *(const bf16x8*)(UA + (row0 + row) * NA_ + 1024 + h * 256 + col); }
    __syncthreads();
    const unsigned vb = lds_addr(R1) + v_rd_base(lane) + eh * 16384;
    pv_d0(o, vb, pa[0][0], pa[0][1], pa[0][2], pa[0][3]);
    if (wq >= 2) pv_d0(o, vb + 32768, pa[1][0], pa[1][1], pa[1][2], pa[1][3]);
    LAS float* ssq = (LAS float*)(F.lds + WSCR_OFF);
    float qs[16];
#pragma unroll
    for (int r = 0; r < 16; ++r) { float q = (o[0][r] * o[0][r] + o[1][r] * o[1][r]) + (o[2][r] * o[2][r] + o[3][r] * o[3][r]);
        q += __shfl_xor(q, 1); q += __shfl_xor(q, 2); q += __shfl_xor(q, 4); q += __shfl_xor(q, 8); q += __shfl_xor(q, 16); qs[r] = q;
        if (r32 == 0) ssq[w * 32 + crow(r, hi)] = q; }
    __syncthreads();
    { bf16_t* base = UA + (row0 + 32 * wq) * NA_ + 2048 + h * 256 + 128 * eh + r32;
#pragma unroll
      for (int r = 0; r < 16; ++r) { const float rn = 1.0f / sqrtf((qs[r] + ssq[(w ^ 4) * 32 + crow(r, hi)]) * (1.0f / 256) + EPS_); bf16_t* rp = base + (size_t)crow(r, hi) * NA_;
#pragma unroll
          for (int db = 0; db < 4; ++db) { const float g = bf2f(rp[32 * db]); rp[32 * db] = f2bf(o[db][r] * rn * g); } } }
    LDS_WAIT();
}
#ifndef PG8_SP2
#define PG8_SP2 true
#endif
#ifndef PG8_ALIGN
#define PG8_ALIGN true
#endif
__device__ __forceinline__ void phase1(const Frame& F) {
    const size_t rb = (size_t)F.b0 * S_;
    pg8::Gemm g{(const bf16_t*)x1b_ptr(F.ws, F.b0) + rb * D_, (const bf16_t*)(F.ws + WS_WINA), F.nb * S_, NA_, D_, D_}; pg8::StaticOrder S; S.init(F.nb * S_, NA_, F.gs, F.gi);
    pg8::EpiA E{ua_ptr(F.ws, F.b0) + rb * NA_, (const float*)(F.ws + WS_RS0) + rb, (const int*)F.in[2] + rb};
    pg8::gemm_phase<pg8::EpiA, pg8::StaticOrder, PG8_ALIGN, PG8_SP2>(F.lds, g, S, E);
}
__device__ __forceinline__ void memkv_publish(const Frame& F) {
    asm volatile("s_waitcnt vmcnt(0)" ::: "memory"); __syncthreads();
    if (F.tid == 0) { __builtin_amdgcn_fence(__ATOMIC_RELEASE, "agent"); asm volatile("s_waitcnt vmcnt(0)" ::: "memory");
        __hip_atomic_fetch_add((unsigned*)(F.ws + WS_CTL) + CW_MEMKV, 1u, __ATOMIC_RELAXED, __HIP_MEMORY_SCOPE_AGENT); }
}
__device__ __forceinline__ void memkv_acquire(const Frame& F) {
    if (F.tid == 0) { unsigned* c = (unsigned*)(F.ws + WS_CTL) + CW_MEMKV; unsigned sp = 0;
        while (__hip_atomic_load(c, __ATOMIC_RELAXED, __HIP_MEMORY_SCOPE_AGENT) < (unsigned)F.gs) { __builtin_amdgcn_s_sleep(2); if (++sp > (1u << 22)) break; }
        __builtin_amdgcn_fence(__ATOMIC_ACQUIRE, "agent"); asm volatile("s_waitcnt vmcnt(0)" ::: "memory"); }
    __syncthreads();
}
__device__ __forceinline__ void phase2(const Frame& F) {
    for (int u = F.gi; u < F.nb * 256; u += F.gs) kvt_unit(F, F.b0 * 256 + u);
    if (NGRP == 2) memkv_acquire(F);
    for (int u = F.gi; u < F.nb * 128; u += F.gs) memattn_unit(F, ua_ptr(F.ws, (F.b0 * 128 + u) >> 7), NA_, 3072, 3584, 0, F.b0 * 128 + u);
}
__device__ __forceinline__ void phase4(const Frame& F) { for (int u = F.gi; u < F.nb * 256; u += F.gs) ret_unit(F, F.b0 * 256 + u); }
__device__ __forceinline__ void phase5(const Frame& F) {
    const size_t rb = (size_t)F.b0 * S_;
    pg8::Gemm g{(const bf16_t*)ua_ptr(F.ws, F.b0) + rb * NA_ + 2048, (const bf16_t*)(F.ws + WS_WOUTA), F.nb * S_, D_, KO_, NA_}; pg8::StaticOrder S; S.init(F.nb * S_, D_, F.gs, F.gi);
    pg8::EpiOutA E{F.in[0] + rb * D_, F.out + rb * D_, x1b_ptr(F.ws, F.b0) + rb * D_, (float*)(F.ws + WS_SS1P) + rb * 16};
    pg8::gemm_phase<pg8::EpiOutA, pg8::StaticOrder, PG8_ALIGN, PG8_SP2>(F.lds, g, S, E);
}
__device__ __forceinline__ void phase6(const Frame& F) {
    const size_t rb = (size_t)F.b0 * S_;
    pg8::Gemm g{(const bf16_t*)x1b_ptr(F.ws, F.b0) + rb * D_, (const bf16_t*)(F.ws + WS_WB), F.nb * S_, NBW_, D_, D_}; pg8::StaticOrder S; S.init(F.nb * S_, NBW_, F.gs, F.gi);
    pg8::EpiB E{ub_ptr(F.ws, F.b0) + rb * NBW_, (const float*)(F.ws + WS_SS1P) + rb * 16};
    pg8::gemm_phase<pg8::EpiB, pg8::StaticOrder, PG8_ALIGN, PG8_SP2>(F.lds, g, S, E);
}
__device__ __forceinline__ void phase7(const Frame& F) {
    for (int u = F.gi; u < F.nb * 256; u += F.gs) { const int U = F.b0 * 256 + u; sb_unit(F, U >> 8, (U >> 5) & 7, U & 31); }
    for (int u = F.gi; u < F.nb * 128; u += F.gs) memattn_unit(F, ub_ptr(F.ws, (F.b0 * 128 + u) >> 7), NBW_, 4096, 4608, 1, F.b0 * 128 + u);
}
__device__ __forceinline__ void phase8(const Frame& F) {
    const size_t rb = (size_t)F.b0 * S_;
    pg8::Gemm g{(const bf16_t*)ub_ptr(F.ws, F.b0) + rb * NBW_ + 3072, (const bf16_t*)(F.ws + WS_WOUTB), F.nb * S_, D_, KO_, NBW_}; pg8::StaticOrder S; S.init(F.nb * S_, D_, F.gs, F.gi);
    pg8::EpiOutB E{F.out + rb * D_, (const bf16_t*)x1b_ptr(F.ws, F.b0) + rb * D_};
    pg8::gemm_phase<pg8::EpiOutB, pg8::StaticOrder, PG8_ALIGN, PG8_SP2>(F.lds, g, S, E);
}

__global__ void __launch_bounds__(NWAVES * 64, 2) mega(MArgs args) {
    extern __shared__ __attribute__((aligned(16))) unsigned char lds_raw[];
    Frame F;
    F.lds = (LAS unsigned char*)lds_raw; F.tid = threadIdx.x; F.lane = F.tid & 63; F.wave = __builtin_amdgcn_readfirstlane(F.tid >> 6); F.G = gridDim.x; F.bid = blockIdx.x;
    if (NGRP == 2 && (F.G & 15) == 0) { F.grp = (F.bid >> 3) & 1; F.gi = (F.bid & 7) + 8 * (F.bid >> 4); F.gs = F.G >> 1; F.b0 = F.grp; F.nb = 1; }
    else { F.grp = 0; F.gi = F.bid; F.gs = F.G; F.b0 = 0; F.nb = 2; }
#pragma unroll
    for (int i = 0; i < 16; ++i) F.in[i] = args.in[i];
    F.out = args.out; F.ws = args.ws;
    for (int u = F.tid; u < (LDS_BYTES - LDSCTL_OFF) / 4; u += NWAVES * 64) ((LAS unsigned*)(F.lds + LDSCTL_OFF))[u] = 0u;
    __syncthreads();
    unsigned* ctl = (unsigned*)(F.ws + WS_CTL);
    volatile LAS unsigned* lw = (volatile LAS unsigned*)(F.lds + LDSCTL_OFF);
    XcdBarrier barG = xcd_barrier_post(ctl + CW_BAR, lw + 8, (unsigned)F.G);
    XcdBarrier bar = xcd_barrier_post(ctl + CW_BAR + (1 + F.grp) * XCD_BAR_WORDS, lw + 12, (unsigned)F.gs);
#define PHB(call) do { call; xcd_barrier(bar); } while (0)
    p0_prologue(F); xcd_barrier(barG);
    if (NGRP == 2 && F.nb == 1 && F.grp == 1) { for (int u = F.gi; u < 256; u += F.gs) p0_memkv(F, u); memkv_publish(F);
#ifdef GRP1_DELAY_US
        { const unsigned long long t0 = __builtin_amdgcn_s_memrealtime(); while (__builtin_amdgcn_s_memrealtime() - t0 < (unsigned long long)(GRP1_DELAY_US) * 100ull) __builtin_amdgcn_s_sleep(8); }
#endif
    }
    PHB(phase1(F));
    PHB(phase2(F));
    PHB(scan_phase(F));
    PHB(phase4(F));
    PHB(phase5(F));
    PHB(phase6(F));
    PHB(phase7(F));
    phase8(F);
#undef PHB
}

extern "C" void kernel_launch(void* const* d_in, const int* in_sizes, int n_in, void* d_out, int out_size, void* d_ws, size_t ws_size, hipStream_t stream) {
    static int grid = 0;
    if (grid == 0) {
        int dev = 0, cus = 0;
        if (hipGetDevice(&dev) != hipSuccess || hipDeviceGetAttribute(&cus, hipDeviceAttributeMultiprocessorCount, dev) != hipSuccess) { grid = -1; return; }
        if (hipFuncSetAttribute((const void*)mega, hipFuncAttributeMaxDynamicSharedMemorySize, LDS_BYTES) != hipSuccess) { grid = -1; return; }
        (void)hipGetLastError();
        grid = cus;
    }
    if (grid < 0) return;
    unsigned char* ws = (unsigned char*)d_ws;
    (void)hipMemsetAsync(ws + WS_CTL, 0, CTL_ZERO_BYTES, stream);
    MArgs a{};
    for (int i = 0; i < 16; ++i) a.in[i] = (const float*)d_in[i];
    a.out = (float*)d_out; a.ws = ws; a.ph_lo = 0; a.ph_hi = 9; a.li = 0; a.pad = 0;
    hipLaunchKernelGGL(mega, dim3(grid), dim3(NWAVES * 64), LDS_BYTES, stream, a);
}
```

```cpp
#include <hip/hip_runtime.h>
#include <stdint.h>

typedef unsigned short bf16_t;

constexpr int NB_ = 2, S_ = 8192, T_ = NB_ * S_, D_ = 1024;
constexpr int NA_ = 4096, NBW_ = 5120, KO_ = 1536;
constexpr float EPS_ = 1e-6f;
constexpr float QK_SCALE = 0.08838834764831845f;

constexpr size_t MiB = 1u << 20;
constexpr size_t WS_CTL = 0;
constexpr size_t WS_WINA = 1 * MiB;
constexpr size_t WS_WOUTA = 9 * MiB;
constexpr size_t WS_WB = 12 * MiB;
constexpr size_t WS_WOUTB = 22 * MiB;
constexpr size_t WS_MEMK = 25 * MiB;
constexpr size_t WS_MEMV = 26 * MiB;
constexpr size_t WS_RS0 = 27 * MiB;
constexpr size_t WS_SS1P = 28 * MiB;
#ifndef NGRP
#define NGRP 2
#endif
#if NGRP == 2
constexpr size_t WS_BSTRIDE = 96 * MiB;
constexpr size_t WS_UA = 30 * MiB, WS_UA_STRIDE = WS_BSTRIDE, WS_UB = 30 * MiB, WS_UB_STRIDE = WS_BSTRIDE, WS_KVT = 94 * MiB, WS_KVT_STRIDE = WS_BSTRIDE, WS_X1B = 110 * MiB, WS_X1B_STRIDE = WS_BSTRIDE;
#else
constexpr size_t WS_UA = 30 * MiB, WS_UA_STRIDE = 64 * MiB, WS_UB = 30 * MiB, WS_UB_STRIDE = 80 * MiB, WS_KVT = 158 * MiB, WS_KVT_STRIDE = 16 * MiB, WS_X1B = 190 * MiB, WS_X1B_STRIDE = 16 * MiB;
#endif
__device__ __forceinline__ bf16_t* ua_ptr(unsigned char* ws, int b) { return (bf16_t*)(ws + WS_UA + (size_t)b * WS_UA_STRIDE) - (size_t)b * S_ * NA_; }
__device__ __forceinline__ bf16_t* ub_ptr(unsigned char* ws, int b) { return (bf16_t*)(ws + WS_UB + (size_t)b * WS_UB_STRIDE) - (size_t)b * S_ * NBW_; }
__device__ __forceinline__ bf16_t* kvt_ptr(unsigned char* ws, int b) { return (bf16_t*)(ws + WS_KVT + (size_t)b * WS_KVT_STRIDE) - (size_t)b * 256 * 32768; }
__device__ __forceinline__ bf16_t* x1b_ptr(unsigned char* ws, int b) { return (bf16_t*)(ws + WS_X1B + (size_t)b * WS_X1B_STRIDE) - (size_t)b * S_ * D_; }


__device__ __forceinline__ float bf2f(bf16_t v) { return __uint_as_float(((unsigned)v) << 16); }
__device__ __forceinline__ bf16_t f2bf(float f) { unsigned u = __float_as_uint(f); u += 0x7fffu + ((u >> 16) & 1u); return (bf16_t)(u >> 16); }
__device__ __forceinline__ float silu_f(float v) { return v / (1.0f + __expf(-v)); }
__device__ __forceinline__ float softplus_f(float z) { return fmaxf(z, 0.f) + log1pf(__expf(-fabsf(z))); }
__device__ __forceinline__ float ret_lg(int h) { return logf(1.0f - exp2f(-5.0f - (float)h)); }

__device__ __forceinline__ void rot_sincos(float ang, float& s, float& c) {
    const float n = rintf(ang * 0.15915494309189535f);
    float r = fmaf(-n, 6.28318548202514648f, ang);
    r = fmaf(-n, -1.74845553e-7f, r);
    const float rev = r * 0.15915494309189535f;
    s = __builtin_amdgcn_sinf(rev); c = __builtin_amdgcn_cosf(rev);
}
__device__ __forceinline__ float rope_inv_freq(int i) { return exp2f(-(float)i * 0.20762050593046014f); }

__global__ __launch_bounds__(256) void n0_x(const float* __restrict__ x, bf16_t* __restrict__ xb, float* __restrict__ rs) {
    const int row = blockIdx.x * 4 + (threadIdx.x >> 6), lane = threadIdx.x & 63;
    const float* xr = x + (size_t)row * D_; float s = 0.f;
    for (int j = lane; j < D_; j += 64) { const float v = xr[j]; s += v * v; xb[(size_t)row * D_ + j] = f2bf(v); }
    for (int o = 32; o; o >>= 1) s += __shfl_xor(s, o);
    if (lane == 0) rs[row] = 1.0f / sqrtf(s * (1.0f / D_) + EPS_);
}

struct WArgs { const float* w_in_a; const float* w_out_a; const float* w_kv; const float* w_in_b; const float* w_out_b;
               const float* g_norm_a; const float* g_ret_head; const float* g_kv; const float* g_norm_b; };
__device__ __forceinline__ int permA_src(int n) {
    if (n >= 1024) return n;
    const int tile = n >> 8, c = n & 255, bj = c >> 7, p = c & 127, hit = p >> 6, i = p & 63;
    return tile * 256 + hit * 128 + bj * 64 + i;
}
__global__ __launch_bounds__(256) void n0_w(WArgs a, int mode, bf16_t* __restrict__ out) {
    const int K = (mode == 0 || mode == 2) ? 1024 : 1536;
    const int N = mode == 0 ? 4096 : (mode == 2 ? 5120 : 1024);
    const size_t idx = (size_t)blockIdx.x * 256 + threadIdx.x; if (idx >= (size_t)N * K) return;
    const int k = (int)(idx % K), n = (int)(idx / K);
    float v;
    if (mode == 0) v = a.w_in_a[(size_t)k * 4096 + permA_src(n)] * a.g_norm_a[k];
    else if (mode == 1) v = a.w_out_a[(size_t)k * 1024 + n] * (k < 1024 ? a.g_ret_head[k & 255] : 1.0f);
    else if (mode == 2) {
        if (n < 2048) v = a.w_kv[(size_t)k * 2048 + n] * a.g_kv[k];
        else { const int c = n - 2048; const int src = c < 1024 ? 1024 + c : (c < 2048 ? c - 1024 : c);
               v = a.w_in_b[(size_t)k * 3072 + src] * a.g_norm_b[k]; }
    } else v = a.w_out_b[(size_t)k * 1024 + n];
    out[idx] = f2bf(v);
}

__global__ __launch_bounds__(256) void n0_mem(const float* __restrict__ mem, const float* __restrict__ g_mem, const float* __restrict__ w_mem_kv,
                                              const float* __restrict__ g_mem_q, const float* __restrict__ g_mem_k, bf16_t* __restrict__ memK, bf16_t* __restrict__ memV) {
    __shared__ float sm[1024]; __shared__ float skv[1024]; __shared__ float red[256]; __shared__ float hn[4];
    const int l = blockIdx.x >> 9, b = (blockIdx.x >> 8) & 1, m = blockIdx.x & 255, tid = threadIdx.x;
    const float* mr = mem + ((size_t)b * 256 + m) * D_;
    float s = 0.f; for (int j = tid; j < D_; j += 256) { const float v = mr[j]; s += v * v; }
    red[tid] = s; __syncthreads();
    for (int o = 128; o; o >>= 1) { if (tid < o) red[tid] += red[tid + o]; __syncthreads(); }
    const float r = 1.0f / sqrtf(red[0] * (1.0f / D_) + EPS_);
    for (int j = tid; j < D_; j += 256) sm[j] = mr[j] * r * g_mem[l * D_ + j];
    __syncthreads();
    const float* W = w_mem_kv + (size_t)l * D_ * 1024;
    float acc[4] = {0.f, 0.f, 0.f, 0.f};
    for (int k = 0; k < D_; ++k) { const float a = sm[k];
#pragma unroll
        for (int j = 0; j < 4; ++j) acc[j] += a * W[(size_t)k * 1024 + tid + 256 * j]; }
#pragma unroll
    for (int j = 0; j < 4; ++j) skv[tid + 256 * j] = acc[j];
    __syncthreads();
    if (tid < 4) { float q = 0.f; for (int d = 0; d < 128; ++d) { const float v = skv[tid * 128 + d]; q += v * v; } hn[tid] = 1.0f / sqrtf(q * (1.0f / 128) + EPS_); }
    __syncthreads();
    for (int j = tid; j < 512; j += 256) { const int h = j >> 7, d = j & 127;
        const size_t o = ((((size_t)l * 2 + b) * 4 + h) * 256 + m) * 128 + d;
        memK[o] = f2bf(skv[j] * hn[h] * g_mem_k[l * 128 + d] * g_mem_q[l * 128 + d] * QK_SCALE);
        memV[o] = f2bf(skv[512 + j]); }
}

struct GArgs { const bf16_t* A; int lda; const bf16_t* Bt; int K; int N;
               const float* rs0; const int* pos; bf16_t* U; const float* xres; float* out; bf16_t* x1b; float* ss1p; };
template <int EPI> __global__ __launch_bounds__(256) void n_gemm(GArgs g) {
    __shared__ float sA[16][36]; __shared__ float sC[16][257];
    const int ntn = g.N / 256, pm = blockIdx.x / ntn, pn = blockIdx.x % ntn, row0 = pm * 16, c = threadIdx.x;
    const bf16_t* brow = g.Bt + (size_t)(pn * 256 + c) * g.K;
    float acc[16];
#pragma unroll
    for (int r = 0; r < 16; ++r) acc[r] = 0.f;
    for (int k0 = 0; k0 < g.K; k0 += 32) {
        __syncthreads();
        for (int e = threadIdx.x; e < 512; e += 256) { const int r = e >> 5, kk = e & 31; sA[r][kk] = bf2f(g.A[(size_t)(row0 + r) * g.lda + k0 + kk]); }
        __syncthreads();
#pragma unroll
        for (int j = 0; j < 4; ++j) { const uint4 bv = *(const uint4*)(brow + k0 + 8 * j); const unsigned w[4] = {bv.x, bv.y, bv.z, bv.w};
#pragma unroll
            for (int q = 0; q < 4; ++q) { const float b0 = __uint_as_float(w[q] << 16), b1 = __uint_as_float(w[q] & 0xffff0000u); const int kk = 8 * j + 2 * q;
#pragma unroll
                for (int r = 0; r < 16; ++r) acc[r] += sA[r][kk] * b0 + sA[r][kk + 1] * b1; } }
    }
#pragma unroll
    for (int r = 0; r < 16; ++r) sC[r][c] = acc[r];
    __syncthreads();
    if (EPI == 0) {
        for (int r = 0; r < 16; ++r) { const int row = row0 + r; const float rs = g.rs0[row]; bf16_t* urow = g.U + (size_t)row * NA_;
            if (pn < 4) { if (c < 128) { const int hit = c >> 6, i = c & 63; const float x1 = sC[r][c] * rs, x2 = sC[r][c + 128] * rs;
                    float sn, cs; rot_sincos((float)g.pos[row] * rope_inv_freq(i), sn, cs); const float sc = pn >= 2 ? QK_SCALE : 1.0f;
                    urow[pn * 256 + hit * 128 + i] = f2bf((x1 * cs - x2 * sn) * sc); urow[pn * 256 + hit * 128 + 64 + i] = f2bf((x1 * sn + x2 * cs) * sc); } }
            else { const float v = sC[r][c] * rs; const bool silu = (pn >= 8 && pn < 12) || pn >= 14; urow[pn * 256 + c] = f2bf(silu ? silu_f(v) : v); } }
    } else if (EPI == 1) {
        for (int r = 0; r < 16; ++r) { const size_t o = (size_t)(row0 + r) * D_ + pn * 256 + c; const float v = g.xres[o] + sC[r][c]; g.out[o] = v; g.x1b[o] = f2bf(v); sC[r][c] = v * v; }
        __syncthreads();
        if (c < 16) { float s = 0.f; for (int j = 0; j < 256; ++j) s += sC[c][j]; float* p = g.ss1p + (size_t)(row0 + c) * 16 + pn * 4; p[0] = s; p[1] = 0.f; p[2] = 0.f; p[3] = 0.f; }
    } else if (EPI == 2) {
        for (int r = 0; r < 16; ++r) { const int row = row0 + r; const float* sp = g.ss1p + (size_t)row * 16; float ss = 0.f; for (int j = 0; j < 16; ++j) ss += sp[j];
            const float rs = 1.0f / sqrtf(ss * (1.0f / D_) + EPS_); float v = sC[r][c] * rs;
            if ((pn >= 8 && pn < 12) || pn >= 18) v = silu_f(v); else if (pn >= 12 && pn < 16) v *= QK_SCALE * 1.4426950408889634f;
            g.U[(size_t)row * NBW_ + pn * 256 + c] = f2bf(v); }
    } else {
        for (int r = 0; r < 16; ++r) { const size_t o = (size_t)(row0 + r) * D_ + pn * 256 + c; g.out[o] = bf2f(g.x1b[o]) + sC[r][c]; }
    }
}

__global__ __launch_bounds__(256) void n2_kv(const bf16_t* __restrict__ UA, bf16_t* __restrict__ KVT) {
    const int u = blockIdx.x >> 2, eg = blockIdx.x & 3, tid = threadIdx.x, e = eg * 64 + (tid & 63), dq = tid >> 6;
    const int b = u >> 8, h = (u >> 6) & 3, n = u & 63; const size_t row0 = (size_t)b * S_ + n * 128; const float lg = ret_lg(h);
    float acc[32];
#pragma unroll
    for (int j = 0; j < 32; ++j) acc[j] = 0.f;
    for (int m = 0; m < 128; ++m) { const bf16_t* ur = UA + (row0 + m) * NA_; const float vz = bf2f(ur[1024 + h * 256 + e]) * __expf((float)(127 - m) * lg);
#pragma unroll
        for (int j = 0; j < 32; ++j) acc[j] += vz * bf2f(ur[512 + h * 128 + dq * 32 + j]); }
#pragma unroll
    for (int j = 0; j < 32; ++j) KVT[((size_t)u * 256 + e) * 128 + dq * 32 + j] = f2bf(acc[j]);
}
__global__ __launch_bounds__(256) void n3_scan(bf16_t* __restrict__ KVT) {
    const int idx = blockIdx.x * 256 + threadIdx.x; const int bh = idx >> 15, off = idx & 32767; const float gc = __expf(128.0f * ret_lg(bh & 3));
    float s = 0.f;
    for (int n = 0; n < 64; ++n) { bf16_t* p = KVT + ((size_t)(bh * 64 + n) << 15) + off; const float t = bf2f(*p); *p = f2bf(s); s = gc * s + t; }
}
__global__ __launch_bounds__(256) void n4_ret(bf16_t* __restrict__ UA, const bf16_t* __restrict__ KVT) {
    __shared__ float sq[128], ss[128], red[256];
    const int u = blockIdx.x >> 7, c = blockIdx.x & 127, tid = threadIdx.x; const int b = u >> 8, h = (u >> 6) & 3, n = u & 63;
    const size_t row0 = (size_t)b * S_ + n * 128, row = row0 + c; const float lg = ret_lg(h);
    if (tid < 128) sq[tid] = bf2f(UA[row * NA_ + h * 128 + tid]);
    __syncthreads();
    if (tid < 128) { float d = 0.f; if (tid <= c) { const bf16_t* kr = UA + (row0 + tid) * NA_ + 512 + h * 128; for (int j = 0; j < 128; ++j) d += sq[j] * bf2f(kr[j]); d *= __expf((float)(c - tid) * lg); } ss[tid] = d; }
    __syncthreads();
    const int e = tid; float o = 0.f;
    for (int m = 0; m <= c; ++m) o += ss[m] * bf2f(UA[(row0 + m) * NA_ + 1024 + h * 256 + e]);
    float cr = 0.f; const bf16_t* st = KVT + ((size_t)u * 256 + e) * 128; for (int j = 0; j < 128; ++j) cr += sq[j] * bf2f(st[j]);
    o += __expf((float)(c + 1) * lg) * cr;
    red[tid] = o * o; __syncthreads();
    for (int w = 128; w; w >>= 1) { if (tid < w) red[tid] += red[tid + w]; __syncthreads(); }
    const float r = 1.0f / sqrtf(red[0] * (1.0f / 256) + EPS_);
    bf16_t* gp = UA + row * NA_ + 2048 + h * 256 + e; *gp = f2bf(o * r * bf2f(*gp));
}
__global__ __launch_bounds__(256) void n_memattn(bf16_t* __restrict__ U, int ld, int qoff, int goff, const bf16_t* __restrict__ memK, const bf16_t* __restrict__ memV, int layer) {
    __shared__ float sq[4][128]; __shared__ float sp[4][256];
    const int w = threadIdx.x >> 6, lane = threadIdx.x & 63; const int gw = blockIdx.x * 4 + w, row = gw >> 2, hd = gw & 3, b = row / S_;
    bf16_t* qp = U + (size_t)row * ld + qoff + hd * 128; const bf16_t* gp = U + (size_t)row * ld + goff + hd * 128;
    const float q0 = bf2f(qp[lane]), q1 = bf2f(qp[lane + 64]); sq[w][lane] = q0; sq[w][lane + 64] = q1;
    float s = q0 * q0 + q1 * q1; for (int o = 32; o; o >>= 1) s += __shfl_xor(s, o);
    const float rq = 1.0f / sqrtf(s * (1.0f / 128) + EPS_);
    __syncthreads();
    const bf16_t* Kb = memK + (((size_t)layer * 2 + b) * 4 + hd) * 256 * 128; const bf16_t* Vb = memV + (((size_t)layer * 2 + b) * 4 + hd) * 256 * 128;
    float lgt[4]; float mx = -1e30f;
    for (int j = 0; j < 4; ++j) { const bf16_t* kr = Kb + (size_t)(lane + 64 * j) * 128; float d = 0.f; for (int t = 0; t < 128; ++t) d += sq[w][t] * bf2f(kr[t]); lgt[j] = d * rq; mx = fmaxf(mx, lgt[j]); }
    for (int o = 32; o; o >>= 1) mx = fmaxf(mx, __shfl_xor(mx, o));
    float ps = 0.f; for (int j = 0; j < 4; ++j) { lgt[j] = __expf(lgt[j] - mx); ps += lgt[j]; }
    for (int o = 32; o; o >>= 1) ps += __shfl_xor(ps, o);
    for (int j = 0; j < 4; ++j) sp[w][lane + 64 * j] = lgt[j] / ps;
    __syncthreads();
    float o0 = 0.f, o1 = 0.f;
    for (int m = 0; m < 256; ++m) { const float p = sp[w][m]; o0 += p * bf2f(Vb[(size_t)m * 128 + lane]); o1 += p * bf2f(Vb[(size_t)m * 128 + lane + 64]); }
    const float g0 = bf2f(gp[lane]), g1 = bf2f(gp[lane + 64]);
    qp[lane] = f2bf(o0 * g0); qp[lane + 64] = f2bf(o1 * g1);
}
#ifndef NAIVE_SB_EXIT
#define NAIVE_SB_EXIT 1
#endif
__global__ __launch_bounds__(256) void n7_sb(bf16_t* __restrict__ UB) {
    __shared__ float sq[128]; __shared__ float sa[256]; __shared__ float wtot[4]; __shared__ float wpre[4];
    const int t = blockIdx.x & (S_ - 1), h = (blockIdx.x >> 13) & 7, b = blockIdx.x >> 16, tid = threadIdx.x, lane = tid & 63, w = tid >> 6;
    const size_t rowb = (size_t)b * S_; bf16_t* qp = UB + (rowb + t) * NBW_ + 3072 + h * 128;
    if (tid < 128) sq[tid] = bf2f(qp[tid]);
    __syncthreads();
    float carry = 0.f, od = 0.f;
    for (int s_hi = t - 1; s_hi >= 0; s_hi -= 256) {
        const int s = s_hi - tid; const bool valid = s >= 0;
        float z = 0.f; if (valid) { const bf16_t* kr = UB + (rowb + s) * NBW_ + h * 128; for (int j = 0; j < 128; ++j) z += sq[j] * bf2f(kr[j]); z *= 0.6931471805599453f; }
        const float spv = softplus_f(z); const float lf = valid ? -spv : 0.f;
        float inc = lf;
        for (int o = 1; o < 64; o <<= 1) { const float v = __shfl_up(inc, o); if (lane >= o) inc += v; }
        if (lane == 63) wtot[w] = inc;
        __syncthreads();
        if (tid == 0) { float a = 0.f; for (int j = 0; j < 4; ++j) { wpre[j] = a; a += wtot[j]; } }
        __syncthreads();
        const float pre = wpre[w] + inc - lf;
        const float tot = wpre[3] + wtot[3];
        sa[tid] = valid ? __expf((z - spv) + pre + carry) : 0.f;
        __syncthreads();
        if (tid < 128) { const int cnt = min(256, s_hi + 1); const bf16_t* vb = UB + rowb * NBW_ + 1024 + h * 128 + tid;
            for (int i = 0; i < cnt; ++i) od += sa[i] * bf2f(vb[(size_t)(s_hi - i) * NBW_]); }
        carry += tot;
        __syncthreads();
        if (NAIVE_SB_EXIT && carry < -104.0f) break;
    }
    if (tid < 128) { const float g = bf2f(UB[(rowb + t) * NBW_ + 2048 + h * 128 + tid]); qp[tid] = f2bf(od * g); }
}


namespace pg8 {
#define PG8_LAS __attribute__((address_space(3)))
typedef unsigned short bf16_t;
typedef short bf16x8 __attribute__((ext_vector_type(8)));
typedef float f32x4 __attribute__((ext_vector_type(4)));
typedef unsigned u32x4 __attribute__((ext_vector_type(4)));
constexpr int BM = 256, BK = 64, HALF = 128, HTB = HALF * BK * 2  , STAGE_BYTES = 8 * HTB, NXCD = 8, WGM = 4;

__host__ __device__ __forceinline__ int lds_byte(int r, int c) { const int st = (r >> 4) * 2 + (c >> 5), rr = r & 15, cc = c & 31, ob = rr * 64 + cc * 2; return st * 1024 + (ob ^ (((ob >> 9) & 1) << 5)); }
__host__ __device__ __forceinline__ void stage_rc(int b, int& R, int& C) { const int st = b / 1024, sb = b % 1024, swz = sb ^ (((sb >> 9) & 1) << 5); R = (st >> 1) * 16 + swz / 64; C = (st & 1) * 32 + (swz % 64) / 2; }
__host__ __device__ __forceinline__ int perm32(int rho) { const int n = rho >> 4, i = rho & 15; return 8 * (i >> 2) + 4 * n + (i & 3); }

struct Unit { int pm, pn; };
struct Gemm { const bf16_t* A; const bf16_t* Bt; int M, N, K, lda; };

struct StaticOrder {
    int nM, nN, nwg, G, c;
    __host__ __device__ void init(int M, int N, int G_, int c_) { nM = M / BM; nN = N / BM; nwg = nM * nN; G = G_; c = c_; }
    __host__ __device__ bool next(int i, Unit& u) const {
        const long L = (long)i * G + c; if (L >= nwg) return false;
        int wgid = (int)L; { const int q = nwg / NXCD, r = nwg % NXCD, xcd = wgid % NXCD, off = wgid / NXCD; wgid = (xcd < r ? xcd * (q + 1) : r * (q + 1) + (xcd - r) * q) + off; }
        const int nig = WGM * nN, gid = wgid / nig, fm = gid * WGM, gsz = (nM - fm) < WGM ? (nM - fm) : WGM;
        u.pm = fm + ((wgid % nig) % gsz); u.pn = (wgid % nig) / gsz; return true;
    }
    __device__ __forceinline__ void a_ready(const Unit&) const {}
    __device__ __forceinline__ void done(const Unit&) const {}
};

typedef __bf16 bf16x2_hw __attribute__((ext_vector_type(2)));
typedef float f32x2_hw __attribute__((ext_vector_type(2)));
__device__ __forceinline__ unsigned cvt_pk_bf16_safe(float lo, float hi) { const f32x2_hw v = {lo, hi}; return __builtin_bit_cast(unsigned, __builtin_convertvector(v, bf16x2_hw)); }
__device__ __forceinline__ unsigned cvt_pk_bf16(float lo, float hi) { unsigned r; asm volatile("v_cvt_pk_bf16_f32 %0, %1, %2" : "=v"(r) : "v"(lo), "v"(hi)); return r; }
__device__ __forceinline__ float silu_fast(float v) { return v * __builtin_amdgcn_rcpf(1.0f + __builtin_amdgcn_exp2f(-1.4426950408889634f * v)); }
__device__ __forceinline__ u32x4 pack8_safe(const f32x4 a, const f32x4 b) { u32x4 w; w.x = cvt_pk_bf16_safe(a[0], a[1]); w.y = cvt_pk_bf16_safe(a[2], a[3]); w.z = cvt_pk_bf16_safe(b[0], b[1]); w.w = cvt_pk_bf16_safe(b[2], b[3]); return w; }
__device__ __forceinline__ u32x4 pack8(const f32x4 a, const f32x4 b) { u32x4 w; w.x = cvt_pk_bf16(a[0], a[1]); w.y = cvt_pk_bf16(a[2], a[3]); w.z = cvt_pk_bf16(b[0], b[1]); w.w = cvt_pk_bf16(b[2], b[3]); return w; }

struct EpiA {
    static constexpr bool PERM = true, AFTER_DRAIN = false, ACC_INIT = false;
    bf16_t* U; const float* rs0; const int* pos;
    __device__ __forceinline__ void operator()(const f32x4 (&acc)[2][2][4][2], const Unit& u, int wr, int wc, int fr, int fq) const {
        const int row0 = u.pm * BM + wr * 64 + fr;
        if (u.pn < 4) {
            const int hit = wc >> 1, i0 = 32 * (wc & 1) + 8 * fq; const float sc = u.pn >= 2 ? QK_SCALE : 1.0f;
            float inv[8];
#pragma unroll
            for (int j = 0; j < 8; ++j) inv[j] = rope_inv_freq(i0 + j);
#pragma unroll
            for (int ai = 0; ai < 2; ++ai)
#pragma unroll
                for (int m = 0; m < 4; ++m) { const int row = row0 + ai * HALF + m * 16; const float rs = rs0[row] * sc, pf = (float)pos[row];
                    bf16_t* up = U + (size_t)row * NA_ + u.pn * BM + hit * 128 + i0;
                    f32x4 o1[2], o2[2];
#pragma unroll
                    for (int n = 0; n < 2; ++n)
#pragma unroll
                        for (int e = 0; e < 4; ++e) { float sn, cs; rot_sincos(pf * inv[4 * n + e], sn, cs); const float x1 = acc[ai][0][m][n][e] * rs, x2 = acc[ai][1][m][n][e] * rs;
                            o1[n][e] = x1 * cs - x2 * sn; o2[n][e] = x1 * sn + x2 * cs; }
                    *(u32x4*)up = pack8(o1[0], o1[1]); *(u32x4*)(up + 64) = pack8(o2[0], o2[1]); }
        } else {
            const bool silu = (u.pn >= 8 && u.pn < 12) || u.pn >= 14;
#pragma unroll
            for (int ai = 0; ai < 2; ++ai)
#pragma unroll
                for (int m = 0; m < 4; ++m) { const int row = row0 + ai * HALF + m * 16; const float rs = rs0[row]; bf16_t* rowp = U + (size_t)row * NA_ + u.pn * BM + wc * 32 + 8 * fq;
#pragma unroll
                    for (int bj = 0; bj < 2; ++bj) { f32x4 v0 = acc[ai][bj][m][0] * rs, v1 = acc[ai][bj][m][1] * rs;
                        if (silu) {
#pragma unroll
                            for (int e = 0; e < 4; ++e) { v0[e] = silu_fast(v0[e]); v1[e] = silu_fast(v1[e]); } }
                        *(u32x4*)(rowp + bj * HALF) = pack8(v0, v1); } }
        }
    }
};
struct EpiOutA {
    static constexpr bool PERM = true, AFTER_DRAIN = false, ACC_INIT = true;
    const float* xres; float* out; bf16_t* x1b; float* ss1p;
    __device__ __forceinline__ void init(f32x4 (&acc)[2][2][4][2], const Unit& u, int wr, int wc, int fr, int fq) const {
        const int row0 = u.pm * BM + wr * 64 + fr;
#pragma unroll
        for (int ai = 0; ai < 2; ++ai)
#pragma unroll
            for (int m = 0; m < 4; ++m) { const size_t off = (size_t)(row0 + ai * HALF + m * 16) * D_ + u.pn * BM + wc * 32 + 8 * fq;
#pragma unroll
                for (int bj = 0; bj < 2; ++bj) { acc[ai][bj][m][0] = *(const f32x4*)(xres + off + bj * HALF); acc[ai][bj][m][1] = *(const f32x4*)(xres + off + bj * HALF + 4); } }
    }
    __device__ __forceinline__ void operator()(const f32x4 (&acc)[2][2][4][2], const Unit& u, int wr, int wc, int fr, int fq) const {
        const int row0 = u.pm * BM + wr * 64 + fr;
#pragma unroll
        for (int ai = 0; ai < 2; ++ai)
#pragma unroll
            for (int m = 0; m < 4; ++m) { const int row = row0 + ai * HALF + m * 16; const size_t off = (size_t)row * D_ + u.pn * BM + wc * 32 + 8 * fq; float ssq = 0.f;
#pragma unroll
                for (int bj = 0; bj < 2; ++bj) { const f32x4 v0 = acc[ai][bj][m][0], v1 = acc[ai][bj][m][1];
                    *(u32x4*)(x1b + off + bj * HALF) = pack8_safe(v0, v1);
                    ssq += (v0[0] * v0[0] + v0[1] * v0[1]) + (v0[2] * v0[2] + v0[3] * v0[3]) + (v1[0] * v1[0] + v1[1] * v1[1]) + (v1[2] * v1[2] + v1[3] * v1[3]); }
                ssq += __shfl_xor(ssq, 16); ssq += __shfl_xor(ssq, 32);
                if (fq == 0) ss1p[(size_t)row * 16 + u.pn * 4 + wc] = ssq; }
    }
};
struct EpiB {
    static constexpr bool PERM = true, AFTER_DRAIN = false, ACC_INIT = false;
    bf16_t* U; const float* ss1p;
    __device__ __forceinline__ void operator()(const f32x4 (&acc)[2][2][4][2], const Unit& u, int wr, int wc, int fr, int fq) const {
        const int row0 = u.pm * BM + wr * 64 + fr; const bool silu = (u.pn >= 8 && u.pn < 12) || u.pn >= 18; const float sc = (u.pn >= 12 && u.pn < 16) ? QK_SCALE * 1.4426950408889634f : 1.0f;
#pragma unroll
        for (int ai = 0; ai < 2; ++ai)
#pragma unroll
            for (int m = 0; m < 4; ++m) { const int row = row0 + ai * HALF + m * 16; const f32x4 pv = *(const f32x4*)(ss1p + (size_t)row * 16 + 4 * fq);
                float s = (pv[0] + pv[1]) + (pv[2] + pv[3]); s += __shfl_xor(s, 16); s += __shfl_xor(s, 32);
                const float rs = sc / sqrtf(s * (1.0f / D_) + EPS_); bf16_t* rowp = U + (size_t)row * NBW_ + u.pn * BM + wc * 32 + 8 * fq;
#pragma unroll
                for (int bj = 0; bj < 2; ++bj) { f32x4 v0 = acc[ai][bj][m][0] * rs, v1 = acc[ai][bj][m][1] * rs;
                    if (silu) {
#pragma unroll
                        for (int e = 0; e < 4; ++e) { v0[e] = silu_fast(v0[e]); v1[e] = silu_fast(v1[e]); } }
                    *(u32x4*)(rowp + bj * HALF) = pack8(v0, v1); } }
    }
};
struct EpiOutB {
    static constexpr bool PERM = false, AFTER_DRAIN = false, ACC_INIT = true;
    float* out; const bf16_t* x1b;
    __device__ __forceinline__ void init(f32x4 (&acc)[2][2][4][2], const Unit& u, int wr, int wc, int fr, int fq) const {
        const int row0 = u.pm * BM + wr * 64 + fr;
#pragma unroll
        for (int ai = 0; ai < 2; ++ai)
#pragma unroll
            for (int m = 0; m < 4; ++m) { const size_t off = (size_t)(row0 + ai * HALF + m * 16) * D_ + u.pn * BM + wc * 32 + 4 * fq;
#pragma unroll
                for (int bj = 0; bj < 2; ++bj)
#pragma unroll
                    for (int n = 0; n < 2; ++n) { const unsigned long long w = *(const unsigned long long*)(x1b + off + bj * HALF + n * 16); const unsigned lo = (unsigned)w, hi = (unsigned)(w >> 32);
                        acc[ai][bj][m][n] = (f32x4){__uint_as_float(lo << 16), __uint_as_float(lo & 0xffff0000u), __uint_as_float(hi << 16), __uint_as_float(hi & 0xffff0000u)}; } }
    }
    __device__ __forceinline__ void operator()(const f32x4 (&acc)[2][2][4][2], const Unit& u, int wr, int wc, int fr, int fq) const {
        const int row0 = u.pm * BM + wr * 64 + fr;
#pragma unroll
        for (int ai = 0; ai < 2; ++ai)
#pragma unroll
            for (int m = 0; m < 4; ++m) { const size_t off = (size_t)(row0 + ai * HALF + m * 16) * D_ + u.pn * BM + wc * 32 + 4 * fq;
#pragma unroll
                for (int bj = 0; bj < 2; ++bj)
#pragma unroll
                    for (int n = 0; n < 2; ++n) *(f32x4*)(out + off + bj * HALF + n * 16) = acc[ai][bj][m][n]; }
    }
};

struct EpiNull {
    static constexpr bool PERM = true, AFTER_DRAIN = false, ACC_INIT = false;
    float* sink;
    __device__ __forceinline__ void operator()(const f32x4 (&acc)[2][2][4][2], const Unit& u, int wr, int wc, int fr, int fq) const {
        f32x4 s = (f32x4){0.f, 0.f, 0.f, 0.f};
#pragma unroll
        for (int ai = 0; ai < 2; ++ai)
#pragma unroll
            for (int bj = 0; bj < 2; ++bj)
#pragma unroll
                for (int m = 0; m < 4; ++m) s += acc[ai][bj][m][0] + acc[ai][bj][m][1];
        const float t = (s[0] + s[1]) + (s[2] + s[3]);
        if (t == 1.2345678e33f) sink[0] = t;
    }
};
template <class Epi, class Sched, bool ALIGN_EPI = false, bool SP2 = false>
__device__ __forceinline__ void gemm_phase(PG8_LAS unsigned char* lds, const Gemm g, const Sched& S, const Epi& E) {
    const int tid = threadIdx.x, wid = __builtin_amdgcn_readfirstlane(tid >> 6), lane = tid & 63, wr = wid >> 2, wc = wid & 3, fr = lane & 15, fq = lane >> 4;
    const int K = g.K, nt = K / BK;
    unsigned voffA[2], voffB[2];
#pragma unroll
    for (int i = 0; i < 2; ++i) { int R, C; stage_rc(tid * 16 + i * 8192, R, C); const int Rb = Epi::PERM ? ((R & ~31) + perm32(R & 31)) : R;
        voffA[i] = (unsigned)(R * g.lda + C) * 2u; voffB[i] = (unsigned)(Rb * K + C) * 2u; }
    const size_t kstep = (size_t)(BK * 2);
    const size_t hstepA = (size_t)HALF * g.lda * 2, hstepB = (size_t)HALF * K * 2;
    const size_t tstepA = 2 * hstepA, tstepB = 2 * hstepB;
    const unsigned ldsw = (unsigned)wid * 1024u;
    const int aoff = lds_byte(wr * 64 + fr, fq * 8), boff = lds_byte(wc * 32 + fr, fq * 8);
#define PG8_SA(b, h) (((b) * 2 + (h)) * HTB)
#define PG8_SB(b, h) ((4 + (b) * 2 + (h)) * HTB)
#define PG8_STAGE(bufoff, gbase, voff) do { _Pragma("unroll") for (int _i = 0; _i < 2; ++_i) \
        __builtin_amdgcn_global_load_lds((const unsigned*)((const char*)(gbase) + (voff)[_i]), (PG8_LAS unsigned*)(lds + (bufoff) + ldsw + _i * 8192), 16, 0, 0); } while (0)
#define PG8_LDA(dst, b, h) do { _Pragma("unroll") for (int m = 0; m < 4; ++m) _Pragma("unroll") for (int k = 0; k < 2; ++k) dst[m][k] = *(const PG8_LAS bf16x8*)(lds + PG8_SA(b, h) + aoff + m * 2048 + k * 1024); } while (0)
#define PG8_LDB(dst, b, h) do { _Pragma("unroll") for (int n = 0; n < 2; ++n) _Pragma("unroll") for (int k = 0; k < 2; ++k) dst[n][k] = *(const PG8_LAS bf16x8*)(lds + PG8_SB(b, h) + boff + n * 2048 + k * 1024); } while (0)
#define PG8_MMA(ai, bj, At, Bt) do { __builtin_amdgcn_s_setprio(1); _Pragma("unroll") for (int m = 0; m < 4; ++m) _Pragma("unroll") for (int n = 0; n < 2; ++n) _Pragma("unroll") for (int k = 0; k < 2; ++k) \
        acc[ai][bj][m][n] = __builtin_amdgcn_mfma_f32_16x16x32_bf16(Bt[n][k], At[m][k], acc[ai][bj][m][n], 0, 0, 0); __builtin_amdgcn_s_setprio(0); } while (0)
#define PG8_WAIT_V(n) asm volatile("s_waitcnt vmcnt(" #n ")" ::: "memory")
#define PG8_WAIT_L(n) asm volatile("s_waitcnt lgkmcnt(" #n ")" ::: "memory")
#define PG8_BAR __builtin_amdgcn_s_barrier()
#define PG8_SCHED __builtin_amdgcn_sched_barrier(0)
    Unit cur, nxt; int ui = 0;
    if (!S.next(0, cur)) return;
    f32x4 acc[2][2][4][2];
#pragma unroll
    for (int a = 0; a < 2; ++a)
#pragma unroll
        for (int b = 0; b < 2; ++b)
#pragma unroll
            for (int m = 0; m < 4; ++m)
#pragma unroll
                for (int n = 0; n < 2; ++n) acc[a][b][m][n] = (f32x4){0.f, 0.f, 0.f, 0.f};
    if constexpr (Epi::ACC_INIT) E.init(acc, cur, wr, wc, fr, fq);
    bf16x8 At[4][2], B0[2][2], B1[2][2];
    const char* cA = (const char*)g.A + (size_t)cur.pm * tstepA; const char* cB = (const char*)g.Bt + (size_t)cur.pn * tstepB;
    S.a_ready(cur);
    if constexpr (SP2) {
        PG8_STAGE(PG8_SB(0, 0), cB, voffB); PG8_STAGE(PG8_SB(0, 1), cB + hstepB, voffB); PG8_STAGE(PG8_SA(0, 0), cA, voffA); PG8_STAGE(PG8_SA(0, 1), cA + hstepA, voffA);
        if (wr == 1) PG8_BAR;
        PG8_WAIT_V(2); PG8_BAR;
        PG8_STAGE(PG8_SB(1, 0), cB + kstep, voffB); PG8_STAGE(PG8_SA(1, 0), cA + kstep, voffA); PG8_STAGE(PG8_SB(1, 1), cB + hstepB + kstep, voffB);
        PG8_WAIT_V(6); PG8_BAR;
    } else {
        PG8_STAGE(PG8_SB(0, 0), cB, voffB); PG8_STAGE(PG8_SA(0, 0), cA, voffA); PG8_STAGE(PG8_SB(0, 1), cB + hstepB, voffB); PG8_STAGE(PG8_SA(0, 1), cA + hstepA, voffA);
        if (wr == 1) PG8_BAR;
        PG8_WAIT_V(4); PG8_BAR;
        PG8_STAGE(PG8_SB(1, 0), cB + kstep, voffB); PG8_STAGE(PG8_SA(1, 0), cA + kstep, voffA); PG8_STAGE(PG8_SB(1, 1), cB + hstepB + kstep, voffB);
        PG8_WAIT_V(6); PG8_BAR;
    }
    for (;;) {
        const bool has_next = S.next(ui + 1, nxt);
        const char* nA = has_next ? (const char*)g.A + (size_t)nxt.pm * tstepA : cA; const char* nB = has_next ? (const char*)g.Bt + (size_t)nxt.pn * tstepB : cB;
        for (int t = 0; t < nt; t += 2) {
            const bool last = (t == nt - 2);
            const char* a1 = cA + (size_t)(t + 1) * kstep;
            const char* a2 = last ? nA : cA + (size_t)(t + 2) * kstep; const char* b2 = last ? nB : cB + (size_t)(t + 2) * kstep;
            const char* a3 = a2 + kstep; const char* b3 = b2 + kstep;
            if (last && has_next) S.a_ready(nxt);
            if constexpr (SP2) {
            PG8_LDB(B0, 0, 0); PG8_LDB(B1, 0, 1); PG8_SCHED; PG8_LDA(At, 0, 0); PG8_STAGE(PG8_SA(1, 1), a1 + hstepA, voffA);
            PG8_WAIT_V(8); PG8_WAIT_L(0); PG8_BAR; PG8_MMA(0, 0, At, B0); PG8_MMA(0, 1, At, B1); PG8_BAR; PG8_SCHED;
            PG8_LDA(At, 0, 1); PG8_STAGE(PG8_SB(0, 0), b2, voffB); PG8_STAGE(PG8_SB(0, 1), b2 + hstepB, voffB); PG8_STAGE(PG8_SA(0, 0), a2, voffA);
            PG8_WAIT_V(8); PG8_WAIT_L(0); PG8_BAR; PG8_MMA(1, 0, At, B0); PG8_MMA(1, 1, At, B1); PG8_BAR; PG8_SCHED;
            PG8_LDB(B0, 1, 0); PG8_LDB(B1, 1, 1); PG8_SCHED; PG8_LDA(At, 1, 0); PG8_STAGE(PG8_SA(0, 1), a2 + hstepA, voffA);
            PG8_WAIT_V(8); PG8_WAIT_L(0); PG8_BAR; PG8_MMA(0, 0, At, B0); PG8_MMA(0, 1, At, B1); PG8_BAR; PG8_SCHED;
            PG8_LDA(At, 1, 1); PG8_STAGE(PG8_SB(1, 0), b3, voffB); PG8_STAGE(PG8_SB(1, 1), b3 + hstepB, voffB); PG8_STAGE(PG8_SA(1, 0), a3, voffA);
            PG8_WAIT_V(8); PG8_WAIT_L(0); PG8_BAR; PG8_MMA(1, 0, At, B0); PG8_MMA(1, 1, At, B1); PG8_BAR; PG8_SCHED;
            } else {
            PG8_LDB(B0, 0, 0); PG8_SCHED; PG8_LDA(At, 0, 0); PG8_STAGE(PG8_SA(1, 1), a1 + hstepA, voffA);
            PG8_WAIT_L(8); PG8_BAR; PG8_WAIT_L(0); PG8_MMA(0, 0, At, B0); PG8_BAR; PG8_SCHED;
            PG8_LDB(B1, 0, 1); PG8_STAGE(PG8_SB(0, 0), b2, voffB);
            PG8_BAR; PG8_WAIT_L(0); PG8_MMA(0, 1, At, B1); PG8_BAR;
            PG8_LDA(At, 0, 1); PG8_STAGE(PG8_SA(0, 0), a2, voffA);
            PG8_BAR; PG8_WAIT_L(0); PG8_MMA(1, 0, At, B0); PG8_BAR; PG8_SCHED;
            PG8_STAGE(PG8_SB(0, 1), b2 + hstepB, voffB);
            PG8_WAIT_V(6); PG8_BAR; PG8_MMA(1, 1, At, B1); PG8_BAR;
            PG8_LDB(B0, 1, 0); PG8_SCHED; PG8_LDA(At, 1, 0); PG8_STAGE(PG8_SA(0, 1), a2 + hstepA, voffA);
            PG8_WAIT_L(8); PG8_BAR; PG8_WAIT_L(0); PG8_MMA(0, 0, At, B0); PG8_BAR; PG8_SCHED;
            PG8_LDB(B1, 1, 1); PG8_STAGE(PG8_SB(1, 0), b3, voffB);
            PG8_BAR; PG8_WAIT_L(0); PG8_MMA(0, 1, At, B1); PG8_BAR;
            PG8_LDA(At, 1, 1); PG8_STAGE(PG8_SA(1, 0), a3, voffA);
            PG8_BAR; PG8_WAIT_L(0); PG8_MMA(1, 0, At, B0); PG8_BAR; PG8_SCHED;
            PG8_STAGE(PG8_SB(1, 1), b3 + hstepB, voffB);
            PG8_WAIT_V(6); PG8_BAR; PG8_MMA(1, 1, At, B1); PG8_BAR;
            }
        }
        if constexpr (ALIGN_EPI) { if (wr == 0) PG8_BAR; }
        if constexpr (!Epi::AFTER_DRAIN) { E(acc, cur, wr, wc, fr, fq); S.done(cur); }
        if (!has_next) break;
#pragma unroll
        for (int a = 0; a < 2; ++a)
#pragma unroll
            for (int b = 0; b < 2; ++b)
#pragma unroll
                for (int m = 0; m < 4; ++m)
#pragma unroll
                    for (int n = 0; n < 2; ++n) acc[a][b][m][n] = (f32x4){0.f, 0.f, 0.f, 0.f};
        cur = nxt; cA = nA; cB = nB; ++ui;
        if constexpr (Epi::ACC_INIT) E.init(acc, cur, wr, wc, fr, fq);
        if constexpr (ALIGN_EPI) { if (wr == 1) PG8_BAR; }
    }
    PG8_WAIT_V(0);
    if constexpr (!ALIGN_EPI) { if (wr == 0) PG8_BAR; }
    PG8_BAR;
    if constexpr (Epi::AFTER_DRAIN) { E.fused(acc, cur, wr, wc, fr, fq, lds, wid, lane); S.done(cur); }
#undef PG8_SA
#undef PG8_SB
#undef PG8_STAGE
#undef PG8_LDA
#undef PG8_LDB
#undef PG8_MMA
#undef PG8_WAIT_V
#undef PG8_WAIT_L
#undef PG8_BAR
#undef PG8_SCHED
}
}

#define LAS __attribute__((address_space(3)))
#define XB_TMO      128
#define XB_XCNT(j)  (256  + 64 * (j))
#define XB_XSUB(j)  (1280 + 64 * (j))
#define XB_XGEN(j)  (2304 + 64 * (j))
#define XB_TOP      3328
#define XB_TOPGEN   3392
#define XCD_BAR_WORDS 3456
#define XB_SPIN_CAP (1u << 18)

__device__ __forceinline__ unsigned xb_ld(unsigned* p)              { return __hip_atomic_load(p, __ATOMIC_RELAXED, __HIP_MEMORY_SCOPE_AGENT); }
__device__ __forceinline__ unsigned xb_add(unsigned* p, unsigned v) { return __hip_atomic_fetch_add(p, v, __ATOMIC_RELAXED, __HIP_MEMORY_SCOPE_AGENT); }
__device__ __forceinline__ unsigned xb_xcc_id() { return (unsigned)__builtin_amdgcn_s_getreg((3 << 11) | 20) & 0xFu; }
#define XB_SPIN(cond, bar) do { unsigned _sp = 0; while (cond) { __builtin_amdgcn_s_sleep(1); \
    if ((++_sp & 255u) == 0u) { if (xb_ld(&(bar)[XB_TMO])) break; if (_sp > XB_SPIN_CAP) { atomicAdd(&(bar)[XB_TMO], 1u); break; } } } } while (0)

struct XcdBarrier {
    unsigned* bar; unsigned x; unsigned G;
    volatile LAS unsigned* st;
};

__device__ __forceinline__ XcdBarrier xcd_barrier_post(unsigned* bar, volatile LAS unsigned* st, unsigned G) {
    XcdBarrier b; b.bar = bar; b.x = xb_xcc_id(); b.st = st; b.G = G;
    if (threadIdx.x == 0) (void)xb_add(&bar[XB_XCNT(b.x)], 1u);
    return b;
}
__device__ __forceinline__ void xcd_barrier_complete(unsigned* bar, unsigned x, unsigned G, unsigned& nloc, unsigned& nx) {
    unsigned sum, cnt, mine, sp = 0u;
    for (;;) {
        sum = 0u; cnt = 0u; mine = 0u;
#pragma unroll
        for (unsigned j = 0; j < 16; ++j) { const unsigned c = xb_ld(&bar[XB_XCNT(j)]); sum += c; cnt += (c > 0u) ? 1u : 0u; mine = (j == x) ? c : mine; }
        if (sum == G) break;
        __builtin_amdgcn_s_sleep(1);
        if ((++sp & 255u) == 0u) { if (xb_ld(&bar[XB_TMO])) break; if (sp > XB_SPIN_CAP) { atomicAdd(&bar[XB_TMO], 1u); break; } }
    }
    nloc = mine > 0u ? mine : 1u; nx = cnt > 0u ? cnt : 1u;
}

__device__ __forceinline__ void xcd_barrier(const XcdBarrier& b) {
    asm volatile("s_waitcnt vmcnt(0)" ::: "memory");
    __syncthreads();
    if (threadIdx.x == 0) {
        unsigned* bar = b.bar;
        __builtin_amdgcn_s_waitcnt(0);
        unsigned nloc = b.st[0], nx = b.st[1];
        if (nloc == 0u) { xcd_barrier_complete(bar, b.x, b.G, nloc, nx); b.st[0] = nloc; b.st[1] = nx; }
        const unsigned old = xb_add(&bar[XB_XSUB(b.x)], 1u);
        const unsigned gen = old / nloc;
        if (old + 1u == (gen + 1u) * nloc) {
            __builtin_amdgcn_fence(__ATOMIC_RELEASE, "agent");
            asm volatile("s_waitcnt vmcnt(0)" ::: "memory");
            const unsigned og = xb_add(&bar[XB_TOP], 1u);
            const unsigned tg = og / nx;
            if (og + 1u == (tg + 1u) * nx) xb_add(&bar[XB_TOPGEN], 1u);
            else XB_SPIN(xb_ld(&bar[XB_TOPGEN]) == tg, bar);
            __builtin_amdgcn_fence(__ATOMIC_ACQUIRE, "agent");
            xb_add(&bar[XB_XGEN(b.x)], 1u);
            asm volatile("s_waitcnt vmcnt(0)" ::: "memory");
        } else {
            XB_SPIN(xb_ld(&bar[XB_XGEN(b.x)]) == gen, bar);
            __builtin_amdgcn_fence(__ATOMIC_ACQUIRE, "agent");
            asm volatile("s_waitcnt vmcnt(0)" ::: "memory");
        }
    }
    __syncthreads();
}

constexpr int NWAVES = 8;
constexpr int RING_BYTES = 131072;
constexpr int LDSCTL_OFF = 139264;
constexpr int LDS_BYTES = 147456;
constexpr int CW_BAR = 4096;
constexpr size_t CTL_ZERO_BYTES = 131072;
#ifndef OPT_MASK
#define OPT_MASK 0x1FF
#endif

typedef float f32x4 __attribute__((ext_vector_type(4)));
typedef unsigned u32x4v __attribute__((ext_vector_type(4)));
typedef unsigned u32x2v __attribute__((ext_vector_type(2)));
typedef short bf16x8 __attribute__((ext_vector_type(8)));
#define LDS_WAIT() asm volatile("s_waitcnt lgkmcnt(0)" ::: "memory")

struct MArgs { const float* in[16]; float* out; unsigned char* ws; int ph_lo, ph_hi, li, pad; };
struct Frame { LAS unsigned char* lds; int tid, lane, wave, G, bid, grp, gi, gs, b0, nb; const float* in[16]; float* out; unsigned char* ws; };
#ifndef NGRP
#define NGRP 2
#endif
constexpr int CW_LATE = 64;

__device__ __forceinline__ unsigned pk2(float lo, float hi) { return pg8::cvt_pk_bf16(lo, hi); }
__device__ __forceinline__ float wave_sum(float v) {
#pragma unroll
    for (int o = 1; o < 64; o <<= 1) v += __shfl_xor(v, o);
    return v;
}

template <int NR> __device__ __forceinline__ void p0_x_rows(const float* x, bf16_t* xb, float* rs, int row, int lane) {
    f32x4 v[NR][4]; float s[NR];
#pragma unroll
    for (int r = 0; r < NR; ++r) { const f32x4* xr = (const f32x4*)(x + (size_t)(row + r) * D_) + lane;
#pragma unroll
        for (int j = 0; j < 4; ++j) v[r][j] = xr[64 * j]; }
#pragma unroll
    for (int r = 0; r < NR; ++r) { s[r] = 0.f;
#pragma unroll
        for (int j = 0; j < 4; ++j) s[r] += (v[r][j][0] * v[r][j][0] + v[r][j][1] * v[r][j][1]) + (v[r][j][2] * v[r][j][2] + v[r][j][3] * v[r][j][3]); }
#pragma unroll
    for (int o = 1; o < 64; o <<= 1)
#pragma unroll
        for (int r = 0; r < NR; ++r) s[r] += __shfl_xor(s[r], o);
#pragma unroll
    for (int r = 0; r < NR; ++r) { u32x2v* o8 = (u32x2v*)(xb + (size_t)(row + r) * D_) + lane;
#pragma unroll
        for (int j = 0; j < 4; ++j) { u32x2v w; w.x = pk2(v[r][j][0], v[r][j][1]); w.y = pk2(v[r][j][2], v[r][j][3]); o8[64 * j] = w; }
        if (lane == 0) rs[row + r] = 1.0f / sqrtf(s[r] * (1.0f / D_) + EPS_); }
}
constexpr int TSCR_BYTES = 64 * 65 * 4;
__device__ __forceinline__ void p0_transpose_item(const float* W, int ldw, int csrc, const float* gain, int gmask, bf16_t* WT, int K, int nrow, int k0, LAS float* scr, int lane) {
    const int kk = lane >> 4, nq = lane & 15;
    f32x4 v[16];
#pragma unroll
    for (int j = 0; j < 16; ++j) v[j] = *(const f32x4*)(W + (size_t)(k0 + 4 * j + kk) * ldw + csrc + 4 * nq);
#pragma unroll
    for (int j = 0; j < 16; ++j) { const int k = 4 * j + kk; LAS float* d = scr + k * 65 + ((4 * nq + 4 * (j >> 3)) & 63);
        d[0] = v[j][0]; d[1] = v[j][1]; d[2] = v[j][2]; d[3] = v[j][3]; }
    const int c = lane & 7, nr = lane >> 3;
    f32x4 g0 = (f32x4){1.f, 1.f, 1.f, 1.f}, g1 = g0;
    if (gain) { g0 = *(const f32x4*)(gain + ((k0 + 8 * c) & gmask)); g1 = *(const f32x4*)(gain + ((k0 + 8 * c + 4) & gmask)); }
    LDS_WAIT(); asm volatile("" ::: "memory");
#pragma unroll
    for (int jj = 0; jj < 8; ++jj) { const int n = nr + 8 * jj; const LAS float* s = scr + (8 * c) * 65 + ((n + 4 * (c >> 2)) & 63);
        u32x4v o; o.x = pk2(s[0 * 65] * g0[0], s[1 * 65] * g0[1]); o.y = pk2(s[2 * 65] * g0[2], s[3 * 65] * g0[3]); o.z = pk2(s[4 * 65] * g1[0], s[5 * 65] * g1[1]); o.w = pk2(s[6 * 65] * g1[2], s[7 * 65] * g1[3]);
        *(u32x4v*)(WT + (size_t)(nrow + n) * K + k0 + 8 * c) = o; }
    LDS_WAIT(); asm volatile("" ::: "memory");
}
__device__ __forceinline__ void p0_memkv(const Frame& F, int unit) {
    const int l = unit >> 7, b = (unit >> 6) & 1, mt = (unit >> 3) & 7, cg = unit & 7, lane = F.lane, w = F.wave, c = lane & 15, g4 = lane >> 4, cgw = w & 1, kq = w >> 1;
    const float* mem = F.in[1] + ((size_t)b * 256 + mt * 32) * D_; const float* W = F.in[13] + (size_t)l * D_ * 1024 + cg * 128 + 64 * cgw + 4 * c; const float* gm = F.in[12] + l * D_;
    f32x4 acc[4][2];
#pragma unroll
    for (int t = 0; t < 4; ++t) { acc[t][0] = (f32x4){0.f, 0.f, 0.f, 0.f}; acc[t][1] = (f32x4){0.f, 0.f, 0.f, 0.f}; }
#pragma unroll 4
    for (int ks = 0; ks < 8; ++ks) { const int kb = kq * 256 + ks * 32 + 8 * g4;
        const f32x4 g0 = *(const f32x4*)(gm + kb), g1 = *(const f32x4*)(gm + kb + 4);
        bf16x8 afr[2], bfr[4];
#pragma unroll
        for (int rb = 0; rb < 2; ++rb) { const float* p = mem + (size_t)(rb * 16 + c) * D_ + kb; const f32x4 a0 = *(const f32x4*)p * g0, a1 = *(const f32x4*)(p + 4) * g1;
            u32x4v t; t.x = pk2(a0[0], a0[1]); t.y = pk2(a0[2], a0[3]); t.z = pk2(a1[0], a1[1]); t.w = pk2(a1[2], a1[3]); afr[rb] = __builtin_bit_cast(bf16x8, t); }
        f32x4 wv[8];
#pragma unroll
        for (int j = 0; j < 8; ++j) wv[j] = *(const f32x4*)(W + (size_t)(kb + j) * 1024);
#pragma unroll
        for (int t = 0; t < 4; ++t) { u32x4v q; q.x = pk2(wv[0][t], wv[1][t]); q.y = pk2(wv[2][t], wv[3][t]); q.z = pk2(wv[4][t], wv[5][t]); q.w = pk2(wv[6][t], wv[7][t]); bfr[t] = __builtin_bit_cast(bf16x8, q); }
#pragma unroll
        for (int t = 0; t < 4; ++t)
#pragma unroll
            for (int rb = 0; rb < 2; ++rb) acc[t][rb] = __builtin_amdgcn_mfma_f32_16x16x32_bf16(afr[rb], bfr[t], acc[t][rb], 0, 0, 0);
    }
    LAS float* P = (LAS float*)F.lds;
#pragma unroll
    for (int rb = 0; rb < 2; ++rb)
#pragma unroll
        for (int r = 0; r < 4; ++r) { const int tok = rb * 16 + 4 * g4 + r; *(LAS f32x4*)(P + ((kq * 32 + tok) * 128 + 64 * cgw + 4 * c)) = (f32x4){acc[0][rb][r], acc[1][rb][r], acc[2][rb][r], acc[3][rb][r]}; }
    __syncthreads();
    const int tok = F.tid >> 4, cb = F.tid & 15;
    f32x4 s0 = (f32x4){0.f, 0.f, 0.f, 0.f}, s1 = s0;
#pragma unroll
    for (int q = 0; q < 4; ++q) { s0 += *(const LAS f32x4*)(P + ((q * 32 + tok) * 128 + cb * 8)); s1 += *(const LAS f32x4*)(P + ((q * 32 + tok) * 128 + cb * 8 + 4)); }
    float ms = 0.f; { const f32x4* mr = (const f32x4*)(mem + (size_t)tok * D_ + cb * 64);
#pragma unroll
        for (int j = 0; j < 16; ++j) { const f32x4 v = mr[j]; ms += (v[0] * v[0] + v[1] * v[1]) + (v[2] * v[2] + v[3] * v[3]); } }
    ms += __shfl_xor(ms, 1); ms += __shfl_xor(ms, 2); ms += __shfl_xor(ms, 4); ms += __shfl_xor(ms, 8);
    const float rm = 1.0f / sqrtf(ms * (1.0f / D_) + EPS_);
    s0 *= rm; s1 *= rm;
    const size_t orow = ((((size_t)l * 2 + b) * 4 + (cg & 3)) * 256 + mt * 32 + tok) * 128 + cb * 8;
    if (cg < 4) {
        float q = (s0[0] * s0[0] + s0[1] * s0[1]) + (s0[2] * s0[2] + s0[3] * s0[3]) + (s1[0] * s1[0] + s1[1] * s1[1]) + (s1[2] * s1[2] + s1[3] * s1[3]);
        q += __shfl_xor(q, 1); q += __shfl_xor(q, 2); q += __shfl_xor(q, 4); q += __shfl_xor(q, 8);
        const float hn = QK_SCALE / sqrtf(q * (1.0f / 128) + EPS_);
        const f32x4 gk0 = *(const f32x4*)(F.in[15] + l * 128 + cb * 8), gk1 = *(const f32x4*)(F.in[15] + l * 128 + cb * 8 + 4);
        const f32x4 gq0 = *(const f32x4*)(F.in[14] + l * 128 + cb * 8), gq1 = *(const f32x4*)(F.in[14] + l * 128 + cb * 8 + 4);
        s0 = s0 * hn * gk0 * gq0; s1 = s1 * hn * gk1 * gq1;
        *(u32x4v*)((bf16_t*)(F.ws + WS_MEMK) + orow) = pg8::pack8(s0, s1);
    } else *(u32x4v*)((bf16_t*)(F.ws + WS_MEMV) + orow) = pg8::pack8(s0, s1);
    __syncthreads();
}
__device__ __forceinline__ void p0_weight_item(const Frame& F, int r, LAS float* scr) {
    constexpr int I_A = 16 * 64, I_OA = 24 * 16, I_B = 16 * 80;
    if (r < I_A) { const int kb = r / 64, n0 = 64 * (r % 64); p0_transpose_item(F.in[4], 4096, permA_src(n0), F.in[3], 0xffff, (bf16_t*)(F.ws + WS_WINA), 1024, n0, 64 * kb, scr, F.lane); return; } r -= I_A;
    if (r < I_OA) { const int kb = r / 16, n0 = 64 * (r % 16); p0_transpose_item(F.in[6], 1024, n0, kb < 16 ? F.in[5] : nullptr, 255, (bf16_t*)(F.ws + WS_WOUTA), 1536, n0, 64 * kb, scr, F.lane); return; } r -= I_OA;
    if (r < I_B) { const int kb = r / 80, n0 = 64 * (r % 80);
        if (n0 < 2048) p0_transpose_item(F.in[8], 2048, n0, F.in[7], 0xffff, (bf16_t*)(F.ws + WS_WB), 1024, n0, 64 * kb, scr, F.lane);
        else { const int c = n0 - 2048, src = c < 1024 ? 1024 + c : (c < 2048 ? c - 1024 : c); p0_transpose_item(F.in[10], 3072, src, F.in[9], 0xffff, (bf16_t*)(F.ws + WS_WB), 1024, n0, 64 * kb, scr, F.lane); }
        return; } r -= I_B;
    { const int kb = r / 16, n0 = 64 * (r % 16); p0_transpose_item(F.in[11], 1024, n0, nullptr, 0, (bf16_t*)(F.ws + WS_WOUTB), 1536, n0, 64 * kb, scr, F.lane); }
}
__device__ __forceinline__ void p0_prologue(const Frame& F) {
    for (int u = F.bid; u < 256; u += F.G) p0_memkv(F, u);
    const int gw = F.bid * NWAVES + F.wave, NGW = F.G * NWAVES;
    LAS float* scr = (LAS float*)(F.lds + F.wave * TSCR_BYTES);
    float* RS0 = (float*)(F.ws + WS_RS0); const float* x = F.in[0];
    if (NGW == 2048) {
        if (gw < 1024) { p0_weight_item(F, gw, scr); p0_x_rows<4>(x, x1b_ptr(F.ws, (6 * gw) >> 13), RS0, 6 * gw, F.lane); if (NGRP == 1) p0_weight_item(F, gw + 2048, scr); p0_x_rows<2>(x, x1b_ptr(F.ws, (6 * gw + 4) >> 13), RS0, 6 * gw + 4, F.lane); }
        else { const int r0 = 6144 + 10 * (gw - 1024); p0_x_rows<4>(x, x1b_ptr(F.ws, r0 >> 13), RS0, r0, F.lane); if (NGRP == 1) p0_weight_item(F, gw, scr); p0_x_rows<4>(x, x1b_ptr(F.ws, (r0 + 4) >> 13), RS0, r0 + 4, F.lane); p0_x_rows<2>(x, x1b_ptr(F.ws, (r0 + 8) >> 13), RS0, r0 + 8, F.lane); }
    } else {
        for (int it = gw; it < (NGRP == 2 ? 1024 : 3072); it += NGW) p0_weight_item(F, it, scr);
        for (int m = 4 * gw; m < T_; m += 4 * NGW) p0_x_rows<4>(x, x1b_ptr(F.ws, m >> 13), RS0, m, F.lane);
    }
}
__device__ __forceinline__ void p0_late_weights(const Frame& F) {
    LAS float* scr = (LAS float*)(F.lds + F.wave * TSCR_BYTES);
    for (int it = 1024 + F.gi * NWAVES + F.wave; it < 3072; it += F.gs * NWAVES) p0_weight_item(F, it, scr);
}

typedef float f32x16 __attribute__((ext_vector_type(16)));
typedef short s16x4 __attribute__((ext_vector_type(4)));
#define KSWZ(row, colB) ((row) * 256 + ((colB) ^ (((row) & 7) << 4)))
#define SBAR() __builtin_amdgcn_sched_barrier(0)
constexpr float LOG2E = 1.4426950408889634f;
__device__ __forceinline__ int crow(int r, int hi) { return (r & 3) + 8 * (r >> 2) + 4 * hi; }
__device__ __forceinline__ unsigned lds_addr(const LAS void* p) { return (unsigned)(size_t)p; }
__device__ __forceinline__ int v_st(int k, int c) { const int kk = (k & ~0xC) | ((k & 4) << 1) | ((k & 8) >> 1); return ((kk >> 3) * 4 + (c >> 5)) * 512 + ((kk & 7) * 32 + (c & 31)) * 2; }
__device__ __forceinline__ int v_rd_base(int lane) { return ((lane & 3) << 3) | (((lane >> 2) & 3) << 6) | (((lane >> 4) & 1) << 5) | (((lane >> 5) & 1) << 8); }
constexpr int v_rd_off(int d0, int ks, int half) { return d0 * 512 + ks * 4096 + half * 2048; }
template <int OFF> __device__ __forceinline__ s16x4 tr_read(unsigned vb) { s16x4 r; asm volatile("ds_read_b64_tr_b16 %0, %1 offset:%2" : "=&v"(r) : "v"(vb), "i"(OFF) : "memory"); return r; }
#define PKLH(L, H) (bf16x8){L[0], L[1], L[2], L[3], H[0], H[1], H[2], H[3]}
__device__ __forceinline__ float partner32(float x, int hi) { auto rr = __builtin_amdgcn_permlane32_swap(__float_as_uint(x), __float_as_uint(x), false, false); return __uint_as_float(hi ? rr[0] : rr[1]); }

__device__ __forceinline__ void qkt(f32x16& p0, f32x16& p1, const LAS unsigned char* Ks, const bf16x8* qr, int r32, int hi) {
    p0 = f32x16{}; p1 = f32x16{};
#pragma unroll
    for (int d0 = 0; d0 < 8; ++d0) { const int cb = (d0 * 16 + hi * 8) * 2;
        const bf16x8 b0 = *(const LAS bf16x8*)(Ks + KSWZ(r32, cb)), b1 = *(const LAS bf16x8*)(Ks + KSWZ(32 + r32, cb));
        p0 = __builtin_amdgcn_mfma_f32_32x32x16_bf16(b0, qr[d0], p0, 0, 0, 0);
        p1 = __builtin_amdgcn_mfma_f32_32x32x16_bf16(b1, qr[d0], p1, 0, 0, 0); }
}
#define PK4(P, BASE, OUT) do { unsigned a0_ = pg8::cvt_pk_bf16(P[BASE + 0], P[BASE + 1]), a1_ = pg8::cvt_pk_bf16(P[BASE + 2], P[BASE + 3]); \
    unsigned b0_ = pg8::cvt_pk_bf16(P[BASE + 4], P[BASE + 5]), b1_ = pg8::cvt_pk_bf16(P[BASE + 6], P[BASE + 7]); \
    auto r0_ = __builtin_amdgcn_permlane32_swap(a0_, b0_, false, false); auto r1_ = __builtin_amdgcn_permlane32_swap(a1_, b1_, false, false); \
    u32x4v w_ = {r0_[0], r1_[0], r0_[1], r1_[1]}; OUT = __builtin_bit_cast(bf16x8, w_); } while (0)
template <int D0> __device__ __forceinline__ void pv_one(f32x16& od, unsigned vb, bf16x8 pa0, bf16x8 pa1, bf16x8 pa2, bf16x8 pa3) {
    const s16x4 l0 = tr_read<v_rd_off(D0, 0, 0)>(vb), h0 = tr_read<v_rd_off(D0, 0, 1)>(vb), l1 = tr_read<v_rd_off(D0, 1, 0)>(vb), h1 = tr_read<v_rd_off(D0, 1, 1)>(vb);
    const s16x4 l2 = tr_read<v_rd_off(D0, 2, 0)>(vb), h2 = tr_read<v_rd_off(D0, 2, 1)>(vb), l3 = tr_read<v_rd_off(D0, 3, 0)>(vb), h3 = tr_read<v_rd_off(D0, 3, 1)>(vb);
    asm volatile("s_waitcnt lgkmcnt(0)" ::: "memory"); SBAR();
    od = __builtin_amdgcn_mfma_f32_32x32x16_bf16(pa0, PKLH(l0, h0), od, 0, 0, 0);
    od = __builtin_amdgcn_mfma_f32_32x32x16_bf16(pa1, PKLH(l1, h1), od, 0, 0, 0);
    od = __builtin_amdgcn_mfma_f32_32x32x16_bf16(pa2, PKLH(l2, h2), od, 0, 0, 0);
    od = __builtin_amdgcn_mfma_f32_32x32x16_bf16(pa3, PKLH(l3, h3), od, 0, 0, 0);
}
__device__ __forceinline__ void pv_d0(f32x16* o, unsigned vb, bf16x8 pa0, bf16x8 pa1, bf16x8 pa2, bf16x8 pa3) {
    pv_one<0>(o[0], vb, pa0, pa1, pa2, pa3); pv_one<1>(o[1], vb, pa0, pa1, pa2, pa3); pv_one<2>(o[2], vb, pa0, pa1, pa2, pa3); pv_one<3>(o[3], vb, pa0, pa1, pa2, pa3);
}
constexpr int WSCR_OFF = LDSCTL_OFF + 1024, WFLAG_OFF = LDSCTL_OFF + 512;


__device__ __forceinline__ void o_tile_stage(const f32x16* o, const float* rsc, LAS unsigned char* stg, int r32, int hi) {
#pragma unroll
    for (int r = 0; r < 16; ++r) { LAS bf16_t* sp = (LAS bf16_t*)(stg + crow(r, hi) * 256) + r32;
#pragma unroll
        for (int db = 0; db < 4; ++db) sp[32 * db] = (bf16_t)(pg8::cvt_pk_bf16_safe(o[db][r] * rsc[r], 0.f) & 0xffffu); }
}
__device__ __forceinline__ void o_tile_out(const LAS unsigned char* stg, const bf16_t* gate, bf16_t* out, size_t ld, int lane) {
    const int rr = lane >> 4, ch = lane & 15;
#pragma unroll
    for (int ps = 0; ps < 8; ++ps) { const int row = 4 * ps + rr; const bf16x8 v = *(const LAS bf16x8*)(stg + row * 256 + ch * 16); const bf16x8 g = *(const bf16x8*)(gate + (size_t)row * ld + ch * 8);
        u32x4v w; w.x = pk2(bf2f((bf16_t)v[0]) * bf2f((bf16_t)g[0]), bf2f((bf16_t)v[1]) * bf2f((bf16_t)g[1])); w.y = pk2(bf2f((bf16_t)v[2]) * bf2f((bf16_t)g[2]), bf2f((bf16_t)v[3]) * bf2f((bf16_t)g[3]));
        w.z = pk2(bf2f((bf16_t)v[4]) * bf2f((bf16_t)g[4]), bf2f((bf16_t)v[5]) * bf2f((bf16_t)g[5])); w.w = pk2(bf2f((bf16_t)v[6]) * bf2f((bf16_t)g[6]), bf2f((bf16_t)v[7]) * bf2f((bf16_t)g[7]));
        *(u32x4v*)(out + (size_t)row * ld + ch * 8) = w; }
}


template <bool MASK, int KOFF> __device__ __forceinline__ void sb_half_a(f32x16& p, float* go, int lim) {
#pragma unroll
    for (int i = 0; i < 4; ++i) { float l[4];
#pragma unroll
        for (int e = 0; e < 4; ++e) { const float y = fminf(p[4 * i + e], 60.f), sp = __builtin_amdgcn_logf(1.0f + __builtin_amdgcn_exp2f(y));
            l[e] = -sp; p[4 * i + e] = y - sp; if (MASK) l[e] = KOFF + 8 * i + e < lim ? l[e] : 0.f; }
        go[i] = (l[0] + l[1]) + (l[2] + l[3]);
        const float s2 = l[3], s1 = s2 + l[2], s0 = s1 + l[1]; p[4 * i + 2] += s2; p[4 * i + 1] += s1; p[4 * i] += s0; }
}
template <bool MASK, int KOFF> __device__ __forceinline__ void sb_half_b(f32x16& p, const float* go, int lim, float carry, float& tail, int hi) {
#pragma unroll
    for (int i = 3; i >= 0; --i) { const float gpi = partner32(go[i], hi); const float so = tail + (hi ? 0.f : gpi) + carry; tail += go[i] + gpi;
#pragma unroll
        for (int e = 0; e < 4; ++e) { float a = __builtin_amdgcn_exp2f(p[4 * i + e] + so); if (MASK) a = KOFF + 8 * i + e < lim ? a : 0.f; p[4 * i + e] = a; } }
}
template <bool MASK> __device__ __forceinline__ float sb_weights(f32x16& p0, f32x16& p1, int lim, float carry, int hi) {
    float go[8], tail = 0.f;
    sb_half_a<MASK, 0>(p0, go, lim); sb_half_a<MASK, 32>(p1, go + 4, lim);
    sb_half_b<MASK, 32>(p1, go + 4, lim, carry, tail, hi); sb_half_b<MASK, 0>(p0, go, lim, carry, tail, hi);
    return tail;
}

constexpr float SB_EXIT = -150.1f;
__device__ __forceinline__ int swap23(int k) { return (k & ~0xC) | ((k & 4) << 1) | ((k & 8) >> 1); }
__device__ __forceinline__ void sb_unit(const Frame& F, int b, int h, int qb) {
    int tid = F.tid; asm volatile("" : "+v"(tid));
    const int w = F.wave, lane = tid & 63, r32 = lane & 31, hi = lane >> 5;
    bf16_t* UB = ub_ptr(F.ws, b); const size_t rowb = (size_t)b * S_;
    const int q0 = qb * 256, tq = q0 + 32 * w + r32;
    unsigned offK[2], offV[2];
#pragma unroll
    for (int i = 0; i < 2; ++i) { const int pc = w + 8 * i;
        { const int row = pc * 4 + (lane >> 4), colB = ((lane & 15) * 16) ^ ((row & 7) << 4); offK[i] = (unsigned)(row * NBW_ + colB / 2); }
        { const int d = pc * 1024 + lane * 16, st = d >> 9, o = d & 511, kk = ((st >> 2) << 3) | (o >> 6), k = swap23(kk), c = (st & 3) * 32 + (o & 63) / 2; offV[i] = (unsigned)(k * NBW_ + c); } }
    const bf16_t* kg = UB + rowb * NBW_ + h * 128; const bf16_t* vg = kg + 1024;
#define SB_DMA(kt_) do { const int bo_ = ((kt_) % 3) * 32768; const bf16_t* kt0_ = kg + (size_t)(kt_) * 64 * NBW_; const bf16_t* vt0_ = vg + (size_t)(kt_) * 64 * NBW_; \
        _Pragma("unroll") for (int i_ = 0; i_ < 2; ++i_) { \
            __builtin_amdgcn_global_load_lds((const unsigned*)(kt0_ + offK[i_]), (LAS unsigned*)(F.lds + bo_ + (w + 8 * i_) * 1024), 16, 0, 0); \
            __builtin_amdgcn_global_load_lds((const unsigned*)(vt0_ + offV[i_]), (LAS unsigned*)(F.lds + bo_ + 16384 + (w + 8 * i_) * 1024), 16, 0, 0); } } while (0)
    volatile LAS unsigned* flags = (volatile LAS unsigned*)(F.lds + WFLAG_OFF);
    f32x16 o[4] = {}; float carry = 0.f; bool wdone = false;
    const int kt_hi = qb * 4 + 3;
    __syncthreads();
    if (lane == 0) { flags[w] = 0u; flags[8 + w] = 0u; }
    SB_DMA(kt_hi); SB_DMA(kt_hi - 1);
    bf16x8 qr[8];
    { const bf16_t* qp = UB + (rowb + tq) * NBW_ + 3072 + h * 128 + hi * 8;
#pragma unroll
      for (int d0 = 0; d0 < 8; ++d0) qr[d0] = *(const bf16x8*)(qp + d0 * 16); }
    asm volatile("s_waitcnt vmcnt(0)" ::: "memory");
    const unsigned vbase = lds_addr(F.lds) + 16384 + v_rd_base(lane);
    for (int kt = kt_hi; kt >= 0; --kt) {
        if (kt >= 1) asm volatile("s_waitcnt vmcnt(4)" ::: "memory"); else asm volatile("s_waitcnt vmcnt(0)" ::: "memory");
        asm volatile("s_waitcnt lgkmcnt(0)" ::: "memory"); __builtin_amdgcn_s_barrier(); asm volatile("" ::: "memory");
        unsigned alld = 1u;
#pragma unroll
        for (int j = 0; j < 8; ++j) alld &= flags[8 * (kt & 1) + j];
        if (alld) break;
        if (kt >= 2) SB_DMA(kt - 2);
        const int bo = (kt % 3) * 32768;
        if (!wdone && kt * 64 < q0 + 32 * w + 31) {
            f32x16 p0, p1;
            qkt(p0, p1, F.lds + bo, qr, r32, hi);
            const int lim = tq - kt * 64 - 4 * hi;
            const bool need_mask = kt * 64 + 63 >= q0 + 32 * w;
            carry += need_mask ? sb_weights<true>(p0, p1, lim, carry, hi) : sb_weights<false>(p0, p1, lim, carry, hi);
            bf16x8 pa0, pa1, pa2, pa3;
            PK4(p0, 0, pa0); PK4(p0, 8, pa1); PK4(p1, 0, pa2); PK4(p1, 8, pa3);
            pv_d0(o, vbase + bo, pa0, pa1, pa2, pa3);
            wdone = __all(carry < SB_EXIT);
        }
        if (lane == 0) flags[8 * ((kt & 1) ^ 1) + w] = wdone ? 1u : 0u;
    }
#undef SB_DMA
    asm volatile("s_waitcnt vmcnt(0) lgkmcnt(0)" ::: "memory"); __builtin_amdgcn_s_barrier(); asm volatile("" ::: "memory");
    { float one[16];
#pragma unroll
      for (int r = 0; r < 16; ++r) one[r] = 1.0f;
      LAS unsigned char* stg = F.lds + w * 8192; bf16_t* base = UB + (rowb + q0 + 32 * w) * NBW_ + h * 128;
      o_tile_stage(o, one, stg, r32, hi); LDS_WAIT();
      o_tile_out(stg, base + 2048, base + 3072, NBW_, lane); LDS_WAIT(); }
}

__device__ __forceinline__ void memattn_unit(const Frame& F, bf16_t* U, int ld, int qoff, int goff, int layer, int unit) {
    int tid = F.tid; asm volatile("" : "+v"(tid));
    const int w = F.wave, lane = tid & 63, r32 = lane & 31, hi = lane >> 5;
    const int qblk = unit >> 2, hd = unit & 3, row0 = qblk * 256, b = row0 / S_;
    const bf16_t* Kg = (const bf16_t*)(F.ws + WS_MEMK) + (((size_t)layer * 2 + b) * 4 + hd) * 256 * 128; const bf16_t* Vg = (const bf16_t*)(F.ws + WS_MEMV) + (((size_t)layer * 2 + b) * 4 + hd) * 256 * 128;
    LAS unsigned char* Kb = F.lds; LAS unsigned char* Vb = F.lds + 65536;
    __syncthreads();
#pragma unroll
    for (int j = 0; j < 8; ++j) { const int c = tid + 512 * j, row = c >> 4, ch = c & 15;
        *(LAS bf16x8*)(Kb + KSWZ(row, ch * 16)) = *(const bf16x8*)(Kg + (size_t)row * 128 + ch * 8);
        *(LAS bf16x8*)(Vb + (row >> 6) * 16384 + v_st(row & 63, ch * 8)) = *(const bf16x8*)(Vg + (size_t)row * 128 + ch * 8); }
    bf16x8 qr[8]; float ssq = 0.f;
    { const bf16_t* qp = U + (size_t)(row0 + 32 * w + r32) * ld + qoff + hd * 128 + hi * 8;
#pragma unroll
      for (int d0 = 0; d0 < 8; ++d0) { qr[d0] = *(const bf16x8*)(qp + d0 * 16);
#pragma unroll
          for (int j = 0; j < 8; ++j) { const float v = bf2f((bf16_t)qr[d0][j]); ssq += v * v; } } }
    ssq += partner32(ssq, hi);
    const float C = LOG2E / sqrtf(ssq * (1.0f / 128) + EPS_);
    __syncthreads();
    LAS float* wscr = (LAS float*)(F.lds + WSCR_OFF) + w * 64;
    const unsigned vb0 = lds_addr(Vb) + v_rd_base(lane);
    f32x16 o[4] = {}; float m_reg = -1e30f, l_reg = 0.f;
#pragma unroll 1
    for (int t = 0; t < 4; ++t) {
        f32x16 p0, p1;
        qkt(p0, p1, Kb + t * 16384, qr, r32, hi);
        float pmax = p0[0];
#pragma unroll
        for (int r = 1; r < 16; ++r) pmax = fmaxf(pmax, p0[r]);
#pragma unroll
        for (int r = 0; r < 16; ++r) pmax = fmaxf(pmax, p1[r]);
        pmax = fmaxf(pmax, partner32(pmax, hi));
        float alpha = 1.f;
        if (!__all(pmax <= m_reg)) { const float mn = fmaxf(m_reg, pmax); alpha = __builtin_amdgcn_exp2f((m_reg - mn) * C); m_reg = mn;
            if (hi == 0) wscr[r32] = alpha; LDS_WAIT();
#pragma unroll
            for (int d = 0; d < 4; ++d)
#pragma unroll
                for (int r = 0; r < 16; ++r) o[d][r] *= wscr[crow(r, hi)];
            LDS_WAIT(); }
        const float mC = -m_reg * C; float ps = 0.f;
#pragma unroll
        for (int r = 0; r < 16; ++r) { p0[r] = __builtin_amdgcn_exp2f(fmaf(p0[r], C, mC)); p1[r] = __builtin_amdgcn_exp2f(fmaf(p1[r], C, mC)); ps += p0[r] + p1[r]; }
        ps += partner32(ps, hi);
        l_reg = l_reg * alpha + ps;
        bf16x8 pa0, pa1, pa2, pa3;
        PK4(p0, 0, pa0); PK4(p0, 8, pa1); PK4(p1, 0, pa2); PK4(p1, 8, pa3);
        pv_d0(o, vb0 + t * 16384, pa0, pa1, pa2, pa3);
    }
    if (hi == 0) wscr[32 + r32] = l_reg; LDS_WAIT();
    { float rl[16];
#pragma unroll
      for (int r = 0; r < 16; ++r) rl[r] = 1.0f / wscr[32 + crow(r, hi)];
      __syncthreads();
      LAS unsigned char* stg = F.lds + w * 8192; bf16_t* base = U + (size_t)(row0 + 32 * w) * ld + hd * 128;
      o_tile_stage(o, rl, stg, r32, hi); LDS_WAIT();
      o_tile_out(stg, base + goff, base + qoff, ld, lane); LDS_WAIT(); }
}

__device__ __forceinline__ float ret_lg2(int h) { return log2f(1.0f - exp2f(-5.0f - (float)h)); }
template <int H2> __device__ __forceinline__ void o_half_stage(const f32x16* o, const float* rsc, LAS unsigned char* stg, int r32, int hi) {
#pragma unroll
    for (int r = 8 * H2; r < 8 * H2 + 8; ++r) { LAS bf16_t* sp = (LAS bf16_t*)(stg + ((r & 3) + 8 * ((r >> 2) & 1) + 4 * hi) * 256) + r32;
#pragma unroll
        for (int db = 0; db < 4; ++db) sp[32 * db] = (bf16_t)(pg8::cvt_pk_bf16_safe(o[db][r] * rsc[r], 0.f) & 0xffffu); }
}
__device__ __forceinline__ bf16x8 mul8_bf16(bf16x8 v, bf16x8 g) {
    u32x4v w; w.x = pk2(bf2f((bf16_t)v[0]) * bf2f((bf16_t)g[0]), bf2f((bf16_t)v[1]) * bf2f((bf16_t)g[1])); w.y = pk2(bf2f((bf16_t)v[2]) * bf2f((bf16_t)g[2]), bf2f((bf16_t)v[3]) * bf2f((bf16_t)g[3]));
    w.z = pk2(bf2f((bf16_t)v[4]) * bf2f((bf16_t)g[4]), bf2f((bf16_t)v[5]) * bf2f((bf16_t)g[5])); w.w = pk2(bf2f((bf16_t)v[6]) * bf2f((bf16_t)g[6]), bf2f((bf16_t)v[7]) * bf2f((bf16_t)g[7]));
    return __builtin_bit_cast(bf16x8, w);
}
__device__ __forceinline__ void kvt_unit(const Frame& F, int u) {
    int tid = F.tid; asm volatile("" : "+v"(tid));
    const int w = F.wave, lane = tid & 63, r32 = lane & 31, hi = lane >> 5;
    const int b = u >> 8, h = (u >> 6) & 3, n = u & 63; const size_t row0 = (size_t)b * S_ + n * 128; const float lg2 = ret_lg2(h);
    const bf16_t* UA = ua_ptr(F.ws, b); bf16_t* KVT = kvt_ptr(F.ws, b);
    LAS unsigned char* Vb = F.lds; LAS unsigned char* Kb = F.lds + 65536;
    __syncthreads();
#pragma unroll
    for (int j = 0; j < 8; ++j) { const int c = tid + 512 * j, row = c >> 5, col = (c & 31) * 8;
        *(LAS bf16x8*)(Vb + ((row >> 6) * 2 + (col >> 7)) * 16384 + v_st(row & 63, col & 127)) = *(const bf16x8*)(UA + (row0 + row) * NA_ + 1024 + h * 256 + col); }
#pragma unroll
    for (int j = 0; j < 4; ++j) { const int c = tid + 512 * j, row = c >> 4, col = (c & 15) * 8; const float z = exp2f((float)(127 - row) * lg2);
        const bf16x8 kv = *(const bf16x8*)(UA + (row0 + row) * NA_ + 512 + h * 128 + col);
        u32x4v t; t.x = pk2(bf2f((bf16_t)kv[0]) * z, bf2f((bf16_t)kv[1]) * z); t.y = pk2(bf2f((bf16_t)kv[2]) * z, bf2f((bf16_t)kv[3]) * z);
        t.z = pk2(bf2f((bf16_t)kv[4]) * z, bf2f((bf16_t)kv[5]) * z); t.w = pk2(bf2f((bf16_t)kv[6]) * z, bf2f((bf16_t)kv[7]) * z);
        *(LAS u32x4v*)(Kb + (row >> 6) * 16384 + v_st(row & 63, col)) = t; }
    __syncthreads();
    f32x16 acc[4] = {};
    const unsigned vbV = lds_addr(Vb) + v_rd_base(lane) + (w >> 2) * 16384 + (w & 3) * 512, vbK = lds_addr(Kb) + v_rd_base(lane);
#define KVT_STEP(TH, KS) do { const unsigned va_ = vbV + (TH) * 32768, vk_ = vbK + (TH) * 16384; \
        const s16x4 al_ = tr_read<v_rd_off(0, KS, 0)>(va_), ah_ = tr_read<v_rd_off(0, KS, 1)>(va_); \
        const s16x4 b0l_ = tr_read<v_rd_off(0, KS, 0)>(vk_), b0h_ = tr_read<v_rd_off(0, KS, 1)>(vk_), b1l_ = tr_read<v_rd_off(1, KS, 0)>(vk_), b1h_ = tr_read<v_rd_off(1, KS, 1)>(vk_); \
        const s16x4 b2l_ = tr_read<v_rd_off(2, KS, 0)>(vk_), b2h_ = tr_read<v_rd_off(2, KS, 1)>(vk_), b3l_ = tr_read<v_rd_off(3, KS, 0)>(vk_), b3h_ = tr_read<v_rd_off(3, KS, 1)>(vk_); \
        asm volatile("s_waitcnt lgkmcnt(0)" ::: "memory"); SBAR(); const bf16x8 a_ = PKLH(al_, ah_); \
        acc[0] = __builtin_amdgcn_mfma_f32_32x32x16_bf16(a_, PKLH(b0l_, b0h_), acc[0], 0, 0, 0); acc[1] = __builtin_amdgcn_mfma_f32_32x32x16_bf16(a_, PKLH(b1l_, b1h_), acc[1], 0, 0, 0); \
        acc[2] = __builtin_amdgcn_mfma_f32_32x32x16_bf16(a_, PKLH(b2l_, b2h_), acc[2], 0, 0, 0); acc[3] = __builtin_amdgcn_mfma_f32_32x32x16_bf16(a_, PKLH(b3l_, b3h_), acc[3], 0, 0, 0); } while (0)
    KVT_STEP(0, 0); KVT_STEP(0, 1); KVT_STEP(0, 2); KVT_STEP(0, 3); KVT_STEP(1, 0); KVT_STEP(1, 1); KVT_STEP(1, 2); KVT_STEP(1, 3);
#undef KVT_STEP
    bf16_t* ob = KVT + ((size_t)u * 256 + 32 * w) * 128 + r32;
#pragma unroll
    for (int r = 0; r < 16; ++r)
#pragma unroll
        for (int db = 0; db < 4; ++db) ob[(size_t)crow(r, hi) * 128 + 32 * db] = f2bf(acc[db][r]);
}
__device__ __forceinline__ void scan_phase(const Frame& F) {
    for (int idx = F.gi * (NWAVES * 64) + F.tid; idx < F.nb * 4 * 16384; idx += F.gs * NWAVES * 64) {
        const int bh = F.b0 * 4 + (idx >> 14), off = idx & 16383; const float gc = exp2f(128.0f * ret_lg2(bh & 3));
        unsigned* p = (unsigned*)kvt_ptr(F.ws, bh >> 2) + (size_t)bh * 64 * 16384 + off; float s0 = 0.f, s1 = 0.f;
#pragma unroll 1
        for (int n0 = 0; n0 < 64; n0 += 16) { unsigned v[16];
#pragma unroll
            for (int j = 0; j < 16; ++j) v[j] = p[(size_t)(n0 + j) * 16384];
#pragma unroll
            for (int j = 0; j < 16; ++j) { p[(size_t)(n0 + j) * 16384] = pk2(s0, s1); s0 = fmaf(gc, s0, __uint_as_float(v[j] << 16)); s1 = fmaf(gc, s1, __uint_as_float(v[j] & 0xffff0000u)); } }
    }
}
__device__ __forceinline__ void ret_unit(const Frame& F, int u) {
    int tid = F.tid; asm volatile("" : "+v"(tid));
    const int w = F.wave, lane = tid & 63, r32 = lane & 31, hi = lane >> 5, wq = w & 3, eh = w >> 2;
    const int b = u >> 8, h = (u >> 6) & 3, n = u & 63; const size_t row0 = (size_t)b * S_ + n * 128; const float lg2 = ret_lg2(h);
    bf16_t* UA = ua_ptr(F.ws, b); const bf16_t* KVT = kvt_ptr(F.ws, b);
    LAS unsigned char* R1 = F.lds; LAS unsigned char* R2 = F.lds + 65536;
    __syncthreads();
#pragma unroll
    for (int j = 0; j < 8; ++j) { const int c = tid + 512 * j, row = c >> 4, ch = c & 15; *(LAS bf16x8*)(R1 + KSWZ(row, ch * 16)) = *(const bf16x8*)(KVT + ((size_t)u * 256 + row) * 128 + ch * 8); }
#pragma unroll
    for (int j = 0; j < 4; ++j) { const int c = tid + 512 * j, row = c >> 4, ch = c & 15; *(LAS bf16x8*)(R2 + KSWZ(row, ch * 16)) = *(const bf16x8*)(UA + (row0 + row) * NA_ + 512 + h * 128 + ch * 8); }
    bf16x8 qr[8];
    { const bf16_t* qp = UA + (row0 + 32 * wq + r32) * NA_ + h * 128 + hi * 8;
#pragma unroll
      for (int d0 = 0; d0 < 8; ++d0) qr[d0] = *(const bf16x8*)(qp + d0 * 16); }
    __syncthreads();
    f32x16 o[4] = {};
#pragma unroll
    for (int db = 0; db < 4; ++db) {
#pragma unroll
        for (int d0 = 0; d0 < 8; ++d0) { const bf16x8 bs = *(const LAS bf16x8*)(R1 + KSWZ(128 * eh + 32 * db + r32, (d0 * 16 + hi * 8) * 2)); o[db] = __builtin_amdgcn_mfma_f32_32x32x16_bf16(qr[d0], bs, o[db], 0, 0, 0); }
        asm volatile("" ::: "memory"); }
    const float gm1 = exp2f(lg2), gm2 = gm1 * gm1, gm4 = gm2 * gm2, gm8 = gm4 * gm4, gm16 = gm8 * gm8;
    const float gi1 = exp2f(-lg2), gi2 = gi1 * gi1, gi4 = gi2 * gi2, gi8 = gi4 * gi4, gi16 = gi8 * gi8, gi32 = gi16 * gi16;
    const float ga[4] = {1.0f, gm1, gm2, gm2 * gm1}, gb[4] = {1.0f, gm8, gm16, gm16 * gm8};
    const float ia[4] = {1.0f, gi1, gi2, gi2 * gi1}, ib[4] = {1.0f, gi8, gi16, gi16 * gi8};
    { const float xl = exp2f((float)(32 * wq + 4 * hi + 1) * lg2);
#pragma unroll
      for (int r = 0; r < 16; ++r) { const float xi = xl * (ga[r & 3] * gb[r >> 2]);
#pragma unroll
          for (int db = 0; db < 4; ++db) o[db][r] *= xi; } }
    bf16x8 pa[2][4]; const int cq = 32 * wq + r32;
#define RET_P(ST) do { f32x16 p0, p1; qkt(p0, p1, R2 + (ST) * 16384, qr, r32, hi); const int limq_ = cq - 64 * (ST) - 4 * hi; const float al_ = exp2f((float)limq_ * lg2); \
        _Pragma("unroll") for (int r = 0; r < 16; ++r) { const int cr_ = (r & 3) + 8 * (r >> 2); const float f_ = al_ * (ia[r & 3] * ib[r >> 2]); \
            p0[r] = cr_ <= limq_ ? p0[r] * f_ : 0.f; p1[r] = cr_ + 32 <= limq_ ? p1[r] * (f_ * gi32) : 0.f; } \
        PK4(p0, 0, pa[ST][0]); PK4(p0, 8, pa[ST][1]); PK4(p1, 0, pa[ST][2]); PK4(p1, 8, pa[ST][3]); } while (0)
    RET_P(0);
    if (wq >= 2) RET_P(1);
#undef RET_P
    __syncthreads();
#pragma unroll 4
    for (int j = 0; j < 8; ++j) { const int c = tid + 512 * j, row = c >> 5, col = (c & 31) * 8;
        *(LAS bf16x8*)(R1 + ((row >> 6) * 2 + (col >> 7)) * 16384 + v_st(row & 63, col & 127)) = *(const bf16x8*)(UA + (row0 + row) * NA_ + 1024 + h * 256 + col); }
    __syncthreads();
    const unsigned vb = lds_addr(R1) + v_rd_base(lane) + eh * 16384;
    pv_d0(o, vb, pa[0][0], pa[0][1], pa[0][2], pa[0][3]);
    if (wq >= 2) pv_d0(o, vb + 32768, pa[1][0], pa[1][1], pa[1][2], pa[1][3]);
    LAS float* ssq = (LAS float*)(F.lds + WSCR_OFF);
    float qs[16];
#pragma unroll
    for (int r = 0; r < 16; ++r) { float q = (o[0][r] * o[0][r] + o[1][r] * o[1][r]) + (o[2][r] * o[2][r] + o[3][r] * o[3][r]);
        q += __shfl_xor(q, 1); q += __shfl_xor(q, 2); q += __shfl_xor(q, 4); q += __shfl_xor(q, 8); q += __shfl_xor(q, 16); qs[r] = q;
        if (r32 == 0) ssq[w * 32 + crow(r, hi)] = q; }
    __syncthreads();
    { bf16_t* base = UA + (row0 + 32 * wq) * NA_ + 2048 + h * 256 + 128 * eh + r32;
#pragma unroll
      for (int r = 0; r < 16; ++r) { const float rn = 1.0f / sqrtf((qs[r] + ssq[(w ^ 4) * 32 + crow(r, hi)]) * (1.0f / 256) + EPS_); bf16_t* rp = base + (size_t)crow(r, hi) * NA_;
#pragma unroll
          for (int db = 0; db < 4; ++db) { const float g = bf2f(rp[32 * db]); rp[32 * db] = f2bf(o[db][r] * rn * g); } } }
    LDS_WAIT();
}
#ifndef PG8_SP2
#define PG8_SP2 true
#endif
#ifndef PG8_ALIGN
#define PG8_ALIGN true
#endif
__device__ __forceinline__ void phase1(const Frame& F) {
    const size_t rb = (size_t)F.b0 * S_;
    pg8::Gemm g{(const bf16_t*)x1b_ptr(F.ws, F.b0) + rb * D_, (const bf16_t*)(F.ws + WS_WINA), F.nb * S_, NA_, D_, D_}; pg8::StaticOrder S; S.init(F.nb * S_, NA_, F.gs, F.gi);
    pg8::EpiA E{ua_ptr(F.ws, F.b0) + rb * NA_, (const float*)(F.ws + WS_RS0) + rb, (const int*)F.in[2] + rb};
    pg8::gemm_phase<pg8::EpiA, pg8::StaticOrder, PG8_ALIGN, PG8_SP2>(F.lds, g, S, E);
}
__device__ __forceinline__ void late_publish(const Frame& F) {
    asm volatile("s_waitcnt vmcnt(0)" ::: "memory"); __syncthreads();
    if (F.tid == 0) { __builtin_amdgcn_fence(__ATOMIC_RELEASE, "agent"); asm volatile("s_waitcnt vmcnt(0)" ::: "memory");
        __hip_atomic_fetch_add((unsigned*)(F.ws + WS_CTL) + CW_LATE, 1u, __ATOMIC_RELAXED, __HIP_MEMORY_SCOPE_AGENT); }
}
__device__ __forceinline__ void late_acquire(const Frame& F) {
    if (F.tid == 0) { unsigned* c = (unsigned*)(F.ws + WS_CTL) + CW_LATE; unsigned sp = 0;
        while (__hip_atomic_load(c, __ATOMIC_RELAXED, __HIP_MEMORY_SCOPE_AGENT) < (unsigned)F.gs) { __builtin_amdgcn_s_sleep(2); if (++sp > (1u << 22)) break; }
        __builtin_amdgcn_fence(__ATOMIC_ACQUIRE, "agent"); asm volatile("s_waitcnt vmcnt(0)" ::: "memory"); }
    __syncthreads();
}
__device__ __forceinline__ void phase2(const Frame& F) {
    for (int u = F.gi; u < F.nb * 256; u += F.gs) kvt_unit(F, F.b0 * 256 + u);
    for (int u = F.gi; u < F.nb * 128; u += F.gs) memattn_unit(F, ua_ptr(F.ws, (F.b0 * 128 + u) >> 7), NA_, 3072, 3584, 0, F.b0 * 128 + u);
}
__device__ __forceinline__ void phase4(const Frame& F) { for (int u = F.gi; u < F.nb * 256; u += F.gs) ret_unit(F, F.b0 * 256 + u); }
__device__ __forceinline__ void phase5(const Frame& F) {
    if (NGRP == 2) late_acquire(F);
    const size_t rb = (size_t)F.b0 * S_;
    pg8::Gemm g{(const bf16_t*)ua_ptr(F.ws, F.b0) + rb * NA_ + 2048, (const bf16_t*)(F.ws + WS_WOUTA), F.nb * S_, D_, KO_, NA_}; pg8::StaticOrder S; S.init(F.nb * S_, D_, F.gs, F.gi);
    pg8::EpiOutA E{F.in[0] + rb * D_, F.out + rb * D_, x1b_ptr(F.ws, F.b0) + rb * D_, (float*)(F.ws + WS_SS1P) + rb * 16};
    pg8::gemm_phase<pg8::EpiOutA, pg8::StaticOrder, PG8_ALIGN, PG8_SP2>(F.lds, g, S, E);
}
__device__ __forceinline__ void phase6(const Frame& F) {
    const size_t rb = (size_t)F.b0 * S_;
    pg8::Gemm g{(const bf16_t*)x1b_ptr(F.ws, F.b0) + rb * D_, (const bf16_t*)(F.ws + WS_WB), F.nb * S_, NBW_, D_, D_}; pg8::StaticOrder S; S.init(F.nb * S_, NBW_, F.gs, F.gi);
    pg8::EpiB E{ub_ptr(F.ws, F.b0) + rb * NBW_, (const float*)(F.ws + WS_SS1P) + rb * 16};
    pg8::gemm_phase<pg8::EpiB, pg8::StaticOrder, PG8_ALIGN, PG8_SP2>(F.lds, g, S, E);
}
__device__ __forceinline__ void phase7(const Frame& F) {
    for (int u = F.gi; u < F.nb * 256; u += F.gs) { const int U = F.b0 * 256 + u; sb_unit(F, U >> 8, (U >> 5) & 7, U & 31); }
    for (int u = F.gi; u < F.nb * 128; u += F.gs) memattn_unit(F, ub_ptr(F.ws, (F.b0 * 128 + u) >> 7), NBW_, 4096, 4608, 1, F.b0 * 128 + u);
}
__device__ __forceinline__ void phase8(const Frame& F) {
    const size_t rb = (size_t)F.b0 * S_;
    pg8::Gemm g{(const bf16_t*)ub_ptr(F.ws, F.b0) + rb * NBW_ + 3072, (const bf16_t*)(F.ws + WS_WOUTB), F.nb * S_, D_, KO_, NBW_}; pg8::StaticOrder S; S.init(F.nb * S_, D_, F.gs, F.gi);
    pg8::EpiOutB E{F.out + rb * D_, (const bf16_t*)x1b_ptr(F.ws, F.b0) + rb * D_};
    pg8::gemm_phase<pg8::EpiOutB, pg8::StaticOrder, PG8_ALIGN, PG8_SP2>(F.lds, g, S, E);
}

__global__ void __launch_bounds__(NWAVES * 64, 2) mega(MArgs args) {
    extern __shared__ __attribute__((aligned(16))) unsigned char lds_raw[];
    Frame F;
    F.lds = (LAS unsigned char*)lds_raw; F.tid = threadIdx.x; F.lane = F.tid & 63; F.wave = __builtin_amdgcn_readfirstlane(F.tid >> 6); F.G = gridDim.x; F.bid = blockIdx.x;
    if (NGRP == 2 && (F.G & 15) == 0) { F.grp = (F.bid >> 3) & 1; F.gi = (F.bid & 7) + 8 * (F.bid >> 4); F.gs = F.G >> 1; F.b0 = F.grp; F.nb = 1; }
    else { F.grp = 0; F.gi = F.bid; F.gs = F.G; F.b0 = 0; F.nb = 2; }
#pragma unroll
    for (int i = 0; i < 16; ++i) F.in[i] = args.in[i];
    F.out = args.out; F.ws = args.ws;
    for (int u = F.tid; u < (LDS_BYTES - LDSCTL_OFF) / 4; u += NWAVES * 64) ((LAS unsigned*)(F.lds + LDSCTL_OFF))[u] = 0u;
    __syncthreads();
    unsigned* ctl = (unsigned*)(F.ws + WS_CTL);
    volatile LAS unsigned* lw = (volatile LAS unsigned*)(F.lds + LDSCTL_OFF);
    XcdBarrier barG = xcd_barrier_post(ctl + CW_BAR, lw + 8, (unsigned)F.G);
    XcdBarrier bar = xcd_barrier_post(ctl + CW_BAR + (1 + F.grp) * XCD_BAR_WORDS, lw + 12, (unsigned)F.gs);
#define PHB(call) do { call; xcd_barrier(bar); } while (0)
    p0_prologue(F); xcd_barrier(barG);
    if (NGRP == 2 && F.nb == 1 && F.grp == 1) { p0_late_weights(F); late_publish(F);
#ifdef GRP1_DELAY_US
        { const unsigned long long t0 = __builtin_amdgcn_s_memrealtime(); while (__builtin_amdgcn_s_memrealtime() - t0 < (unsigned long long)(GRP1_DELAY_US) * 100ull) __builtin_amdgcn_s_sleep(8); }
#endif
    }
    PHB(phase1(F));
    PHB(phase2(F));
    PHB(scan_phase(F));
    PHB(phase4(F));
    PHB(phase5(F));
    PHB(phase6(F));
    PHB(phase7(F));
    phase8(F);
#undef PHB
}

extern "C" void kernel_launch(void* const* d_in, const int* in_sizes, int n_in, void* d_out, int out_size, void* d_ws, size_t ws_size, hipStream_t stream) {
    static int grid = 0;
    if (grid == 0) {
        int dev = 0, cus = 0;
        if (hipGetDevice(&dev) != hipSuccess || hipDeviceGetAttribute(&cus, hipDeviceAttributeMultiprocessorCount, dev) != hipSuccess) { grid = -1; return; }
        if (hipFuncSetAttribute((const void*)mega, hipFuncAttributeMaxDynamicSharedMemorySize, LDS_BYTES) != hipSuccess) { grid = -1; return; }
        (void)hipGetLastError();
        grid = cus;
    }
    if (grid < 0) return;
    unsigned char* ws = (unsigned char*)d_ws;
    (void)hipMemsetAsync(ws + WS_CTL, 0, CTL_ZERO_BYTES, stream);
    MArgs a{};
    for (int i = 0; i < 16; ++i) a.in[i] = (const float*)d_in[i];
    a.out = (float*)d_out; a.ws = ws; a.ph_lo = 0; a.ph_hi = 9; a.li = 0; a.pad = 0;
    hipLaunchKernelGGL(mega, dim3(grid), dim3(NWAVES * 64), LDS_BYTES, stream, a);
}
```

```cpp
#include <hip/hip_runtime.h>
#include <stdint.h>

typedef unsigned short bf16_t;

constexpr int NB_ = 2, S_ = 8192, T_ = NB_ * S_, D_ = 1024;
constexpr int NA_ = 4096, NBW_ = 5120, KO_ = 1536;
constexpr float EPS_ = 1e-6f;
constexpr float QK_SCALE = 0.08838834764831845f;

constexpr size_t MiB = 1u << 20;
constexpr size_t WS_CTL = 0;
constexpr size_t WS_WINA = 1 * MiB;
constexpr size_t WS_WOUTA = 9 * MiB;
constexpr size_t WS_WB = 12 * MiB;
constexpr size_t WS_WOUTB = 22 * MiB;
constexpr size_t WS_MEMK = 25 * MiB;
constexpr size_t WS_MEMV = 26 * MiB;
constexpr size_t WS_RS0 = 27 * MiB;
constexpr size_t WS_SS1P = 28 * MiB;
#ifndef NGRP
#define NGRP 2
#endif
#if NGRP == 2
constexpr size_t WS_BSTRIDE = 96 * MiB;
constexpr size_t WS_UA = 30 * MiB, WS_UA_STRIDE = WS_BSTRIDE, WS_UB = 30 * MiB, WS_UB_STRIDE = WS_BSTRIDE, WS_KVT = 94 * MiB, WS_KVT_STRIDE = WS_BSTRIDE, WS_X1B = 110 * MiB, WS_X1B_STRIDE = WS_BSTRIDE;
#else
constexpr size_t WS_UA = 30 * MiB, WS_UA_STRIDE = 64 * MiB, WS_UB = 30 * MiB, WS_UB_STRIDE = 80 * MiB, WS_KVT = 158 * MiB, WS_KVT_STRIDE = 16 * MiB, WS_X1B = 190 * MiB, WS_X1B_STRIDE = 16 * MiB;
#endif
__device__ __forceinline__ bf16_t* ua_ptr(unsigned char* ws, int b) { return (bf16_t*)(ws + WS_UA + (size_t)b * WS_UA_STRIDE) - (size_t)b * S_ * NA_; }
__device__ __forceinline__ bf16_t* ub_ptr(unsigned char* ws, int b) { return (bf16_t*)(ws + WS_UB + (size_t)b * WS_UB_STRIDE) - (size_t)b * S_ * NBW_; }
__device__ __forceinline__ bf16_t* kvt_ptr(unsigned char* ws, int b) { return (bf16_t*)(ws + WS_KVT + (size_t)b * WS_KVT_STRIDE) - (size_t)b * 256 * 32768; }
__device__ __forceinline__ bf16_t* x1b_ptr(unsigned char* ws, int b) { return (bf16_t*)(ws + WS_X1B + (size_t)b * WS_X1B_STRIDE) - (size_t)b * S_ * D_; }


__device__ __forceinline__ float bf2f(bf16_t v) { return __uint_as_float(((unsigned)v) << 16); }
__device__ __forceinline__ bf16_t f2bf(float f) { unsigned u = __float_as_uint(f); u += 0x7fffu + ((u >> 16) & 1u); return (bf16_t)(u >> 16); }

__device__ __forceinline__ void rot_sincos(float ang, float& s, float& c) {
    const float n = rintf(ang * 0.15915494309189535f);
    float r = fmaf(-n, 6.28318548202514648f, ang);
    r = fmaf(-n, -1.74845553e-7f, r);
    const float rev = r * 0.15915494309189535f;
    s = __builtin_amdgcn_sinf(rev); c = __builtin_amdgcn_cosf(rev);
}
__device__ __forceinline__ float rope_inv_freq(int i) { return exp2f(-(float)i * 0.20762050593046014f); }

__device__ __forceinline__ int permA_src(int n) {
    if (n >= 1024) return n;
    const int tile = n >> 8, c = n & 255, bj = c >> 7, p = c & 127, hit = p >> 6, i = p & 63;
    return tile * 256 + hit * 128 + bj * 64 + i;
}

namespace pg8 {
#define PG8_LAS __attribute__((address_space(3)))
typedef unsigned short bf16_t;
typedef short bf16x8 __attribute__((ext_vector_type(8)));
typedef float f32x4 __attribute__((ext_vector_type(4)));
typedef unsigned u32x4 __attribute__((ext_vector_type(4)));
constexpr int BM = 256, BK = 64, HALF = 128, HTB = HALF * BK * 2  , STAGE_BYTES = 8 * HTB, NXCD = 8, WGM = 4;

__host__ __device__ __forceinline__ int lds_byte(int r, int c) { const int st = (r >> 4) * 2 + (c >> 5), rr = r & 15, cc = c & 31, ob = rr * 64 + cc * 2; return st * 1024 + (ob ^ (((ob >> 9) & 1) << 5)); }
__host__ __device__ __forceinline__ void stage_rc(int b, int& R, int& C) { const int st = b / 1024, sb = b % 1024, swz = sb ^ (((sb >> 9) & 1) << 5); R = (st >> 1) * 16 + swz / 64; C = (st & 1) * 32 + (swz % 64) / 2; }
__host__ __device__ __forceinline__ int perm32(int rho) { const int n = rho >> 4, i = rho & 15; return 8 * (i >> 2) + 4 * n + (i & 3); }

struct Unit { int pm, pn; };
struct Gemm { const bf16_t* A; const bf16_t* Bt; int M, N, K, lda; };

struct StaticOrder {
    int nM, nN, nwg, G, c;
    __host__ __device__ void init(int M, int N, int G_, int c_) { nM = M / BM; nN = N / BM; nwg = nM * nN; G = G_; c = c_; }
    __host__ __device__ bool next(int i, Unit& u) const {
        const long L = (long)i * G + c; if (L >= nwg) return false;
        int wgid = (int)L; { const int q = nwg / NXCD, r = nwg % NXCD, xcd = wgid % NXCD, off = wgid / NXCD; wgid = (xcd < r ? xcd * (q + 1) : r * (q + 1) + (xcd - r) * q) + off; }
        const int nig = WGM * nN, gid = wgid / nig, fm = gid * WGM, gsz = (nM - fm) < WGM ? (nM - fm) : WGM;
        u.pm = fm + ((wgid % nig) % gsz); u.pn = (wgid % nig) / gsz; return true;
    }
    __device__ __forceinline__ void a_ready(const Unit&) const {}
    __device__ __forceinline__ void done(const Unit&) const {}
};

typedef __bf16 bf16x2_hw __attribute__((ext_vector_type(2)));
typedef float f32x2_hw __attribute__((ext_vector_type(2)));
__device__ __forceinline__ unsigned cvt_pk_bf16_safe(float lo, float hi) { const f32x2_hw v = {lo, hi}; return __builtin_bit_cast(unsigned, __builtin_convertvector(v, bf16x2_hw)); }
__device__ __forceinline__ unsigned cvt_pk_bf16(float lo, float hi) { unsigned r; asm volatile("v_cvt_pk_bf16_f32 %0, %1, %2" : "=v"(r) : "v"(lo), "v"(hi)); return r; }
__device__ __forceinline__ float silu_fast(float v) { return v * __builtin_amdgcn_rcpf(1.0f + __builtin_amdgcn_exp2f(-1.4426950408889634f * v)); }
__device__ __forceinline__ u32x4 pack8_safe(const f32x4 a, const f32x4 b) { u32x4 w; w.x = cvt_pk_bf16_safe(a[0], a[1]); w.y = cvt_pk_bf16_safe(a[2], a[3]); w.z = cvt_pk_bf16_safe(b[0], b[1]); w.w = cvt_pk_bf16_safe(b[2], b[3]); return w; }
__device__ __forceinline__ u32x4 pack8(const f32x4 a, const f32x4 b) { u32x4 w; w.x = cvt_pk_bf16(a[0], a[1]); w.y = cvt_pk_bf16(a[2], a[3]); w.z = cvt_pk_bf16(b[0], b[1]); w.w = cvt_pk_bf16(b[2], b[3]); return w; }

struct EpiA {
    static constexpr bool PERM = true, AFTER_DRAIN = false, ACC_INIT = false;
    bf16_t* U; const float* rs0; const int* pos;
    __device__ __forceinline__ void operator()(const f32x4 (&acc)[2][2][4][2], const Unit& u, int wr, int wc, int fr, int fq) const {
        const int row0 = u.pm * BM + wr * 64 + fr;
        if (u.pn < 4) {
            const int hit = wc >> 1, i0 = 32 * (wc & 1) + 8 * fq; const float sc = u.pn >= 2 ? QK_SCALE : 1.0f;
            float inv[8];
#pragma unroll
            for (int j = 0; j < 8; ++j) inv[j] = rope_inv_freq(i0 + j);
#pragma unroll
            for (int ai = 0; ai < 2; ++ai)
#pragma unroll
                for (int m = 0; m < 4; ++m) { const int row = row0 + ai * HALF + m * 16; const float rs = rs0[row] * sc, pf = (float)pos[row];
                    bf16_t* up = U + (size_t)row * NA_ + u.pn * BM + hit * 128 + i0;
                    f32x4 o1[2], o2[2];
#pragma unroll
                    for (int n = 0; n < 2; ++n)
#pragma unroll
                        for (int e = 0; e < 4; ++e) { float sn, cs; rot_sincos(pf * inv[4 * n + e], sn, cs); const float x1 = acc[ai][0][m][n][e] * rs, x2 = acc[ai][1][m][n][e] * rs;
                            o1[n][e] = x1 * cs - x2 * sn; o2[n][e] = x1 * sn + x2 * cs; }
                    *(u32x4*)up = pack8(o1[0], o1[1]); *(u32x4*)(up + 64) = pack8(o2[0], o2[1]); }
        } else {
            const bool silu = (u.pn >= 8 && u.pn < 12) || u.pn >= 14;
#pragma unroll
            for (int ai = 0; ai < 2; ++ai)
#pragma unroll
                for (int m = 0; m < 4; ++m) { const int row = row0 + ai * HALF + m * 16; const float rs = rs0[row]; bf16_t* rowp = U + (size_t)row * NA_ + u.pn * BM + wc * 32 + 8 * fq;
#pragma unroll
                    for (int bj = 0; bj < 2; ++bj) { f32x4 v0 = acc[ai][bj][m][0] * rs, v1 = acc[ai][bj][m][1] * rs;
                        if (silu) {
#pragma unroll
                            for (int e = 0; e < 4; ++e) { v0[e] = silu_fast(v0[e]); v1[e] = silu_fast(v1[e]); } }
                        *(u32x4*)(rowp + bj * HALF) = pack8(v0, v1); } }
        }
    }
};
struct EpiOutA {
    static constexpr bool PERM = true, AFTER_DRAIN = false, ACC_INIT = true;
    const float* xres; float* out; bf16_t* x1b; float* ss1p;
    __device__ __forceinline__ void init(f32x4 (&acc)[2][2][4][2], const Unit& u, int wr, int wc, int fr, int fq) const {
        const int row0 = u.pm * BM + wr * 64 + fr;
#pragma unroll
        for (int ai = 0; ai < 2; ++ai)
#pragma unroll
            for (int m = 0; m < 4; ++m) { const size_t off = (size_t)(row0 + ai * HALF + m * 16) * D_ + u.pn * BM + wc * 32 + 8 * fq;
#pragma unroll
                for (int bj = 0; bj < 2; ++bj) { acc[ai][bj][m][0] = *(const f32x4*)(xres + off + bj * HALF); acc[ai][bj][m][1] = *(const f32x4*)(xres + off + bj * HALF + 4); } }
    }
    __device__ __forceinline__ void operator()(const f32x4 (&acc)[2][2][4][2], const Unit& u, int wr, int wc, int fr, int fq) const {
        const int row0 = u.pm * BM + wr * 64 + fr;
#pragma unroll
        for (int ai = 0; ai < 2; ++ai)
#pragma unroll
            for (int m = 0; m < 4; ++m) { const int row = row0 + ai * HALF + m * 16; const size_t off = (size_t)row * D_ + u.pn * BM + wc * 32 + 8 * fq; float ssq = 0.f;
#pragma unroll
                for (int bj = 0; bj < 2; ++bj) { const f32x4 v0 = acc[ai][bj][m][0], v1 = acc[ai][bj][m][1];
                    *(u32x4*)(x1b + off + bj * HALF) = pack8_safe(v0, v1);
                    ssq += (v0[0] * v0[0] + v0[1] * v0[1]) + (v0[2] * v0[2] + v0[3] * v0[3]) + (v1[0] * v1[0] + v1[1] * v1[1]) + (v1[2] * v1[2] + v1[3] * v1[3]); }
                ssq += __shfl_xor(ssq, 16); ssq += __shfl_xor(ssq, 32);
                if (fq == 0) ss1p[(size_t)row * 16 + u.pn * 4 + wc] = ssq; }
    }
};
struct EpiB {
    static constexpr bool PERM = true, AFTER_DRAIN = false, ACC_INIT = false;
    bf16_t* U; const float* ss1p;
    __device__ __forceinline__ void operator()(const f32x4 (&acc)[2][2][4][2], const Unit& u, int wr, int wc, int fr, int fq) const {
        const int row0 = u.pm * BM + wr * 64 + fr; const bool silu = (u.pn >= 8 && u.pn < 12) || u.pn >= 18; const float sc = (u.pn >= 12 && u.pn < 16) ? QK_SCALE * 1.4426950408889634f : 1.0f;
#pragma unroll
        for (int ai = 0; ai < 2; ++ai)
#pragma unroll
            for (int m = 0; m < 4; ++m) { const int row = row0 + ai * HALF + m * 16; const f32x4 pv = *(const f32x4*)(ss1p + (size_t)row * 16 + 4 * fq);
                float s = (pv[0] + pv[1]) + (pv[2] + pv[3]); s += __shfl_xor(s, 16); s += __shfl_xor(s, 32);
                const float rs = sc / sqrtf(s * (1.0f / D_) + EPS_); bf16_t* rowp = U + (size_t)row * NBW_ + u.pn * BM + wc * 32 + 8 * fq;
#pragma unroll
                for (int bj = 0; bj < 2; ++bj) { f32x4 v0 = acc[ai][bj][m][0] * rs, v1 = acc[ai][bj][m][1] * rs;
                    if (silu) {
#pragma unroll
                        for (int e = 0; e < 4; ++e) { v0[e] = silu_fast(v0[e]); v1[e] = silu_fast(v1[e]); } }
                    *(u32x4*)(rowp + bj * HALF) = pack8(v0, v1); } }
    }
};
struct EpiOutB {
    static constexpr bool PERM = false, AFTER_DRAIN = false, ACC_INIT = true;
    float* out; const bf16_t* x1b;
    __device__ __forceinline__ void init(f32x4 (&acc)[2][2][4][2], const Unit& u, int wr, int wc, int fr, int fq) const {
        const int row0 = u.pm * BM + wr * 64 + fr;
#pragma unroll
        for (int ai = 0; ai < 2; ++ai)
#pragma unroll
            for (int m = 0; m < 4; ++m) { const size_t off = (size_t)(row0 + ai * HALF + m * 16) * D_ + u.pn * BM + wc * 32 + 4 * fq;
#pragma unroll
                for (int bj = 0; bj < 2; ++bj)
#pragma unroll
                    for (int n = 0; n < 2; ++n) { const unsigned long long w = *(const unsigned long long*)(x1b + off + bj * HALF + n * 16); const unsigned lo = (unsigned)w, hi = (unsigned)(w >> 32);
                        acc[ai][bj][m][n] = (f32x4){__uint_as_float(lo << 16), __uint_as_float(lo & 0xffff0000u), __uint_as_float(hi << 16), __uint_as_float(hi & 0xffff0000u)}; } }
    }
    __device__ __forceinline__ void operator()(const f32x4 (&acc)[2][2][4][2], const Unit& u, int wr, int wc, int fr, int fq) const {
        const int row0 = u.pm * BM + wr * 64 + fr;
#pragma unroll
        for (int ai = 0; ai < 2; ++ai)
#pragma unroll
            for (int m = 0; m < 4; ++m) { const size_t off = (size_t)(row0 + ai * HALF + m * 16) * D_ + u.pn * BM + wc * 32 + 4 * fq;
#pragma unroll
                for (int bj = 0; bj < 2; ++bj)
#pragma unroll
                    for (int n = 0; n < 2; ++n) *(f32x4*)(out + off + bj * HALF + n * 16) = acc[ai][bj][m][n]; }
    }
};

struct EpiNull {
    static constexpr bool PERM = true, AFTER_DRAIN = false, ACC_INIT = false;
    float* sink;
    __device__ __forceinline__ void operator()(const f32x4 (&acc)[2][2][4][2], const Unit& u, int wr, int wc, int fr, int fq) const {
        f32x4 s = (f32x4){0.f, 0.f, 0.f, 0.f};
#pragma unroll
        for (int ai = 0; ai < 2; ++ai)
#pragma unroll
            for (int bj = 0; bj < 2; ++bj)
#pragma unroll
                for (int m = 0; m < 4; ++m) s += acc[ai][bj][m][0] + acc[ai][bj][m][1];
        const float t = (s[0] + s[1]) + (s[2] + s[3]);
        if (t == 1.2345678e33f) sink[0] = t;
    }
};
template <class Epi, class Sched, bool ALIGN_EPI = false, bool SP2 = false>
__device__ __forceinline__ void gemm_phase(PG8_LAS unsigned char* lds, const Gemm g, const Sched& S, const Epi& E) {
    const int tid = threadIdx.x, wid = __builtin_amdgcn_readfirstlane(tid >> 6), lane = tid & 63, wr = wid >> 2, wc = wid & 3, fr = lane & 15, fq = lane >> 4;
    const int K = g.K, nt = K / BK;
    unsigned voffA[2], voffB[2];
#pragma unroll
    for (int i = 0; i < 2; ++i) { int R, C; stage_rc(tid * 16 + i * 8192, R, C); const int Rb = Epi::PERM ? ((R & ~31) + perm32(R & 31)) : R;
        voffA[i] = (unsigned)(R * g.lda + C) * 2u; voffB[i] = (unsigned)(Rb * K + C) * 2u; }
    const size_t kstep = (size_t)(BK * 2);
    const size_t hstepA = (size_t)HALF * g.lda * 2, hstepB = (size_t)HALF * K * 2;
    const size_t tstepA = 2 * hstepA, tstepB = 2 * hstepB;
    const unsigned ldsw = (unsigned)wid * 1024u;
    const int aoff = lds_byte(wr * 64 + fr, fq * 8), boff = lds_byte(wc * 32 + fr, fq * 8);
#define PG8_SA(b, h) (((b) * 2 + (h)) * HTB)
#define PG8_SB(b, h) ((4 + (b) * 2 + (h)) * HTB)
#define PG8_STAGE(bufoff, gbase, voff) do { _Pragma("unroll") for (int _i = 0; _i < 2; ++_i) \
        __builtin_amdgcn_global_load_lds((const unsigned*)((const char*)(gbase) + (voff)[_i]), (PG8_LAS unsigned*)(lds + (bufoff) + ldsw + _i * 8192), 16, 0, 0); } while (0)
#define PG8_LDA(dst, b, h) do { _Pragma("unroll") for (int m = 0; m < 4; ++m) _Pragma("unroll") for (int k = 0; k < 2; ++k) dst[m][k] = *(const PG8_LAS bf16x8*)(lds + PG8_SA(b, h) + aoff + m * 2048 + k * 1024); } while (0)
#define PG8_LDB(dst, b, h) do { _Pragma("unroll") for (int n = 0; n < 2; ++n) _Pragma("unroll") for (int k = 0; k < 2; ++k) dst[n][k] = *(const PG8_LAS bf16x8*)(lds + PG8_SB(b, h) + boff + n * 2048 + k * 1024); } while (0)
#define PG8_MMA(ai, bj, At, Bt) do { __builtin_amdgcn_s_setprio(1); _Pragma("unroll") for (int m = 0; m < 4; ++m) _Pragma("unroll") for (int n = 0; n < 2; ++n) _Pragma("unroll") for (int k = 0; k < 2; ++k) \
        acc[ai][bj][m][n] = __builtin_amdgcn_mfma_f32_16x16x32_bf16(Bt[n][k], At[m][k], acc[ai][bj][m][n], 0, 0, 0); __builtin_amdgcn_s_setprio(0); } while (0)
#define PG8_WAIT_V(n) asm volatile("s_waitcnt vmcnt(" #n ")" ::: "memory")
#define PG8_WAIT_L(n) asm volatile("s_waitcnt lgkmcnt(" #n ")" ::: "memory")
#define PG8_BAR __builtin_amdgcn_s_barrier()
#define PG8_SCHED __builtin_amdgcn_sched_barrier(0)
    Unit cur, nxt; int ui = 0;
    if (!S.next(0, cur)) return;
    f32x4 acc[2][2][4][2];
#pragma unroll
    for (int a = 0; a < 2; ++a)
#pragma unroll
        for (int b = 0; b < 2; ++b)
#pragma unroll
            for (int m = 0; m < 4; ++m)
#pragma unroll
                for (int n = 0; n < 2; ++n) acc[a][b][m][n] = (f32x4){0.f, 0.f, 0.f, 0.f};
    if constexpr (Epi::ACC_INIT) E.init(acc, cur, wr, wc, fr, fq);
    bf16x8 At[4][2], B0[2][2], B1[2][2];
    const char* cA = (const char*)g.A + (size_t)cur.pm * tstepA; const char* cB = (const char*)g.Bt + (size_t)cur.pn * tstepB;
    S.a_ready(cur);
    if constexpr (SP2) {
        PG8_STAGE(PG8_SB(0, 0), cB, voffB); PG8_STAGE(PG8_SB(0, 1), cB + hstepB, voffB); PG8_STAGE(PG8_SA(0, 0), cA, voffA); PG8_STAGE(PG8_SA(0, 1), cA + hstepA, voffA);
        if (wr == 1) PG8_BAR;
        PG8_WAIT_V(2); PG8_BAR;
        PG8_STAGE(PG8_SB(1, 0), cB + kstep, voffB); PG8_STAGE(PG8_SA(1, 0), cA + kstep, voffA); PG8_STAGE(PG8_SB(1, 1), cB + hstepB + kstep, voffB);
        PG8_WAIT_V(6); PG8_BAR;
    } else {
        PG8_STAGE(PG8_SB(0, 0), cB, voffB); PG8_STAGE(PG8_SA(0, 0), cA, voffA); PG8_STAGE(PG8_SB(0, 1), cB + hstepB, voffB); PG8_STAGE(PG8_SA(0, 1), cA + hstepA, voffA);
        if (wr == 1) PG8_BAR;
        PG8_WAIT_V(4); PG8_BAR;
        PG8_STAGE(PG8_SB(1, 0), cB + kstep, voffB); PG8_STAGE(PG8_SA(1, 0), cA + kstep, voffA); PG8_STAGE(PG8_SB(1, 1), cB + hstepB + kstep, voffB);
        PG8_WAIT_V(6); PG8_BAR;
    }
    for (;;) {
        const bool has_next = S.next(ui + 1, nxt);
        const char* nA = has_next ? (const char*)g.A + (size_t)nxt.pm * tstepA : cA; const char* nB = has_next ? (const char*)g.Bt + (size_t)nxt.pn * tstepB : cB;
        for (int t = 0; t < nt; t += 2) {
            const bool last = (t == nt - 2);
            const char* a1 = cA + (size_t)(t + 1) * kstep;
            const char* a2 = last ? nA : cA + (size_t)(t + 2) * kstep; const char* b2 = last ? nB : cB + (size_t)(t + 2) * kstep;
            const char* a3 = a2 + kstep; const char* b3 = b2 + kstep;
            if (last && has_next) S.a_ready(nxt);
            if constexpr (SP2) {
            PG8_LDB(B0, 0, 0); PG8_LDB(B1, 0, 1); PG8_SCHED; PG8_LDA(At, 0, 0); PG8_STAGE(PG8_SA(1, 1), a1 + hstepA, voffA);
            PG8_WAIT_V(8); PG8_WAIT_L(0); PG8_BAR; PG8_MMA(0, 0, At, B0); PG8_MMA(0, 1, At, B1); PG8_BAR; PG8_SCHED;
            PG8_LDA(At, 0, 1); PG8_STAGE(PG8_SB(0, 0), b2, voffB); PG8_STAGE(PG8_SB(0, 1), b2 + hstepB, voffB); PG8_STAGE(PG8_SA(0, 0), a2, voffA);
            PG8_WAIT_V(8); PG8_WAIT_L(0); PG8_BAR; PG8_MMA(1, 0, At, B0); PG8_MMA(1, 1, At, B1); PG8_BAR; PG8_SCHED;
            PG8_LDB(B0, 1, 0); PG8_LDB(B1, 1, 1); PG8_SCHED; PG8_LDA(At, 1, 0); PG8_STAGE(PG8_SA(0, 1), a2 + hstepA, voffA);
            PG8_WAIT_V(8); PG8_WAIT_L(0); PG8_BAR; PG8_MMA(0, 0, At, B0); PG8_MMA(0, 1, At, B1); PG8_BAR; PG8_SCHED;
            PG8_LDA(At, 1, 1); PG8_STAGE(PG8_SB(1, 0), b3, voffB); PG8_STAGE(PG8_SB(1, 1), b3 + hstepB, voffB); PG8_STAGE(PG8_SA(1, 0), a3, voffA);
            PG8_WAIT_V(8); PG8_WAIT_L(0); PG8_BAR; PG8_MMA(1, 0, At, B0); PG8_MMA(1, 1, At, B1); PG8_BAR; PG8_SCHED;
            } else {
            PG8_LDB(B0, 0, 0); PG8_SCHED; PG8_LDA(At, 0, 0); PG8_STAGE(PG8_SA(1, 1), a1 + hstepA, voffA);
            PG8_WAIT_L(8); PG8_BAR; PG8_WAIT_L(0); PG8_MMA(0, 0, At, B0); PG8_BAR; PG8_SCHED;
            PG8_LDB(B1, 0, 1); PG8_STAGE(PG8_SB(0, 0), b2, voffB);
            PG8_BAR; PG8_WAIT_L(0); PG8_MMA(0, 1, At, B1); PG8_BAR;
            PG8_LDA(At, 0, 1); PG8_STAGE(PG8_SA(0, 0), a2, voffA);
            PG8_BAR; PG8_WAIT_L(0); PG8_MMA(1, 0, At, B0); PG8_BAR; PG8_SCHED;
            PG8_STAGE(PG8_SB(0, 1), b2 + hstepB, voffB);
            PG8_WAIT_V(6); PG8_BAR; PG8_MMA(1, 1, At, B1); PG8_BAR;
            PG8_LDB(B0, 1, 0); PG8_SCHED; PG8_LDA(At, 1, 0); PG8_STAGE(PG8_SA(0, 1), a2 + hstepA, voffA);
            PG8_WAIT_L(8); PG8_BAR; PG8_WAIT_L(0); PG8_MMA(0, 0, At, B0); PG8_BAR; PG8_SCHED;
            PG8_LDB(B1, 1, 1); PG8_STAGE(PG8_SB(1, 0), b3, voffB);
            PG8_BAR; PG8_WAIT_L(0); PG8_MMA(0, 1, At, B1); PG8_BAR;
            PG8_LDA(At, 1, 1); PG8_STAGE(PG8_SA(1, 0), a3, voffA);
            PG8_BAR; PG8_WAIT_L(0); PG8_MMA(1, 0, At, B0); PG8_BAR; PG8_SCHED;
            PG8_STAGE(PG8_SB(1, 1), b3 + hstepB, voffB);
            PG8_WAIT_V(6); PG8_BAR; PG8_MMA(1, 1, At, B1); PG8_BAR;
            }
        }
        if constexpr (ALIGN_EPI) { if (wr == 0) PG8_BAR; }
        if constexpr (!Epi::AFTER_DRAIN) { E(acc, cur, wr, wc, fr, fq); S.done(cur); }
        if (!has_next) break;
#pragma unroll
        for (int a = 0; a < 2; ++a)
#pragma unroll
            for (int b = 0; b < 2; ++b)
#pragma unroll
                for (int m = 0; m < 4; ++m)
#pragma unroll
                    for (int n = 0; n < 2; ++n) acc[a][b][m][n] = (f32x4){0.f, 0.f, 0.f, 0.f};
        cur = nxt; cA = nA; cB = nB; ++ui;
        if constexpr (Epi::ACC_INIT) E.init(acc, cur, wr, wc, fr, fq);
        if constexpr (ALIGN_EPI) { if (wr == 1) PG8_BAR; }
    }
    PG8_WAIT_V(0);
    if constexpr (!ALIGN_EPI) { if (wr == 0) PG8_BAR; }
    PG8_BAR;
    if constexpr (Epi::AFTER_DRAIN) { E.fused(acc, cur, wr, wc, fr, fq, lds, wid, lane); S.done(cur); }
#undef PG8_SA
#undef PG8_SB
#undef PG8_STAGE
#undef PG8_LDA
#undef PG8_LDB
#undef PG8_MMA
#undef PG8_WAIT_V
#undef PG8_WAIT_L
#undef PG8_BAR
#undef PG8_SCHED
}
}

#define LAS __attribute__((address_space(3)))
#define XB_TMO      128
#define XB_XCNT(j)  (256  + 64 * (j))
#define XB_XSUB(j)  (1280 + 64 * (j))
#define XB_XGEN(j)  (2304 + 64 * (j))
#define XB_TOP      3328
#define XB_TOPGEN   3392
#define XCD_BAR_WORDS 3456
#define XB_SPIN_CAP (1u << 18)

__device__ __forceinline__ unsigned xb_ld(unsigned* p)              { return __hip_atomic_load(p, __ATOMIC_RELAXED, __HIP_MEMORY_SCOPE_AGENT); }
__device__ __forceinline__ unsigned xb_add(unsigned* p, unsigned v) { return __hip_atomic_fetch_add(p, v, __ATOMIC_RELAXED, __HIP_MEMORY_SCOPE_AGENT); }
__device__ __forceinline__ unsigned xb_xcc_id() { return (unsigned)__builtin_amdgcn_s_getreg((3 << 11) | 20) & 0xFu; }
#define XB_SPIN(cond, bar) do { unsigned _sp = 0; while (cond) { __builtin_amdgcn_s_sleep(1); \
    if ((++_sp & 255u) == 0u) { if (xb_ld(&(bar)[XB_TMO])) break; if (_sp > XB_SPIN_CAP) { atomicAdd(&(bar)[XB_TMO], 1u); break; } } } } while (0)

struct XcdBarrier {
    unsigned* bar; unsigned x; unsigned G;
    volatile LAS unsigned* st;
};

__device__ __forceinline__ XcdBarrier xcd_barrier_post(unsigned* bar, volatile LAS unsigned* st, unsigned G) {
    XcdBarrier b; b.bar = bar; b.x = xb_xcc_id(); b.st = st; b.G = G;
    if (threadIdx.x == 0) (void)xb_add(&bar[XB_XCNT(b.x)], 1u);
    return b;
}
__device__ __forceinline__ void xcd_barrier_complete(unsigned* bar, unsigned x, unsigned G, unsigned& nloc, unsigned& nx) {
    unsigned sum, cnt, mine, sp = 0u;
    for (;;) {
        sum = 0u; cnt = 0u; mine = 0u;
#pragma unroll
        for (unsigned j = 0; j < 16; ++j) { const unsigned c = xb_ld(&bar[XB_XCNT(j)]); sum += c; cnt += (c > 0u) ? 1u : 0u; mine = (j == x) ? c : mine; }
        if (sum == G) break;
        __builtin_amdgcn_s_sleep(1);
        if ((++sp & 255u) == 0u) { if (xb_ld(&bar[XB_TMO])) break; if (sp > XB_SPIN_CAP) { atomicAdd(&bar[XB_TMO], 1u); break; } }
    }
    nloc = mine > 0u ? mine : 1u; nx = cnt > 0u ? cnt : 1u;
}

__device__ __forceinline__ void xcd_barrier(const XcdBarrier& b) {
    asm volatile("s_waitcnt vmcnt(0)" ::: "memory");
    __syncthreads();
    if (threadIdx.x == 0) {
        unsigned* bar = b.bar;
        __builtin_amdgcn_s_waitcnt(0);
        unsigned nloc = b.st[0], nx = b.st[1];
        if (nloc == 0u) { xcd_barrier_complete(bar, b.x, b.G, nloc, nx); b.st[0] = nloc; b.st[1] = nx; }
        const unsigned old = xb_add(&bar[XB_XSUB(b.x)], 1u);
        const unsigned gen = old / nloc;
        if (old + 1u == (gen + 1u) * nloc) {
            __builtin_amdgcn_fence(__ATOMIC_RELEASE, "agent");
            asm volatile("s_waitcnt vmcnt(0)" ::: "memory");
            const unsigned og = xb_add(&bar[XB_TOP], 1u);
            const unsigned tg = og / nx;
            if (og + 1u == (tg + 1u) * nx) xb_add(&bar[XB_TOPGEN], 1u);
            else XB_SPIN(xb_ld(&bar[XB_TOPGEN]) == tg, bar);
            __builtin_amdgcn_fence(__ATOMIC_ACQUIRE, "agent");
            xb_add(&bar[XB_XGEN(b.x)], 1u);
            asm volatile("s_waitcnt vmcnt(0)" ::: "memory");
        } else {
            XB_SPIN(xb_ld(&bar[XB_XGEN(b.x)]) == gen, bar);
            __builtin_amdgcn_fence(__ATOMIC_ACQUIRE, "agent");
            asm volatile("s_waitcnt vmcnt(0)" ::: "memory");
        }
    }
    __syncthreads();
}

constexpr int NWAVES = 8;
constexpr int RING_BYTES = 131072;
constexpr int LDSCTL_OFF = 139264;
constexpr int LDS_BYTES = 147456;
constexpr int CW_BAR = 4096;
constexpr size_t CTL_ZERO_BYTES = 131072;
#ifndef OPT_MASK
#define OPT_MASK 0x1FF
#endif

typedef float f32x4 __attribute__((ext_vector_type(4)));
typedef unsigned u32x4v __attribute__((ext_vector_type(4)));
typedef unsigned u32x2v __attribute__((ext_vector_type(2)));
typedef short bf16x8 __attribute__((ext_vector_type(8)));
#define LDS_WAIT() asm volatile("s_waitcnt lgkmcnt(0)" ::: "memory")

struct MArgs { const float* in[16]; float* out; unsigned char* ws; int ph_lo, ph_hi, li, pad; };
struct Frame { LAS unsigned char* lds; int tid, lane, wave, G, bid, grp, gi, gs, b0, nb; const float* in[16]; float* out; unsigned char* ws; };
#ifndef NGRP
#define NGRP 2
#endif
#ifndef LATE_G0
#define LATE_G0 0
#endif
constexpr int CW_LATE = 64;

__device__ __forceinline__ unsigned pk2(float lo, float hi) { return pg8::cvt_pk_bf16(lo, hi); }
__device__ __forceinline__ float wave_sum(float v) {
#pragma unroll
    for (int o = 1; o < 64; o <<= 1) v += __shfl_xor(v, o);
    return v;
}

template <int NR> __device__ __forceinline__ void p0_x_rows(const float* x, bf16_t* xb, float* rs, int row, int lane) {
    f32x4 v[NR][4]; float s[NR];
#pragma unroll
    for (int r = 0; r < NR; ++r) { const f32x4* xr = (const f32x4*)(x + (size_t)(row + r) * D_) + lane;
#pragma unroll
        for (int j = 0; j < 4; ++j) v[r][j] = xr[64 * j]; }
#pragma unroll
    for (int r = 0; r < NR; ++r) { s[r] = 0.f;
#pragma unroll
        for (int j = 0; j < 4; ++j) s[r] += (v[r][j][0] * v[r][j][0] + v[r][j][1] * v[r][j][1]) + (v[r][j][2] * v[r][j][2] + v[r][j][3] * v[r][j][3]); }
#pragma unroll
    for (int o = 1; o < 64; o <<= 1)
#pragma unroll
        for (int r = 0; r < NR; ++r) s[r] += __shfl_xor(s[r], o);
#pragma unroll
    for (int r = 0; r < NR; ++r) { u32x2v* o8 = (u32x2v*)(xb + (size_t)(row + r) * D_) + lane;
#pragma unroll
        for (int j = 0; j < 4; ++j) { u32x2v w; w.x = pk2(v[r][j][0], v[r][j][1]); w.y = pk2(v[r][j][2], v[r][j][3]); o8[64 * j] = w; }
        if (lane == 0) rs[row + r] = 1.0f / sqrtf(s[r] * (1.0f / D_) + EPS_); }
}
constexpr int TSCR_BYTES = 64 * 65 * 4;
__device__ __forceinline__ void p0_transpose_item(const float* W, int ldw, int csrc, const float* gain, int gmask, bf16_t* WT, int K, int nrow, int k0, LAS float* scr, int lane) {
    const int kk = lane >> 4, nq = lane & 15;
    f32x4 v[16];
#pragma unroll
    for (int j = 0; j < 16; ++j) v[j] = *(const f32x4*)(W + (size_t)(k0 + 4 * j + kk) * ldw + csrc + 4 * nq);
#pragma unroll
    for (int j = 0; j < 16; ++j) { const int k = 4 * j + kk; LAS float* d = scr + k * 65 + ((4 * nq + 4 * (j >> 3)) & 63);
        d[0] = v[j][0]; d[1] = v[j][1]; d[2] = v[j][2]; d[3] = v[j][3]; }
    const int c = lane & 7, nr = lane >> 3;
    f32x4 g0 = (f32x4){1.f, 1.f, 1.f, 1.f}, g1 = g0;
    if (gain) { g0 = *(const f32x4*)(gain + ((k0 + 8 * c) & gmask)); g1 = *(const f32x4*)(gain + ((k0 + 8 * c + 4) & gmask)); }
    LDS_WAIT(); asm volatile("" ::: "memory");
#pragma unroll
    for (int jj = 0; jj < 8; ++jj) { const int n = nr + 8 * jj; const LAS float* s = scr + (8 * c) * 65 + ((n + 4 * (c >> 2)) & 63);
        u32x4v o; o.x = pk2(s[0 * 65] * g0[0], s[1 * 65] * g0[1]); o.y = pk2(s[2 * 65] * g0[2], s[3 * 65] * g0[3]); o.z = pk2(s[4 * 65] * g1[0], s[5 * 65] * g1[1]); o.w = pk2(s[6 * 65] * g1[2], s[7 * 65] * g1[3]);
        *(u32x4v*)(WT + (size_t)(nrow + n) * K + k0 + 8 * c) = o; }
    LDS_WAIT(); asm volatile("" ::: "memory");
}
__device__ __forceinline__ void p0_memkv(const Frame& F, int unit) {
    const int l = unit >> 7, b = (unit >> 6) & 1, mt = (unit >> 3) & 7, cg = unit & 7, lane = F.lane, w = F.wave, c = lane & 15, g4 = lane >> 4, cgw = w & 1, kq = w >> 1;
    const float* mem = F.in[1] + ((size_t)b * 256 + mt * 32) * D_; const float* W = F.in[13] + (size_t)l * D_ * 1024 + cg * 128 + 64 * cgw + 4 * c; const float* gm = F.in[12] + l * D_;
    f32x4 acc[4][2];
#pragma unroll
    for (int t = 0; t < 4; ++t) { acc[t][0] = (f32x4){0.f, 0.f, 0.f, 0.f}; acc[t][1] = (f32x4){0.f, 0.f, 0.f, 0.f}; }
#pragma unroll 4
    for (int ks = 0; ks < 8; ++ks) { const int kb = kq * 256 + ks * 32 + 8 * g4;
        const f32x4 g0 = *(const f32x4*)(gm + kb), g1 = *(const f32x4*)(gm + kb + 4);
        bf16x8 afr[2], bfr[4];
#pragma unroll
        for (int rb = 0; rb < 2; ++rb) { const float* p = mem + (size_t)(rb * 16 + c) * D_ + kb; const f32x4 a0 = *(const f32x4*)p * g0, a1 = *(const f32x4*)(p + 4) * g1;
            u32x4v t; t.x = pk2(a0[0], a0[1]); t.y = pk2(a0[2], a0[3]); t.z = pk2(a1[0], a1[1]); t.w = pk2(a1[2], a1[3]); afr[rb] = __builtin_bit_cast(bf16x8, t); }
        f32x4 wv[8];
#pragma unroll
        for (int j = 0; j < 8; ++j) wv[j] = *(const f32x4*)(W + (size_t)(kb + j) * 1024);
#pragma unroll
        for (int t = 0; t < 4; ++t) { u32x4v q; q.x = pk2(wv[0][t], wv[1][t]); q.y = pk2(wv[2][t], wv[3][t]); q.z = pk2(wv[4][t], wv[5][t]); q.w = pk2(wv[6][t], wv[7][t]); bfr[t] = __builtin_bit_cast(bf16x8, q); }
#pragma unroll
        for (int t = 0; t < 4; ++t)
#pragma unroll
            for (int rb = 0; rb < 2; ++rb) acc[t][rb] = __builtin_amdgcn_mfma_f32_16x16x32_bf16(afr[rb], bfr[t], acc[t][rb], 0, 0, 0);
    }
    LAS float* P = (LAS float*)F.lds;
#pragma unroll
    for (int rb = 0; rb < 2; ++rb)
#pragma unroll
        for (int r = 0; r < 4; ++r) { const int tok = rb * 16 + 4 * g4 + r; *(LAS f32x4*)(P + ((kq * 32 + tok) * 128 + 64 * cgw + 4 * c)) = (f32x4){acc[0][rb][r], acc[1][rb][r], acc[2][rb][r], acc[3][rb][r]}; }
    __syncthreads();
    const int tok = F.tid >> 4, cb = F.tid & 15;
    f32x4 s0 = (f32x4){0.f, 0.f, 0.f, 0.f}, s1 = s0;
#pragma unroll
    for (int q = 0; q < 4; ++q) { s0 += *(const LAS f32x4*)(P + ((q * 32 + tok) * 128 + cb * 8)); s1 += *(const LAS f32x4*)(P + ((q * 32 + tok) * 128 + cb * 8 + 4)); }
    float ms = 0.f; { const f32x4* mr = (const f32x4*)(mem + (size_t)tok * D_ + cb * 64);
#pragma unroll
        for (int j = 0; j < 16; ++j) { const f32x4 v = mr[j]; ms += (v[0] * v[0] + v[1] * v[1]) + (v[2] * v[2] + v[3] * v[3]); } }
    ms += __shfl_xor(ms, 1); ms += __shfl_xor(ms, 2); ms += __shfl_xor(ms, 4); ms += __shfl_xor(ms, 8);
    const float rm = 1.0f / sqrtf(ms * (1.0f / D_) + EPS_);
    s0 *= rm; s1 *= rm;
    const size_t orow = ((((size_t)l * 2 + b) * 4 + (cg & 3)) * 256 + mt * 32 + tok) * 128 + cb * 8;
    if (cg < 4) {
        float q = (s0[0] * s0[0] + s0[1] * s0[1]) + (s0[2] * s0[2] + s0[3] * s0[3]) + (s1[0] * s1[0] + s1[1] * s1[1]) + (s1[2] * s1[2] + s1[3] * s1[3]);
        q += __shfl_xor(q, 1); q += __shfl_xor(q, 2); q += __shfl_xor(q, 4); q += __shfl_xor(q, 8);
        const float hn = QK_SCALE / sqrtf(q * (1.0f / 128) + EPS_);
        const f32x4 gk0 = *(const f32x4*)(F.in[15] + l * 128 + cb * 8), gk1 = *(const f32x4*)(F.in[15] + l * 128 + cb * 8 + 4);
        const f32x4 gq0 = *(const f32x4*)(F.in[14] + l * 128 + cb * 8), gq1 = *(const f32x4*)(F.in[14] + l * 128 + cb * 8 + 4);
        s0 = s0 * hn * gk0 * gq0; s1 = s1 * hn * gk1 * gq1;
        *(u32x4v*)((bf16_t*)(F.ws + WS_MEMK) + orow) = pg8::pack8(s0, s1);
    } else *(u32x4v*)((bf16_t*)(F.ws + WS_MEMV) + orow) = pg8::pack8(s0, s1);
    __syncthreads();
}
__device__ __forceinline__ void p0_weight_item(const Frame& F, int r, LAS float* scr) {
    constexpr int I_A = 16 * 64, I_OA = 24 * 16, I_B = 16 * 80;
    if (r < I_A) { const int kb = r / 64, n0 = 64 * (r % 64); p0_transpose_item(F.in[4], 4096, permA_src(n0), F.in[3], 0xffff, (bf16_t*)(F.ws + WS_WINA), 1024, n0, 64 * kb, scr, F.lane); return; } r -= I_A;
    if (r < I_OA) { const int kb = r / 16, n0 = 64 * (r % 16); p0_transpose_item(F.in[6], 1024, n0, kb < 16 ? F.in[5] : nullptr, 255, (bf16_t*)(F.ws + WS_WOUTA), 1536, n0, 64 * kb, scr, F.lane); return; } r -= I_OA;
    if (r < I_B) { const int kb = r / 80, n0 = 64 * (r % 80);
        if (n0 < 2048) p0_transpose_item(F.in[8], 2048, n0, F.in[7], 0xffff, (bf16_t*)(F.ws + WS_WB), 1024, n0, 64 * kb, scr, F.lane);
        else { const int c = n0 - 2048, src = c < 1024 ? 1024 + c : (c < 2048 ? c - 1024 : c); p0_transpose_item(F.in[10], 3072, src, F.in[9], 0xffff, (bf16_t*)(F.ws + WS_WB), 1024, n0, 64 * kb, scr, F.lane); }
        return; } r -= I_B;
    { const int kb = r / 16, n0 = 64 * (r % 16); p0_transpose_item(F.in[11], 1024, n0, nullptr, 0, (bf16_t*)(F.ws + WS_WOUTB), 1536, n0, 64 * kb, scr, F.lane); }
}
__device__ __forceinline__ void p0_prologue(const Frame& F) {
    for (int u = F.bid; u < 256; u += F.G) p0_memkv(F, u);
    const int gw = F.bid * NWAVES + F.wave, NGW = F.G * NWAVES;
    LAS float* scr = (LAS float*)(F.lds + F.wave * TSCR_BYTES);
    float* RS0 = (float*)(F.ws + WS_RS0); const float* x = F.in[0];
    if (NGW == 2048) {
        if (gw < 1024) { p0_weight_item(F, gw, scr); p0_x_rows<4>(x, x1b_ptr(F.ws, (6 * gw) >> 13), RS0, 6 * gw, F.lane); if (NGRP == 1) p0_weight_item(F, gw + 2048, scr); p0_x_rows<2>(x, x1b_ptr(F.ws, (6 * gw + 4) >> 13), RS0, 6 * gw + 4, F.lane); }
        else { const int r0 = 6144 + 10 * (gw - 1024); p0_x_rows<4>(x, x1b_ptr(F.ws, r0 >> 13), RS0, r0, F.lane); if (NGRP == 1) p0_weight_item(F, gw, scr); p0_x_rows<4>(x, x1b_ptr(F.ws, (r0 + 4) >> 13), RS0, r0 + 4, F.lane); p0_x_rows<2>(x, x1b_ptr(F.ws, (r0 + 8) >> 13), RS0, r0 + 8, F.lane); }
    } else {
        for (int it = gw; it < (NGRP == 2 ? 1024 : 3072); it += NGW) p0_weight_item(F, it, scr);
        for (int m = 4 * gw; m < T_; m += 4 * NGW) p0_x_rows<4>(x, x1b_ptr(F.ws, m >> 13), RS0, m, F.lane);
    }
}
__device__ __forceinline__ void p0_late_weights(const Frame& F) {
    LAS float* scr = (LAS float*)(F.lds + F.wave * TSCR_BYTES);
    const int wv = F.gi * NWAVES + F.wave, nw = F.gs * NWAVES;
    if (F.grp == 0) { for (int it = 1024 + wv; it < 1024 + LATE_G0; it += nw) p0_weight_item(F, it, scr); }
    else { for (int it = 1024 + LATE_G0 + wv; it < 3072; it += nw) p0_weight_item(F, it, scr); }
}

typedef float f32x16 __attribute__((ext_vector_type(16)));
typedef short s16x4 __attribute__((ext_vector_type(4)));
#define KSWZ(row, colB) ((row) * 256 + ((colB) ^ (((row) & 7) << 4)))
#define SBAR() __builtin_amdgcn_sched_barrier(0)
constexpr float LOG2E = 1.4426950408889634f;
__device__ __forceinline__ int crow(int r, int hi) { return (r & 3) + 8 * (r >> 2) + 4 * hi; }
__device__ __forceinline__ unsigned lds_addr(const LAS void* p) { return (unsigned)(size_t)p; }
__device__ __forceinline__ int v_st(int k, int c) { const int kk = (k & ~0xC) | ((k & 4) << 1) | ((k & 8) >> 1); return ((kk >> 3) * 4 + (c >> 5)) * 512 + ((kk & 7) * 32 + (c & 31)) * 2; }
__device__ __forceinline__ int v_rd_base(int lane) { return ((lane & 3) << 3) | (((lane >> 2) & 3) << 6) | (((lane >> 4) & 1) << 5) | (((lane >> 5) & 1) << 8); }
constexpr int v_rd_off(int d0, int ks, int half) { return d0 * 512 + ks * 4096 + half * 2048; }
template <int OFF> __device__ __forceinline__ s16x4 tr_read(unsigned vb) { s16x4 r; asm volatile("ds_read_b64_tr_b16 %0, %1 offset:%2" : "=&v"(r) : "v"(vb), "i"(OFF) : "memory"); return r; }
#define PKLH(L, H) (bf16x8){L[0], L[1], L[2], L[3], H[0], H[1], H[2], H[3]}
__device__ __forceinline__ float partner32(float x, int hi) { auto rr = __builtin_amdgcn_permlane32_swap(__float_as_uint(x), __float_as_uint(x), false, false); return __uint_as_float(hi ? rr[0] : rr[1]); }

__device__ __forceinline__ void qkt(f32x16& p0, f32x16& p1, const LAS unsigned char* Ks, const bf16x8* qr, int r32, int hi) {
    p0 = f32x16{}; p1 = f32x16{};
#pragma unroll
    for (int d0 = 0; d0 < 8; ++d0) { const int cb = (d0 * 16 + hi * 8) * 2;
        const bf16x8 b0 = *(const LAS bf16x8*)(Ks + KSWZ(r32, cb)), b1 = *(const LAS bf16x8*)(Ks + KSWZ(32 + r32, cb));
        p0 = __builtin_amdgcn_mfma_f32_32x32x16_bf16(b0, qr[d0], p0, 0, 0, 0);
        p1 = __builtin_amdgcn_mfma_f32_32x32x16_bf16(b1, qr[d0], p1, 0, 0, 0); }
}
#define PK4(P, BASE, OUT) do { unsigned a0_ = pg8::cvt_pk_bf16(P[BASE + 0], P[BASE + 1]), a1_ = pg8::cvt_pk_bf16(P[BASE + 2], P[BASE + 3]); \
    unsigned b0_ = pg8::cvt_pk_bf16(P[BASE + 4], P[BASE + 5]), b1_ = pg8::cvt_pk_bf16(P[BASE + 6], P[BASE + 7]); \
    auto r0_ = __builtin_amdgcn_permlane32_swap(a0_, b0_, false, false); auto r1_ = __builtin_amdgcn_permlane32_swap(a1_, b1_, false, false); \
    u32x4v w_ = {r0_[0], r1_[0], r0_[1], r1_[1]}; OUT = __builtin_bit_cast(bf16x8, w_); } while (0)
template <int D0> __device__ __forceinline__ void pv_one(f32x16& od, unsigned vb, bf16x8 pa0, bf16x8 pa1, bf16x8 pa2, bf16x8 pa3) {
    const s16x4 l0 = tr_read<v_rd_off(D0, 0, 0)>(vb), h0 = tr_read<v_rd_off(D0, 0, 1)>(vb), l1 = tr_read<v_rd_off(D0, 1, 0)>(vb), h1 = tr_read<v_rd_off(D0, 1, 1)>(vb);
    const s16x4 l2 = tr_read<v_rd_off(D0, 2, 0)>(vb), h2 = tr_read<v_rd_off(D0, 2, 1)>(vb), l3 = tr_read<v_rd_off(D0, 3, 0)>(vb), h3 = tr_read<v_rd_off(D0, 3, 1)>(vb);
    asm volatile("s_waitcnt lgkmcnt(0)" ::: "memory"); SBAR();
    od = __builtin_amdgcn_mfma_f32_32x32x16_bf16(pa0, PKLH(l0, h0), od, 0, 0, 0);
    od = __builtin_amdgcn_mfma_f32_32x32x16_bf16(pa1, PKLH(l1, h1), od, 0, 0, 0);
    od = __builtin_amdgcn_mfma_f32_32x32x16_bf16(pa2, PKLH(l2, h2), od, 0, 0, 0);
    od = __builtin_amdgcn_mfma_f32_32x32x16_bf16(pa3, PKLH(l3, h3), od, 0, 0, 0);
}
__device__ __forceinline__ void pv_d0(f32x16* o, unsigned vb, bf16x8 pa0, bf16x8 pa1, bf16x8 pa2, bf16x8 pa3) {
    pv_one<0>(o[0], vb, pa0, pa1, pa2, pa3); pv_one<1>(o[1], vb, pa0, pa1, pa2, pa3); pv_one<2>(o[2], vb, pa0, pa1, pa2, pa3); pv_one<3>(o[3], vb, pa0, pa1, pa2, pa3);
}
constexpr int WSCR_OFF = LDSCTL_OFF + 1024, WFLAG_OFF = LDSCTL_OFF + 512;


__device__ __forceinline__ void o_tile_stage(const f32x16* o, const float* rsc, LAS unsigned char* stg, int r32, int hi) {
#pragma unroll
    for (int r = 0; r < 16; ++r) { LAS bf16_t* sp = (LAS bf16_t*)(stg + crow(r, hi) * 256) + r32;
#pragma unroll
        for (int db = 0; db < 4; ++db) sp[32 * db] = (bf16_t)(pg8::cvt_pk_bf16_safe(o[db][r] * rsc[r], 0.f) & 0xffffu); }
}
__device__ __forceinline__ void o_tile_out(const LAS unsigned char* stg, const bf16_t* gate, bf16_t* out, size_t ld, int lane) {
    const int rr = lane >> 4, ch = lane & 15;
#pragma unroll
    for (int ps = 0; ps < 8; ++ps) { const int row = 4 * ps + rr; const bf16x8 v = *(const LAS bf16x8*)(stg + row * 256 + ch * 16); const bf16x8 g = *(const bf16x8*)(gate + (size_t)row * ld + ch * 8);
        u32x4v w; w.x = pk2(bf2f((bf16_t)v[0]) * bf2f((bf16_t)g[0]), bf2f((bf16_t)v[1]) * bf2f((bf16_t)g[1])); w.y = pk2(bf2f((bf16_t)v[2]) * bf2f((bf16_t)g[2]), bf2f((bf16_t)v[3]) * bf2f((bf16_t)g[3]));
        w.z = pk2(bf2f((bf16_t)v[4]) * bf2f((bf16_t)g[4]), bf2f((bf16_t)v[5]) * bf2f((bf16_t)g[5])); w.w = pk2(bf2f((bf16_t)v[6]) * bf2f((bf16_t)g[6]), bf2f((bf16_t)v[7]) * bf2f((bf16_t)g[7]));
        *(u32x4v*)(out + (size_t)row * ld + ch * 8) = w; }
}


template <bool MASK, int KOFF> __device__ __forceinline__ void sb_half_a(f32x16& p, float* go, int lim) {
#pragma unroll
    for (int i = 0; i < 4; ++i) { float l[4];
#pragma unroll
        for (int e = 0; e < 4; ++e) { const float y = fminf(p[4 * i + e], 60.f), sp = __builtin_amdgcn_logf(1.0f + __builtin_amdgcn_exp2f(y));
            l[e] = -sp; p[4 * i + e] = y - sp; if (MASK) l[e] = KOFF + 8 * i + e < lim ? l[e] : 0.f; }
        go[i] = (l[0] + l[1]) + (l[2] + l[3]);
        const float s2 = l[3], s1 = s2 + l[2], s0 = s1 + l[1]; p[4 * i + 2] += s2; p[4 * i + 1] += s1; p[4 * i] += s0; }
}
template <bool MASK, int KOFF> __device__ __forceinline__ void sb_half_b(f32x16& p, const float* go, int lim, float carry, float& tail, int hi) {
#pragma unroll
    for (int i = 3; i >= 0; --i) { const float gpi = partner32(go[i], hi); const float so = tail + (hi ? 0.f : gpi) + carry; tail += go[i] + gpi;
#pragma unroll
        for (int e = 0; e < 4; ++e) { float a = __builtin_amdgcn_exp2f(p[4 * i + e] + so); if (MASK) a = KOFF + 8 * i + e < lim ? a : 0.f; p[4 * i + e] = a; } }
}
template <bool MASK> __device__ __forceinline__ float sb_weights(f32x16& p0, f32x16& p1, int lim, float carry, int hi) {
    float go[8], tail = 0.f;
    sb_half_a<MASK, 0>(p0, go, lim); sb_half_a<MASK, 32>(p1, go + 4, lim);
    sb_half_b<MASK, 32>(p1, go + 4, lim, carry, tail, hi); sb_half_b<MASK, 0>(p0, go, lim, carry, tail, hi);
    return tail;
}

constexpr float SB_EXIT = -150.1f;
__device__ __forceinline__ int swap23(int k) { return (k & ~0xC) | ((k & 4) << 1) | ((k & 8) >> 1); }
__device__ __forceinline__ void sb_unit(const Frame& F, int b, int h, int qb) {
    int tid = F.tid; asm volatile("" : "+v"(tid));
    const int w = F.wave, lane = tid & 63, r32 = lane & 31, hi = lane >> 5;
    bf16_t* UB = ub_ptr(F.ws, b); const size_t rowb = (size_t)b * S_;
    const int q0 = qb * 256, tq = q0 + 32 * w + r32;
    unsigned offK[2], offV[2];
#pragma unroll
    for (int i = 0; i < 2; ++i) { const int pc = w + 8 * i;
        { const int row = pc * 4 + (lane >> 4), colB = ((lane & 15) * 16) ^ ((row & 7) << 4); offK[i] = (unsigned)(row * NBW_ + colB / 2); }
        { const int d = pc * 1024 + lane * 16, st = d >> 9, o = d & 511, kk = ((st >> 2) << 3) | (o >> 6), k = swap23(kk), c = (st & 3) * 32 + (o & 63) / 2; offV[i] = (unsigned)(k * NBW_ + c); } }
    const bf16_t* kg = UB + rowb * NBW_ + h * 128; const bf16_t* vg = kg + 1024;
#define SB_DMA(kt_) do { const int bo_ = ((kt_) % 3) * 32768; const bf16_t* kt0_ = kg + (size_t)(kt_) * 64 * NBW_; const bf16_t* vt0_ = vg + (size_t)(kt_) * 64 * NBW_; \
        _Pragma("unroll") for (int i_ = 0; i_ < 2; ++i_) { \
            __builtin_amdgcn_global_load_lds((const unsigned*)(kt0_ + offK[i_]), (LAS unsigned*)(F.lds + bo_ + (w + 8 * i_) * 1024), 16, 0, 0); \
            __builtin_amdgcn_global_load_lds((const unsigned*)(vt0_ + offV[i_]), (LAS unsigned*)(F.lds + bo_ + 16384 + (w + 8 * i_) * 1024), 16, 0, 0); } } while (0)
    volatile LAS unsigned* flags = (volatile LAS unsigned*)(F.lds + WFLAG_OFF);
    f32x16 o[4] = {}; float carry = 0.f; bool wdone = false;
    const int kt_hi = qb * 4 + 3;
    __syncthreads();
    if (lane == 0) { flags[w] = 0u; flags[8 + w] = 0u; }
    SB_DMA(kt_hi); SB_DMA(kt_hi - 1);
    bf16x8 qr[8];
    { const bf16_t* qp = UB + (rowb + tq) * NBW_ + 3072 + h * 128 + hi * 8;
#pragma unroll
      for (int d0 = 0; d0 < 8; ++d0) qr[d0] = *(const bf16x8*)(qp + d0 * 16); }
    asm volatile("s_waitcnt vmcnt(0)" ::: "memory");
    const unsigned vbase = lds_addr(F.lds) + 16384 + v_rd_base(lane);
    for (int kt = kt_hi; kt >= 0; --kt) {
        if (kt >= 1) asm volatile("s_waitcnt vmcnt(4)" ::: "memory"); else asm volatile("s_waitcnt vmcnt(0)" ::: "memory");
        asm volatile("s_waitcnt lgkmcnt(0)" ::: "memory"); __builtin_amdgcn_s_barrier(); asm volatile("" ::: "memory");
        unsigned alld = 1u;
#pragma unroll
        for (int j = 0; j < 8; ++j) alld &= flags[8 * (kt & 1) + j];
        if (alld) break;
        if (kt >= 2) SB_DMA(kt - 2);
        const int bo = (kt % 3) * 32768;
        if (!wdone && kt * 64 < q0 + 32 * w + 31) {
            f32x16 p0, p1;
            qkt(p0, p1, F.lds + bo, qr, r32, hi);
            const int lim = tq - kt * 64 - 4 * hi;
            const bool need_mask = kt * 64 + 63 >= q0 + 32 * w;
            carry += need_mask ? sb_weights<true>(p0, p1, lim, carry, hi) : sb_weights<false>(p0, p1, lim, carry, hi);
            bf16x8 pa0, pa1, pa2, pa3;
            PK4(p0, 0, pa0); PK4(p0, 8, pa1); PK4(p1, 0, pa2); PK4(p1, 8, pa3);
            pv_d0(o, vbase + bo, pa0, pa1, pa2, pa3);
            wdone = __all(carry < SB_EXIT);
        }
        if (lane == 0) flags[8 * ((kt & 1) ^ 1) + w] = wdone ? 1u : 0u;
    }
#undef SB_DMA
    asm volatile("s_waitcnt vmcnt(0) lgkmcnt(0)" ::: "memory"); __builtin_amdgcn_s_barrier(); asm volatile("" ::: "memory");
    { float one[16];
#pragma unroll
      for (int r = 0; r < 16; ++r) one[r] = 1.0f;
      LAS unsigned char* stg = F.lds + w * 8192; bf16_t* base = UB + (rowb + q0 + 32 * w) * NBW_ + h * 128;
      o_tile_stage(o, one, stg, r32, hi); LDS_WAIT();
      o_tile_out(stg, base + 2048, base + 3072, NBW_, lane); LDS_WAIT(); }
}

template <bool STORE = true> __device__ __forceinline__ void memattn_unit(const Frame& F, bf16_t* U, int ld, int qoff, int goff, int layer, int unit) {
    int tid = F.tid; asm volatile("" : "+v"(tid));
    const int w = F.wave, lane = tid & 63, r32 = lane & 31, hi = lane >> 5;
    const int qblk = unit >> 2, hd = unit & 3, row0 = qblk * 256, b = row0 / S_;
    const bf16_t* Kg = (const bf16_t*)(F.ws + WS_MEMK) + (((size_t)layer * 2 + b) * 4 + hd) * 256 * 128; const bf16_t* Vg = (const bf16_t*)(F.ws + WS_MEMV) + (((size_t)layer * 2 + b) * 4 + hd) * 256 * 128;
    LAS unsigned char* Kb = F.lds; LAS unsigned char* Vb = F.lds + 65536;
    __syncthreads();
#pragma unroll
    for (int j = 0; j < 8; ++j) { const int c = tid + 512 * j, row = c >> 4, ch = c & 15;
        *(LAS bf16x8*)(Kb + KSWZ(row, ch * 16)) = *(const bf16x8*)(Kg + (size_t)row * 128 + ch * 8);
        *(LAS bf16x8*)(Vb + (row >> 6) * 16384 + v_st(row & 63, ch * 8)) = *(const bf16x8*)(Vg + (size_t)row * 128 + ch * 8); }
    bf16x8 qr[8]; float ssq = 0.f;
    { const bf16_t* qp = U + (size_t)(row0 + 32 * w + r32) * ld + qoff + hd * 128 + hi * 8;
#pragma unroll
      for (int d0 = 0; d0 < 8; ++d0) { qr[d0] = *(const bf16x8*)(qp + d0 * 16);
#pragma unroll
          for (int j = 0; j < 8; ++j) { const float v = bf2f((bf16_t)qr[d0][j]); ssq += v * v; } } }
    ssq += partner32(ssq, hi);
    const float C = LOG2E / sqrtf(ssq * (1.0f / 128) + EPS_);
    __syncthreads();
    LAS float* wscr = (LAS float*)(F.lds + WSCR_OFF) + w * 64;
    const unsigned vb0 = lds_addr(Vb) + v_rd_base(lane);
    f32x16 o[4] = {}; float m_reg = -1e30f, l_reg = 0.f;
#pragma unroll 1
    for (int t = 0; t < 4; ++t) {
        f32x16 p0, p1;
        qkt(p0, p1, Kb + t * 16384, qr, r32, hi);
        float pmax = p0[0];
#pragma unroll
        for (int r = 1; r < 16; ++r) pmax = fmaxf(pmax, p0[r]);
#pragma unroll
        for (int r = 0; r < 16; ++r) pmax = fmaxf(pmax, p1[r]);
        pmax = fmaxf(pmax, partner32(pmax, hi));
        float alpha = 1.f;
        if (!__all(pmax <= m_reg)) { const float mn = fmaxf(m_reg, pmax); alpha = __builtin_amdgcn_exp2f((m_reg - mn) * C); m_reg = mn;
            if (hi == 0) wscr[r32] = alpha; LDS_WAIT();
#pragma unroll
            for (int d = 0; d < 4; ++d)
#pragma unroll
                for (int r = 0; r < 16; ++r) o[d][r] *= wscr[crow(r, hi)];
            LDS_WAIT(); }
        const float mC = -m_reg * C; float ps = 0.f;
#pragma unroll
        for (int r = 0; r < 16; ++r) { p0[r] = __builtin_amdgcn_exp2f(fmaf(p0[r], C, mC)); p1[r] = __builtin_amdgcn_exp2f(fmaf(p1[r], C, mC)); ps += p0[r] + p1[r]; }
        ps += partner32(ps, hi);
        l_reg = l_reg * alpha + ps;
        bf16x8 pa0, pa1, pa2, pa3;
        PK4(p0, 0, pa0); PK4(p0, 8, pa1); PK4(p1, 0, pa2); PK4(p1, 8, pa3);
        pv_d0(o, vb0 + t * 16384, pa0, pa1, pa2, pa3);
    }
    if (hi == 0) wscr[32 + r32] = l_reg; LDS_WAIT();
    { float rl[16];
#pragma unroll
      for (int r = 0; r < 16; ++r) rl[r] = 1.0f / wscr[32 + crow(r, hi)];
      __syncthreads();
      LAS unsigned char* stg = F.lds + w * 8192; bf16_t* base = U + (size_t)(row0 + 32 * w) * ld + hd * 128;
      o_tile_stage(o, rl, stg, r32, hi); LDS_WAIT();
      if (STORE) o_tile_out(stg, base + goff, base + qoff, ld, lane); else if (rl[0] == 1.2345e33f) o_tile_out(stg, base + goff, base + qoff, ld, lane);
      LDS_WAIT(); }
}

__device__ __forceinline__ float ret_lg2(int h) { return log2f(1.0f - exp2f(-5.0f - (float)h)); }
template <int H2> __device__ __forceinline__ void o_half_stage(const f32x16* o, const float* rsc, LAS unsigned char* stg, int r32, int hi) {
#pragma unroll
    for (int r = 8 * H2; r < 8 * H2 + 8; ++r) { LAS bf16_t* sp = (LAS bf16_t*)(stg + ((r & 3) + 8 * ((r >> 2) & 1) + 4 * hi) * 256) + r32;
#pragma unroll
        for (int db = 0; db < 4; ++db) sp[32 * db] = (bf16_t)(pg8::cvt_pk_bf16_safe(o[db][r] * rsc[r], 0.f) & 0xffffu); }
}
__device__ __forceinline__ bf16x8 mul8_bf16(bf16x8 v, bf16x8 g) {
    u32x4v w; w.x = pk2(bf2f((bf16_t)v[0]) * bf2f((bf16_t)g[0]), bf2f((bf16_t)v[1]) * bf2f((bf16_t)g[1])); w.y = pk2(bf2f((bf16_t)v[2]) * bf2f((bf16_t)g[2]), bf2f((bf16_t)v[3]) * bf2f((bf16_t)g[3]));
    w.z = pk2(bf2f((bf16_t)v[4]) * bf2f((bf16_t)g[4]), bf2f((bf16_t)v[5]) * bf2f((bf16_t)g[5])); w.w = pk2(bf2f((bf16_t)v[6]) * bf2f((bf16_t)g[6]), bf2f((bf16_t)v[7]) * bf2f((bf16_t)g[7]));
    return __builtin_bit_cast(bf16x8, w);
}
__device__ __forceinline__ void kvt_unit(const Frame& F, int u) {
    int tid = F.tid; asm volatile("" : "+v"(tid));
    const int w = F.wave, lane = tid & 63, r32 = lane & 31, hi = lane >> 5;
    const int b = u >> 8, h = (u >> 6) & 3, n = u & 63; const size_t row0 = (size_t)b * S_ + n * 128; const float lg2 = ret_lg2(h);
    const bf16_t* UA = ua_ptr(F.ws, b); bf16_t* KVT = kvt_ptr(F.ws, b);
    LAS unsigned char* Vb = F.lds; LAS unsigned char* Kb = F.lds + 65536;
    __syncthreads();
#pragma unroll
    for (int j = 0; j < 8; ++j) { const int c = tid + 512 * j, row = c >> 5, col = (c & 31) * 8;
        *(LAS bf16x8*)(Vb + ((row >> 6) * 2 + (col >> 7)) * 16384 + v_st(row & 63, col & 127)) = *(const bf16x8*)(UA + (row0 + row) * NA_ + 1024 + h * 256 + col); }
#pragma unroll
    for (int j = 0; j < 4; ++j) { const int c = tid + 512 * j, row = c >> 4, col = (c & 15) * 8; const float z = exp2f((float)(127 - row) * lg2);
        const bf16x8 kv = *(const bf16x8*)(UA + (row0 + row) * NA_ + 512 + h * 128 + col);
        u32x4v t; t.x = pk2(bf2f((bf16_t)kv[0]) * z, bf2f((bf16_t)kv[1]) * z); t.y = pk2(bf2f((bf16_t)kv[2]) * z, bf2f((bf16_t)kv[3]) * z);
        t.z = pk2(bf2f((bf16_t)kv[4]) * z, bf2f((bf16_t)kv[5]) * z); t.w = pk2(bf2f((bf16_t)kv[6]) * z, bf2f((bf16_t)kv[7]) * z);
        *(LAS u32x4v*)(Kb + (row >> 6) * 16384 + v_st(row & 63, col)) = t; }
    __syncthreads();
    f32x16 acc[4] = {};
    const unsigned vbV = lds_addr(Vb) + v_rd_base(lane) + (w >> 2) * 16384 + (w & 3) * 512, vbK = lds_addr(Kb) + v_rd_base(lane);
#define KVT_STEP(TH, KS) do { const unsigned va_ = vbV + (TH) * 32768, vk_ = vbK + (TH) * 16384; \
        const s16x4 al_ = tr_read<v_rd_off(0, KS, 0)>(va_), ah_ = tr_read<v_rd_off(0, KS, 1)>(va_); \
        const s16x4 b0l_ = tr_read<v_rd_off(0, KS, 0)>(vk_), b0h_ = tr_read<v_rd_off(0, KS, 1)>(vk_), b1l_ = tr_read<v_rd_off(1, KS, 0)>(vk_), b1h_ = tr_read<v_rd_off(1, KS, 1)>(vk_); \
        const s16x4 b2l_ = tr_read<v_rd_off(2, KS, 0)>(vk_), b2h_ = tr_read<v_rd_off(2, KS, 1)>(vk_), b3l_ = tr_read<v_rd_off(3, KS, 0)>(vk_), b3h_ = tr_read<v_rd_off(3, KS, 1)>(vk_); \
        asm volatile("s_waitcnt lgkmcnt(0)" ::: "memory"); SBAR(); const bf16x8 a_ = PKLH(al_, ah_); \
        acc[0] = __builtin_amdgcn_mfma_f32_32x32x16_bf16(a_, PKLH(b0l_, b0h_), acc[0], 0, 0, 0); acc[1] = __builtin_amdgcn_mfma_f32_32x32x16_bf16(a_, PKLH(b1l_, b1h_), acc[1], 0, 0, 0); \
        acc[2] = __builtin_amdgcn_mfma_f32_32x32x16_bf16(a_, PKLH(b2l_, b2h_), acc[2], 0, 0, 0); acc[3] = __builtin_amdgcn_mfma_f32_32x32x16_bf16(a_, PKLH(b3l_, b3h_), acc[3], 0, 0, 0); } while (0)
    KVT_STEP(0, 0); KVT_STEP(0, 1); KVT_STEP(0, 2); KVT_STEP(0, 3); KVT_STEP(1, 0); KVT_STEP(1, 1); KVT_STEP(1, 2); KVT_STEP(1, 3);
#undef KVT_STEP
    bf16_t* ob = KVT + ((size_t)u * 256 + 32 * w) * 128 + r32;
#pragma unroll
    for (int r = 0; r < 16; ++r)
#pragma unroll
        for (int db = 0; db < 4; ++db) ob[(size_t)crow(r, hi) * 128 + 32 * db] = f2bf(acc[db][r]);
}
__device__ __forceinline__ void scan_phase(const Frame& F) {
    for (int idx = F.gi * (NWAVES * 64) + F.tid; idx < F.nb * 4 * 16384; idx += F.gs * NWAVES * 64) {
        const int bh = F.b0 * 4 + (idx >> 14), off = idx & 16383; const float gc = exp2f(128.0f * ret_lg2(bh & 3));
        unsigned* p = (unsigned*)kvt_ptr(F.ws, bh >> 2) + (size_t)bh * 64 * 16384 + off; float s0 = 0.f, s1 = 0.f;
#pragma unroll 1
        for (int n0 = 0; n0 < 64; n0 += 16) { unsigned v[16];
#pragma unroll
            for (int j = 0; j < 16; ++j) v[j] = p[(size_t)(n0 + j) * 16384];
#pragma unroll
            for (int j = 0; j < 16; ++j) { p[(size_t)(n0 + j) * 16384] = pk2(s0, s1); s0 = fmaf(gc, s0, __uint_as_float(v[j] << 16)); s1 = fmaf(gc, s1, __uint_as_float(v[j] & 0xffff0000u)); } }
    }
}
__device__ __forceinline__ void ret_unit(const Frame& F, int u) {
    int tid = F.tid; asm volatile("" : "+v"(tid));
    const int w = F.wave, lane = tid & 63, r32 = lane & 31, hi = lane >> 5, wq = w & 3, eh = w >> 2;
    const int b = u >> 8, h = (u >> 6) & 3, n = u & 63; const size_t row0 = (size_t)b * S_ + n * 128; const float lg2 = ret_lg2(h);
    bf16_t* UA = ua_ptr(F.ws, b); const bf16_t* KVT = kvt_ptr(F.ws, b);
    LAS unsigned char* R1 = F.lds; LAS unsigned char* R2 = F.lds + 65536;
    __syncthreads();
#pragma unroll
    for (int j = 0; j < 8; ++j) { const int c = tid + 512 * j, row = c >> 4, ch = c & 15; *(LAS bf16x8*)(R1 + KSWZ(row, ch * 16)) = *(const bf16x8*)(KVT + ((size_t)u * 256 + row) * 128 + ch * 8); }
#pragma unroll
    for (int j = 0; j < 4; ++j) { const int c = tid + 512 * j, row = c >> 4, ch = c & 15; *(LAS bf16x8*)(R2 + KSWZ(row, ch * 16)) = *(const bf16x8*)(UA + (row0 + row) * NA_ + 512 + h * 128 + ch * 8); }
    bf16x8 qr[8];
    { const bf16_t* qp = UA + (row0 + 32 * wq + r32) * NA_ + h * 128 + hi * 8;
#pragma unroll
      for (int d0 = 0; d0 < 8; ++d0) qr[d0] = *(const bf16x8*)(qp + d0 * 16); }
    __syncthreads();
    f32x16 o[4] = {};
#pragma unroll
    for (int db = 0; db < 4; ++db) {
#pragma unroll
        for (int d0 = 0; d0 < 8; ++d0) { const bf16x8 bs = *(const LAS bf16x8*)(R1 + KSWZ(128 * eh + 32 * db + r32, (d0 * 16 + hi * 8) * 2)); o[db] = __builtin_amdgcn_mfma_f32_32x32x16_bf16(qr[d0], bs, o[db], 0, 0, 0); }
        asm volatile("" ::: "memory"); }
    const float gm1 = exp2f(lg2), gm2 = gm1 * gm1, gm4 = gm2 * gm2, gm8 = gm4 * gm4, gm16 = gm8 * gm8;
    const float gi1 = exp2f(-lg2), gi2 = gi1 * gi1, gi4 = gi2 * gi2, gi8 = gi4 * gi4, gi16 = gi8 * gi8, gi32 = gi16 * gi16;
    const float ga[4] = {1.0f, gm1, gm2, gm2 * gm1}, gb[4] = {1.0f, gm8, gm16, gm16 * gm8};
    const float ia[4] = {1.0f, gi1, gi2, gi2 * gi1}, ib[4] = {1.0f, gi8, gi16, gi16 * gi8};
    { const float xl = exp2f((float)(32 * wq + 4 * hi + 1) * lg2);
#pragma unroll
      for (int r = 0; r < 16; ++r) { const float xi = xl * (ga[r & 3] * gb[r >> 2]);
#pragma unroll
          for (int db = 0; db < 4; ++db) o[db][r] *= xi; } }
    bf16x8 pa[2][4]; const int cq = 32 * wq + r32;
#define RET_P(ST) do { f32x16 p0, p1; qkt(p0, p1, R2 + (ST) * 16384, qr, r32, hi); const int limq_ = cq - 64 * (ST) - 4 * hi; const float al_ = exp2f((float)limq_ * lg2); \
        _Pragma("unroll") for (int r = 0; r < 16; ++r) { const int cr_ = (r & 3) + 8 * (r >> 2); const float f_ = al_ * (ia[r & 3] * ib[r >> 2]); \
            p0[r] = cr_ <= limq_ ? p0[r] * f_ : 0.f; p1[r] = cr_ + 32 <= limq_ ? p1[r] * (f_ * gi32) : 0.f; } \
        PK4(p0, 0, pa[ST][0]); PK4(p0, 8, pa[ST][1]); PK4(p1, 0, pa[ST][2]); PK4(p1, 8, pa[ST][3]); } while (0)
    RET_P(0);
    if (wq >= 2) RET_P(1);
#undef RET_P
    __syncthreads();
#pragma unroll 4
    for (int j = 0; j < 8; ++j) { const int c = tid + 512 * j, row = c >> 5, col = (c & 31) * 8;
        *(LAS bf16x8*)(R1 + ((row >> 6) * 2 + (col >> 7)) * 16384 + v_st(row & 63, col & 127)) = *(const bf16x8*)(UA + (row0 + row) * NA_ + 1024 + h * 256 + col); }
    __syncthreads();
    const unsigned vb = lds_addr(R1) + v_rd_base(lane) + eh * 16384;
    pv_d0(o, vb, pa[0][0], pa[0][1], pa[0][2], pa[0][3]);
    if (wq >= 2) pv_d0(o, vb + 32768, pa[1][0], pa[1][1], pa[1][2], pa[1][3]);
    LAS float* ssq = (LAS float*)(F.lds + WSCR_OFF);
    float qs[16];
#pragma unroll
    for (int r = 0; r < 16; ++r) { float q = (o[0][r] * o[0][r] + o[1][r] * o[1][r]) + (o[2][r] * o[2][r] + o[3][r] * o[3][r]);
        q += __shfl_xor(q, 1); q += __shfl_xor(q, 2); q += __shfl_xor(q, 4); q += __shfl_xor(q, 8); q += __shfl_xor(q, 16); qs[r] = q;
        if (r32 == 0) ssq[w * 32 + crow(r, hi)] = q; }
    __syncthreads();
    { bf16_t* base = UA + (row0 + 32 * wq) * NA_ + 2048 + h * 256 + 128 * eh + r32;
#pragma unroll
      for (int r = 0; r < 16; ++r) { const float rn = 1.0f / sqrtf((qs[r] + ssq[(w ^ 4) * 32 + crow(r, hi)]) * (1.0f / 256) + EPS_); bf16_t* rp = base + (size_t)crow(r, hi) * NA_;
#pragma unroll
          for (int db = 0; db < 4; ++db) { const float g = bf2f(rp[32 * db]); rp[32 * db] = f2bf(o[db][r] * rn * g); } } }
    LDS_WAIT();
}
#ifndef PG8_SP2
#define PG8_SP2 true
#endif
#ifndef PG8_ALIGN
#define PG8_ALIGN true
#endif
#define RET_UNIT(i) (i)
__device__ __forceinline__ void phase1(const Frame& F) {
    const size_t rb = (size_t)F.b0 * S_;
    pg8::Gemm g{(const bf16_t*)x1b_ptr(F.ws, F.b0) + rb * D_, (const bf16_t*)(F.ws + WS_WINA), F.nb * S_, NA_, D_, D_}; pg8::StaticOrder S; S.init(F.nb * S_, NA_, F.gs, F.gi);
    pg8::EpiA E{ua_ptr(F.ws, F.b0) + rb * NA_, (const float*)(F.ws + WS_RS0) + rb, (const int*)F.in[2] + rb};
    pg8::gemm_phase<pg8::EpiA, pg8::StaticOrder, PG8_ALIGN, PG8_SP2>(F.lds, g, S, E);
}
__device__ __forceinline__ void late_publish(const Frame& F) {
    asm volatile("s_waitcnt vmcnt(0)" ::: "memory"); __syncthreads();
    if (F.tid == 0) { __builtin_amdgcn_fence(__ATOMIC_RELEASE, "agent"); asm volatile("s_waitcnt vmcnt(0)" ::: "memory");
        __hip_atomic_fetch_add((unsigned*)(F.ws + WS_CTL) + CW_LATE, 1u, __ATOMIC_RELAXED, __HIP_MEMORY_SCOPE_AGENT); }
}
__device__ __forceinline__ void late_acquire(const Frame& F) {
    if (F.tid == 0) { unsigned* c = (unsigned*)(F.ws + WS_CTL) + CW_LATE; unsigned sp = 0;
        while (__hip_atomic_load(c, __ATOMIC_RELAXED, __HIP_MEMORY_SCOPE_AGENT) < (unsigned)F.G) { __builtin_amdgcn_s_sleep(2); if (++sp > (1u << 22)) break; }
        __builtin_amdgcn_fence(__ATOMIC_ACQUIRE, "agent"); asm volatile("s_waitcnt vmcnt(0)" ::: "memory"); }
    __syncthreads();
}
__device__ __forceinline__ void phase2(const Frame& F) {
    for (int i = F.gi; i < F.nb * 256; i += F.gs) kvt_unit(F, RET_UNIT(F.b0 * 256 + i));
    for (int u = F.gi; u < F.nb * 128; u += F.gs) memattn_unit(F, ua_ptr(F.ws, (F.b0 * 128 + u) >> 7), NA_, 3072, 3584, 0, F.b0 * 128 + u);
}
__device__ __forceinline__ void phase4(const Frame& F) { for (int i = F.gi; i < F.nb * 256; i += F.gs) ret_unit(F, RET_UNIT(F.b0 * 256 + i)); }
__device__ __forceinline__ void phase5(const Frame& F) {
    if (NGRP == 2) late_acquire(F);
    const size_t rb = (size_t)F.b0 * S_;
    pg8::Gemm g{(const bf16_t*)ua_ptr(F.ws, F.b0) + rb * NA_ + 2048, (const bf16_t*)(F.ws + WS_WOUTA), F.nb * S_, D_, KO_, NA_}; pg8::StaticOrder S; S.init(F.nb * S_, D_, F.gs, F.gi);
    pg8::EpiOutA E{F.in[0] + rb * D_, F.out + rb * D_, x1b_ptr(F.ws, F.b0) + rb * D_, (float*)(F.ws + WS_SS1P) + rb * 16};
    pg8::gemm_phase<pg8::EpiOutA, pg8::StaticOrder, PG8_ALIGN, PG8_SP2>(F.lds, g, S, E);
}
__device__ __forceinline__ void phase6(const Frame& F) {
    const size_t rb = (size_t)F.b0 * S_;
    pg8::Gemm g{(const bf16_t*)x1b_ptr(F.ws, F.b0) + rb * D_, (const bf16_t*)(F.ws + WS_WB), F.nb * S_, NBW_, D_, D_}; pg8::StaticOrder S; S.init(F.nb * S_, NBW_, F.gs, F.gi);
    pg8::EpiB E{ub_ptr(F.ws, F.b0) + rb * NBW_, (const float*)(F.ws + WS_SS1P) + rb * 16};
    pg8::gemm_phase<pg8::EpiB, pg8::StaticOrder, PG8_ALIGN, PG8_SP2>(F.lds, g, S, E);
}
__device__ __forceinline__ void phase7(const Frame& F) {
    for (int u = F.gi; u < F.nb * 256; u += F.gs) { const int U = F.b0 * 256 + u; sb_unit(F, U >> 8, (U >> 5) & 7, U & 31); }
    for (int u = F.gi; u < F.nb * 128; u += F.gs) memattn_unit(F, ub_ptr(F.ws, (F.b0 * 128 + u) >> 7), NBW_, 4096, 4608, 1, F.b0 * 128 + u);
}
__device__ __forceinline__ void phase8(const Frame& F) {
    const size_t rb = (size_t)F.b0 * S_;
    pg8::Gemm g{(const bf16_t*)ub_ptr(F.ws, F.b0) + rb * NBW_ + 3072, (const bf16_t*)(F.ws + WS_WOUTB), F.nb * S_, D_, KO_, NBW_}; pg8::StaticOrder S; S.init(F.nb * S_, D_, F.gs, F.gi);
    pg8::EpiOutB E{F.out + rb * D_, (const bf16_t*)x1b_ptr(F.ws, F.b0) + rb * D_};
    pg8::gemm_phase<pg8::EpiOutB, pg8::StaticOrder, PG8_ALIGN, PG8_SP2>(F.lds, g, S, E);
}

__global__ void __launch_bounds__(NWAVES * 64, 2) mega(MArgs args) {
    extern __shared__ __attribute__((aligned(16))) unsigned char lds_raw[];
    Frame F;
    F.lds = (LAS unsigned char*)lds_raw; F.tid = threadIdx.x; F.lane = F.tid & 63; F.wave = __builtin_amdgcn_readfirstlane(F.tid >> 6); F.G = gridDim.x; F.bid = blockIdx.x;
    if (NGRP == 2 && (F.G & 15) == 0) { F.grp = (F.bid >> 3) & 1; F.gi = (F.bid & 7) + 8 * (F.bid >> 4); F.gs = F.G >> 1; F.b0 = F.grp; F.nb = 1; }
    else { F.grp = 0; F.gi = F.bid; F.gs = F.G; F.b0 = 0; F.nb = 2; }
#pragma unroll
    for (int i = 0; i < 16; ++i) F.in[i] = args.in[i];
    F.out = args.out; F.ws = args.ws;
    for (int u = F.tid; u < (LDS_BYTES - LDSCTL_OFF) / 4; u += NWAVES * 64) ((LAS unsigned*)(F.lds + LDSCTL_OFF))[u] = 0u;
    __syncthreads();
    unsigned* ctl = (unsigned*)(F.ws + WS_CTL);
    volatile LAS unsigned* lw = (volatile LAS unsigned*)(F.lds + LDSCTL_OFF);
    XcdBarrier barG = xcd_barrier_post(ctl + CW_BAR, lw + 8, (unsigned)F.G);
    XcdBarrier bar = xcd_barrier_post(ctl + CW_BAR + (1 + F.grp) * XCD_BAR_WORDS, lw + 12, (unsigned)F.gs);
#define PHB(call) do { call; xcd_barrier(bar); } while (0)
    p0_prologue(F); xcd_barrier(barG);
    if (NGRP == 2 && F.nb == 1) { p0_late_weights(F); late_publish(F);
    }
    PHB(phase1(F));
    PHB(phase2(F));
    PHB(scan_phase(F));
    PHB(phase4(F));
    PHB(phase5(F));
    PHB(phase6(F));
    PHB(phase7(F));
    phase8(F);
#undef PHB
}

extern "C" void kernel_launch(void* const* d_in, const int* in_sizes, int n_in, void* d_out, int out_size, void* d_ws, size_t ws_size, hipStream_t stream) {
    static int grid = 0;
    if (grid == 0) {
        int dev = 0, cus = 0;
        if (hipGetDevice(&dev) != hipSuccess || hipDeviceGetAttribute(&cus, hipDeviceAttributeMultiprocessorCount, dev) != hipSuccess) { grid = -1; return; }
        if (hipFuncSetAttribute((const void*)mega, hipFuncAttributeMaxDynamicSharedMemorySize, LDS_BYTES) != hipSuccess) { grid = -1; return; }
        (void)hipGetLastError();
        grid = (cus / 16) * 16;
        if (grid == 0) { grid = -1; return; }
    }
    if (grid < 0) return;
    unsigned char* ws = (unsigned char*)d_ws;
    (void)hipMemsetAsync(ws + WS_CTL, 0, CTL_ZERO_BYTES, stream);
    MArgs a{};
    for (int i = 0; i < 16; ++i) a.in[i] = (const float*)d_in[i];
    a.out = (float*)d_out; a.ws = ws; a.ph_lo = 0; a.ph_hi = 9; a.li = 0; a.pad = 0;
    hipLaunchKernelGGL(mega, dim3(grid), dim3(NWAVES * 64), LDS_BYTES, stream, a);
}
```

```cpp
#include <hip/hip_runtime.h>
#include <stdint.h>

typedef unsigned short bf16_t;

constexpr int NB_ = 2, S_ = 8192, T_ = NB_ * S_, D_ = 1024;
constexpr int NA_ = 4096, NBW_ = 5120, KO_ = 1536;
constexpr float EPS_ = 1e-6f;
constexpr float QK_SCALE = 0.08838834764831845f;

constexpr size_t MiB = 1u << 20;
constexpr size_t WS_CTL = 0;
constexpr size_t WS_WINA = 1 * MiB;
constexpr size_t WS_WOUTA = 9 * MiB;
constexpr size_t WS_WB = 12 * MiB;
constexpr size_t WS_WOUTB = 22 * MiB;
constexpr size_t WS_MEMK = 25 * MiB;
constexpr size_t WS_MEMV = 26 * MiB;
constexpr size_t WS_RS0 = 27 * MiB;
constexpr size_t WS_SS1P = 28 * MiB;
#ifndef NGRP
#define NGRP 2
#endif
#if NGRP == 2
constexpr size_t WS_BSTRIDE = 96 * MiB;
constexpr size_t WS_UA = 30 * MiB, WS_UA_STRIDE = WS_BSTRIDE, WS_UB = 30 * MiB, WS_UB_STRIDE = WS_BSTRIDE, WS_KVT = 94 * MiB, WS_KVT_STRIDE = WS_BSTRIDE, WS_X1B = 110 * MiB, WS_X1B_STRIDE = WS_BSTRIDE;
#else
constexpr size_t WS_UA = 30 * MiB, WS_UA_STRIDE = 64 * MiB, WS_UB = 30 * MiB, WS_UB_STRIDE = 80 * MiB, WS_KVT = 158 * MiB, WS_KVT_STRIDE = 16 * MiB, WS_X1B = 190 * MiB, WS_X1B_STRIDE = 16 * MiB;
#endif
__device__ __forceinline__ bf16_t* ua_ptr(unsigned char* ws, int b) { return (bf16_t*)(ws + WS_UA + (size_t)b * WS_UA_STRIDE) - (size_t)b * S_ * NA_; }
__device__ __forceinline__ bf16_t* ub_ptr(unsigned char* ws, int b) { return (bf16_t*)(ws + WS_UB + (size_t)b * WS_UB_STRIDE) - (size_t)b * S_ * NBW_; }
__device__ __forceinline__ bf16_t* kvt_ptr(unsigned char* ws, int b) { return (bf16_t*)(ws + WS_KVT + (size_t)b * WS_KVT_STRIDE) - (size_t)b * 256 * 32768; }
__device__ __forceinline__ bf16_t* x1b_ptr(unsigned char* ws, int b) { return (bf16_t*)(ws + WS_X1B + (size_t)b * WS_X1B_STRIDE) - (size_t)b * S_ * D_; }


__device__ __forceinline__ float bf2f(bf16_t v) { return __uint_as_float(((unsigned)v) << 16); }
__device__ __forceinline__ bf16_t f2bf(float f) { unsigned u = __float_as_uint(f); u += 0x7fffu + ((u >> 16) & 1u); return (bf16_t)(u >> 16); }

__device__ __forceinline__ void rot_sincos(float ang, float& s, float& c) {
    const float n = rintf(ang * 0.15915494309189535f);
    float r = fmaf(-n, 6.28318548202514648f, ang);
    r = fmaf(-n, -1.74845553e-7f, r);
    const float rev = r * 0.15915494309189535f;
    s = __builtin_amdgcn_sinf(rev); c = __builtin_amdgcn_cosf(rev);
}
__device__ __forceinline__ float rope_inv_freq(int i) { return exp2f(-(float)i * 0.20762050593046014f); }

__device__ __forceinline__ int permA_src(int n) {
    if (n >= 1024) return n;
    const int tile = n >> 8, c = n & 255, bj = c >> 7, p = c & 127, hit = p >> 6, i = p & 63;
    return tile * 256 + hit * 128 + bj * 64 + i;
}

namespace pg8 {
#define PG8_LAS __attribute__((address_space(3)))
typedef unsigned short bf16_t;
typedef short bf16x8 __attribute__((ext_vector_type(8)));
typedef float f32x4 __attribute__((ext_vector_type(4)));
typedef unsigned u32x4 __attribute__((ext_vector_type(4)));
constexpr int BM = 256, BK = 64, HALF = 128, HTB = HALF * BK * 2  , STAGE_BYTES = 8 * HTB, NXCD = 8, WGM = 4;

__host__ __device__ __forceinline__ int lds_byte(int r, int c) { const int st = (r >> 4) * 2 + (c >> 5), rr = r & 15, cc = c & 31, ob = rr * 64 + cc * 2; return st * 1024 + (ob ^ (((ob >> 9) & 1) << 5)); }
__host__ __device__ __forceinline__ void stage_rc(int b, int& R, int& C) { const int st = b / 1024, sb = b % 1024, swz = sb ^ (((sb >> 9) & 1) << 5); R = (st >> 1) * 16 + swz / 64; C = (st & 1) * 32 + (swz % 64) / 2; }
__host__ __device__ __forceinline__ int perm32(int rho) { const int n = rho >> 4, i = rho & 15; return 8 * (i >> 2) + 4 * n + (i & 3); }

struct Unit { int pm, pn; };
struct Gemm { const bf16_t* A; const bf16_t* Bt; int M, N, K, lda; };

struct StaticOrder {
    int nM, nN, nwg, G, c;
    __host__ __device__ void init(int M, int N, int G_, int c_) { nM = M / BM; nN = N / BM; nwg = nM * nN; G = G_; c = c_; }
    __host__ __device__ bool next(int i, Unit& u) const {
        const long L = (long)i * G + c; if (L >= nwg) return false;
        int wgid = (int)L; { const int q = nwg / NXCD, r = nwg % NXCD, xcd = wgid % NXCD, off = wgid / NXCD; wgid = (xcd < r ? xcd * (q + 1) : r * (q + 1) + (xcd - r) * q) + off; }
        const int nig = WGM * nN, gid = wgid / nig, fm = gid * WGM, gsz = (nM - fm) < WGM ? (nM - fm) : WGM;
        u.pm = fm + ((wgid % nig) % gsz); u.pn = (wgid % nig) / gsz; return true;
    }
    __device__ __forceinline__ void a_ready(const Unit&) const {}
    __device__ __forceinline__ void done(const Unit&) const {}
};

typedef __bf16 bf16x2_hw __attribute__((ext_vector_type(2)));
typedef float f32x2_hw __attribute__((ext_vector_type(2)));
__device__ __forceinline__ unsigned cvt_pk_bf16_safe(float lo, float hi) { const f32x2_hw v = {lo, hi}; return __builtin_bit_cast(unsigned, __builtin_convertvector(v, bf16x2_hw)); }
__device__ __forceinline__ unsigned cvt_pk_bf16(float lo, float hi) { unsigned r; asm volatile("v_cvt_pk_bf16_f32 %0, %1, %2" : "=v"(r) : "v"(lo), "v"(hi)); return r; }
__device__ __forceinline__ float silu_fast(float v) { return v * __builtin_amdgcn_rcpf(1.0f + __builtin_amdgcn_exp2f(-1.4426950408889634f * v)); }
__device__ __forceinline__ u32x4 pack8_safe(const f32x4 a, const f32x4 b) { u32x4 w; w.x = cvt_pk_bf16_safe(a[0], a[1]); w.y = cvt_pk_bf16_safe(a[2], a[3]); w.z = cvt_pk_bf16_safe(b[0], b[1]); w.w = cvt_pk_bf16_safe(b[2], b[3]); return w; }
__device__ __forceinline__ u32x4 pack8(const f32x4 a, const f32x4 b) { u32x4 w; w.x = cvt_pk_bf16(a[0], a[1]); w.y = cvt_pk_bf16(a[2], a[3]); w.z = cvt_pk_bf16(b[0], b[1]); w.w = cvt_pk_bf16(b[2], b[3]); return w; }

struct EpiA {
    static constexpr bool PERM = true, AFTER_DRAIN = false, ACC_INIT = false;
    bf16_t* U; const float* rs0; const int* pos;
    __device__ __forceinline__ void operator()(const f32x4 (&acc)[2][2][4][2], const Unit& u, int wr, int wc, int fr, int fq) const {
        const int row0 = u.pm * BM + wr * 64 + fr;
        if (u.pn < 4) {
            const int hit = wc >> 1, i0 = 32 * (wc & 1) + 8 * fq; const float sc = u.pn >= 2 ? QK_SCALE : 1.0f;
            float inv[8];
#pragma unroll
            for (int j = 0; j < 8; ++j) inv[j] = rope_inv_freq(i0 + j);
#pragma unroll
            for (int ai = 0; ai < 2; ++ai)
#pragma unroll
                for (int m = 0; m < 4; ++m) { const int row = row0 + ai * HALF + m * 16; const float rs = rs0[row] * sc, pf = (float)pos[row];
                    bf16_t* up = U + (size_t)row * NA_ + u.pn * BM + hit * 128 + i0;
                    f32x4 o1[2], o2[2];
#pragma unroll
                    for (int n = 0; n < 2; ++n)
#pragma unroll
                        for (int e = 0; e < 4; ++e) { float sn, cs; rot_sincos(pf * inv[4 * n + e], sn, cs); const float x1 = acc[ai][0][m][n][e] * rs, x2 = acc[ai][1][m][n][e] * rs;
                            o1[n][e] = x1 * cs - x2 * sn; o2[n][e] = x1 * sn + x2 * cs; }
                    *(u32x4*)up = pack8(o1[0], o1[1]); *(u32x4*)(up + 64) = pack8(o2[0], o2[1]); }
        } else {
            const bool silu = (u.pn >= 8 && u.pn < 12) || u.pn >= 14;
#pragma unroll
            for (int ai = 0; ai < 2; ++ai)
#pragma unroll
                for (int m = 0; m < 4; ++m) { const int row = row0 + ai * HALF + m * 16; const float rs = rs0[row]; bf16_t* rowp = U + (size_t)row * NA_ + u.pn * BM + wc * 32 + 8 * fq;
#pragma unroll
                    for (int bj = 0; bj < 2; ++bj) { f32x4 v0 = acc[ai][bj][m][0] * rs, v1 = acc[ai][bj][m][1] * rs;
                        if (silu) {
#pragma unroll
                            for (int e = 0; e < 4; ++e) { v0[e] = silu_fast(v0[e]); v1[e] = silu_fast(v1[e]); } }
                        *(u32x4*)(rowp + bj * HALF) = pack8(v0, v1); } }
        }
    }
};
struct EpiOutA {
    static constexpr bool PERM = true, AFTER_DRAIN = false, ACC_INIT = true;
    const float* xres; float* out; bf16_t* x1b; float* ss1p;
    __device__ __forceinline__ void init(f32x4 (&acc)[2][2][4][2], const Unit& u, int wr, int wc, int fr, int fq) const {
        const int row0 = u.pm * BM + wr * 64 + fr;
#pragma unroll
        for (int ai = 0; ai < 2; ++ai)
#pragma unroll
            for (int m = 0; m < 4; ++m) { const size_t off = (size_t)(row0 + ai * HALF + m * 16) * D_ + u.pn * BM + wc * 32 + 8 * fq;
#pragma unroll
                for (int bj = 0; bj < 2; ++bj) { acc[ai][bj][m][0] = __builtin_nontemporal_load((const f32x4*)(xres + off + bj * HALF)); acc[ai][bj][m][1] = __builtin_nontemporal_load((const f32x4*)(xres + off + bj * HALF + 4)); } }
    }
    __device__ __forceinline__ void operator()(const f32x4 (&acc)[2][2][4][2], const Unit& u, int wr, int wc, int fr, int fq) const {
        const int row0 = u.pm * BM + wr * 64 + fr;
#pragma unroll
        for (int ai = 0; ai < 2; ++ai)
#pragma unroll
            for (int m = 0; m < 4; ++m) { const int row = row0 + ai * HALF + m * 16; const size_t off = (size_t)row * D_ + u.pn * BM + wc * 32 + 8 * fq; float ssq = 0.f;
#pragma unroll
                for (int bj = 0; bj < 2; ++bj) { const f32x4 v0 = acc[ai][bj][m][0], v1 = acc[ai][bj][m][1];
                    *(u32x4*)(x1b + off + bj * HALF) = pack8_safe(v0, v1);
                    ssq += (v0[0] * v0[0] + v0[1] * v0[1]) + (v0[2] * v0[2] + v0[3] * v0[3]) + (v1[0] * v1[0] + v1[1] * v1[1]) + (v1[2] * v1[2] + v1[3] * v1[3]); }
                ssq += __shfl_xor(ssq, 16); ssq += __shfl_xor(ssq, 32);
                if (fq == 0) ss1p[(size_t)row * 16 + u.pn * 4 + wc] = ssq; }
    }
};
struct EpiB {
    static constexpr bool PERM = true, AFTER_DRAIN = false, ACC_INIT = false;
    bf16_t* U; const float* ss1p;
    __device__ __forceinline__ void operator()(const f32x4 (&acc)[2][2][4][2], const Unit& u, int wr, int wc, int fr, int fq) const {
        const int row0 = u.pm * BM + wr * 64 + fr; const bool silu = (u.pn >= 8 && u.pn < 12) || u.pn >= 18; const float sc = (u.pn >= 12 && u.pn < 16) ? QK_SCALE * 1.4426950408889634f : 1.0f;
#pragma unroll
        for (int ai = 0; ai < 2; ++ai)
#pragma unroll
            for (int m = 0; m < 4; ++m) { const int row = row0 + ai * HALF + m * 16; const f32x4 pv = *(const f32x4*)(ss1p + (size_t)row * 16 + 4 * fq);
                float s = (pv[0] + pv[1]) + (pv[2] + pv[3]); s += __shfl_xor(s, 16); s += __shfl_xor(s, 32);
                const float rs = sc / sqrtf(s * (1.0f / D_) + EPS_); bf16_t* rowp = U + (size_t)row * NBW_ + u.pn * BM + wc * 32 + 8 * fq;
#pragma unroll
                for (int bj = 0; bj < 2; ++bj) { f32x4 v0 = acc[ai][bj][m][0] * rs, v1 = acc[ai][bj][m][1] * rs;
                    if (silu) {
#pragma unroll
                        for (int e = 0; e < 4; ++e) { v0[e] = silu_fast(v0[e]); v1[e] = silu_fast(v1[e]); } }
                    *(u32x4*)(rowp + bj * HALF) = pack8(v0, v1); } }
    }
};
struct EpiOutB {
    static constexpr bool PERM = false, AFTER_DRAIN = false, ACC_INIT = true;
    float* out; const bf16_t* x1b;
    __device__ __forceinline__ void init(f32x4 (&acc)[2][2][4][2], const Unit& u, int wr, int wc, int fr, int fq) const {
        const int row0 = u.pm * BM + wr * 64 + fr;
#pragma unroll
        for (int ai = 0; ai < 2; ++ai)
#pragma unroll
            for (int m = 0; m < 4; ++m) { const size_t off = (size_t)(row0 + ai * HALF + m * 16) * D_ + u.pn * BM + wc * 32 + 4 * fq;
#pragma unroll
                for (int bj = 0; bj < 2; ++bj)
#pragma unroll
                    for (int n = 0; n < 2; ++n) { const unsigned long long w = __builtin_nontemporal_load((const unsigned long long*)(x1b + off + bj * HALF + n * 16)); const unsigned lo = (unsigned)w, hi = (unsigned)(w >> 32);
                        acc[ai][bj][m][n] = (f32x4){__uint_as_float(lo << 16), __uint_as_float(lo & 0xffff0000u), __uint_as_float(hi << 16), __uint_as_float(hi & 0xffff0000u)}; } }
    }
    __device__ __forceinline__ void operator()(const f32x4 (&acc)[2][2][4][2], const Unit& u, int wr, int wc, int fr, int fq) const {
        const int row0 = u.pm * BM + wr * 64 + fr;
#pragma unroll
        for (int ai = 0; ai < 2; ++ai)
#pragma unroll
            for (int m = 0; m < 4; ++m) { const size_t off = (size_t)(row0 + ai * HALF + m * 16) * D_ + u.pn * BM + wc * 32 + 4 * fq;
#pragma unroll
                for (int bj = 0; bj < 2; ++bj)
#pragma unroll
                    for (int n = 0; n < 2; ++n) *(f32x4*)(out + off + bj * HALF + n * 16) = acc[ai][bj][m][n]; }
    }
};

struct EpiNull {
    static constexpr bool PERM = true, AFTER_DRAIN = false, ACC_INIT = false;
    float* sink;
    __device__ __forceinline__ void operator()(const f32x4 (&acc)[2][2][4][2], const Unit& u, int wr, int wc, int fr, int fq) const {
        f32x4 s = (f32x4){0.f, 0.f, 0.f, 0.f};
#pragma unroll
        for (int ai = 0; ai < 2; ++ai)
#pragma unroll
            for (int bj = 0; bj < 2; ++bj)
#pragma unroll
                for (int m = 0; m < 4; ++m) s += acc[ai][bj][m][0] + acc[ai][bj][m][1];
        const float t = (s[0] + s[1]) + (s[2] + s[3]);
        if (t == 1.2345678e33f) sink[0] = t;
    }
};
template <class Epi, class Sched, bool ALIGN_EPI = false, bool SP2 = false>
__device__ __forceinline__ void gemm_phase(PG8_LAS unsigned char* lds, const Gemm g, const Sched& S, const Epi& E) {
    const int tid = threadIdx.x, wid = __builtin_amdgcn_readfirstlane(tid >> 6), lane = tid & 63, wr = wid >> 2, wc = wid & 3, fr = lane & 15, fq = lane >> 4;
    const int K = g.K, nt = K / BK;
    unsigned voffA[2], voffB[2];
#pragma unroll
    for (int i = 0; i < 2; ++i) { int R, C; stage_rc(tid * 16 + i * 8192, R, C); const int Rb = Epi::PERM ? ((R & ~31) + perm32(R & 31)) : R;
        voffA[i] = (unsigned)(R * g.lda + C) * 2u; voffB[i] = (unsigned)(Rb * K + C) * 2u; }
    const size_t kstep = (size_t)(BK * 2);
    const size_t hstepA = (size_t)HALF * g.lda * 2, hstepB = (size_t)HALF * K * 2;
    const size_t tstepA = 2 * hstepA, tstepB = 2 * hstepB;
    const unsigned ldsw = (unsigned)wid * 1024u;
    const int aoff = lds_byte(wr * 64 + fr, fq * 8), boff = lds_byte(wc * 32 + fr, fq * 8);
#define PG8_SA(b, h) (((b) * 2 + (h)) * HTB)
#define PG8_SB(b, h) ((4 + (b) * 2 + (h)) * HTB)
#define PG8_STAGE(bufoff, gbase, voff) do { _Pragma("unroll") for (int _i = 0; _i < 2; ++_i) \
        __builtin_amdgcn_global_load_lds((const unsigned*)((const char*)(gbase) + (voff)[_i]), (PG8_LAS unsigned*)(lds + (bufoff) + ldsw + _i * 8192), 16, 0, 0); } while (0)
#define PG8_LDA(dst, b, h) do { _Pragma("unroll") for (int m = 0; m < 4; ++m) _Pragma("unroll") for (int k = 0; k < 2; ++k) dst[m][k] = *(const PG8_LAS bf16x8*)(lds + PG8_SA(b, h) + aoff + m * 2048 + k * 1024); } while (0)
#define PG8_LDB(dst, b, h) do { _Pragma("unroll") for (int n = 0; n < 2; ++n) _Pragma("unroll") for (int k = 0; k < 2; ++k) dst[n][k] = *(const PG8_LAS bf16x8*)(lds + PG8_SB(b, h) + boff + n * 2048 + k * 1024); } while (0)
#define PG8_MMA(ai, bj, At, Bt) do { __builtin_amdgcn_s_setprio(1); _Pragma("unroll") for (int m = 0; m < 4; ++m) _Pragma("unroll") for (int n = 0; n < 2; ++n) _Pragma("unroll") for (int k = 0; k < 2; ++k) \
        acc[ai][bj][m][n] = __builtin_amdgcn_mfma_f32_16x16x32_bf16(Bt[n][k], At[m][k], acc[ai][bj][m][n], 0, 0, 0); __builtin_amdgcn_s_setprio(0); } while (0)
#define PG8_WAIT_V(n) asm volatile("s_waitcnt vmcnt(" #n ")" ::: "memory")
#define PG8_WAIT_L(n) asm volatile("s_waitcnt lgkmcnt(" #n ")" ::: "memory")
#define PG8_BAR __builtin_amdgcn_s_barrier()
#define PG8_SCHED __builtin_amdgcn_sched_barrier(0)
    Unit cur, nxt; int ui = 0;
    if (!S.next(0, cur)) return;
    f32x4 acc[2][2][4][2];
#pragma unroll
    for (int a = 0; a < 2; ++a)
#pragma unroll
        for (int b = 0; b < 2; ++b)
#pragma unroll
            for (int m = 0; m < 4; ++m)
#pragma unroll
                for (int n = 0; n < 2; ++n) acc[a][b][m][n] = (f32x4){0.f, 0.f, 0.f, 0.f};
    if constexpr (Epi::ACC_INIT) E.init(acc, cur, wr, wc, fr, fq);
    bf16x8 At[4][2], B0[2][2], B1[2][2];
    const char* cA = (const char*)g.A + (size_t)cur.pm * tstepA; const char* cB = (const char*)g.Bt + (size_t)cur.pn * tstepB;
    S.a_ready(cur);
    if constexpr (SP2) {
        PG8_STAGE(PG8_SB(0, 0), cB, voffB); PG8_STAGE(PG8_SB(0, 1), cB + hstepB, voffB); PG8_STAGE(PG8_SA(0, 0), cA, voffA); PG8_STAGE(PG8_SA(0, 1), cA + hstepA, voffA);
        if (wr == 1) PG8_BAR;
        PG8_WAIT_V(2); PG8_BAR;
        PG8_STAGE(PG8_SB(1, 0), cB + kstep, voffB); PG8_STAGE(PG8_SA(1, 0), cA + kstep, voffA); PG8_STAGE(PG8_SB(1, 1), cB + hstepB + kstep, voffB);
        PG8_WAIT_V(6); PG8_BAR;
    } else {
        PG8_STAGE(PG8_SB(0, 0), cB, voffB); PG8_STAGE(PG8_SA(0, 0), cA, voffA); PG8_STAGE(PG8_SB(0, 1), cB + hstepB, voffB); PG8_STAGE(PG8_SA(0, 1), cA + hstepA, voffA);
        if (wr == 1) PG8_BAR;
        PG8_WAIT_V(4); PG8_BAR;
        PG8_STAGE(PG8_SB(1, 0), cB + kstep, voffB); PG8_STAGE(PG8_SA(1, 0), cA + kstep, voffA); PG8_STAGE(PG8_SB(1, 1), cB + hstepB + kstep, voffB);
        PG8_WAIT_V(6); PG8_BAR;
    }
    for (;;) {
        const bool has_next = S.next(ui + 1, nxt);
        const char* nA = has_next ? (const char*)g.A + (size_t)nxt.pm * tstepA : cA; const char* nB = has_next ? (const char*)g.Bt + (size_t)nxt.pn * tstepB : cB;
        for (int t = 0; t < nt; t += 2) {
            const bool last = (t == nt - 2);
            const char* a1 = cA + (size_t)(t + 1) * kstep;
            const char* a2 = last ? nA : cA + (size_t)(t + 2) * kstep; const char* b2 = last ? nB : cB + (size_t)(t + 2) * kstep;
            const char* a3 = a2 + kstep; const char* b3 = b2 + kstep;
            if (last && has_next) S.a_ready(nxt);
            if constexpr (SP2) {
            PG8_LDB(B0, 0, 0); PG8_LDB(B1, 0, 1); PG8_SCHED; PG8_LDA(At, 0, 0); PG8_STAGE(PG8_SA(1, 1), a1 + hstepA, voffA);
            PG8_WAIT_V(8); PG8_WAIT_L(0); PG8_BAR; PG8_MMA(0, 0, At, B0); PG8_MMA(0, 1, At, B1); PG8_BAR; PG8_SCHED;
            PG8_LDA(At, 0, 1); PG8_STAGE(PG8_SB(0, 0), b2, voffB); PG8_STAGE(PG8_SB(0, 1), b2 + hstepB, voffB); PG8_STAGE(PG8_SA(0, 0), a2, voffA);
            PG8_WAIT_V(8); PG8_WAIT_L(0); PG8_BAR; PG8_MMA(1, 0, At, B0); PG8_MMA(1, 1, At, B1); PG8_BAR; PG8_SCHED;
            PG8_LDB(B0, 1, 0); PG8_LDB(B1, 1, 1); PG8_SCHED; PG8_LDA(At, 1, 0); PG8_STAGE(PG8_SA(0, 1), a2 + hstepA, voffA);
            PG8_WAIT_V(8); PG8_WAIT_L(0); PG8_BAR; PG8_MMA(0, 0, At, B0); PG8_MMA(0, 1, At, B1); PG8_BAR; PG8_SCHED;
            PG8_LDA(At, 1, 1); PG8_STAGE(PG8_SB(1, 0), b3, voffB); PG8_STAGE(PG8_SB(1, 1), b3 + hstepB, voffB); PG8_STAGE(PG8_SA(1, 0), a3, voffA);
            PG8_WAIT_V(8); PG8_WAIT_L(0); PG8_BAR; PG8_MMA(1, 0, At, B0); PG8_MMA(1, 1, At, B1); PG8_BAR; PG8_SCHED;
            } else {
            PG8_LDB(B0, 0, 0); PG8_SCHED; PG8_LDA(At, 0, 0); PG8_STAGE(PG8_SA(1, 1), a1 + hstepA, voffA);
            PG8_WAIT_L(8); PG8_BAR; PG8_WAIT_L(0); PG8_MMA(0, 0, At, B0); PG8_BAR; PG8_SCHED;
            PG8_LDB(B1, 0, 1); PG8_STAGE(PG8_SB(0, 0), b2, voffB);
            PG8_BAR; PG8_WAIT_L(0); PG8_MMA(0, 1, At, B1); PG8_BAR;
            PG8_LDA(At, 0, 1); PG8_STAGE(PG8_SA(0, 0), a2, voffA);
            PG8_BAR; PG8_WAIT_L(0); PG8_MMA(1, 0, At, B0); PG8_BAR; PG8_SCHED;
            PG8_STAGE(PG8_SB(0, 1), b2 + hstepB, voffB);
            PG8_WAIT_V(6); PG8_BAR; PG8_MMA(1, 1, At, B1); PG8_BAR;
            PG8_LDB(B0, 1, 0); PG8_SCHED; PG8_LDA(At, 1, 0); PG8_STAGE(PG8_SA(0, 1), a2 + hstepA, voffA);
            PG8_WAIT_L(8); PG8_BAR; PG8_WAIT_L(0); PG8_MMA(0, 0, At, B0); PG8_BAR; PG8_SCHED;
            PG8_LDB(B1, 1, 1); PG8_STAGE(PG8_SB(1, 0), b3, voffB);
            PG8_BAR; PG8_WAIT_L(0); PG8_MMA(0, 1, At, B1); PG8_BAR;
            PG8_LDA(At, 1, 1); PG8_STAGE(PG8_SA(1, 0), a3, voffA);
            PG8_BAR; PG8_WAIT_L(0); PG8_MMA(1, 0, At, B0); PG8_BAR; PG8_SCHED;
            PG8_STAGE(PG8_SB(1, 1), b3 + hstepB, voffB);
            PG8_WAIT_V(6); PG8_BAR; PG8_MMA(1, 1, At, B1); PG8_BAR;
            }
        }
        if constexpr (ALIGN_EPI) { if (wr == 0) PG8_BAR; }
        if constexpr (!Epi::AFTER_DRAIN) { E(acc, cur, wr, wc, fr, fq); S.done(cur); }
        if (!has_next) break;
#pragma unroll
        for (int a = 0; a < 2; ++a)
#pragma unroll
            for (int b = 0; b < 2; ++b)
#pragma unroll
                for (int m = 0; m < 4; ++m)
#pragma unroll
                    for (int n = 0; n < 2; ++n) acc[a][b][m][n] = (f32x4){0.f, 0.f, 0.f, 0.f};
        cur = nxt; cA = nA; cB = nB; ++ui;
        if constexpr (Epi::ACC_INIT) E.init(acc, cur, wr, wc, fr, fq);
        if constexpr (ALIGN_EPI) { if (wr == 1) PG8_BAR; }
    }
    PG8_WAIT_V(0);
    if constexpr (!ALIGN_EPI) { if (wr == 0) PG8_BAR; }
    PG8_BAR;
    if constexpr (Epi::AFTER_DRAIN) { E.fused(acc, cur, wr, wc, fr, fq, lds, wid, lane); S.done(cur); }
#undef PG8_SA
#undef PG8_SB
#undef PG8_STAGE
#undef PG8_LDA
#undef PG8_LDB
#undef PG8_MMA
#undef PG8_WAIT_V
#undef PG8_WAIT_L
#undef PG8_BAR
#undef PG8_SCHED
}
}

#define LAS __attribute__((address_space(3)))
#define XB_TMO      128
#define XB_XCNT(j)  (256  + 64 * (j))
#define XB_XSUB(j)  (1280 + 64 * (j))
#define XB_XGEN(j)  (2304 + 64 * (j))
#define XB_TOP      3328
#define XB_TOPGEN   3392
#define XCD_BAR_WORDS 3456
#define XB_SPIN_CAP (1u << 18)

__device__ __forceinline__ unsigned xb_ld(unsigned* p)              { return __hip_atomic_load(p, __ATOMIC_RELAXED, __HIP_MEMORY_SCOPE_AGENT); }
__device__ __forceinline__ unsigned xb_add(unsigned* p, unsigned v) { return __hip_atomic_fetch_add(p, v, __ATOMIC_RELAXED, __HIP_MEMORY_SCOPE_AGENT); }
__device__ __forceinline__ unsigned xb_xcc_id() { return (unsigned)__builtin_amdgcn_s_getreg((3 << 11) | 20) & 0xFu; }
#define XB_SPIN(cond, bar) do { unsigned _sp = 0; while (cond) { __builtin_amdgcn_s_sleep(1); \
    if ((++_sp & 255u) == 0u) { if (xb_ld(&(bar)[XB_TMO])) break; if (_sp > XB_SPIN_CAP) { atomicAdd(&(bar)[XB_TMO], 1u); break; } } } } while (0)

struct XcdBarrier {
    unsigned* bar; unsigned x; unsigned G;
    volatile LAS unsigned* st;
};

__device__ __forceinline__ XcdBarrier xcd_barrier_post(unsigned* bar, volatile LAS unsigned* st, unsigned G) {
    XcdBarrier b; b.bar = bar; b.x = xb_xcc_id(); b.st = st; b.G = G;
    if (threadIdx.x == 0) (void)xb_add(&bar[XB_XCNT(b.x)], 1u);
    return b;
}
__device__ __forceinline__ void xcd_barrier_complete(unsigned* bar, unsigned x, unsigned G, unsigned& nloc, unsigned& nx) {
    unsigned sum, cnt, mine, sp = 0u;
    for (;;) {
        sum = 0u; cnt = 0u; mine = 0u;
#pragma unroll
        for (unsigned j = 0; j < 16; ++j) { const unsigned c = xb_ld(&bar[XB_XCNT(j)]); sum += c; cnt += (c > 0u) ? 1u : 0u; mine = (j == x) ? c : mine; }
        if (sum == G) break;
        __builtin_amdgcn_s_sleep(1);
        if ((++sp & 255u) == 0u) { if (xb_ld(&bar[XB_TMO])) break; if (sp > XB_SPIN_CAP) { atomicAdd(&bar[XB_TMO], 1u); break; } }
    }
    nloc = mine > 0u ? mine : 1u; nx = cnt > 0u ? cnt : 1u;
}

__device__ __forceinline__ void xcd_barrier(const XcdBarrier& b) {
    asm volatile("s_waitcnt vmcnt(0)" ::: "memory");
    __syncthreads();
    if (threadIdx.x == 0) {
        unsigned* bar = b.bar;
        __builtin_amdgcn_s_waitcnt(0);
        unsigned nloc = b.st[0], nx = b.st[1];
        if (nloc == 0u) { xcd_barrier_complete(bar, b.x, b.G, nloc, nx); b.st[0] = nloc; b.st[1] = nx; }
        const unsigned old = xb_add(&bar[XB_XSUB(b.x)], 1u);
        const unsigned gen = old / nloc;
        if (old + 1u == (gen + 1u) * nloc) {
            __builtin_amdgcn_fence(__ATOMIC_RELEASE, "agent");
            asm volatile("s_waitcnt vmcnt(0)" ::: "memory");
            const unsigned og = xb_add(&bar[XB_TOP], 1u);
            const unsigned tg = og / nx;
            if (og + 1u == (tg + 1u) * nx) xb_add(&bar[XB_TOPGEN], 1u);
            else XB_SPIN(xb_ld(&bar[XB_TOPGEN]) == tg, bar);
            __builtin_amdgcn_fence(__ATOMIC_ACQUIRE, "agent");
            xb_add(&bar[XB_XGEN(b.x)], 1u);
            asm volatile("s_waitcnt vmcnt(0)" ::: "memory");
        } else {
            XB_SPIN(xb_ld(&bar[XB_XGEN(b.x)]) == gen, bar);
            __builtin_amdgcn_fence(__ATOMIC_ACQUIRE, "agent");
            asm volatile("s_waitcnt vmcnt(0)" ::: "memory");
        }
    }
    __syncthreads();
}

constexpr int NWAVES = 8;
constexpr int RING_BYTES = 131072;
constexpr int LDSCTL_OFF = 139264;
constexpr int LDS_BYTES = 147456;
constexpr int CW_BAR = 4096;
constexpr size_t CTL_ZERO_BYTES = 131072;
#ifndef OPT_MASK
#define OPT_MASK 0x1FF
#endif

typedef float f32x4 __attribute__((ext_vector_type(4)));
typedef unsigned u32x4v __attribute__((ext_vector_type(4)));
typedef unsigned u32x2v __attribute__((ext_vector_type(2)));
typedef short bf16x8 __attribute__((ext_vector_type(8)));
#define LDS_WAIT() asm volatile("s_waitcnt lgkmcnt(0)" ::: "memory")

struct MArgs { const float* in[16]; float* out; unsigned char* ws; int ph_lo, ph_hi, li, pad; };
struct Frame { LAS unsigned char* lds; int tid, lane, wave, G, bid, grp, gi, gs, b0, nb; const float* in[16]; float* out; unsigned char* ws; };
#ifndef NGRP
#define NGRP 2
#endif
#ifndef LATE_G0
#define LATE_G0 0
#endif
constexpr int CW_LATE = 64;

__device__ __forceinline__ unsigned pk2(float lo, float hi) { return pg8::cvt_pk_bf16(lo, hi); }
__device__ __forceinline__ float wave_sum(float v) {
#pragma unroll
    for (int o = 1; o < 64; o <<= 1) v += __shfl_xor(v, o);
    return v;
}

template <int NR> __device__ __forceinline__ void p0_x_rows(const float* x, bf16_t* xb, float* rs, int row, int lane) {
    f32x4 v[NR][4]; float s[NR];
#pragma unroll
    for (int r = 0; r < NR; ++r) { const f32x4* xr = (const f32x4*)(x + (size_t)(row + r) * D_) + lane;
#pragma unroll
        for (int j = 0; j < 4; ++j) v[r][j] = __builtin_nontemporal_load(xr + 64 * j); }
#pragma unroll
    for (int r = 0; r < NR; ++r) { s[r] = 0.f;
#pragma unroll
        for (int j = 0; j < 4; ++j) s[r] += (v[r][j][0] * v[r][j][0] + v[r][j][1] * v[r][j][1]) + (v[r][j][2] * v[r][j][2] + v[r][j][3] * v[r][j][3]); }
#pragma unroll
    for (int o = 1; o < 64; o <<= 1)
#pragma unroll
        for (int r = 0; r < NR; ++r) s[r] += __shfl_xor(s[r], o);
#pragma unroll
    for (int r = 0; r < NR; ++r) { u32x2v* o8 = (u32x2v*)(xb + (size_t)(row + r) * D_) + lane;
#pragma unroll
        for (int j = 0; j < 4; ++j) { u32x2v w; w.x = pk2(v[r][j][0], v[r][j][1]); w.y = pk2(v[r][j][2], v[r][j][3]); o8[64 * j] = w; }
        if (lane == 0) rs[row + r] = 1.0f / sqrtf(s[r] * (1.0f / D_) + EPS_); }
}
constexpr int TSCR_BYTES = 64 * 65 * 4;
__device__ __forceinline__ void p0_transpose_item(const float* W, int ldw, int csrc, const float* gain, int gmask, bf16_t* WT, int K, int nrow, int k0, LAS float* scr, int lane) {
    const int kk = lane >> 4, nq = lane & 15;
    f32x4 v[16];
#pragma unroll
    for (int j = 0; j < 16; ++j) v[j] = __builtin_nontemporal_load((const f32x4*)(W + (size_t)(k0 + 4 * j + kk) * ldw + csrc + 4 * nq));
#pragma unroll
    for (int j = 0; j < 16; ++j) { const int k = 4 * j + kk; LAS float* d = scr + k * 65 + ((4 * nq + 4 * (j >> 3)) & 63);
        d[0] = v[j][0]; d[1] = v[j][1]; d[2] = v[j][2]; d[3] = v[j][3]; }
    const int c = lane & 7, nr = lane >> 3;
    f32x4 g0 = (f32x4){1.f, 1.f, 1.f, 1.f}, g1 = g0;
    if (gain) { g0 = *(const f32x4*)(gain + ((k0 + 8 * c) & gmask)); g1 = *(const f32x4*)(gain + ((k0 + 8 * c + 4) & gmask)); }
    LDS_WAIT(); asm volatile("" ::: "memory");
#pragma unroll
    for (int jj = 0; jj < 8; ++jj) { const int n = nr + 8 * jj; const LAS float* s = scr + (8 * c) * 65 + ((n + 4 * (c >> 2)) & 63);
        u32x4v o; o.x = pk2(s[0 * 65] * g0[0], s[1 * 65] * g0[1]); o.y = pk2(s[2 * 65] * g0[2], s[3 * 65] * g0[3]); o.z = pk2(s[4 * 65] * g1[0], s[5 * 65] * g1[1]); o.w = pk2(s[6 * 65] * g1[2], s[7 * 65] * g1[3]);
        *(u32x4v*)(WT + (size_t)(nrow + n) * K + k0 + 8 * c) = o; }
    LDS_WAIT(); asm volatile("" ::: "memory");
}
__device__ __forceinline__ void p0_memkv(const Frame& F, int unit) {
    const int l = unit >> 7, b = (unit >> 6) & 1, mt = (unit >> 3) & 7, cg = unit & 7, lane = F.lane, w = F.wave, c = lane & 15, g4 = lane >> 4, cgw = w & 1, kq = w >> 1;
    const float* mem = F.in[1] + ((size_t)b * 256 + mt * 32) * D_; const float* W = F.in[13] + (size_t)l * D_ * 1024 + cg * 128 + 64 * cgw + 4 * c; const float* gm = F.in[12] + l * D_;
    f32x4 acc[4][2];
#pragma unroll
    for (int t = 0; t < 4; ++t) { acc[t][0] = (f32x4){0.f, 0.f, 0.f, 0.f}; acc[t][1] = (f32x4){0.f, 0.f, 0.f, 0.f}; }
#pragma unroll 4
    for (int ks = 0; ks < 8; ++ks) { const int kb = kq * 256 + ks * 32 + 8 * g4;
        const f32x4 g0 = *(const f32x4*)(gm + kb), g1 = *(const f32x4*)(gm + kb + 4);
        bf16x8 afr[2], bfr[4];
#pragma unroll
        for (int rb = 0; rb < 2; ++rb) { const float* p = mem + (size_t)(rb * 16 + c) * D_ + kb; const f32x4 a0 = *(const f32x4*)p * g0, a1 = *(const f32x4*)(p + 4) * g1;
            u32x4v t; t.x = pk2(a0[0], a0[1]); t.y = pk2(a0[2], a0[3]); t.z = pk2(a1[0], a1[1]); t.w = pk2(a1[2], a1[3]); afr[rb] = __builtin_bit_cast(bf16x8, t); }
        f32x4 wv[8];
#pragma unroll
        for (int j = 0; j < 8; ++j) wv[j] = *(const f32x4*)(W + (size_t)(kb + j) * 1024);
#pragma unroll
        for (int t = 0; t < 4; ++t) { u32x4v q; q.x = pk2(wv[0][t], wv[1][t]); q.y = pk2(wv[2][t], wv[3][t]); q.z = pk2(wv[4][t], wv[5][t]); q.w = pk2(wv[6][t], wv[7][t]); bfr[t] = __builtin_bit_cast(bf16x8, q); }
#pragma unroll
        for (int t = 0; t < 4; ++t)
#pragma unroll
            for (int rb = 0; rb < 2; ++rb) acc[t][rb] = __builtin_amdgcn_mfma_f32_16x16x32_bf16(afr[rb], bfr[t], acc[t][rb], 0, 0, 0);
    }
    LAS float* P = (LAS float*)F.lds;
#pragma unroll
    for (int rb = 0; rb < 2; ++rb)
#pragma unroll
        for (int r = 0; r < 4; ++r) { const int tok = rb * 16 + 4 * g4 + r; *(LAS f32x4*)(P + ((kq * 32 + tok) * 128 + 64 * cgw + 4 * c)) = (f32x4){acc[0][rb][r], acc[1][rb][r], acc[2][rb][r], acc[3][rb][r]}; }
    __syncthreads();
    const int tok = F.tid >> 4, cb = F.tid & 15;
    f32x4 s0 = (f32x4){0.f, 0.f, 0.f, 0.f}, s1 = s0;
#pragma unroll
    for (int q = 0; q < 4; ++q) { s0 += *(const LAS f32x4*)(P + ((q * 32 + tok) * 128 + cb * 8)); s1 += *(const LAS f32x4*)(P + ((q * 32 + tok) * 128 + cb * 8 + 4)); }
    float ms = 0.f; { const f32x4* mr = (const f32x4*)(mem + (size_t)tok * D_ + cb * 64);
#pragma unroll
        for (int j = 0; j < 16; ++j) { const f32x4 v = mr[j]; ms += (v[0] * v[0] + v[1] * v[1]) + (v[2] * v[2] + v[3] * v[3]); } }
    ms += __shfl_xor(ms, 1); ms += __shfl_xor(ms, 2); ms += __shfl_xor(ms, 4); ms += __shfl_xor(ms, 8);
    const float rm = 1.0f / sqrtf(ms * (1.0f / D_) + EPS_);
    s0 *= rm; s1 *= rm;
    const size_t orow = ((((size_t)l * 2 + b) * 4 + (cg & 3)) * 256 + mt * 32 + tok) * 128 + cb * 8;
    if (cg < 4) {
        float q = (s0[0] * s0[0] + s0[1] * s0[1]) + (s0[2] * s0[2] + s0[3] * s0[3]) + (s1[0] * s1[0] + s1[1] * s1[1]) + (s1[2] * s1[2] + s1[3] * s1[3]);
        q += __shfl_xor(q, 1); q += __shfl_xor(q, 2); q += __shfl_xor(q, 4); q += __shfl_xor(q, 8);
        const float hn = QK_SCALE / sqrtf(q * (1.0f / 128) + EPS_);
        const f32x4 gk0 = *(const f32x4*)(F.in[15] + l * 128 + cb * 8), gk1 = *(const f32x4*)(F.in[15] + l * 128 + cb * 8 + 4);
        const f32x4 gq0 = *(const f32x4*)(F.in[14] + l * 128 + cb * 8), gq1 = *(const f32x4*)(F.in[14] + l * 128 + cb * 8 + 4);
        s0 = s0 * hn * gk0 * gq0; s1 = s1 * hn * gk1 * gq1;
        *(u32x4v*)((bf16_t*)(F.ws + WS_MEMK) + orow) = pg8::pack8(s0, s1);
    } else *(u32x4v*)((bf16_t*)(F.ws + WS_MEMV) + orow) = pg8::pack8(s0, s1);
    __syncthreads();
}
__device__ __forceinline__ void p0_weight_item(const Frame& F, int r, LAS float* scr) {
    constexpr int I_A = 16 * 64, I_OA = 24 * 16, I_B = 16 * 80;
    if (r < I_A) { const int kb = r / 64, n0 = 64 * (r % 64); p0_transpose_item(F.in[4], 4096, permA_src(n0), F.in[3], 0xffff, (bf16_t*)(F.ws + WS_WINA), 1024, n0, 64 * kb, scr, F.lane); return; } r -= I_A;
    if (r < I_OA) { const int kb = r / 16, n0 = 64 * (r % 16); p0_transpose_item(F.in[6], 1024, n0, kb < 16 ? F.in[5] : nullptr, 255, (bf16_t*)(F.ws + WS_WOUTA), 1536, n0, 64 * kb, scr, F.lane); return; } r -= I_OA;
    if (r < I_B) { const int kb = r / 80, n0 = 64 * (r % 80);
        if (n0 < 2048) p0_transpose_item(F.in[8], 2048, n0, F.in[7], 0xffff, (bf16_t*)(F.ws + WS_WB), 1024, n0, 64 * kb, scr, F.lane);
        else { const int c = n0 - 2048, src = c < 1024 ? 1024 + c : (c < 2048 ? c - 1024 : c); p0_transpose_item(F.in[10], 3072, src, F.in[9], 0xffff, (bf16_t*)(F.ws + WS_WB), 1024, n0, 64 * kb, scr, F.lane); }
        return; } r -= I_B;
    { const int kb = r / 16, n0 = 64 * (r % 16); p0_transpose_item(F.in[11], 1024, n0, nullptr, 0, (bf16_t*)(F.ws + WS_WOUTB), 1536, n0, 64 * kb, scr, F.lane); }
}
__device__ __forceinline__ void p0_prologue(const Frame& F) {
    for (int u = F.bid; u < 256; u += F.G) p0_memkv(F, u);
    const int gw = F.bid * NWAVES + F.wave, NGW = F.G * NWAVES;
    LAS float* scr = (LAS float*)(F.lds + F.wave * TSCR_BYTES);
    float* RS0 = (float*)(F.ws + WS_RS0); const float* x = F.in[0];
    if (NGW == 2048) {
        if (gw < 1024) { p0_weight_item(F, gw, scr); p0_x_rows<4>(x, x1b_ptr(F.ws, (6 * gw) >> 13), RS0, 6 * gw, F.lane); if (NGRP == 1) p0_weight_item(F, gw + 2048, scr); p0_x_rows<2>(x, x1b_ptr(F.ws, (6 * gw + 4) >> 13), RS0, 6 * gw + 4, F.lane); }
        else { const int r0 = 6144 + 10 * (gw - 1024); p0_x_rows<4>(x, x1b_ptr(F.ws, r0 >> 13), RS0, r0, F.lane); if (NGRP == 1) p0_weight_item(F, gw, scr); p0_x_rows<4>(x, x1b_ptr(F.ws, (r0 + 4) >> 13), RS0, r0 + 4, F.lane); p0_x_rows<2>(x, x1b_ptr(F.ws, (r0 + 8) >> 13), RS0, r0 + 8, F.lane); }
    } else {
        for (int it = gw; it < (NGRP == 2 ? 1024 : 3072); it += NGW) p0_weight_item(F, it, scr);
        for (int m = 4 * gw; m < T_; m += 4 * NGW) p0_x_rows<4>(x, x1b_ptr(F.ws, m >> 13), RS0, m, F.lane);
    }
}
__device__ __forceinline__ void p0_late_weights(const Frame& F) {
    LAS float* scr = (LAS float*)(F.lds + F.wave * TSCR_BYTES);
    const int wv = F.gi * NWAVES + F.wave, nw = F.gs * NWAVES;
    if (F.grp == 0) { for (int it = 1024 + wv; it < 1024 + LATE_G0; it += nw) p0_weight_item(F, it, scr); }
    else { for (int it = 1024 + LATE_G0 + wv; it < 3072; it += nw) p0_weight_item(F, it, scr); }
}

typedef float f32x16 __attribute__((ext_vector_type(16)));
typedef short s16x4 __attribute__((ext_vector_type(4)));
#define KSWZ(row, colB) ((row) * 256 + ((colB) ^ (((row) & 7) << 4)))
#define SBAR() __builtin_amdgcn_sched_barrier(0)
constexpr float LOG2E = 1.4426950408889634f;
__device__ __forceinline__ int crow(int r, int hi) { return (r & 3) + 8 * (r >> 2) + 4 * hi; }
__device__ __forceinline__ unsigned lds_addr(const LAS void* p) { return (unsigned)(size_t)p; }
__device__ __forceinline__ int v_st(int k, int c) { const int kk = (k & ~0xC) | ((k & 4) << 1) | ((k & 8) >> 1); return ((kk >> 3) * 4 + (c >> 5)) * 512 + ((kk & 7) * 32 + (c & 31)) * 2; }
__device__ __forceinline__ int v_rd_base(int lane) { return ((lane & 3) << 3) | (((lane >> 2) & 3) << 6) | (((lane >> 4) & 1) << 5) | (((lane >> 5) & 1) << 8); }
constexpr int v_rd_off(int d0, int ks, int half) { return d0 * 512 + ks * 4096 + half * 2048; }
template <int OFF> __device__ __forceinline__ s16x4 tr_read(unsigned vb) { s16x4 r; asm volatile("ds_read_b64_tr_b16 %0, %1 offset:%2" : "=&v"(r) : "v"(vb), "i"(OFF) : "memory"); return r; }
#define PKLH(L, H) (bf16x8){L[0], L[1], L[2], L[3], H[0], H[1], H[2], H[3]}
__device__ __forceinline__ float partner32(float x, int hi) { auto rr = __builtin_amdgcn_permlane32_swap(__float_as_uint(x), __float_as_uint(x), false, false); return __uint_as_float(hi ? rr[0] : rr[1]); }

__device__ __forceinline__ void qkt(f32x16& p0, f32x16& p1, const LAS unsigned char* Ks, const bf16x8* qr, int r32, int hi) {
    p0 = f32x16{}; p1 = f32x16{};
#pragma unroll
    for (int d0 = 0; d0 < 8; ++d0) { const int cb = (d0 * 16 + hi * 8) * 2;
        const bf16x8 b0 = *(const LAS bf16x8*)(Ks + KSWZ(r32, cb)), b1 = *(const LAS bf16x8*)(Ks + KSWZ(32 + r32, cb));
        p0 = __builtin_amdgcn_mfma_f32_32x32x16_bf16(b0, qr[d0], p0, 0, 0, 0);
        p1 = __builtin_amdgcn_mfma_f32_32x32x16_bf16(b1, qr[d0], p1, 0, 0, 0); }
}
#define PK4(P, BASE, OUT) do { unsigned a0_ = pg8::cvt_pk_bf16(P[BASE + 0], P[BASE + 1]), a1_ = pg8::cvt_pk_bf16(P[BASE + 2], P[BASE + 3]); \
    unsigned b0_ = pg8::cvt_pk_bf16(P[BASE + 4], P[BASE + 5]), b1_ = pg8::cvt_pk_bf16(P[BASE + 6], P[BASE + 7]); \
    auto r0_ = __builtin_amdgcn_permlane32_swap(a0_, b0_, false, false); auto r1_ = __builtin_amdgcn_permlane32_swap(a1_, b1_, false, false); \
    u32x4v w_ = {r0_[0], r1_[0], r0_[1], r1_[1]}; OUT = __builtin_bit_cast(bf16x8, w_); } while (0)
template <int D0> __device__ __forceinline__ void pv_one(f32x16& od, unsigned vb, bf16x8 pa0, bf16x8 pa1, bf16x8 pa2, bf16x8 pa3) {
    const s16x4 l0 = tr_read<v_rd_off(D0, 0, 0)>(vb), h0 = tr_read<v_rd_off(D0, 0, 1)>(vb), l1 = tr_read<v_rd_off(D0, 1, 0)>(vb), h1 = tr_read<v_rd_off(D0, 1, 1)>(vb);
    const s16x4 l2 = tr_read<v_rd_off(D0, 2, 0)>(vb), h2 = tr_read<v_rd_off(D0, 2, 1)>(vb), l3 = tr_read<v_rd_off(D0, 3, 0)>(vb), h3 = tr_read<v_rd_off(D0, 3, 1)>(vb);
    asm volatile("s_waitcnt lgkmcnt(0)" ::: "memory"); SBAR();
    od = __builtin_amdgcn_mfma_f32_32x32x16_bf16(pa0, PKLH(l0, h0), od, 0, 0, 0);
    od = __builtin_amdgcn_mfma_f32_32x32x16_bf16(pa1, PKLH(l1, h1), od, 0, 0, 0);
    od = __builtin_amdgcn_mfma_f32_32x32x16_bf16(pa2, PKLH(l2, h2), od, 0, 0, 0);
    od = __builtin_amdgcn_mfma_f32_32x32x16_bf16(pa3, PKLH(l3, h3), od, 0, 0, 0);
}
__device__ __forceinline__ void pv_d0(f32x16* o, unsigned vb, bf16x8 pa0, bf16x8 pa1, bf16x8 pa2, bf16x8 pa3) {
    pv_one<0>(o[0], vb, pa0, pa1, pa2, pa3); pv_one<1>(o[1], vb, pa0, pa1, pa2, pa3); pv_one<2>(o[2], vb, pa0, pa1, pa2, pa3); pv_one<3>(o[3], vb, pa0, pa1, pa2, pa3);
}
constexpr int WSCR_OFF = LDSCTL_OFF + 1024, WFLAG_OFF = LDSCTL_OFF + 512;


__device__ __forceinline__ void o_tile_stage(const f32x16* o, const float* rsc, LAS unsigned char* stg, int r32, int hi) {
#pragma unroll
    for (int r = 0; r < 16; ++r) { LAS bf16_t* sp = (LAS bf16_t*)(stg + crow(r, hi) * 256) + r32;
#pragma unroll
        for (int db = 0; db < 4; ++db) sp[32 * db] = (bf16_t)(pg8::cvt_pk_bf16_safe(o[db][r] * rsc[r], 0.f) & 0xffffu); }
}
__device__ __forceinline__ void o_tile_out(const LAS unsigned char* stg, const bf16_t* gate, bf16_t* out, size_t ld, int lane) {
    const int rr = lane >> 4, ch = lane & 15;
#pragma unroll
    for (int ps = 0; ps < 8; ++ps) { const int row = 4 * ps + rr; const bf16x8 v = *(const LAS bf16x8*)(stg + row * 256 + ch * 16); const bf16x8 g = __builtin_nontemporal_load((const bf16x8*)(gate + (size_t)row * ld + ch * 8));
        u32x4v w; w.x = pk2(bf2f((bf16_t)v[0]) * bf2f((bf16_t)g[0]), bf2f((bf16_t)v[1]) * bf2f((bf16_t)g[1])); w.y = pk2(bf2f((bf16_t)v[2]) * bf2f((bf16_t)g[2]), bf2f((bf16_t)v[3]) * bf2f((bf16_t)g[3]));
        w.z = pk2(bf2f((bf16_t)v[4]) * bf2f((bf16_t)g[4]), bf2f((bf16_t)v[5]) * bf2f((bf16_t)g[5])); w.w = pk2(bf2f((bf16_t)v[6]) * bf2f((bf16_t)g[6]), bf2f((bf16_t)v[7]) * bf2f((bf16_t)g[7]));
        *(u32x4v*)(out + (size_t)row * ld + ch * 8) = w; }
}


template <bool MASK, int KOFF> __device__ __forceinline__ void sb_half_a(f32x16& p, float* go, int lim) {
#pragma unroll
    for (int i = 0; i < 4; ++i) { float l[4];
#pragma unroll
        for (int e = 0; e < 4; ++e) { const float y = fminf(p[4 * i + e], 60.f), sp = __builtin_amdgcn_logf(1.0f + __builtin_amdgcn_exp2f(y));
            l[e] = -sp; p[4 * i + e] = y - sp; if (MASK) l[e] = KOFF + 8 * i + e < lim ? l[e] : 0.f; }
        go[i] = (l[0] + l[1]) + (l[2] + l[3]);
        const float s2 = l[3], s1 = s2 + l[2], s0 = s1 + l[1]; p[4 * i + 2] += s2; p[4 * i + 1] += s1; p[4 * i] += s0; }
}
template <bool MASK, int KOFF> __device__ __forceinline__ void sb_half_b(f32x16& p, const float* go, int lim, float carry, float& tail, int hi) {
#pragma unroll
    for (int i = 3; i >= 0; --i) { const float gpi = partner32(go[i], hi); const float so = tail + (hi ? 0.f : gpi) + carry; tail += go[i] + gpi;
#pragma unroll
        for (int e = 0; e < 4; ++e) { float a = __builtin_amdgcn_exp2f(p[4 * i + e] + so); if (MASK) a = KOFF + 8 * i + e < lim ? a : 0.f; p[4 * i + e] = a; } }
}
template <bool MASK> __device__ __forceinline__ float sb_weights(f32x16& p0, f32x16& p1, int lim, float carry, int hi) {
    float go[8], tail = 0.f;
    sb_half_a<MASK, 0>(p0, go, lim); sb_half_a<MASK, 32>(p1, go + 4, lim);
    sb_half_b<MASK, 32>(p1, go + 4, lim, carry, tail, hi); sb_half_b<MASK, 0>(p0, go, lim, carry, tail, hi);
    return tail;
}

constexpr float SB_EXIT = -150.1f;
__device__ __forceinline__ int swap23(int k) { return (k & ~0xC) | ((k & 4) << 1) | ((k & 8) >> 1); }
__device__ __forceinline__ void sb_unit(const Frame& F, int b, int h, int qb) {
    int tid = F.tid; asm volatile("" : "+v"(tid));
    const int w = F.wave, lane = tid & 63, r32 = lane & 31, hi = lane >> 5;
    bf16_t* UB = ub_ptr(F.ws, b); const size_t rowb = (size_t)b * S_;
    const int q0 = qb * 256, tq = q0 + 32 * w + r32;
    unsigned offK[2], offV[2];
#pragma unroll
    for (int i = 0; i < 2; ++i) { const int pc = w + 8 * i;
        { const int row = pc * 4 + (lane >> 4), colB = ((lane & 15) * 16) ^ ((row & 7) << 4); offK[i] = (unsigned)(row * NBW_ + colB / 2); }
        { const int d = pc * 1024 + lane * 16, st = d >> 9, o = d & 511, kk = ((st >> 2) << 3) | (o >> 6), k = swap23(kk), c = (st & 3) * 32 + (o & 63) / 2; offV[i] = (unsigned)(k * NBW_ + c); } }
    const bf16_t* kg = UB + rowb * NBW_ + h * 128; const bf16_t* vg = kg + 1024;
#define SB_DMA(kt_) do { const int bo_ = ((kt_) % 3) * 32768; const bf16_t* kt0_ = kg + (size_t)(kt_) * 64 * NBW_; const bf16_t* vt0_ = vg + (size_t)(kt_) * 64 * NBW_; \
        _Pragma("unroll") for (int i_ = 0; i_ < 2; ++i_) { \
            __builtin_amdgcn_global_load_lds((const unsigned*)(kt0_ + offK[i_]), (LAS unsigned*)(F.lds + bo_ + (w + 8 * i_) * 1024), 16, 0, 0); \
            __builtin_amdgcn_global_load_lds((const unsigned*)(vt0_ + offV[i_]), (LAS unsigned*)(F.lds + bo_ + 16384 + (w + 8 * i_) * 1024), 16, 0, 0); } } while (0)
    volatile LAS unsigned* flags = (volatile LAS unsigned*)(F.lds + WFLAG_OFF);
    f32x16 o[4] = {}; float carry = 0.f; bool wdone = false;
    const int kt_hi = qb * 4 + 3;
    __syncthreads();
    if (lane == 0) { flags[w] = 0u; flags[8 + w] = 0u; }
    SB_DMA(kt_hi); SB_DMA(kt_hi - 1);
    bf16x8 qr[8];
    { const bf16_t* qp = UB + (rowb + tq) * NBW_ + 3072 + h * 128 + hi * 8;
#pragma unroll
      for (int d0 = 0; d0 < 8; ++d0) qr[d0] = __builtin_nontemporal_load((const bf16x8*)(qp + d0 * 16)); }
    asm volatile("s_waitcnt vmcnt(0)" ::: "memory");
    const unsigned vbase = lds_addr(F.lds) + 16384 + v_rd_base(lane);
    for (int kt = kt_hi; kt >= 0; --kt) {
        if (kt >= 1) asm volatile("s_waitcnt vmcnt(4)" ::: "memory"); else asm volatile("s_waitcnt vmcnt(0)" ::: "memory");
        asm volatile("s_waitcnt lgkmcnt(0)" ::: "memory"); __builtin_amdgcn_s_barrier(); asm volatile("" ::: "memory");
        unsigned alld = 1u;
#pragma unroll
        for (int j = 0; j < 8; ++j) alld &= flags[8 * (kt & 1) + j];
        if (alld) break;
        if (kt >= 2) SB_DMA(kt - 2);
        const int bo = (kt % 3) * 32768;
        if (!wdone && kt * 64 < q0 + 32 * w + 31) {
            f32x16 p0, p1;
            qkt(p0, p1, F.lds + bo, qr, r32, hi);
            const int lim = tq - kt * 64 - 4 * hi;
            const bool need_mask = kt * 64 + 63 >= q0 + 32 * w;
            carry += need_mask ? sb_weights<true>(p0, p1, lim, carry, hi) : sb_weights<false>(p0, p1, lim, carry, hi);
            bf16x8 pa0, pa1, pa2, pa3;
            PK4(p0, 0, pa0); PK4(p0, 8, pa1); PK4(p1, 0, pa2); PK4(p1, 8, pa3);
            pv_d0(o, vbase + bo, pa0, pa1, pa2, pa3);
            wdone = __all(carry < SB_EXIT);
        }
        if (lane == 0) flags[8 * ((kt & 1) ^ 1) + w] = wdone ? 1u : 0u;
    }
#undef SB_DMA
    asm volatile("s_waitcnt vmcnt(0) lgkmcnt(0)" ::: "memory"); __builtin_amdgcn_s_barrier(); asm volatile("" ::: "memory");
    { float one[16];
#pragma unroll
      for (int r = 0; r < 16; ++r) one[r] = 1.0f;
      LAS unsigned char* stg = F.lds + w * 8192; bf16_t* base = UB + (rowb + q0 + 32 * w) * NBW_ + h * 128;
      o_tile_stage(o, one, stg, r32, hi); LDS_WAIT();
      o_tile_out(stg, base + 2048, base + 3072, NBW_, lane); LDS_WAIT(); }
}

template <bool STORE = true> __device__ __forceinline__ void memattn_unit(const Frame& F, bf16_t* U, int ld, int qoff, int goff, int layer, int unit) {
    int tid = F.tid; asm volatile("" : "+v"(tid));
    const int w = F.wave, lane = tid & 63, r32 = lane & 31, hi = lane >> 5;
    const int qblk = unit >> 2, hd = unit & 3, row0 = qblk * 256, b = row0 / S_;
    const bf16_t* Kg = (const bf16_t*)(F.ws + WS_MEMK) + (((size_t)layer * 2 + b) * 4 + hd) * 256 * 128; const bf16_t* Vg = (const bf16_t*)(F.ws + WS_MEMV) + (((size_t)layer * 2 + b) * 4 + hd) * 256 * 128;
    LAS unsigned char* Kb = F.lds; LAS unsigned char* Vb = F.lds + 65536;
    __syncthreads();
#pragma unroll
    for (int j = 0; j < 8; ++j) { const int c = tid + 512 * j, row = c >> 4, ch = c & 15;
        *(LAS bf16x8*)(Kb + KSWZ(row, ch * 16)) = *(const bf16x8*)(Kg + (size_t)row * 128 + ch * 8);
        *(LAS bf16x8*)(Vb + (row >> 6) * 16384 + v_st(row & 63, ch * 8)) = *(const bf16x8*)(Vg + (size_t)row * 128 + ch * 8); }
    bf16x8 qr[8]; float ssq = 0.f;
    { const bf16_t* qp = U + (size_t)(row0 + 32 * w + r32) * ld + qoff + hd * 128 + hi * 8;
#pragma unroll
      for (int d0 = 0; d0 < 8; ++d0) { qr[d0] = __builtin_nontemporal_load((const bf16x8*)(qp + d0 * 16));
#pragma unroll
          for (int j = 0; j < 8; ++j) { const float v = bf2f((bf16_t)qr[d0][j]); ssq += v * v; } } }
    ssq += partner32(ssq, hi);
    const float C = LOG2E / sqrtf(ssq * (1.0f / 128) + EPS_);
    __syncthreads();
    LAS float* wscr = (LAS float*)(F.lds + WSCR_OFF) + w * 64;
    const unsigned vb0 = lds_addr(Vb) + v_rd_base(lane);
    f32x16 o[4] = {}; float m_reg = -1e30f, l_reg = 0.f;
#pragma unroll 1
    for (int t = 0; t < 4; ++t) {
        f32x16 p0, p1;
        qkt(p0, p1, Kb + t * 16384, qr, r32, hi);
        float pmax = p0[0];
#pragma unroll
        for (int r = 1; r < 16; ++r) pmax = fmaxf(pmax, p0[r]);
#pragma unroll
        for (int r = 0; r < 16; ++r) pmax = fmaxf(pmax, p1[r]);
        pmax = fmaxf(pmax, partner32(pmax, hi));
        float alpha = 1.f;
        if (!__all(pmax <= m_reg)) { const float mn = fmaxf(m_reg, pmax); alpha = __builtin_amdgcn_exp2f((m_reg - mn) * C); m_reg = mn;
            if (hi == 0) wscr[r32] = alpha; LDS_WAIT();
#pragma unroll
            for (int d = 0; d < 4; ++d)
#pragma unroll
                for (int r = 0; r < 16; ++r) o[d][r] *= wscr[crow(r, hi)];
            LDS_WAIT(); }
        const float mC = -m_reg * C; float ps = 0.f;
#pragma unroll
        for (int r = 0; r < 16; ++r) { p0[r] = __builtin_amdgcn_exp2f(fmaf(p0[r], C, mC)); p1[r] = __builtin_amdgcn_exp2f(fmaf(p1[r], C, mC)); ps += p0[r] + p1[r]; }
        ps += partner32(ps, hi);
        l_reg = l_reg * alpha + ps;
        bf16x8 pa0, pa1, pa2, pa3;
        PK4(p0, 0, pa0); PK4(p0, 8, pa1); PK4(p1, 0, pa2); PK4(p1, 8, pa3);
        pv_d0(o, vb0 + t * 16384, pa0, pa1, pa2, pa3);
    }
    if (hi == 0) wscr[32 + r32] = l_reg; LDS_WAIT();
    { float rl[16];
#pragma unroll
      for (int r = 0; r < 16; ++r) rl[r] = 1.0f / wscr[32 + crow(r, hi)];
      __syncthreads();
      LAS unsigned char* stg = F.lds + w * 8192; bf16_t* base = U + (size_t)(row0 + 32 * w) * ld + hd * 128;
      o_tile_stage(o, rl, stg, r32, hi); LDS_WAIT();
      if (STORE) o_tile_out(stg, base + goff, base + qoff, ld, lane); else if (rl[0] == 1.2345e33f) o_tile_out(stg, base + goff, base + qoff, ld, lane);
      LDS_WAIT(); }
}

__device__ __forceinline__ float ret_lg2(int h) { return log2f(1.0f - exp2f(-5.0f - (float)h)); }
template <int H2> __device__ __forceinline__ void o_half_stage(const f32x16* o, const float* rsc, LAS unsigned char* stg, int r32, int hi) {
#pragma unroll
    for (int r = 8 * H2; r < 8 * H2 + 8; ++r) { LAS bf16_t* sp = (LAS bf16_t*)(stg + ((r & 3) + 8 * ((r >> 2) & 1) + 4 * hi) * 256) + r32;
#pragma unroll
        for (int db = 0; db < 4; ++db) sp[32 * db] = (bf16_t)(pg8::cvt_pk_bf16_safe(o[db][r] * rsc[r], 0.f) & 0xffffu); }
}
__device__ __forceinline__ bf16x8 mul8_bf16(bf16x8 v, bf16x8 g) {
    u32x4v w; w.x = pk2(bf2f((bf16_t)v[0]) * bf2f((bf16_t)g[0]), bf2f((bf16_t)v[1]) * bf2f((bf16_t)g[1])); w.y = pk2(bf2f((bf16_t)v[2]) * bf2f((bf16_t)g[2]), bf2f((bf16_t)v[3]) * bf2f((bf16_t)g[3]));
    w.z = pk2(bf2f((bf16_t)v[4]) * bf2f((bf16_t)g[4]), bf2f((bf16_t)v[5]) * bf2f((bf16_t)g[5])); w.w = pk2(bf2f((bf16_t)v[6]) * bf2f((bf16_t)g[6]), bf2f((bf16_t)v[7]) * bf2f((bf16_t)g[7]));
    return __builtin_bit_cast(bf16x8, w);
}
__device__ __forceinline__ void kvt_unit(const Frame& F, int u) {
    int tid = F.tid; asm volatile("" : "+v"(tid));
    const int w = F.wave, lane = tid & 63, r32 = lane & 31, hi = lane >> 5;
    const int b = u >> 8, h = (u >> 6) & 3, n = u & 63; const size_t row0 = (size_t)b * S_ + n * 128; const float lg2 = ret_lg2(h);
    const bf16_t* UA = ua_ptr(F.ws, b); bf16_t* KVT = kvt_ptr(F.ws, b);
    LAS unsigned char* Vb = F.lds; LAS unsigned char* Kb = F.lds + 65536;
    __syncthreads();
#pragma unroll
    for (int j = 0; j < 8; ++j) { const int c = tid + 512 * j, row = c >> 5, col = (c & 31) * 8;
        *(LAS bf16x8*)(Vb + ((row >> 6) * 2 + (col >> 7)) * 16384 + v_st(row & 63, col & 127)) = *(const bf16x8*)(UA + (row0 + row) * NA_ + 1024 + h * 256 + col); }
#pragma unroll
    for (int j = 0; j < 4; ++j) { const int c = tid + 512 * j, row = c >> 4, col = (c & 15) * 8; const float z = exp2f((float)(127 - row) * lg2);
        const bf16x8 kv = *(const bf16x8*)(UA + (row0 + row) * NA_ + 512 + h * 128 + col);
        u32x4v t; t.x = pk2(bf2f((bf16_t)kv[0]) * z, bf2f((bf16_t)kv[1]) * z); t.y = pk2(bf2f((bf16_t)kv[2]) * z, bf2f((bf16_t)kv[3]) * z);
        t.z = pk2(bf2f((bf16_t)kv[4]) * z, bf2f((bf16_t)kv[5]) * z); t.w = pk2(bf2f((bf16_t)kv[6]) * z, bf2f((bf16_t)kv[7]) * z);
        *(LAS u32x4v*)(Kb + (row >> 6) * 16384 + v_st(row & 63, col)) = t; }
    __syncthreads();
    f32x16 acc[4] = {};
    const unsigned vbV = lds_addr(Vb) + v_rd_base(lane) + (w >> 2) * 16384 + (w & 3) * 512, vbK = lds_addr(Kb) + v_rd_base(lane);
#define KVT_STEP(TH, KS) do { const unsigned va_ = vbV + (TH) * 32768, vk_ = vbK + (TH) * 16384; \
        const s16x4 al_ = tr_read<v_rd_off(0, KS, 0)>(va_), ah_ = tr_read<v_rd_off(0, KS, 1)>(va_); \
        const s16x4 b0l_ = tr_read<v_rd_off(0, KS, 0)>(vk_), b0h_ = tr_read<v_rd_off(0, KS, 1)>(vk_), b1l_ = tr_read<v_rd_off(1, KS, 0)>(vk_), b1h_ = tr_read<v_rd_off(1, KS, 1)>(vk_); \
        const s16x4 b2l_ = tr_read<v_rd_off(2, KS, 0)>(vk_), b2h_ = tr_read<v_rd_off(2, KS, 1)>(vk_), b3l_ = tr_read<v_rd_off(3, KS, 0)>(vk_), b3h_ = tr_read<v_rd_off(3, KS, 1)>(vk_); \
        asm volatile("s_waitcnt lgkmcnt(0)" ::: "memory"); SBAR(); const bf16x8 a_ = PKLH(al_, ah_); \
        acc[0] = __builtin_amdgcn_mfma_f32_32x32x16_bf16(a_, PKLH(b0l_, b0h_), acc[0], 0, 0, 0); acc[1] = __builtin_amdgcn_mfma_f32_32x32x16_bf16(a_, PKLH(b1l_, b1h_), acc[1], 0, 0, 0); \
        acc[2] = __builtin_amdgcn_mfma_f32_32x32x16_bf16(a_, PKLH(b2l_, b2h_), acc[2], 0, 0, 0); acc[3] = __builtin_amdgcn_mfma_f32_32x32x16_bf16(a_, PKLH(b3l_, b3h_), acc[3], 0, 0, 0); } while (0)
    KVT_STEP(0, 0); KVT_STEP(0, 1); KVT_STEP(0, 2); KVT_STEP(0, 3); KVT_STEP(1, 0); KVT_STEP(1, 1); KVT_STEP(1, 2); KVT_STEP(1, 3);
#undef KVT_STEP
    bf16_t* ob = KVT + ((size_t)u * 256 + 32 * w) * 128 + r32;
#pragma unroll
    for (int r = 0; r < 16; ++r)
#pragma unroll
        for (int db = 0; db < 4; ++db) ob[(size_t)crow(r, hi) * 128 + 32 * db] = f2bf(acc[db][r]);
}
__device__ __forceinline__ void scan_phase(const Frame& F) {
    for (int idx = F.gi * (NWAVES * 64) + F.tid; idx < F.nb * 4 * 16384; idx += F.gs * NWAVES * 64) {
        const int bh = F.b0 * 4 + (idx >> 14), off = idx & 16383; const float gc = exp2f(128.0f * ret_lg2(bh & 3));
        unsigned* p = (unsigned*)kvt_ptr(F.ws, bh >> 2) + (size_t)bh * 64 * 16384 + off; float s0 = 0.f, s1 = 0.f;
#pragma unroll 1
        for (int n0 = 0; n0 < 64; n0 += 16) { unsigned v[16];
#pragma unroll
            for (int j = 0; j < 16; ++j) v[j] = __builtin_nontemporal_load(p + (size_t)(n0 + j) * 16384);
#pragma unroll
            for (int j = 0; j < 16; ++j) { p[(size_t)(n0 + j) * 16384] = pk2(s0, s1); s0 = fmaf(gc, s0, __uint_as_float(v[j] << 16)); s1 = fmaf(gc, s1, __uint_as_float(v[j] & 0xffff0000u)); } }
    }
}
__device__ __forceinline__ void ret_unit(const Frame& F, int u) {
    int tid = F.tid; asm volatile("" : "+v"(tid));
    const int w = F.wave, lane = tid & 63, r32 = lane & 31, hi = lane >> 5, wq = w & 3, eh = w >> 2;
    const int b = u >> 8, h = (u >> 6) & 3, n = u & 63; const size_t row0 = (size_t)b * S_ + n * 128; const float lg2 = ret_lg2(h);
    bf16_t* UA = ua_ptr(F.ws, b); const bf16_t* KVT = kvt_ptr(F.ws, b);
    LAS unsigned char* R1 = F.lds; LAS unsigned char* R2 = F.lds + 65536;
    __syncthreads();
#pragma unroll
    for (int j = 0; j < 8; ++j) { const int c = tid + 512 * j, row = c >> 4, ch = c & 15; *(LAS bf16x8*)(R1 + KSWZ(row, ch * 16)) = __builtin_nontemporal_load((const bf16x8*)(KVT + ((size_t)u * 256 + row) * 128 + ch * 8)); }
#pragma unroll
    for (int j = 0; j < 4; ++j) { const int c = tid + 512 * j, row = c >> 4, ch = c & 15; *(LAS bf16x8*)(R2 + KSWZ(row, ch * 16)) = *(const bf16x8*)(UA + (row0 + row) * NA_ + 512 + h * 128 + ch * 8); }
    bf16x8 qr[8];
    { const bf16_t* qp = UA + (row0 + 32 * wq + r32) * NA_ + h * 128 + hi * 8;
#pragma unroll
      for (int d0 = 0; d0 < 8; ++d0) qr[d0] = __builtin_nontemporal_load((const bf16x8*)(qp + d0 * 16)); }
    __syncthreads();
    f32x16 o[4] = {};
#pragma unroll
    for (int db = 0; db < 4; ++db) {
#pragma unroll
        for (int d0 = 0; d0 < 8; ++d0) { const bf16x8 bs = *(const LAS bf16x8*)(R1 + KSWZ(128 * eh + 32 * db + r32, (d0 * 16 + hi * 8) * 2)); o[db] = __builtin_amdgcn_mfma_f32_32x32x16_bf16(qr[d0], bs, o[db], 0, 0, 0); }
        asm volatile("" ::: "memory"); }
    const float gm1 = exp2f(lg2), gm2 = gm1 * gm1, gm4 = gm2 * gm2, gm8 = gm4 * gm4, gm16 = gm8 * gm8;
    const float gi1 = exp2f(-lg2), gi2 = gi1 * gi1, gi4 = gi2 * gi2, gi8 = gi4 * gi4, gi16 = gi8 * gi8, gi32 = gi16 * gi16;
    const float ga[4] = {1.0f, gm1, gm2, gm2 * gm1}, gb[4] = {1.0f, gm8, gm16, gm16 * gm8};
    const float ia[4] = {1.0f, gi1, gi2, gi2 * gi1}, ib[4] = {1.0f, gi8, gi16, gi16 * gi8};
    { const float xl = exp2f((float)(32 * wq + 4 * hi + 1) * lg2);
#pragma unroll
      for (int r = 0; r < 16; ++r) { const float xi = xl * (ga[r & 3] * gb[r >> 2]);
#pragma unroll
          for (int db = 0; db < 4; ++db) o[db][r] *= xi; } }
    bf16x8 pa[2][4]; const int cq = 32 * wq + r32;
#define RET_P(ST) do { f32x16 p0, p1; qkt(p0, p1, R2 + (ST) * 16384, qr, r32, hi); const int limq_ = cq - 64 * (ST) - 4 * hi; const float al_ = exp2f((float)limq_ * lg2); \
        _Pragma("unroll") for (int r = 0; r < 16; ++r) { const int cr_ = (r & 3) + 8 * (r >> 2); const float f_ = al_ * (ia[r & 3] * ib[r >> 2]); \
            p0[r] = cr_ <= limq_ ? p0[r] * f_ : 0.f; p1[r] = cr_ + 32 <= limq_ ? p1[r] * (f_ * gi32) : 0.f; } \
        PK4(p0, 0, pa[ST][0]); PK4(p0, 8, pa[ST][1]); PK4(p1, 0, pa[ST][2]); PK4(p1, 8, pa[ST][3]); } while (0)
    RET_P(0);
    if (wq >= 2) RET_P(1);
#undef RET_P
    __syncthreads();
#pragma unroll 4
    for (int j = 0; j < 8; ++j) { const int c = tid + 512 * j, row = c >> 5, col = (c & 31) * 8;
        *(LAS bf16x8*)(R1 + ((row >> 6) * 2 + (col >> 7)) * 16384 + v_st(row & 63, col & 127)) = *(const bf16x8*)(UA + (row0 + row) * NA_ + 1024 + h * 256 + col); }
    __syncthreads();
    const unsigned vb = lds_addr(R1) + v_rd_base(lane) + eh * 16384;
    pv_d0(o, vb, pa[0][0], pa[0][1], pa[0][2], pa[0][3]);
    if (wq >= 2) pv_d0(o, vb + 32768, pa[1][0], pa[1][1], pa[1][2], pa[1][3]);
    LAS float* ssq = (LAS float*)(F.lds + WSCR_OFF);
    float qs[16];
#pragma unroll
    for (int r = 0; r < 16; ++r) { float q = (o[0][r] * o[0][r] + o[1][r] * o[1][r]) + (o[2][r] * o[2][r] + o[3][r] * o[3][r]);
        q += __shfl_xor(q, 1); q += __shfl_xor(q, 2); q += __shfl_xor(q, 4); q += __shfl_xor(q, 8); q += __shfl_xor(q, 16); qs[r] = q;
        if (r32 == 0) ssq[w * 32 + crow(r, hi)] = q; }
    __syncthreads();
    { bf16_t* base = UA + (row0 + 32 * wq) * NA_ + 2048 + h * 256 + 128 * eh + r32;
#pragma unroll
      for (int r = 0; r < 16; ++r) { const float rn = 1.0f / sqrtf((qs[r] + ssq[(w ^ 4) * 32 + crow(r, hi)]) * (1.0f / 256) + EPS_); bf16_t* rp = base + (size_t)crow(r, hi) * NA_;
#pragma unroll
          for (int db = 0; db < 4; ++db) { const float g = bf2f(rp[32 * db]); rp[32 * db] = f2bf(o[db][r] * rn * g); } } }
    LDS_WAIT();
}
#ifndef PG8_SP2
#define PG8_SP2 true
#endif
#ifndef PG8_ALIGN
#define PG8_ALIGN true
#endif
#define RET_UNIT(i) (i)
__device__ __forceinline__ void phase1(const Frame& F) {
    const size_t rb = (size_t)F.b0 * S_;
    pg8::Gemm g{(const bf16_t*)x1b_ptr(F.ws, F.b0) + rb * D_, (const bf16_t*)(F.ws + WS_WINA), F.nb * S_, NA_, D_, D_}; pg8::StaticOrder S; S.init(F.nb * S_, NA_, F.gs, F.gi);
    pg8::EpiA E{ua_ptr(F.ws, F.b0) + rb * NA_, (const float*)(F.ws + WS_RS0) + rb, (const int*)F.in[2] + rb};
    pg8::gemm_phase<pg8::EpiA, pg8::StaticOrder, PG8_ALIGN, PG8_SP2>(F.lds, g, S, E);
}
__device__ __forceinline__ void late_publish(const Frame& F) {
    asm volatile("s_waitcnt vmcnt(0)" ::: "memory"); __syncthreads();
    if (F.tid == 0) { __builtin_amdgcn_fence(__ATOMIC_RELEASE, "agent"); asm volatile("s_waitcnt vmcnt(0)" ::: "memory");
        __hip_atomic_fetch_add((unsigned*)(F.ws + WS_CTL) + CW_LATE, 1u, __ATOMIC_RELAXED, __HIP_MEMORY_SCOPE_AGENT); }
}
__device__ __forceinline__ void late_acquire(const Frame& F) {
    if (F.tid == 0) { unsigned* c = (unsigned*)(F.ws + WS_CTL) + CW_LATE; unsigned sp = 0;
        while (__hip_atomic_load(c, __ATOMIC_RELAXED, __HIP_MEMORY_SCOPE_AGENT) < (unsigned)F.G) { __builtin_amdgcn_s_sleep(2); if (++sp > (1u << 22)) break; }
        __builtin_amdgcn_fence(__ATOMIC_ACQUIRE, "agent"); asm volatile("s_waitcnt vmcnt(0)" ::: "memory"); }
    __syncthreads();
}
__device__ __forceinline__ void phase2(const Frame& F) {
    for (int i = F.gi; i < F.nb * 256; i += F.gs) kvt_unit(F, RET_UNIT(F.b0 * 256 + i));
    for (int u = F.gi; u < F.nb * 128; u += F.gs) memattn_unit(F, ua_ptr(F.ws, (F.b0 * 128 + u) >> 7), NA_, 3072, 3584, 0, F.b0 * 128 + u);
}
__device__ __forceinline__ void phase4(const Frame& F) { for (int i = F.gi; i < F.nb * 256; i += F.gs) ret_unit(F, RET_UNIT(F.b0 * 256 + i)); }
__device__ __forceinline__ void phase5(const Frame& F) {
    if (NGRP == 2) late_acquire(F);
    const size_t rb = (size_t)F.b0 * S_;
    pg8::Gemm g{(const bf16_t*)ua_ptr(F.ws, F.b0) + rb * NA_ + 2048, (const bf16_t*)(F.ws + WS_WOUTA), F.nb * S_, D_, KO_, NA_}; pg8::StaticOrder S; S.init(F.nb * S_, D_, F.gs, F.gi);
    pg8::EpiOutA E{F.in[0] + rb * D_, F.out + rb * D_, x1b_ptr(F.ws, F.b0) + rb * D_, (float*)(F.ws + WS_SS1P) + rb * 16};
    pg8::gemm_phase<pg8::EpiOutA, pg8::StaticOrder, PG8_ALIGN, PG8_SP2>(F.lds, g, S, E);
}
__device__ __forceinline__ void phase6(const Frame& F) {
    const size_t rb = (size_t)F.b0 * S_;
    pg8::Gemm g{(const bf16_t*)x1b_ptr(F.ws, F.b0) + rb * D_, (const bf16_t*)(F.ws + WS_WB), F.nb * S_, NBW_, D_, D_}; pg8::StaticOrder S; S.init(F.nb * S_, NBW_, F.gs, F.gi);
    pg8::EpiB E{ub_ptr(F.ws, F.b0) + rb * NBW_, (const float*)(F.ws + WS_SS1P) + rb * 16};
    pg8::gemm_phase<pg8::EpiB, pg8::StaticOrder, PG8_ALIGN, PG8_SP2>(F.lds, g, S, E);
}
__device__ __forceinline__ void phase7(const Frame& F) {
    for (int u = F.gi; u < F.nb * 256; u += F.gs) { const int U = F.b0 * 256 + u; sb_unit(F, U >> 8, (U >> 5) & 7, U & 31); }
    for (int u = F.gi; u < F.nb * 128; u += F.gs) memattn_unit(F, ub_ptr(F.ws, (F.b0 * 128 + u) >> 7), NBW_, 4096, 4608, 1, F.b0 * 128 + u);
}
__device__ __forceinline__ void phase8(const Frame& F) {
    const size_t rb = (size_t)F.b0 * S_;
    pg8::Gemm g{(const bf16_t*)ub_ptr(F.ws, F.b0) + rb * NBW_ + 3072, (const bf16_t*)(F.ws + WS_WOUTB), F.nb * S_, D_, KO_, NBW_}; pg8::StaticOrder S; S.init(F.nb * S_, D_, F.gs, F.gi);
    pg8::EpiOutB E{F.out + rb * D_, (const bf16_t*)x1b_ptr(F.ws, F.b0) + rb * D_};
    pg8::gemm_phase<pg8::EpiOutB, pg8::StaticOrder, PG8_ALIGN, PG8_SP2>(F.lds, g, S, E);
}

__global__ void __launch_bounds__(NWAVES * 64, 2) mega(MArgs args) {
    extern __shared__ __attribute__((aligned(16))) unsigned char lds_raw[];
    Frame F;
    F.lds = (LAS unsigned char*)lds_raw; F.tid = threadIdx.x; F.lane = F.tid & 63; F.wave = __builtin_amdgcn_readfirstlane(F.tid >> 6); F.G = gridDim.x; F.bid = blockIdx.x;
    if (NGRP == 2 && (F.G & 15) == 0) { F.grp = (F.bid >> 3) & 1; F.gi = (F.bid & 7) + 8 * (F.bid >> 4); F.gs = F.G >> 1; F.b0 = F.grp; F.nb = 1; }
    else { F.grp = 0; F.gi = F.bid; F.gs = F.G; F.b0 = 0; F.nb = 2; }
#pragma unroll
    for (int i = 0; i < 16; ++i) F.in[i] = args.in[i];
    F.out = args.out; F.ws = args.ws;
    for (int u = F.tid; u < (LDS_BYTES - LDSCTL_OFF) / 4; u += NWAVES * 64) ((LAS unsigned*)(F.lds + LDSCTL_OFF))[u] = 0u;
    __syncthreads();
    unsigned* ctl = (unsigned*)(F.ws + WS_CTL);
    volatile LAS unsigned* lw = (volatile LAS unsigned*)(F.lds + LDSCTL_OFF);
    XcdBarrier barG = xcd_barrier_post(ctl + CW_BAR, lw + 8, (unsigned)F.G);
    XcdBarrier bar = xcd_barrier_post(ctl + CW_BAR + (1 + F.grp) * XCD_BAR_WORDS, lw + 12, (unsigned)F.gs);
#define PHB(call) do { call; xcd_barrier(bar); } while (0)
    p0_prologue(F); xcd_barrier(barG);
    if (NGRP == 2 && F.nb == 1) { p0_late_weights(F); late_publish(F);
    }
    PHB(phase1(F));
    PHB(phase2(F));
    PHB(scan_phase(F));
    PHB(phase4(F));
    PHB(phase5(F));
    PHB(phase6(F));
    PHB(phase7(F));
    phase8(F);
#undef PHB
}

extern "C" void kernel_launch(void* const* d_in, const int* in_sizes, int n_in, void* d_out, int out_size, void* d_ws, size_t ws_size, hipStream_t stream) {
    static int grid = 0;
    if (grid == 0) {
        int dev = 0, cus = 0;
        if (hipGetDevice(&dev) != hipSuccess || hipDeviceGetAttribute(&cus, hipDeviceAttributeMultiprocessorCount, dev) != hipSuccess) { grid = -1; return; }
        if (hipFuncSetAttribute((const void*)mega, hipFuncAttributeMaxDynamicSharedMemorySize, LDS_BYTES) != hipSuccess) { grid = -1; return; }
        (void)hipGetLastError();
        grid = (cus / 16) * 16;
        if (grid == 0) { grid = -1; return; }
    }
    if (grid < 0) return;
    unsigned char* ws = (unsigned char*)d_ws;
    (void)hipMemsetAsync(ws + WS_CTL, 0, CTL_ZERO_BYTES, stream);
    MArgs a{};
    for (int i = 0; i < 16; ++i) a.in[i] = (const float*)d_in[i];
    a.out = (float*)d_out; a.ws = ws; a.ph_lo = 0; a.ph_hi = 9; a.li = 0; a.pad = 0;
    hipLaunchKernelGGL(mega, dim3(grid), dim3(NWAVES * 64), LDS_BYTES, stream, a);
}
```

```cpp
#include <hip/hip_runtime.h>
#include <stdint.h>

typedef unsigned short bf16_t;

constexpr int NB_ = 2, S_ = 8192, T_ = NB_ * S_, D_ = 1024;
constexpr int NA_ = 4096, NBW_ = 5120, KO_ = 1536;
constexpr float EPS_ = 1e-6f;
constexpr float QK_SCALE = 0.08838834764831845f;

constexpr size_t MiB = 1u << 20;
constexpr size_t WS_CTL = 0;
constexpr size_t WS_WINA = 1 * MiB;
constexpr size_t WS_WOUTA = 9 * MiB;
constexpr size_t WS_WB = 12 * MiB;
constexpr size_t WS_WOUTB = 22 * MiB;
constexpr size_t WS_MEMK = 25 * MiB;
constexpr size_t WS_MEMV = 26 * MiB;
constexpr size_t WS_RS0 = 27 * MiB;
constexpr size_t WS_SS1P = 28 * MiB;
#ifndef NGRP
#define NGRP 2
#endif
#if NGRP == 2
constexpr size_t WS_BSTRIDE = 96 * MiB;
constexpr size_t WS_UA = 30 * MiB, WS_UA_STRIDE = WS_BSTRIDE, WS_UB = 30 * MiB, WS_UB_STRIDE = WS_BSTRIDE, WS_KVT = 94 * MiB, WS_KVT_STRIDE = WS_BSTRIDE, WS_X1B = 110 * MiB, WS_X1B_STRIDE = WS_BSTRIDE;
#else
constexpr size_t WS_UA = 30 * MiB, WS_UA_STRIDE = 64 * MiB, WS_UB = 30 * MiB, WS_UB_STRIDE = 80 * MiB, WS_KVT = 158 * MiB, WS_KVT_STRIDE = 16 * MiB, WS_X1B = 190 * MiB, WS_X1B_STRIDE = 16 * MiB;
#endif
__device__ __forceinline__ bf16_t* ua_ptr(unsigned char* ws, int b) { return (bf16_t*)(ws + WS_UA + (size_t)b * WS_UA_STRIDE) - (size_t)b * S_ * NA_; }
__device__ __forceinline__ bf16_t* ub_ptr(unsigned char* ws, int b) { return (bf16_t*)(ws + WS_UB + (size_t)b * WS_UB_STRIDE) - (size_t)b * S_ * NBW_; }
__device__ __forceinline__ bf16_t* kvt_ptr(unsigned char* ws, int b) { return (bf16_t*)(ws + WS_KVT + (size_t)b * WS_KVT_STRIDE) - (size_t)b * 256 * 32768; }
__device__ __forceinline__ bf16_t* x1b_ptr(unsigned char* ws, int b) { return (bf16_t*)(ws + WS_X1B + (size_t)b * WS_X1B_STRIDE) - (size_t)b * S_ * D_; }


__device__ __forceinline__ float bf2f(bf16_t v) { return __uint_as_float(((unsigned)v) << 16); }
__device__ __forceinline__ bf16_t f2bf(float f) { unsigned u = __float_as_uint(f); u += 0x7fffu + ((u >> 16) & 1u); return (bf16_t)(u >> 16); }

__device__ __forceinline__ void rot_sincos(float ang, float& s, float& c) {
    const float n = rintf(ang * 0.15915494309189535f);
    float r = fmaf(-n, 6.28318548202514648f, ang);
    r = fmaf(-n, -1.74845553e-7f, r);
    const float rev = r * 0.15915494309189535f;
    s = __builtin_amdgcn_sinf(rev); c = __builtin_amdgcn_cosf(rev);
}
__device__ __forceinline__ float rope_inv_freq(int i) { return exp2f(-(float)i * 0.20762050593046014f); }

__device__ __forceinline__ int permA_src(int n) {
    if (n >= 1024) return n;
    const int tile = n >> 8, c = n & 255, bj = c >> 7, p = c & 127, hit = p >> 6, i = p & 63;
    return tile * 256 + hit * 128 + bj * 64 + i;
}

namespace pg8 {
#define PG8_LAS __attribute__((address_space(3)))
typedef unsigned short bf16_t;
typedef short bf16x8 __attribute__((ext_vector_type(8)));
typedef float f32x4 __attribute__((ext_vector_type(4)));
typedef unsigned u32x4 __attribute__((ext_vector_type(4)));
constexpr int BM = 256, BK = 64, HALF = 128, HTB = HALF * BK * 2  , STAGE_BYTES = 8 * HTB, NXCD = 8, WGM = 4;

__host__ __device__ __forceinline__ int lds_byte(int r, int c) { const int st = (r >> 4) * 2 + (c >> 5), rr = r & 15, cc = c & 31, ob = rr * 64 + cc * 2; return st * 1024 + (ob ^ (((ob >> 9) & 1) << 5)); }
__host__ __device__ __forceinline__ void stage_rc(int b, int& R, int& C) { const int st = b / 1024, sb = b % 1024, swz = sb ^ (((sb >> 9) & 1) << 5); R = (st >> 1) * 16 + swz / 64; C = (st & 1) * 32 + (swz % 64) / 2; }
__host__ __device__ __forceinline__ int perm32(int rho) { const int n = rho >> 4, i = rho & 15; return 8 * (i >> 2) + 4 * n + (i & 3); }

struct Unit { int pm, pn; };
struct Gemm { const bf16_t* A; const bf16_t* Bt; int M, N, K, lda; };

struct StaticOrder {
    int nM, nN, nwg, G, c;
    __host__ __device__ void init(int M, int N, int G_, int c_) { nM = M / BM; nN = N / BM; nwg = nM * nN; G = G_; c = c_; }
    __host__ __device__ bool next(int i, Unit& u) const {
        const long L = (long)i * G + c; if (L >= nwg) return false;
        int wgid = (int)L; { const int q = nwg / NXCD, r = nwg % NXCD, xcd = wgid % NXCD, off = wgid / NXCD; wgid = (xcd < r ? xcd * (q + 1) : r * (q + 1) + (xcd - r) * q) + off; }
        const int nig = WGM * nN, gid = wgid / nig, fm = gid * WGM, gsz = (nM - fm) < WGM ? (nM - fm) : WGM;
        u.pm = fm + ((wgid % nig) % gsz); u.pn = (wgid % nig) / gsz; return true;
    }
    __device__ __forceinline__ void a_ready(const Unit&) const {}
    __device__ __forceinline__ void done(const Unit&) const {}
};

typedef __bf16 bf16x2_hw __attribute__((ext_vector_type(2)));
typedef float f32x2_hw __attribute__((ext_vector_type(2)));
__device__ __forceinline__ unsigned cvt_pk_bf16_safe(float lo, float hi) { const f32x2_hw v = {lo, hi}; return __builtin_bit_cast(unsigned, __builtin_convertvector(v, bf16x2_hw)); }
__device__ __forceinline__ unsigned cvt_pk_bf16(float lo, float hi) { unsigned r; asm volatile("v_cvt_pk_bf16_f32 %0, %1, %2" : "=v"(r) : "v"(lo), "v"(hi)); return r; }
__device__ __forceinline__ float silu_fast(float v) { return v * __builtin_amdgcn_rcpf(1.0f + __builtin_amdgcn_exp2f(-1.4426950408889634f * v)); }
__device__ __forceinline__ u32x4 pack8_safe(const f32x4 a, const f32x4 b) { u32x4 w; w.x = cvt_pk_bf16_safe(a[0], a[1]); w.y = cvt_pk_bf16_safe(a[2], a[3]); w.z = cvt_pk_bf16_safe(b[0], b[1]); w.w = cvt_pk_bf16_safe(b[2], b[3]); return w; }
__device__ __forceinline__ u32x4 pack8(const f32x4 a, const f32x4 b) { u32x4 w; w.x = cvt_pk_bf16(a[0], a[1]); w.y = cvt_pk_bf16(a[2], a[3]); w.z = cvt_pk_bf16(b[0], b[1]); w.w = cvt_pk_bf16(b[2], b[3]); return w; }

struct EpiA {
    static constexpr bool PERM = true, AFTER_DRAIN = false, ACC_INIT = false, RELAX_STORES = true;
    bf16_t* U; const float* rs0; const int* pos;
    __device__ __forceinline__ void operator()(const f32x4 (&acc)[2][2][4][2], const Unit& u, int wr, int wc, int fr, int fq) const {
        const int row0 = u.pm * BM + wr * 64 + fr;
        float rsv[8], pfv[8];
#pragma unroll
        for (int i = 0; i < 8; ++i) { const int row = row0 + (i >> 2) * HALF + (i & 3) * 16; rsv[i] = rs0[row]; pfv[i] = (float)pos[row]; }
        asm volatile("" : "+v"(rsv[0]), "+v"(rsv[1]), "+v"(rsv[2]), "+v"(rsv[3]), "+v"(rsv[4]), "+v"(rsv[5]), "+v"(rsv[6]), "+v"(rsv[7]));
        asm volatile("s_waitcnt vmcnt(0)" : "+v"(pfv[0]), "+v"(pfv[1]), "+v"(pfv[2]), "+v"(pfv[3]), "+v"(pfv[4]), "+v"(pfv[5]), "+v"(pfv[6]), "+v"(pfv[7]));
        if (u.pn < 4) {
            const int hit = wc >> 1, i0 = 32 * (wc & 1) + 8 * fq; const float sc = u.pn >= 2 ? QK_SCALE : 1.0f;
            float inv[8];
#pragma unroll
            for (int j = 0; j < 8; ++j) inv[j] = rope_inv_freq(i0 + j);
#pragma unroll
            for (int ai = 0; ai < 2; ++ai)
#pragma unroll
                for (int m = 0; m < 4; ++m) { const int row = row0 + ai * HALF + m * 16; const float rs = rsv[ai * 4 + m] * sc, pf = pfv[ai * 4 + m];
                    bf16_t* up = U + (size_t)row * NA_ + u.pn * BM + hit * 128 + i0;
                    f32x4 o1[2], o2[2];
#pragma unroll
                    for (int n = 0; n < 2; ++n)
#pragma unroll
                        for (int e = 0; e < 4; ++e) { float sn, cs; rot_sincos(pf * inv[4 * n + e], sn, cs); const float x1 = acc[ai][0][m][n][e] * rs, x2 = acc[ai][1][m][n][e] * rs;
                            o1[n][e] = x1 * cs - x2 * sn; o2[n][e] = x1 * sn + x2 * cs; }
                    *(u32x4*)up = pack8(o1[0], o1[1]); *(u32x4*)(up + 64) = pack8(o2[0], o2[1]); }
        } else {
            const bool silu = (u.pn >= 8 && u.pn < 12) || u.pn >= 14;
#pragma unroll
            for (int ai = 0; ai < 2; ++ai)
#pragma unroll
                for (int m = 0; m < 4; ++m) { const int row = row0 + ai * HALF + m * 16; const float rs = rsv[ai * 4 + m]; bf16_t* rowp = U + (size_t)row * NA_ + u.pn * BM + wc * 32 + 8 * fq;
#pragma unroll
                    for (int bj = 0; bj < 2; ++bj) { f32x4 v0 = acc[ai][bj][m][0] * rs, v1 = acc[ai][bj][m][1] * rs;
                        if (silu) {
#pragma unroll
                            for (int e = 0; e < 4; ++e) { v0[e] = silu_fast(v0[e]); v1[e] = silu_fast(v1[e]); } }
                        *(u32x4*)(rowp + bj * HALF) = pack8(v0, v1); } }
        }
    }
};
struct EpiOutA {
    static constexpr bool PERM = true, AFTER_DRAIN = false, ACC_INIT = true, RELAX_STORES = false;
    const float* xres; float* out; bf16_t* x1b; float* ss1p;
    __device__ __forceinline__ void init(f32x4 (&acc)[2][2][4][2], const Unit& u, int wr, int wc, int fr, int fq) const {
        const int row0 = u.pm * BM + wr * 64 + fr;
#pragma unroll
        for (int ai = 0; ai < 2; ++ai)
#pragma unroll
            for (int m = 0; m < 4; ++m) { const size_t off = (size_t)(row0 + ai * HALF + m * 16) * D_ + u.pn * BM + wc * 32 + 8 * fq;
#pragma unroll
                for (int bj = 0; bj < 2; ++bj) { const u32x4 w = __builtin_nontemporal_load((const u32x4*)(x1b + off + bj * HALF));
                    acc[ai][bj][m][0] = (f32x4){__uint_as_float(w.x << 16), __uint_as_float(w.x & 0xffff0000u), __uint_as_float(w.y << 16), __uint_as_float(w.y & 0xffff0000u)};
                    acc[ai][bj][m][1] = (f32x4){__uint_as_float(w.z << 16), __uint_as_float(w.z & 0xffff0000u), __uint_as_float(w.w << 16), __uint_as_float(w.w & 0xffff0000u)}; } }
    }
    __device__ __forceinline__ void operator()(const f32x4 (&acc)[2][2][4][2], const Unit& u, int wr, int wc, int fr, int fq) const {
        const int row0 = u.pm * BM + wr * 64 + fr;
#pragma unroll
        for (int ai = 0; ai < 2; ++ai)
#pragma unroll
            for (int m = 0; m < 4; ++m) { const int row = row0 + ai * HALF + m * 16; const size_t off = (size_t)row * D_ + u.pn * BM + wc * 32 + 8 * fq; float ssq = 0.f;
#pragma unroll
                for (int bj = 0; bj < 2; ++bj) { const f32x4 v0 = acc[ai][bj][m][0], v1 = acc[ai][bj][m][1];
                    *(u32x4*)(x1b + off + bj * HALF) = pack8_safe(v0, v1);
                    ssq += (v0[0] * v0[0] + v0[1] * v0[1]) + (v0[2] * v0[2] + v0[3] * v0[3]) + (v1[0] * v1[0] + v1[1] * v1[1]) + (v1[2] * v1[2] + v1[3] * v1[3]); }
                ssq += __shfl_xor(ssq, 16); ssq += __shfl_xor(ssq, 32);
                if (fq == 0) ss1p[(size_t)row * 16 + u.pn * 4 + wc] = ssq; }
    }
};
struct EpiB {
    static constexpr bool PERM = true, AFTER_DRAIN = false, ACC_INIT = false, RELAX_STORES = true;
    bf16_t* U; const float* ss1p;
    __device__ __forceinline__ void operator()(const f32x4 (&acc)[2][2][4][2], const Unit& u, int wr, int wc, int fr, int fq) const {
        const int row0 = u.pm * BM + wr * 64 + fr; const bool silu = (u.pn >= 8 && u.pn < 12) || u.pn >= 18; const float sc = (u.pn >= 12 && u.pn < 16) ? QK_SCALE * 1.4426950408889634f : 1.0f;
        f32x4 pv[8];
#pragma unroll
        for (int i = 0; i < 8; ++i) pv[i] = *(const f32x4*)(ss1p + (size_t)(row0 + (i >> 2) * HALF + (i & 3) * 16) * 16 + 4 * fq);
        asm volatile("s_waitcnt vmcnt(0)" : "+v"(pv[0]), "+v"(pv[1]), "+v"(pv[2]), "+v"(pv[3]), "+v"(pv[4]), "+v"(pv[5]), "+v"(pv[6]), "+v"(pv[7]));
#pragma unroll
        for (int ai = 0; ai < 2; ++ai)
#pragma unroll
            for (int m = 0; m < 4; ++m) { const int row = row0 + ai * HALF + m * 16; const f32x4 p4 = pv[ai * 4 + m];
                float s = (p4[0] + p4[1]) + (p4[2] + p4[3]); s += __shfl_xor(s, 16); s += __shfl_xor(s, 32);
                const float rs = sc / sqrtf(s * (1.0f / D_) + EPS_); bf16_t* rowp = U + (size_t)row * NBW_ + u.pn * BM + wc * 32 + 8 * fq;
#pragma unroll
                for (int bj = 0; bj < 2; ++bj) { f32x4 v0 = acc[ai][bj][m][0] * rs, v1 = acc[ai][bj][m][1] * rs;
                    if (silu) {
#pragma unroll
                        for (int e = 0; e < 4; ++e) { v0[e] = silu_fast(v0[e]); v1[e] = silu_fast(v1[e]); } }
                    *(u32x4*)(rowp + bj * HALF) = pack8(v0, v1); } }
    }
};
struct EpiOutB {
    static constexpr bool PERM = false, AFTER_DRAIN = false, ACC_INIT = true, RELAX_STORES = false;
    float* out; const bf16_t* x1b;
    __device__ __forceinline__ void init(f32x4 (&acc)[2][2][4][2], const Unit& u, int wr, int wc, int fr, int fq) const {
        const int row0 = u.pm * BM + wr * 64 + fr;
#pragma unroll
        for (int ai = 0; ai < 2; ++ai)
#pragma unroll
            for (int m = 0; m < 4; ++m) { const size_t off = (size_t)(row0 + ai * HALF + m * 16) * D_ + u.pn * BM + wc * 32 + 4 * fq;
#pragma unroll
                for (int bj = 0; bj < 2; ++bj)
#pragma unroll
                    for (int n = 0; n < 2; ++n) { const unsigned long long w = __builtin_nontemporal_load((const unsigned long long*)(x1b + off + bj * HALF + n * 16)); const unsigned lo = (unsigned)w, hi = (unsigned)(w >> 32);
                        acc[ai][bj][m][n] = (f32x4){__uint_as_float(lo << 16), __uint_as_float(lo & 0xffff0000u), __uint_as_float(hi << 16), __uint_as_float(hi & 0xffff0000u)}; } }
    }
    __device__ __forceinline__ void operator()(const f32x4 (&acc)[2][2][4][2], const Unit& u, int wr, int wc, int fr, int fq) const {
        const int row0 = u.pm * BM + wr * 64 + fr;
#pragma unroll
        for (int ai = 0; ai < 2; ++ai)
#pragma unroll
            for (int m = 0; m < 4; ++m) { const size_t off = (size_t)(row0 + ai * HALF + m * 16) * D_ + u.pn * BM + wc * 32 + 4 * fq;
#pragma unroll
                for (int bj = 0; bj < 2; ++bj)
#pragma unroll
                    for (int n = 0; n < 2; ++n) *(f32x4*)(out + off + bj * HALF + n * 16) = acc[ai][bj][m][n]; }
    }
};

struct EpiNull {
    static constexpr bool PERM = true, AFTER_DRAIN = false, ACC_INIT = false, RELAX_STORES = false;
    float* sink;
    __device__ __forceinline__ void operator()(const f32x4 (&acc)[2][2][4][2], const Unit& u, int wr, int wc, int fr, int fq) const {
        f32x4 s = (f32x4){0.f, 0.f, 0.f, 0.f};
#pragma unroll
        for (int ai = 0; ai < 2; ++ai)
#pragma unroll
            for (int bj = 0; bj < 2; ++bj)
#pragma unroll
                for (int m = 0; m < 4; ++m) s += acc[ai][bj][m][0] + acc[ai][bj][m][1];
        const float t = (s[0] + s[1]) + (s[2] + s[3]);
        if (t == 1.2345678e33f) sink[0] = t;
    }
};
template <class Epi, class Sched, bool ALIGN_EPI = false, bool SP2 = false>
__device__ __forceinline__ void gemm_phase(PG8_LAS unsigned char* lds, const Gemm g, const Sched& S, const Epi& E) {
    int tid = threadIdx.x; asm volatile("" : "+v"(tid));
    const int wid = __builtin_amdgcn_readfirstlane(tid >> 6), lane = tid & 63, wr = wid >> 2, wc = wid & 3, fr = lane & 15, fq = lane >> 4;
    const int K = g.K, nt = K / BK;
    unsigned voffA[2], voffB[2];
#pragma unroll
    for (int i = 0; i < 2; ++i) { int R, C; stage_rc(tid * 16 + i * 8192, R, C); const int Rb = Epi::PERM ? ((R & ~31) + perm32(R & 31)) : R;
        voffA[i] = (unsigned)(R * g.lda + C) * 2u; voffB[i] = (unsigned)(Rb * K + C) * 2u; }
    const size_t kstep = (size_t)(BK * 2);
    const size_t hstepA = (size_t)HALF * g.lda * 2, hstepB = (size_t)HALF * K * 2;
    const size_t tstepA = 2 * hstepA, tstepB = 2 * hstepB;
    const unsigned ldsw = (unsigned)wid * 1024u;
    const int aoff = lds_byte(wr * 64 + fr, fq * 8), boff = lds_byte(wc * 32 + fr, fq * 8);
#define PG8_SA(b, h) (((b) * 2 + (h)) * HTB)
#define PG8_SB(b, h) ((4 + (b) * 2 + (h)) * HTB)
#define PG8_STAGE(bufoff, gbase, voff) do { _Pragma("unroll") for (int _i = 0; _i < 2; ++_i) \
        __builtin_amdgcn_global_load_lds((const unsigned*)((const char*)(gbase) + (voff)[_i]), (PG8_LAS unsigned*)(lds + (bufoff) + ldsw + _i * 8192), 16, 0, 0); } while (0)
#define PG8_LDA(dst, b, h) do { _Pragma("unroll") for (int m = 0; m < 4; ++m) _Pragma("unroll") for (int k = 0; k < 2; ++k) dst[m][k] = *(const PG8_LAS bf16x8*)(lds + PG8_SA(b, h) + aoff + m * 2048 + k * 1024); } while (0)
#define PG8_LDB(dst, b, h) do { _Pragma("unroll") for (int n = 0; n < 2; ++n) _Pragma("unroll") for (int k = 0; k < 2; ++k) dst[n][k] = *(const PG8_LAS bf16x8*)(lds + PG8_SB(b, h) + boff + n * 2048 + k * 1024); } while (0)
#define PG8_MMA(ai, bj, At, Bt) do { __builtin_amdgcn_s_setprio(1); _Pragma("unroll") for (int m = 0; m < 4; ++m) _Pragma("unroll") for (int n = 0; n < 2; ++n) _Pragma("unroll") for (int k = 0; k < 2; ++k) \
        acc[ai][bj][m][n] = __builtin_amdgcn_mfma_f32_16x16x32_bf16(Bt[n][k], At[m][k], acc[ai][bj][m][n], 0, 0, 0); __builtin_amdgcn_s_setprio(0); } while (0)
#define PG8_WAIT_V(n) asm volatile("s_waitcnt vmcnt(" #n ")" ::: "memory")
#define PG8_WAIT_V_RELAX(flag) asm volatile("s_cmp_eq_u32 %0, 0\n\ts_cbranch_scc1 .Lw8_%=\n\ts_waitcnt vmcnt(24)\n\ts_branch .Lwd_%=\n.Lw8_%=:\n\ts_waitcnt vmcnt(8)\n.Lwd_%=:" :: "s"(flag) : "memory", "scc")
#define PG8_WAIT_L(n) asm volatile("s_waitcnt lgkmcnt(" #n ")" ::: "memory")
#define PG8_BAR __builtin_amdgcn_s_barrier()
#define PG8_SCHED __builtin_amdgcn_sched_barrier(0)
    Unit cur, nxt; int ui = 0;
    if (!S.next(0, cur)) return;
    f32x4 acc[2][2][4][2];
#pragma unroll
    for (int a = 0; a < 2; ++a)
#pragma unroll
        for (int b = 0; b < 2; ++b)
#pragma unroll
            for (int m = 0; m < 4; ++m)
#pragma unroll
                for (int n = 0; n < 2; ++n) acc[a][b][m][n] = (f32x4){0.f, 0.f, 0.f, 0.f};
    if constexpr (Epi::ACC_INIT) E.init(acc, cur, wr, wc, fr, fq);
    bf16x8 At[4][2], B0[2][2], B1[2][2];
    const char* cA = (const char*)g.A + (size_t)cur.pm * tstepA; const char* cB = (const char*)g.Bt + (size_t)cur.pn * tstepB;
    S.a_ready(cur);
    if constexpr (SP2) {
        PG8_STAGE(PG8_SB(0, 0), cB, voffB); PG8_STAGE(PG8_SB(0, 1), cB + hstepB, voffB); PG8_STAGE(PG8_SA(0, 0), cA, voffA); PG8_STAGE(PG8_SA(0, 1), cA + hstepA, voffA);
        if (wr == 1) PG8_BAR;
        PG8_WAIT_V(2); PG8_BAR;
        PG8_STAGE(PG8_SB(1, 0), cB + kstep, voffB); PG8_STAGE(PG8_SA(1, 0), cA + kstep, voffA); PG8_STAGE(PG8_SB(1, 1), cB + hstepB + kstep, voffB);
        PG8_WAIT_V(6); PG8_BAR;
    } else {
        PG8_STAGE(PG8_SB(0, 0), cB, voffB); PG8_STAGE(PG8_SA(0, 0), cA, voffA); PG8_STAGE(PG8_SB(0, 1), cB + hstepB, voffB); PG8_STAGE(PG8_SA(0, 1), cA + hstepA, voffA);
        if (wr == 1) PG8_BAR;
        PG8_WAIT_V(4); PG8_BAR;
        PG8_STAGE(PG8_SB(1, 0), cB + kstep, voffB); PG8_STAGE(PG8_SA(1, 0), cA + kstep, voffA); PG8_STAGE(PG8_SB(1, 1), cB + hstepB + kstep, voffB);
        PG8_WAIT_V(6); PG8_BAR;
    }
    for (;;) {
        const bool has_next = S.next(ui + 1, nxt);
        const char* nA = has_next ? (const char*)g.A + (size_t)nxt.pm * tstepA : cA; const char* nB = has_next ? (const char*)g.Bt + (size_t)nxt.pn * tstepB : cB;
        for (int t = 0; t < nt; t += 2) {
            const bool last = (t == nt - 2);
            const char* a1 = cA + (size_t)(t + 1) * kstep;
            const char* a2 = last ? nA : cA + (size_t)(t + 2) * kstep; const char* b2 = last ? nB : cB + (size_t)(t + 2) * kstep;
            const char* a3 = a2 + kstep; const char* b3 = b2 + kstep;
            if (last && has_next) S.a_ready(nxt);
            const int relax = __builtin_amdgcn_readfirstlane((Epi::RELAX_STORES && ui > 0 && t == 0) ? 1 : 0);
            if constexpr (SP2) {
            PG8_LDB(B0, 0, 0); PG8_LDB(B1, 0, 1); PG8_SCHED; PG8_LDA(At, 0, 0); PG8_STAGE(PG8_SA(1, 1), a1 + hstepA, voffA);
            PG8_WAIT_V_RELAX(relax); PG8_WAIT_L(0); PG8_BAR; PG8_MMA(0, 0, At, B0); PG8_MMA(0, 1, At, B1); PG8_BAR; PG8_SCHED;
            PG8_LDA(At, 0, 1); PG8_STAGE(PG8_SB(0, 0), b2, voffB); PG8_STAGE(PG8_SB(0, 1), b2 + hstepB, voffB); PG8_STAGE(PG8_SA(0, 0), a2, voffA);
            PG8_WAIT_V_RELAX(relax); PG8_WAIT_L(0); PG8_BAR; PG8_MMA(1, 0, At, B0); PG8_MMA(1, 1, At, B1); PG8_BAR; PG8_SCHED;
            PG8_LDB(B0, 1, 0); PG8_LDB(B1, 1, 1); PG8_SCHED; PG8_LDA(At, 1, 0); PG8_STAGE(PG8_SA(0, 1), a2 + hstepA, voffA);
            PG8_WAIT_V(8); PG8_WAIT_L(0); PG8_BAR; PG8_MMA(0, 0, At, B0); PG8_MMA(0, 1, At, B1); PG8_BAR; PG8_SCHED;
            PG8_LDA(At, 1, 1); PG8_STAGE(PG8_SB(1, 0), b3, voffB); PG8_STAGE(PG8_SB(1, 1), b3 + hstepB, voffB); PG8_STAGE(PG8_SA(1, 0), a3, voffA);
            PG8_WAIT_V(8); PG8_WAIT_L(0); PG8_BAR; PG8_MMA(1, 0, At, B0); PG8_MMA(1, 1, At, B1); PG8_BAR; PG8_SCHED;
            } else {
            PG8_LDB(B0, 0, 0); PG8_SCHED; PG8_LDA(At, 0, 0); PG8_STAGE(PG8_SA(1, 1), a1 + hstepA, voffA);
            PG8_WAIT_L(8); PG8_BAR; PG8_WAIT_L(0); PG8_MMA(0, 0, At, B0); PG8_BAR; PG8_SCHED;
            PG8_LDB(B1, 0, 1); PG8_STAGE(PG8_SB(0, 0), b2, voffB);
            PG8_BAR; PG8_WAIT_L(0); PG8_MMA(0, 1, At, B1); PG8_BAR;
            PG8_LDA(At, 0, 1); PG8_STAGE(PG8_SA(0, 0), a2, voffA);
            PG8_BAR; PG8_WAIT_L(0); PG8_MMA(1, 0, At, B0); PG8_BAR; PG8_SCHED;
            PG8_STAGE(PG8_SB(0, 1), b2 + hstepB, voffB);
            PG8_WAIT_V(6); PG8_BAR; PG8_MMA(1, 1, At, B1); PG8_BAR;
            PG8_LDB(B0, 1, 0); PG8_SCHED; PG8_LDA(At, 1, 0); PG8_STAGE(PG8_SA(0, 1), a2 + hstepA, voffA);
            PG8_WAIT_L(8); PG8_BAR; PG8_WAIT_L(0); PG8_MMA(0, 0, At, B0); PG8_BAR; PG8_SCHED;
            PG8_LDB(B1, 1, 1); PG8_STAGE(PG8_SB(1, 0), b3, voffB);
            PG8_BAR; PG8_WAIT_L(0); PG8_MMA(0, 1, At, B1); PG8_BAR;
            PG8_LDA(At, 1, 1); PG8_STAGE(PG8_SA(1, 0), a3, voffA);
            PG8_BAR; PG8_WAIT_L(0); PG8_MMA(1, 0, At, B0); PG8_BAR; PG8_SCHED;
            PG8_STAGE(PG8_SB(1, 1), b3 + hstepB, voffB);
            PG8_WAIT_V(6); PG8_BAR; PG8_MMA(1, 1, At, B1); PG8_BAR;
            }
        }
        if constexpr (ALIGN_EPI) { if (wr == 0) PG8_BAR; }
        if constexpr (!Epi::AFTER_DRAIN) { E(acc, cur, wr, wc, fr, fq); S.done(cur); }
        if (!has_next) break;
#pragma unroll
        for (int a = 0; a < 2; ++a)
#pragma unroll
            for (int b = 0; b < 2; ++b)
#pragma unroll
                for (int m = 0; m < 4; ++m)
#pragma unroll
                    for (int n = 0; n < 2; ++n) acc[a][b][m][n] = (f32x4){0.f, 0.f, 0.f, 0.f};
        cur = nxt; cA = nA; cB = nB; ++ui;
        if constexpr (Epi::ACC_INIT) E.init(acc, cur, wr, wc, fr, fq);
        if constexpr (ALIGN_EPI) { if (wr == 1) PG8_BAR; }
    }
    PG8_WAIT_V(0);
    if constexpr (!ALIGN_EPI) { if (wr == 0) PG8_BAR; }
    PG8_BAR;
    if constexpr (Epi::AFTER_DRAIN) { E.fused(acc, cur, wr, wc, fr, fq, lds, wid, lane); S.done(cur); }
#undef PG8_SA
#undef PG8_SB
#undef PG8_STAGE
#undef PG8_LDA
#undef PG8_LDB
#undef PG8_MMA
#undef PG8_WAIT_V
#undef PG8_WAIT_V_RELAX
#undef PG8_WAIT_L
#undef PG8_BAR
#undef PG8_SCHED
}
}

#define LAS __attribute__((address_space(3)))
#define XB_TMO      128
#define XB_XCNT(j)  (256  + 64 * (j))
#define XB_XSUB(j)  (1280 + 64 * (j))
#define XB_XGEN(j)  (2304 + 64 * (j))
#define XB_TOP      3328
#define XB_TOPGEN   3392
#define XCD_BAR_WORDS 3456
#define XB_SPIN_CAP (1u << 18)

__device__ __forceinline__ unsigned xb_ld(unsigned* p)              { return __hip_atomic_load(p, __ATOMIC_RELAXED, __HIP_MEMORY_SCOPE_AGENT); }
__device__ __forceinline__ unsigned xb_add(unsigned* p, unsigned v) { return __hip_atomic_fetch_add(p, v, __ATOMIC_RELAXED, __HIP_MEMORY_SCOPE_AGENT); }
__device__ __forceinline__ unsigned xb_xcc_id() { return (unsigned)__builtin_amdgcn_s_getreg((3 << 11) | 20) & 0xFu; }
#define XB_SPIN(cond, bar) do { unsigned _sp = 0; while (cond) { __builtin_amdgcn_s_sleep(1); \
    if ((++_sp & 255u) == 0u) { if (xb_ld(&(bar)[XB_TMO])) break; if (_sp > XB_SPIN_CAP) { atomicAdd(&(bar)[XB_TMO], 1u); break; } } } } while (0)

struct XcdBarrier {
    unsigned* bar; unsigned x; unsigned G;
    volatile LAS unsigned* st;
};

__device__ __forceinline__ XcdBarrier xcd_barrier_post(unsigned* bar, volatile LAS unsigned* st, unsigned G) {
    XcdBarrier b; b.bar = bar; b.x = xb_xcc_id(); b.st = st; b.G = G;
    if (threadIdx.x == 0) (void)xb_add(&bar[XB_XCNT(b.x)], 1u);
    return b;
}
__device__ __forceinline__ void xcd_barrier_complete(unsigned* bar, unsigned x, unsigned G, unsigned& nloc, unsigned& nx) {
    unsigned sum, cnt, mine, sp = 0u;
    for (;;) {
        sum = 0u; cnt = 0u; mine = 0u;
#pragma unroll
        for (unsigned j = 0; j < 16; ++j) { const unsigned c = xb_ld(&bar[XB_XCNT(j)]); sum += c; cnt += (c > 0u) ? 1u : 0u; mine = (j == x) ? c : mine; }
        if (sum == G) break;
        __builtin_amdgcn_s_sleep(1);
        if ((++sp & 255u) == 0u) { if (xb_ld(&bar[XB_TMO])) break; if (sp > XB_SPIN_CAP) { atomicAdd(&bar[XB_TMO], 1u); break; } }
    }
    nloc = mine > 0u ? mine : 1u; nx = cnt > 0u ? cnt : 1u;
}

__device__ __forceinline__ void xcd_barrier(const XcdBarrier& b) {
    asm volatile("s_waitcnt vmcnt(0)" ::: "memory");
    __syncthreads();
    if (threadIdx.x == 0) {
        unsigned* bar = b.bar;
        __builtin_amdgcn_s_waitcnt(0);
        unsigned nloc = b.st[0], nx = b.st[1];
        if (nloc == 0u) { xcd_barrier_complete(bar, b.x, b.G, nloc, nx); b.st[0] = nloc; b.st[1] = nx; }
        const unsigned old = xb_add(&bar[XB_XSUB(b.x)], 1u);
        const unsigned gen = old / nloc;
        if (old + 1u == (gen + 1u) * nloc) {
            __builtin_amdgcn_fence(__ATOMIC_RELEASE, "agent");
            asm volatile("s_waitcnt vmcnt(0)" ::: "memory");
            const unsigned og = xb_add(&bar[XB_TOP], 1u);
            const unsigned tg = og / nx;
            if (og + 1u == (tg + 1u) * nx) xb_add(&bar[XB_TOPGEN], 1u);
            else XB_SPIN(xb_ld(&bar[XB_TOPGEN]) == tg, bar);
            __builtin_amdgcn_fence(__ATOMIC_ACQUIRE, "agent");
            xb_add(&bar[XB_XGEN(b.x)], 1u);
            asm volatile("s_waitcnt vmcnt(0)" ::: "memory");
        } else {
            XB_SPIN(xb_ld(&bar[XB_XGEN(b.x)]) == gen, bar);
            __builtin_amdgcn_fence(__ATOMIC_ACQUIRE, "agent");
            asm volatile("s_waitcnt vmcnt(0)" ::: "memory");
        }
    }
    __syncthreads();
}

constexpr int NWAVES = 8;
constexpr int RING_BYTES = 131072;
constexpr int LDSCTL_OFF = 139264;
constexpr int LDS_BYTES = 147456;
constexpr int CW_BAR = 4096;
constexpr size_t CTL_ZERO_BYTES = 131072;
#ifndef OPT_MASK
#define OPT_MASK 0x1FF
#endif

typedef float f32x4 __attribute__((ext_vector_type(4)));
typedef unsigned u32x4v __attribute__((ext_vector_type(4)));
typedef unsigned u32x2v __attribute__((ext_vector_type(2)));
typedef short bf16x8 __attribute__((ext_vector_type(8)));
#define LDS_WAIT() asm volatile("s_waitcnt lgkmcnt(0)" ::: "memory")

struct MArgs { const float* in[16]; float* out; unsigned char* ws; int ph_lo, ph_hi, li, pad; };
struct Frame { LAS unsigned char* lds; int tid, lane, wave, G, bid, grp, gi, gs, b0, nb; const float* in[16]; float* out; unsigned char* ws; };
#ifndef NGRP
#define NGRP 2
#endif
#ifndef LATE_G0
#define LATE_G0 0
#endif
constexpr int CW_LATE = 64;

__device__ __forceinline__ unsigned pk2(float lo, float hi) { return pg8::cvt_pk_bf16(lo, hi); }
__device__ __forceinline__ float wave_sum(float v) {
#pragma unroll
    for (int o = 1; o < 64; o <<= 1) v += __shfl_xor(v, o);
    return v;
}

template <int NR> __device__ __forceinline__ void p0_x_rows(const float* x, bf16_t* xb, float* rs, int row, int lane) {
    f32x4 v[NR][4]; float s[NR];
#pragma unroll
    for (int r = 0; r < NR; ++r) { const f32x4* xr = (const f32x4*)(x + (size_t)(row + r) * D_) + lane;
#pragma unroll
        for (int j = 0; j < 4; ++j) v[r][j] = __builtin_nontemporal_load(xr + 64 * j); }
#pragma unroll
    for (int r = 0; r < NR; ++r) { s[r] = 0.f;
#pragma unroll
        for (int j = 0; j < 4; ++j) s[r] += (v[r][j][0] * v[r][j][0] + v[r][j][1] * v[r][j][1]) + (v[r][j][2] * v[r][j][2] + v[r][j][3] * v[r][j][3]); }
#pragma unroll
    for (int o = 1; o < 64; o <<= 1)
#pragma unroll
        for (int r = 0; r < NR; ++r) s[r] += __shfl_xor(s[r], o);
#pragma unroll
    for (int r = 0; r < NR; ++r) { u32x2v* o8 = (u32x2v*)(xb + (size_t)(row + r) * D_) + lane;
#pragma unroll
        for (int j = 0; j < 4; ++j) { u32x2v w; w.x = pk2(v[r][j][0], v[r][j][1]); w.y = pk2(v[r][j][2], v[r][j][3]); o8[64 * j] = w; }
        if (lane == 0) rs[row + r] = 1.0f / sqrtf(s[r] * (1.0f / D_) + EPS_); }
}
constexpr int TSCR_BYTES = 64 * 65 * 4;
__device__ __forceinline__ void p0_transpose_item(const float* W, int ldw, int csrc, const float* gain, int gmask, bf16_t* WT, int K, int nrow, int k0, LAS float* scr, int lane) {
    const int kk = lane >> 4, nq = lane & 15;
    f32x4 v[16];
#pragma unroll
    for (int j = 0; j < 16; ++j) v[j] = __builtin_nontemporal_load((const f32x4*)(W + (size_t)(k0 + 4 * j + kk) * ldw + csrc + 4 * nq));
#pragma unroll
    for (int j = 0; j < 16; ++j) { const int k = 4 * j + kk; LAS float* d = scr + k * 65 + ((4 * nq + 4 * (j >> 3)) & 63);
        d[0] = v[j][0]; d[1] = v[j][1]; d[2] = v[j][2]; d[3] = v[j][3]; }
    const int c = lane & 7, nr = lane >> 3;
    f32x4 g0 = (f32x4){1.f, 1.f, 1.f, 1.f}, g1 = g0;
    if (gain) { g0 = *(const f32x4*)(gain + ((k0 + 8 * c) & gmask)); g1 = *(const f32x4*)(gain + ((k0 + 8 * c + 4) & gmask)); }
    LDS_WAIT(); asm volatile("" ::: "memory");
#pragma unroll
    for (int jj = 0; jj < 8; ++jj) { const int n = nr + 8 * jj; const LAS float* s = scr + (8 * c) * 65 + ((n + 4 * (c >> 2)) & 63);
        u32x4v o; o.x = pk2(s[0 * 65] * g0[0], s[1 * 65] * g0[1]); o.y = pk2(s[2 * 65] * g0[2], s[3 * 65] * g0[3]); o.z = pk2(s[4 * 65] * g1[0], s[5 * 65] * g1[1]); o.w = pk2(s[6 * 65] * g1[2], s[7 * 65] * g1[3]);
        *(u32x4v*)(WT + (size_t)(nrow + n) * K + k0 + 8 * c) = o; }
    LDS_WAIT(); asm volatile("" ::: "memory");
}
__device__ __forceinline__ void p0_memkv(const Frame& F, int unit) {
    const int l = unit >> 7, b = (unit >> 6) & 1, mt = (unit >> 3) & 7, cg = unit & 7, lane = F.lane, w = F.wave, c = lane & 15, g4 = lane >> 4, cgw = w & 1, kq = w >> 1;
    const float* mem = F.in[1] + ((size_t)b * 256 + mt * 32) * D_; const float* W = F.in[13] + (size_t)l * D_ * 1024 + cg * 128 + 64 * cgw + 4 * c; const float* gm = F.in[12] + l * D_;
    constexpr int MRS = 2064;
    LAS unsigned char* MI = F.lds; LAS float* P = (LAS float*)(F.lds + 32 * MRS); LAS float* RM = (LAS float*)(F.lds + 32 * MRS + 65536);
    f32x4 acc[4][2];
#pragma unroll
    for (int t = 0; t < 4; ++t) { acc[t][0] = (f32x4){0.f, 0.f, 0.f, 0.f}; acc[t][1] = (f32x4){0.f, 0.f, 0.f, 0.f}; }
    struct Raw { f32x4 w[8]; };
#define MKV_LOAD(R_, ks_) do { const int kb_ = kq * 256 + (ks_) * 32 + 8 * g4; \
        _Pragma("unroll") for (int j = 0; j < 8; ++j) (R_).w[j] = *(const f32x4*)(W + (size_t)(kb_ + j) * 1024); } while (0)
#define MKV_MMA(R_, ks_) do { bf16x8 afr[2], bfr[4]; const int ka_ = (kq * 256 + (ks_) * 32 + 8 * g4) * 2; \
        _Pragma("unroll") for (int rb = 0; rb < 2; ++rb) afr[rb] = *(const LAS bf16x8*)(MI + (rb * 16 + c) * MRS + ka_); \
        _Pragma("unroll") for (int t = 0; t < 4; ++t) { u32x4v q_; q_.x = pk2((R_).w[0][t], (R_).w[1][t]); q_.y = pk2((R_).w[2][t], (R_).w[3][t]); q_.z = pk2((R_).w[4][t], (R_).w[5][t]); q_.w = pk2((R_).w[6][t], (R_).w[7][t]); bfr[t] = __builtin_bit_cast(bf16x8, q_); } \
        _Pragma("unroll") for (int t = 0; t < 4; ++t) _Pragma("unroll") for (int rb = 0; rb < 2; ++rb) acc[t][rb] = __builtin_amdgcn_mfma_f32_16x16x32_bf16(afr[rb], bfr[t], acc[t][rb], 0, 0, 0); } while (0)
#define MKV_FENCE() asm volatile("" ::: "memory")
    Raw RA, RB, RC;
    MKV_LOAD(RA, 0); MKV_FENCE();
    { const int row = F.tid >> 4, part = F.tid & 15; const f32x4* mr = (const f32x4*)(mem + (size_t)row * D_) + part; const f32x4* gr = (const f32x4*)gm + part;
      f32x4 v[16];
#pragma unroll
      for (int j = 0; j < 16; ++j) v[j] = mr[16 * j];
      float ss = 0.f;
#pragma unroll
      for (int j = 0; j < 16; ++j) { const f32x4 g = gr[16 * j]; ss += (v[j][0] * v[j][0] + v[j][1] * v[j][1]) + (v[j][2] * v[j][2] + v[j][3] * v[j][3]);
          const f32x4 a = v[j] * g; u32x2v t; t.x = pk2(a[0], a[1]); t.y = pk2(a[2], a[3]); *(LAS u32x2v*)(MI + row * MRS + (part + 16 * j) * 8) = t; }
      ss += __shfl_xor(ss, 1); ss += __shfl_xor(ss, 2); ss += __shfl_xor(ss, 4); ss += __shfl_xor(ss, 8);
      if (part == 0) RM[row] = 1.0f / sqrtf(ss * (1.0f / D_) + EPS_); }
    MKV_LOAD(RB, 1); MKV_FENCE();
    __syncthreads();
#pragma unroll 1
    for (int ks = 0; ks < 6; ks += 3) {
        MKV_LOAD(RC, ks + 2); MKV_FENCE(); MKV_MMA(RA, ks);
        MKV_LOAD(RA, ks + 3); MKV_FENCE(); MKV_MMA(RB, ks + 1);
        MKV_LOAD(RB, ks + 4); MKV_FENCE(); MKV_MMA(RC, ks + 2);
    }
    MKV_MMA(RA, 6);
    MKV_MMA(RB, 7);
#undef MKV_FENCE
#undef MKV_LOAD
#undef MKV_MMA
#pragma unroll
    for (int rb = 0; rb < 2; ++rb)
#pragma unroll
        for (int r = 0; r < 4; ++r) { const int tok = rb * 16 + 4 * g4 + r; *(LAS f32x4*)(P + ((kq * 32 + tok) * 128 + 64 * cgw + 4 * c)) = (f32x4){acc[0][rb][r], acc[1][rb][r], acc[2][rb][r], acc[3][rb][r]}; }
    __syncthreads();
    const int tok = F.tid >> 4, cb = F.tid & 15;
    f32x4 s0 = (f32x4){0.f, 0.f, 0.f, 0.f}, s1 = s0;
#pragma unroll
    for (int q = 0; q < 4; ++q) { s0 += *(const LAS f32x4*)(P + ((q * 32 + tok) * 128 + cb * 8)); s1 += *(const LAS f32x4*)(P + ((q * 32 + tok) * 128 + cb * 8 + 4)); }
    const float rm = RM[tok];
    s0 *= rm; s1 *= rm;
    const size_t orow = ((((size_t)l * 2 + b) * 4 + (cg & 3)) * 256 + mt * 32 + tok) * 128 + cb * 8;
    if (cg < 4) {
        float q = (s0[0] * s0[0] + s0[1] * s0[1]) + (s0[2] * s0[2] + s0[3] * s0[3]) + (s1[0] * s1[0] + s1[1] * s1[1]) + (s1[2] * s1[2] + s1[3] * s1[3]);
        q += __shfl_xor(q, 1); q += __shfl_xor(q, 2); q += __shfl_xor(q, 4); q += __shfl_xor(q, 8);
        const float hn = QK_SCALE / sqrtf(q * (1.0f / 128) + EPS_);
        const f32x4 gk0 = *(const f32x4*)(F.in[15] + l * 128 + cb * 8), gk1 = *(const f32x4*)(F.in[15] + l * 128 + cb * 8 + 4);
        const f32x4 gq0 = *(const f32x4*)(F.in[14] + l * 128 + cb * 8), gq1 = *(const f32x4*)(F.in[14] + l * 128 + cb * 8 + 4);
        s0 = s0 * hn * gk0 * gq0; s1 = s1 * hn * gk1 * gq1;
        *(u32x4v*)((bf16_t*)(F.ws + WS_MEMK) + orow) = pg8::pack8(s0, s1);
    } else *(u32x4v*)((bf16_t*)(F.ws + WS_MEMV) + orow) = pg8::pack8(s0, s1);
    __syncthreads();
}
__device__ __forceinline__ void p0_weight_item(const Frame& F, int r, LAS float* scr) {
    constexpr int I_A = 16 * 64, I_OA = 24 * 16, I_B = 16 * 80;
    if (r < I_A) { const int kb = r / 64, n0 = 64 * (r % 64); p0_transpose_item(F.in[4], 4096, permA_src(n0), F.in[3], 0xffff, (bf16_t*)(F.ws + WS_WINA), 1024, n0, 64 * kb, scr, F.lane); return; } r -= I_A;
    if (r < I_OA) { const int kb = r / 16, n0 = 64 * (r % 16); p0_transpose_item(F.in[6], 1024, n0, kb < 16 ? F.in[5] : nullptr, 255, (bf16_t*)(F.ws + WS_WOUTA), 1536, n0, 64 * kb, scr, F.lane); return; } r -= I_OA;
    if (r < I_B) { const int kb = r / 80, n0 = 64 * (r % 80);
        if (n0 < 2048) p0_transpose_item(F.in[8], 2048, n0, F.in[7], 0xffff, (bf16_t*)(F.ws + WS_WB), 1024, n0, 64 * kb, scr, F.lane);
        else { const int c = n0 - 2048, src = c < 1024 ? 1024 + c : (c < 2048 ? c - 1024 : c); p0_transpose_item(F.in[10], 3072, src, F.in[9], 0xffff, (bf16_t*)(F.ws + WS_WB), 1024, n0, 64 * kb, scr, F.lane); }
        return; } r -= I_B;
    { const int kb = r / 16, n0 = 64 * (r % 16); p0_transpose_item(F.in[11], 1024, n0, nullptr, 0, (bf16_t*)(F.ws + WS_WOUTB), 1536, n0, 64 * kb, scr, F.lane); }
}
__device__ __forceinline__ void p0_prologue(const Frame& F) {
    for (int u = F.bid; u < 256; u += F.G) p0_memkv(F, u);
    const int gw = F.bid * NWAVES + F.wave, NGW = F.G * NWAVES;
    LAS float* scr = (LAS float*)(F.lds + F.wave * TSCR_BYTES);
    float* RS0 = (float*)(F.ws + WS_RS0); const float* x = F.in[0];
    if (NGW == 2048) {
        if (gw < 1024) { p0_weight_item(F, gw, scr); p0_x_rows<4>(x, x1b_ptr(F.ws, (6 * gw) >> 13), RS0, 6 * gw, F.lane); if (NGRP == 1) p0_weight_item(F, gw + 2048, scr); p0_x_rows<2>(x, x1b_ptr(F.ws, (6 * gw + 4) >> 13), RS0, 6 * gw + 4, F.lane); }
        else { const int r0 = 6144 + 10 * (gw - 1024); p0_x_rows<4>(x, x1b_ptr(F.ws, r0 >> 13), RS0, r0, F.lane); if (NGRP == 1) p0_weight_item(F, gw, scr); p0_x_rows<4>(x, x1b_ptr(F.ws, (r0 + 4) >> 13), RS0, r0 + 4, F.lane); p0_x_rows<2>(x, x1b_ptr(F.ws, (r0 + 8) >> 13), RS0, r0 + 8, F.lane); }
    } else {
        for (int it = gw; it < (NGRP == 2 ? 1024 : 3072); it += NGW) p0_weight_item(F, it, scr);
        for (int m = 4 * gw; m < T_; m += 4 * NGW) p0_x_rows<4>(x, x1b_ptr(F.ws, m >> 13), RS0, m, F.lane);
    }
}
__device__ __forceinline__ void p0_late_weights(const Frame& F) {
    LAS float* scr = (LAS float*)(F.lds + F.wave * TSCR_BYTES);
    const int wv = F.gi * NWAVES + F.wave, nw = F.gs * NWAVES;
    if (F.grp == 0) { for (int it = 1024 + wv; it < 1024 + LATE_G0; it += nw) p0_weight_item(F, it, scr); }
    else { for (int it = 1024 + LATE_G0 + wv; it < 3072; it += nw) p0_weight_item(F, it, scr); }
}

typedef float f32x16 __attribute__((ext_vector_type(16)));
typedef short s16x4 __attribute__((ext_vector_type(4)));
#define KSWZ(row, colB) ((row) * 256 + ((colB) ^ (((row) & 7) << 4)))
#define SBAR() __builtin_amdgcn_sched_barrier(0)
constexpr float LOG2E = 1.4426950408889634f;
__device__ __forceinline__ int crow(int r, int hi) { return (r & 3) + 8 * (r >> 2) + 4 * hi; }
__device__ __forceinline__ unsigned lds_addr(const LAS void* p) { return (unsigned)(size_t)p; }
__device__ __forceinline__ int v_st(int k, int c) { const int kk = (k & ~0xC) | ((k & 4) << 1) | ((k & 8) >> 1); return ((kk >> 3) * 4 + (c >> 5)) * 512 + ((kk & 7) * 32 + (c & 31)) * 2; }
__device__ __forceinline__ int v_rd_base(int lane) { return ((lane & 3) << 3) | (((lane >> 2) & 3) << 6) | (((lane >> 4) & 1) << 5) | (((lane >> 5) & 1) << 8); }
constexpr int v_rd_off(int d0, int ks, int half) { return d0 * 512 + ks * 4096 + half * 2048; }
template <int OFF> __device__ __forceinline__ s16x4 tr_read(unsigned vb) { s16x4 r; asm volatile("ds_read_b64_tr_b16 %0, %1 offset:%2" : "=&v"(r) : "v"(vb), "i"(OFF) : "memory"); return r; }
#define PKLH(L, H) (bf16x8){L[0], L[1], L[2], L[3], H[0], H[1], H[2], H[3]}
__device__ __forceinline__ float partner32(float x, int hi) { auto rr = __builtin_amdgcn_permlane32_swap(__float_as_uint(x), __float_as_uint(x), false, false); return __uint_as_float(hi ? rr[0] : rr[1]); }

__device__ __forceinline__ void qkt(f32x16& p0, f32x16& p1, const LAS unsigned char* Ks, const bf16x8* qr, int r32, int hi) {
    p0 = f32x16{}; p1 = f32x16{};
#pragma unroll
    for (int d0 = 0; d0 < 8; ++d0) { const int cb = (d0 * 16 + hi * 8) * 2;
        const bf16x8 b0 = *(const LAS bf16x8*)(Ks + KSWZ(r32, cb)), b1 = *(const LAS bf16x8*)(Ks + KSWZ(32 + r32, cb));
        p0 = __builtin_amdgcn_mfma_f32_32x32x16_bf16(b0, qr[d0], p0, 0, 0, 0);
        p1 = __builtin_amdgcn_mfma_f32_32x32x16_bf16(b1, qr[d0], p1, 0, 0, 0); }
}
#define PK4(P, BASE, OUT) do { unsigned a0_ = pg8::cvt_pk_bf16(P[BASE + 0], P[BASE + 1]), a1_ = pg8::cvt_pk_bf16(P[BASE + 2], P[BASE + 3]); \
    unsigned b0_ = pg8::cvt_pk_bf16(P[BASE + 4], P[BASE + 5]), b1_ = pg8::cvt_pk_bf16(P[BASE + 6], P[BASE + 7]); \
    auto r0_ = __builtin_amdgcn_permlane32_swap(a0_, b0_, false, false); auto r1_ = __builtin_amdgcn_permlane32_swap(a1_, b1_, false, false); \
    u32x4v w_ = {r0_[0], r1_[0], r0_[1], r1_[1]}; OUT = __builtin_bit_cast(bf16x8, w_); } while (0)
template <int D0> __device__ __forceinline__ void pv_one(f32x16& od, unsigned vb, bf16x8 pa0, bf16x8 pa1, bf16x8 pa2, bf16x8 pa3) {
    const s16x4 l0 = tr_read<v_rd_off(D0, 0, 0)>(vb), h0 = tr_read<v_rd_off(D0, 0, 1)>(vb), l1 = tr_read<v_rd_off(D0, 1, 0)>(vb), h1 = tr_read<v_rd_off(D0, 1, 1)>(vb);
    const s16x4 l2 = tr_read<v_rd_off(D0, 2, 0)>(vb), h2 = tr_read<v_rd_off(D0, 2, 1)>(vb), l3 = tr_read<v_rd_off(D0, 3, 0)>(vb), h3 = tr_read<v_rd_off(D0, 3, 1)>(vb);
    asm volatile("s_waitcnt lgkmcnt(0)" ::: "memory"); SBAR();
    od = __builtin_amdgcn_mfma_f32_32x32x16_bf16(pa0, PKLH(l0, h0), od, 0, 0, 0);
    od = __builtin_amdgcn_mfma_f32_32x32x16_bf16(pa1, PKLH(l1, h1), od, 0, 0, 0);
    od = __builtin_amdgcn_mfma_f32_32x32x16_bf16(pa2, PKLH(l2, h2), od, 0, 0, 0);
    od = __builtin_amdgcn_mfma_f32_32x32x16_bf16(pa3, PKLH(l3, h3), od, 0, 0, 0);
}
__device__ __forceinline__ void pv_d0(f32x16* o, unsigned vb, bf16x8 pa0, bf16x8 pa1, bf16x8 pa2, bf16x8 pa3) {
    pv_one<0>(o[0], vb, pa0, pa1, pa2, pa3); pv_one<1>(o[1], vb, pa0, pa1, pa2, pa3); pv_one<2>(o[2], vb, pa0, pa1, pa2, pa3); pv_one<3>(o[3], vb, pa0, pa1, pa2, pa3);
}
constexpr int WSCR_OFF = LDSCTL_OFF + 1024, WFLAG_OFF = LDSCTL_OFF + 512;


template <int H2> __device__ __forceinline__ void o_half_stage(const f32x16* o, const float* rsc, LAS unsigned char* stg, int r32, int hi) {
#pragma unroll
    for (int r = 8 * H2; r < 8 * H2 + 8; ++r) { LAS bf16_t* sp = (LAS bf16_t*)(stg + ((r & 3) + 8 * ((r >> 2) & 1) + 4 * hi) * 256) + r32;
#pragma unroll
        for (int db = 0; db < 4; ++db) sp[32 * db] = (bf16_t)(pg8::cvt_pk_bf16_safe(o[db][r] * rsc[r], 0.f) & 0xffffu); }
}
__device__ __forceinline__ bf16x8 mul8_bf16(bf16x8 v, bf16x8 g) {
    u32x4v w; w.x = pk2(bf2f((bf16_t)v[0]) * bf2f((bf16_t)g[0]), bf2f((bf16_t)v[1]) * bf2f((bf16_t)g[1])); w.y = pk2(bf2f((bf16_t)v[2]) * bf2f((bf16_t)g[2]), bf2f((bf16_t)v[3]) * bf2f((bf16_t)g[3]));
    w.z = pk2(bf2f((bf16_t)v[4]) * bf2f((bf16_t)g[4]), bf2f((bf16_t)v[5]) * bf2f((bf16_t)g[5])); w.w = pk2(bf2f((bf16_t)v[6]) * bf2f((bf16_t)g[6]), bf2f((bf16_t)v[7]) * bf2f((bf16_t)g[7]));
    return __builtin_bit_cast(bf16x8, w);
}
__device__ __forceinline__ void o_tile_stage(const f32x16* o, const float* rsc, LAS unsigned char* stg, int r32, int hi) {
#pragma unroll
    for (int r = 0; r < 16; ++r) { LAS bf16_t* sp = (LAS bf16_t*)(stg + crow(r, hi) * 256) + r32;
#pragma unroll
        for (int db = 0; db < 4; ++db) sp[32 * db] = (bf16_t)(pg8::cvt_pk_bf16_safe(o[db][r] * rsc[r], 0.f) & 0xffffu); }
}
__device__ __forceinline__ void o_tile_out(const LAS unsigned char* stg, const bf16_t* gate, bf16_t* out, size_t ld, int lane) {
    const int rr = lane >> 4, ch = lane & 15;
    bf16x8 g[8];
#pragma unroll
    for (int ps = 0; ps < 8; ++ps) g[ps] = __builtin_nontemporal_load((const bf16x8*)(gate + (size_t)(4 * ps + rr) * ld + ch * 8));
#pragma unroll
    for (int ps = 0; ps < 8; ++ps) { const int row = 4 * ps + rr; *(bf16x8*)(out + (size_t)row * ld + ch * 8) = mul8_bf16(*(const LAS bf16x8*)(stg + row * 256 + ch * 16), g[ps]); }
}


template <bool MASK, int KOFF> __device__ __forceinline__ void sb_half_a(f32x16& p, float* go, int lim) {
#pragma unroll
    for (int i = 0; i < 4; ++i) { float l[4];
#pragma unroll
        for (int e = 0; e < 4; ++e) { float y = fminf(p[4 * i + e], 60.f); if (MASK) y = KOFF + 8 * i + e < lim ? y : -1e30f;
            const float sp = __builtin_amdgcn_logf(1.0f + __builtin_amdgcn_exp2f(y));
            l[e] = -sp; p[4 * i + e] = y - sp; }
        go[i] = (l[0] + l[1]) + (l[2] + l[3]);
        const float s2 = l[3], s1 = s2 + l[2], s0 = s1 + l[1]; p[4 * i + 2] += s2; p[4 * i + 1] += s1; p[4 * i] += s0; }
}
template <bool MASK, int KOFF> __device__ __forceinline__ void sb_half_b(f32x16& p, const float* go, int lim, float carry, float& tail, int hi) {
#pragma unroll
    for (int i = 3; i >= 0; --i) { const float gpi = partner32(go[i], hi); const float so = tail + (hi ? 0.f : gpi) + carry; tail += go[i] + gpi;
#pragma unroll
        for (int e = 0; e < 4; ++e) p[4 * i + e] = __builtin_amdgcn_exp2f(p[4 * i + e] + so); }
}
template <bool MASK> __device__ __forceinline__ float sb_weights(f32x16& p0, f32x16& p1, int lim, float carry, int hi) {
    float go[8], tail = 0.f;
    sb_half_a<MASK, 0>(p0, go, lim); sb_half_a<MASK, 32>(p1, go + 4, lim);
    sb_half_b<MASK, 32>(p1, go + 4, lim, carry, tail, hi); sb_half_b<MASK, 0>(p0, go, lim, carry, tail, hi);
    return tail;
}

constexpr float SB_EXIT = -64.0f;
__device__ __forceinline__ int swap23(int k) { return (k & ~0xC) | ((k & 4) << 1) | ((k & 8) >> 1); }
__device__ __forceinline__ void sb_unit(const Frame& F, int b, int hp, int qb) {
    int tid = F.tid; asm volatile("" : "+v"(tid));
    const int w = F.wave, lane = tid & 63, r32 = lane & 31, hi = lane >> 5;
    const int hh = w >> 2, wl = w & 3, rg = hh ? ((w + 2) & 3) : w, h = 2 * hp + hh;
    bf16_t* UB = ub_ptr(F.ws, b); const size_t rowb = (size_t)b * S_;
    const int q0 = qb * 128, tq = q0 + 32 * rg + r32;
    LAS unsigned char* ring = F.lds + hh * 65536;
    unsigned offK[4], offV[4];
#pragma unroll
    for (int i = 0; i < 4; ++i) { const int pc = wl + 4 * i;
        { const int row = pc * 4 + (lane >> 4), colB = ((lane & 15) * 16) ^ ((row & 7) << 4); offK[i] = (unsigned)(row * NBW_ + colB / 2); }
        { const int d = pc * 1024 + lane * 16, st = d >> 9, o = d & 511, kk = ((st >> 2) << 3) | (o >> 6), k = swap23(kk), c = (st & 3) * 32 + (o & 63) / 2; offV[i] = (unsigned)(k * NBW_ + c); } }
    const bf16_t* kg = UB + rowb * NBW_ + h * 128; const bf16_t* vg = kg + 1024;
#define SB_DMA(kt_) do { const int bo_ = ((kt_) & 1) * 32768; const bf16_t* kt0_ = kg + (size_t)(kt_) * 64 * NBW_; const bf16_t* vt0_ = vg + (size_t)(kt_) * 64 * NBW_; \
        _Pragma("unroll") for (int i_ = 0; i_ < 4; ++i_) { \
            __builtin_amdgcn_global_load_lds((const unsigned*)(kt0_ + offK[i_]), (LAS unsigned*)(ring + bo_ + (wl + 4 * i_) * 1024), 16, 0, 0); \
            __builtin_amdgcn_global_load_lds((const unsigned*)(vt0_ + offV[i_]), (LAS unsigned*)(ring + bo_ + 16384 + (wl + 4 * i_) * 1024), 16, 0, 0); } } while (0)
    volatile LAS unsigned* flags = (volatile LAS unsigned*)(F.lds + WFLAG_OFF);
    f32x16 o[4] = {}; float carry = 0.f; bool wdone = false;
    const int kt_hi = qb * 2 + 1;
    __syncthreads();
    if (lane == 0) { flags[w] = 0u; flags[8 + w] = 0u; }
    SB_DMA(kt_hi);
    bf16x8 qr[8];
    { const bf16_t* qp = UB + (rowb + tq) * NBW_ + 3072 + h * 128 + hi * 8;
#pragma unroll
      for (int d0 = 0; d0 < 8; ++d0) qr[d0] = __builtin_nontemporal_load((const bf16x8*)(qp + d0 * 16)); }
    const unsigned vbase = lds_addr(ring) + 16384 + v_rd_base(lane);
    for (int kt = kt_hi; kt >= 0; --kt) {
        asm volatile("s_waitcnt vmcnt(0)" ::: "memory");
        asm volatile("s_waitcnt lgkmcnt(0)" ::: "memory"); __builtin_amdgcn_s_barrier(); asm volatile("" ::: "memory");
        unsigned alld = 1u;
#pragma unroll
        for (int j = 0; j < 8; ++j) alld &= flags[8 * (kt & 1) + j];
        if (alld) break;
        if (kt >= 1) SB_DMA(kt - 1);
        const int bo = (kt & 1) * 32768;
        if (!wdone && kt * 64 < q0 + 32 * rg + 31) {
            f32x16 p0, p1;
            qkt(p0, p1, ring + bo, qr, r32, hi);
            const int lim = tq - kt * 64 - 4 * hi;
            const bool need_mask = kt * 64 + 63 >= q0 + 32 * rg;
            carry += need_mask ? sb_weights<true>(p0, p1, lim, carry, hi) : sb_weights<false>(p0, p1, lim, carry, hi);
            bf16x8 pa0, pa1, pa2, pa3;
            PK4(p0, 0, pa0); PK4(p0, 8, pa1); PK4(p1, 0, pa2); PK4(p1, 8, pa3);
            pv_d0(o, vbase + bo, pa0, pa1, pa2, pa3);
            wdone = __all(carry < SB_EXIT);
        }
        if (lane == 0) flags[8 * ((kt & 1) ^ 1) + w] = wdone ? 1u : 0u;
    }
#undef SB_DMA
    asm volatile("s_waitcnt vmcnt(0) lgkmcnt(0)" ::: "memory"); __builtin_amdgcn_s_barrier(); asm volatile("" ::: "memory");
    { float one[16];
#pragma unroll
      for (int r = 0; r < 16; ++r) one[r] = 1.0f;
      LAS unsigned char* stg = F.lds + w * 8192; bf16_t* base = UB + (rowb + q0 + 32 * rg) * NBW_ + h * 128;
      o_tile_stage(o, one, stg, r32, hi); LDS_WAIT();
      o_tile_out(stg, base + 2048, base + 3072, NBW_, lane); LDS_WAIT(); }
}

template <bool STORE = true> __device__ __forceinline__ void memattn_unit(const Frame& F, bf16_t* U, int ld, int qoff, int goff, int layer, int unit) {
    int tid = F.tid; asm volatile("" : "+v"(tid));
    const int w = F.wave, lane = tid & 63, r32 = lane & 31, hi = lane >> 5;
    const int qblk = unit >> 2, hd = unit & 3, row0 = qblk * 256, b = row0 / S_;
    const bf16_t* Kg = (const bf16_t*)(F.ws + WS_MEMK) + (((size_t)layer * 2 + b) * 4 + hd) * 256 * 128; const bf16_t* Vg = (const bf16_t*)(F.ws + WS_MEMV) + (((size_t)layer * 2 + b) * 4 + hd) * 256 * 128;
    LAS unsigned char* Kb = F.lds; LAS unsigned char* Vb = F.lds + 65536;
    __syncthreads();
    { bf16x8 kst_[8], vst_[8];
#pragma unroll
      for (int j = 0; j < 8; ++j) { const int c = tid + 512 * j, row = c >> 4, ch = c & 15; kst_[j] = *(const bf16x8*)(Kg + (size_t)row * 128 + ch * 8); vst_[j] = *(const bf16x8*)(Vg + (size_t)row * 128 + ch * 8); }
#pragma unroll
      for (int j = 0; j < 8; ++j) { const int c = tid + 512 * j, row = c >> 4, ch = c & 15;
          *(LAS bf16x8*)(Kb + KSWZ(row, ch * 16)) = kst_[j]; *(LAS bf16x8*)(Vb + (row >> 6) * 16384 + v_st(row & 63, ch * 8)) = vst_[j]; } }
    bf16x8 qr[8]; float ssq = 0.f;
    { const bf16_t* qp = U + (size_t)(row0 + 32 * w + r32) * ld + qoff + hd * 128 + hi * 8;
#pragma unroll
      for (int d0 = 0; d0 < 8; ++d0) { qr[d0] = __builtin_nontemporal_load((const bf16x8*)(qp + d0 * 16));
#pragma unroll
          for (int j = 0; j < 8; ++j) { const float v = bf2f((bf16_t)qr[d0][j]); ssq += v * v; } } }
    ssq += partner32(ssq, hi);
    const float C = LOG2E / sqrtf(ssq * (1.0f / 128) + EPS_);
    __syncthreads();
    LAS float* wscr = (LAS float*)(F.lds + WSCR_OFF) + w * 64;
    const unsigned vb0 = lds_addr(Vb) + v_rd_base(lane);
    f32x16 o[4] = {}; float m_reg = -1e30f, l_reg = 0.f;
#pragma unroll 1
    for (int t = 0; t < 4; ++t) {
        f32x16 p0, p1;
        qkt(p0, p1, Kb + t * 16384, qr, r32, hi);
        float pmax = p0[0];
#pragma unroll
        for (int r = 1; r < 16; ++r) pmax = fmaxf(pmax, p0[r]);
#pragma unroll
        for (int r = 0; r < 16; ++r) pmax = fmaxf(pmax, p1[r]);
        pmax = fmaxf(pmax, partner32(pmax, hi));
        float alpha = 1.f;
        if (!__all((pmax - m_reg) * C <= 8.0f)) { const float mn = fmaxf(m_reg, pmax); alpha = __builtin_amdgcn_exp2f((m_reg - mn) * C); m_reg = mn;
            if (t > 0) {
                if (hi == 0) wscr[r32] = alpha; LDS_WAIT();
#pragma unroll
                for (int d = 0; d < 4; ++d)
#pragma unroll
                    for (int r = 0; r < 16; ++r) o[d][r] *= wscr[crow(r, hi)];
                LDS_WAIT(); } }
        const float mC = -m_reg * C; float ps = 0.f;
#pragma unroll
        for (int r = 0; r < 16; ++r) { p0[r] = __builtin_amdgcn_exp2f(fmaf(p0[r], C, mC)); p1[r] = __builtin_amdgcn_exp2f(fmaf(p1[r], C, mC)); ps += p0[r] + p1[r]; }
        ps += partner32(ps, hi);
        l_reg = l_reg * alpha + ps;
        bf16x8 pa0, pa1, pa2, pa3;
        PK4(p0, 0, pa0); PK4(p0, 8, pa1); PK4(p1, 0, pa2); PK4(p1, 8, pa3);
        pv_d0(o, vb0 + t * 16384, pa0, pa1, pa2, pa3);
    }
    if (hi == 0) wscr[32 + r32] = l_reg; LDS_WAIT();
    { float rl[16];
#pragma unroll
      for (int r = 0; r < 16; ++r) rl[r] = 1.0f / wscr[32 + crow(r, hi)];
      __syncthreads();
      LAS unsigned char* stg = F.lds + w * 8192; bf16_t* base = U + (size_t)(row0 + 32 * w) * ld + hd * 128;
      o_tile_stage(o, rl, stg, r32, hi); LDS_WAIT();
      if (STORE) o_tile_out(stg, base + goff, base + qoff, ld, lane); else if (rl[0] == 1.2345e33f) o_tile_out(stg, base + goff, base + qoff, ld, lane);
      LDS_WAIT(); }
}

__device__ __forceinline__ float ret_lg2(int h) { return log2f(1.0f - exp2f(-5.0f - (float)h)); }
__device__ __forceinline__ void kvt_unit(const Frame& F, int u) {
    int tid = F.tid; asm volatile("" : "+v"(tid));
    const int w = F.wave, lane = tid & 63, r32 = lane & 31, hi = lane >> 5;
    const int b = u >> 8, h = (u >> 6) & 3, n = u & 63; const size_t row0 = (size_t)b * S_ + n * 128; const float lg2 = ret_lg2(h);
    const bf16_t* UA = ua_ptr(F.ws, b); bf16_t* KVT = kvt_ptr(F.ws, b);
    LAS unsigned char* Vb = F.lds; LAS unsigned char* Kb = F.lds + 65536;
    __syncthreads();
    bf16x8 vst_[8], kst_[4];
#pragma unroll
    for (int j = 0; j < 8; ++j) { const int c = tid + 512 * j, row = c >> 5, col = (c & 31) * 8; vst_[j] = *(const bf16x8*)(UA + (row0 + row) * NA_ + 1024 + h * 256 + col); }
#pragma unroll
    for (int j = 0; j < 4; ++j) { const int c = tid + 512 * j, row = c >> 4, col = (c & 15) * 8; kst_[j] = *(const bf16x8*)(UA + (row0 + row) * NA_ + 512 + h * 128 + col); }
#pragma unroll
    for (int j = 0; j < 8; ++j) { const int c = tid + 512 * j, row = c >> 5, col = (c & 31) * 8;
        *(LAS bf16x8*)(Vb + ((row >> 6) * 2 + (col >> 7)) * 16384 + v_st(row & 63, col & 127)) = vst_[j]; }
#pragma unroll
    for (int j = 0; j < 4; ++j) { const int c = tid + 512 * j, row = c >> 4, col = (c & 15) * 8; const float z = exp2f((float)(127 - row) * lg2);
        const bf16x8 kv = kst_[j];
        u32x4v t; t.x = pk2(bf2f((bf16_t)kv[0]) * z, bf2f((bf16_t)kv[1]) * z); t.y = pk2(bf2f((bf16_t)kv[2]) * z, bf2f((bf16_t)kv[3]) * z);
        t.z = pk2(bf2f((bf16_t)kv[4]) * z, bf2f((bf16_t)kv[5]) * z); t.w = pk2(bf2f((bf16_t)kv[6]) * z, bf2f((bf16_t)kv[7]) * z);
        *(LAS u32x4v*)(Kb + (row >> 6) * 16384 + v_st(row & 63, col)) = t; }
    __syncthreads();
    f32x16 acc[4] = {};
    const unsigned vbV = lds_addr(Vb) + v_rd_base(lane) + (w >> 2) * 16384 + (w & 3) * 512, vbK = lds_addr(Kb) + v_rd_base(lane);
#define KVT_STEP(TH, KS) do { const unsigned va_ = vbV + (TH) * 32768, vk_ = vbK + (TH) * 16384; \
        const s16x4 al_ = tr_read<v_rd_off(0, KS, 0)>(va_), ah_ = tr_read<v_rd_off(0, KS, 1)>(va_); \
        const s16x4 b0l_ = tr_read<v_rd_off(0, KS, 0)>(vk_), b0h_ = tr_read<v_rd_off(0, KS, 1)>(vk_), b1l_ = tr_read<v_rd_off(1, KS, 0)>(vk_), b1h_ = tr_read<v_rd_off(1, KS, 1)>(vk_); \
        const s16x4 b2l_ = tr_read<v_rd_off(2, KS, 0)>(vk_), b2h_ = tr_read<v_rd_off(2, KS, 1)>(vk_), b3l_ = tr_read<v_rd_off(3, KS, 0)>(vk_), b3h_ = tr_read<v_rd_off(3, KS, 1)>(vk_); \
        asm volatile("s_waitcnt lgkmcnt(0)" ::: "memory"); SBAR(); const bf16x8 a_ = PKLH(al_, ah_); \
        acc[0] = __builtin_amdgcn_mfma_f32_32x32x16_bf16(a_, PKLH(b0l_, b0h_), acc[0], 0, 0, 0); acc[1] = __builtin_amdgcn_mfma_f32_32x32x16_bf16(a_, PKLH(b1l_, b1h_), acc[1], 0, 0, 0); \
        acc[2] = __builtin_amdgcn_mfma_f32_32x32x16_bf16(a_, PKLH(b2l_, b2h_), acc[2], 0, 0, 0); acc[3] = __builtin_amdgcn_mfma_f32_32x32x16_bf16(a_, PKLH(b3l_, b3h_), acc[3], 0, 0, 0); } while (0)
    KVT_STEP(0, 0); KVT_STEP(0, 1); KVT_STEP(0, 2); KVT_STEP(0, 3); KVT_STEP(1, 0); KVT_STEP(1, 1); KVT_STEP(1, 2); KVT_STEP(1, 3);
#undef KVT_STEP
    bf16_t* ob = KVT + ((size_t)u * 256 + 32 * w) * 128 + r32;
#pragma unroll
    for (int r = 0; r < 16; ++r)
#pragma unroll
        for (int db = 0; db < 4; ++db) ob[(size_t)crow(r, hi) * 128 + 32 * db] = f2bf(acc[db][r]);
}
__device__ __forceinline__ void scan_phase(const Frame& F) {
    for (int idx = F.gi * (NWAVES * 64) + F.tid; idx < F.nb * 4 * 16384; idx += F.gs * NWAVES * 64) {
        const int bh = F.b0 * 4 + (idx >> 14), off = idx & 16383; const float gc = exp2f(128.0f * ret_lg2(bh & 3));
        unsigned* p = (unsigned*)kvt_ptr(F.ws, bh >> 2) + (size_t)bh * 64 * 16384 + off; float s0 = 0.f, s1 = 0.f;
        unsigned v[16], vn[16];
#pragma unroll
        for (int j = 0; j < 16; ++j) v[j] = __builtin_nontemporal_load(p + (size_t)j * 16384);
#pragma unroll
        for (int n0 = 0; n0 < 64; n0 += 16) {
            if (n0 + 16 < 64) {
#pragma unroll
                for (int j = 0; j < 16; ++j) vn[j] = __builtin_nontemporal_load(p + (size_t)(n0 + 16 + j) * 16384); }
#pragma unroll
            for (int j = 0; j < 16; ++j) { p[(size_t)(n0 + j) * 16384] = pk2(s0, s1); s0 = fmaf(gc, s0, __uint_as_float(v[j] << 16)); s1 = fmaf(gc, s1, __uint_as_float(v[j] & 0xffff0000u)); }
#pragma unroll
            for (int j = 0; j < 16; ++j) v[j] = vn[j];
        }
    }
}
__device__ __forceinline__ void ret_unit(const Frame& F, int u) {
    int tid = F.tid; asm volatile("" : "+v"(tid));
    const int w = F.wave, lane = tid & 63, r32 = lane & 31, hi = lane >> 5, wq = w & 3, eh = w >> 2;
    const int b = u >> 8, h = (u >> 6) & 3, n = u & 63; const size_t row0 = (size_t)b * S_ + n * 128; const float lg2 = ret_lg2(h);
    bf16_t* UA = ua_ptr(F.ws, b); const bf16_t* KVT = kvt_ptr(F.ws, b);
    LAS unsigned char* R1 = F.lds; LAS unsigned char* R2 = F.lds + 65536;
    __syncthreads();
    { bf16x8 sst_[8], kst_[4];
#pragma unroll
      for (int j = 0; j < 8; ++j) { const int c = tid + 512 * j, row = c >> 4, ch = c & 15; sst_[j] = __builtin_nontemporal_load((const bf16x8*)(KVT + ((size_t)u * 256 + row) * 128 + ch * 8)); }
#pragma unroll
      for (int j = 0; j < 4; ++j) { const int c = tid + 512 * j, row = c >> 4, ch = c & 15; kst_[j] = *(const bf16x8*)(UA + (row0 + row) * NA_ + 512 + h * 128 + ch * 8); }
#pragma unroll
      for (int j = 0; j < 8; ++j) { const int c = tid + 512 * j, row = c >> 4, ch = c & 15; *(LAS bf16x8*)(R1 + KSWZ(row, ch * 16)) = sst_[j]; }
#pragma unroll
      for (int j = 0; j < 4; ++j) { const int c = tid + 512 * j, row = c >> 4, ch = c & 15; *(LAS bf16x8*)(R2 + KSWZ(row, ch * 16)) = kst_[j]; } }
    bf16x8 qr[8];
    { const bf16_t* qp = UA + (row0 + 32 * wq + r32) * NA_ + h * 128 + hi * 8;
#pragma unroll
      for (int d0 = 0; d0 < 8; ++d0) qr[d0] = __builtin_nontemporal_load((const bf16x8*)(qp + d0 * 16)); }
    __syncthreads();
    f32x16 o[4] = {};
#pragma unroll
    for (int db = 0; db < 4; ++db) {
#pragma unroll
        for (int d0 = 0; d0 < 8; ++d0) { const bf16x8 bs = *(const LAS bf16x8*)(R1 + KSWZ(128 * eh + 32 * db + r32, (d0 * 16 + hi * 8) * 2)); o[db] = __builtin_amdgcn_mfma_f32_32x32x16_bf16(qr[d0], bs, o[db], 0, 0, 0); }
        asm volatile("" ::: "memory"); }
    const float gm1 = exp2f(lg2), gm2 = gm1 * gm1, gm4 = gm2 * gm2, gm8 = gm4 * gm4, gm16 = gm8 * gm8;
    const float gi1 = exp2f(-lg2), gi2 = gi1 * gi1, gi4 = gi2 * gi2, gi8 = gi4 * gi4, gi16 = gi8 * gi8, gi32 = gi16 * gi16;
    const float ga[4] = {1.0f, gm1, gm2, gm2 * gm1}, gb[4] = {1.0f, gm8, gm16, gm16 * gm8};
    const float ia[4] = {1.0f, gi1, gi2, gi2 * gi1}, ib[4] = {1.0f, gi8, gi16, gi16 * gi8};
    { const float xl = exp2f((float)(32 * wq + 4 * hi + 1) * lg2);
#pragma unroll
      for (int r = 0; r < 16; ++r) { const float xi = xl * (ga[r & 3] * gb[r >> 2]);
#pragma unroll
          for (int db = 0; db < 4; ++db) o[db][r] *= xi; } }
    bf16x8 pa[2][4]; const int cq = 32 * wq + r32;
#define RET_P(ST) do { f32x16 p0, p1; qkt(p0, p1, R2 + (ST) * 16384, qr, r32, hi); const int limq_ = cq - 64 * (ST) - 4 * hi; const float al_ = exp2f((float)limq_ * lg2); \
        _Pragma("unroll") for (int r = 0; r < 16; ++r) { const int cr_ = (r & 3) + 8 * (r >> 2); const float f_ = al_ * (ia[r & 3] * ib[r >> 2]); \
            p0[r] = cr_ <= limq_ ? p0[r] * f_ : 0.f; p1[r] = cr_ + 32 <= limq_ ? p1[r] * (f_ * gi32) : 0.f; } \
        PK4(p0, 0, pa[ST][0]); PK4(p0, 8, pa[ST][1]); PK4(p1, 0, pa[ST][2]); PK4(p1, 8, pa[ST][3]); } while (0)
    RET_P(0);
    if (wq >= 2) RET_P(1);
#undef RET_P
    __syncthreads();
    { bf16x8 vst_[8];
#pragma unroll
      for (int j = 0; j < 8; ++j) { const int c = tid + 512 * j, row = c >> 5, col = (c & 31) * 8; vst_[j] = *(const bf16x8*)(UA + (row0 + row) * NA_ + 1024 + h * 256 + col); }
#pragma unroll
      for (int j = 0; j < 8; ++j) { const int c = tid + 512 * j, row = c >> 5, col = (c & 31) * 8; *(LAS bf16x8*)(R1 + ((row >> 6) * 2 + (col >> 7)) * 16384 + v_st(row & 63, col & 127)) = vst_[j]; } }
    __syncthreads();
    const unsigned vb = lds_addr(R1) + v_rd_base(lane) + eh * 16384;
    pv_d0(o, vb, pa[0][0], pa[0][1], pa[0][2], pa[0][3]);
    if (wq >= 2) pv_d0(o, vb + 32768, pa[1][0], pa[1][1], pa[1][2], pa[1][3]);
    LAS float* ssq = (LAS float*)(F.lds + WSCR_OFF);
    float qs[16];
#pragma unroll
    for (int r = 0; r < 16; ++r) { float q = (o[0][r] * o[0][r] + o[1][r] * o[1][r]) + (o[2][r] * o[2][r] + o[3][r] * o[3][r]);
        q += __shfl_xor(q, 1); q += __shfl_xor(q, 2); q += __shfl_xor(q, 4); q += __shfl_xor(q, 8); q += __shfl_xor(q, 16); qs[r] = q;
        if (r32 == 0) ssq[w * 32 + crow(r, hi)] = q; }
    __syncthreads();
    { float rn[16];
#pragma unroll
      for (int r = 0; r < 16; ++r) rn[r] = 1.0f / sqrtf((qs[r] + ssq[(w ^ 4) * 32 + crow(r, hi)]) * (1.0f / 256) + EPS_);
      bf16_t* gbase = UA + (row0 + 32 * wq) * NA_ + 2048 + h * 256 + 128 * eh;
      const int rr = lane >> 4, ch = lane & 15;
      bf16x8 greg[8];
#pragma unroll
      for (int j = 0; j < 8; ++j) greg[j] = __builtin_nontemporal_load((const bf16x8*)(gbase + (size_t)(16 * (j >> 2) + 4 * (j & 3) + rr) * NA_ + ch * 8));
      LAS unsigned char* stg = F.lds + 98304 + w * 4096;
      o_half_stage<0>(o, rn, stg, r32, hi); LDS_WAIT();
#pragma unroll
      for (int ps = 0; ps < 4; ++ps) { const int row = 4 * ps + rr; *(bf16x8*)(gbase + (size_t)row * NA_ + ch * 8) = mul8_bf16(*(const LAS bf16x8*)(stg + row * 256 + ch * 16), greg[ps]); }
      LDS_WAIT();
      o_half_stage<1>(o, rn, stg, r32, hi); LDS_WAIT();
#pragma unroll
      for (int ps = 0; ps < 4; ++ps) { const int row = 4 * ps + rr; *(bf16x8*)(gbase + (size_t)(16 + row) * NA_ + ch * 8) = mul8_bf16(*(const LAS bf16x8*)(stg + row * 256 + ch * 16), greg[4 + ps]); } }
    LDS_WAIT();
}
#ifndef PG8_SP2
#define PG8_SP2 true
#endif
#ifndef PG8_ALIGN
#define PG8_ALIGN true
#endif
#define RET_UNIT(i) (i)
__device__ __forceinline__ void phase1(const Frame& F) {
    const size_t rb = (size_t)F.b0 * S_;
    pg8::Gemm g{(const bf16_t*)x1b_ptr(F.ws, F.b0) + rb * D_, (const bf16_t*)(F.ws + WS_WINA), F.nb * S_, NA_, D_, D_}; pg8::StaticOrder S; S.init(F.nb * S_, NA_, F.gs, F.gi);
    pg8::EpiA E{ua_ptr(F.ws, F.b0) + rb * NA_, (const float*)(F.ws + WS_RS0) + rb, (const int*)F.in[2] + rb};
    pg8::gemm_phase<pg8::EpiA, pg8::StaticOrder, PG8_ALIGN, PG8_SP2>(F.lds, g, S, E);
}
__device__ __forceinline__ void late_publish(const Frame& F) {
    asm volatile("s_waitcnt vmcnt(0)" ::: "memory"); __syncthreads();
    if (F.tid == 0) { __builtin_amdgcn_fence(__ATOMIC_RELEASE, "agent"); asm volatile("s_waitcnt vmcnt(0)" ::: "memory");
        __hip_atomic_fetch_add((unsigned*)(F.ws + WS_CTL) + CW_LATE, 1u, __ATOMIC_RELAXED, __HIP_MEMORY_SCOPE_AGENT); }
}
__device__ __forceinline__ void late_poll(const Frame& F) {
    if (F.tid == 0) { unsigned* c = (unsigned*)(F.ws + WS_CTL) + CW_LATE; unsigned sp = 0;
        while (__hip_atomic_load(c, __ATOMIC_RELAXED, __HIP_MEMORY_SCOPE_AGENT) < (unsigned)F.G) { __builtin_amdgcn_s_sleep(2); if (++sp > (1u << 22)) break; } }
}
__device__ __forceinline__ void phase2(const Frame& F) {
    for (int i = F.gi; i < F.nb * 256; i += F.gs) kvt_unit(F, RET_UNIT(F.b0 * 256 + i));
    for (int u = F.gi; u < F.nb * 128; u += F.gs) memattn_unit(F, ua_ptr(F.ws, (F.b0 * 128 + u) >> 7), NA_, 3072, 3584, 0, F.b0 * 128 + u);
}
__device__ __forceinline__ void phase4(const Frame& F) { for (int i = F.gi; i < F.nb * 256; i += F.gs) ret_unit(F, RET_UNIT(F.b0 * 256 + i)); }
__device__ __forceinline__ void phase5(const Frame& F) {
    const size_t rb = (size_t)F.b0 * S_;
    pg8::Gemm g{(const bf16_t*)ua_ptr(F.ws, F.b0) + rb * NA_ + 2048, (const bf16_t*)(F.ws + WS_WOUTA), F.nb * S_, D_, KO_, NA_}; pg8::StaticOrder S; S.init(F.nb * S_, D_, F.gs, F.gi);
    pg8::EpiOutA E{F.in[0] + rb * D_, F.out + rb * D_, x1b_ptr(F.ws, F.b0) + rb * D_, (float*)(F.ws + WS_SS1P) + rb * 16};
    pg8::gemm_phase<pg8::EpiOutA, pg8::StaticOrder, PG8_ALIGN, PG8_SP2>(F.lds, g, S, E);
}
__device__ __forceinline__ void phase6(const Frame& F) {
    const size_t rb = (size_t)F.b0 * S_;
    pg8::Gemm g{(const bf16_t*)x1b_ptr(F.ws, F.b0) + rb * D_, (const bf16_t*)(F.ws + WS_WB), F.nb * S_, NBW_, D_, D_}; pg8::StaticOrder S; S.init(F.nb * S_, NBW_, F.gs, F.gi);
    pg8::EpiB E{ub_ptr(F.ws, F.b0) + rb * NBW_, (const float*)(F.ws + WS_SS1P) + rb * 16};
    pg8::gemm_phase<pg8::EpiB, pg8::StaticOrder, PG8_ALIGN, PG8_SP2>(F.lds, g, S, E);
}
__device__ __forceinline__ void phase7(const Frame& F) {
    for (int u = F.gi; u < F.nb * 256; u += F.gs) { const int U = F.b0 * 256 + u; sb_unit(F, U >> 8, (U >> 6) & 3, U & 63); }
    for (int u = F.gi; u < F.nb * 128; u += F.gs) memattn_unit(F, ub_ptr(F.ws, (F.b0 * 128 + u) >> 7), NBW_, 4096, 4608, 1, F.b0 * 128 + u);
}
__device__ __forceinline__ void phase8(const Frame& F) {
    const size_t rb = (size_t)F.b0 * S_;
    pg8::Gemm g{(const bf16_t*)ub_ptr(F.ws, F.b0) + rb * NBW_ + 3072, (const bf16_t*)(F.ws + WS_WOUTB), F.nb * S_, D_, KO_, NBW_}; pg8::StaticOrder S; S.init(F.nb * S_, D_, F.gs, F.gi);
    pg8::EpiOutB E{F.out + rb * D_, (const bf16_t*)x1b_ptr(F.ws, F.b0) + rb * D_};
    pg8::gemm_phase<pg8::EpiOutB, pg8::StaticOrder, PG8_ALIGN, PG8_SP2>(F.lds, g, S, E);
}

__global__ void __launch_bounds__(NWAVES * 64, 2) mega(MArgs args) {
    extern __shared__ __attribute__((aligned(16))) unsigned char lds_raw[];
    Frame F;
    F.lds = (LAS unsigned char*)lds_raw; F.tid = threadIdx.x; F.lane = F.tid & 63; F.wave = __builtin_amdgcn_readfirstlane(F.tid >> 6); F.G = gridDim.x; F.bid = blockIdx.x;
    if (NGRP == 2 && (F.G & 15) == 0) { F.grp = (F.bid >> 3) & 1; F.gi = (F.bid & 7) + 8 * (F.bid >> 4); F.gs = F.G >> 1; F.b0 = F.grp; F.nb = 1; }
    else { F.grp = 0; F.gi = F.bid; F.gs = F.G; F.b0 = 0; F.nb = 2; }
#pragma unroll
    for (int i = 0; i < 16; ++i) F.in[i] = args.in[i];
    F.out = args.out; F.ws = args.ws;
    for (int u = F.tid; u < (LDS_BYTES - LDSCTL_OFF) / 4; u += NWAVES * 64) ((LAS unsigned*)(F.lds + LDSCTL_OFF))[u] = 0u;
    __syncthreads();
    unsigned* ctl = (unsigned*)(F.ws + WS_CTL);
    volatile LAS unsigned* lw = (volatile LAS unsigned*)(F.lds + LDSCTL_OFF);
    XcdBarrier barG = xcd_barrier_post(ctl + CW_BAR, lw + 8, (unsigned)F.G);
    XcdBarrier bar = xcd_barrier_post(ctl + CW_BAR + (1 + F.grp) * XCD_BAR_WORDS, lw + 12, (unsigned)F.gs);
#define PHB(call) do { call; xcd_barrier(bar); } while (0)
    p0_prologue(F); xcd_barrier(barG);
    if (NGRP == 2 && F.nb == 1) { p0_late_weights(F); late_publish(F);
    }
    PHB(phase1(F));
    PHB(phase2(F));
    PHB(scan_phase(F));
    phase4(F); if (NGRP == 2) late_poll(F); xcd_barrier(bar);
    PHB(phase5(F));
    PHB(phase6(F));
    PHB(phase7(F));
    phase8(F);
#undef PHB
}

extern "C" void kernel_launch(void* const* d_in, const int* in_sizes, int n_in, void* d_out, int out_size, void* d_ws, size_t ws_size, hipStream_t stream) {
    static int grid = 0;
    if (grid == 0) {
        int dev = 0, cus = 0;
        if (hipGetDevice(&dev) != hipSuccess || hipDeviceGetAttribute(&cus, hipDeviceAttributeMultiprocessorCount, dev) != hipSuccess) { grid = -1; return; }
        if (hipFuncSetAttribute((const void*)mega, hipFuncAttributeMaxDynamicSharedMemorySize, LDS_BYTES) != hipSuccess) { grid = -1; return; }
        (void)hipGetLastError();
        grid = (cus / 16) * 16;
        if (grid == 0) { grid = -1; return; }
    }
    if (grid < 0) return;
    unsigned char* ws = (unsigned char*)d_ws;
    (void)hipMemsetAsync(ws + WS_CTL, 0, CTL_ZERO_BYTES, stream);
    MArgs a{};
    for (int i = 0; i < 16; ++i) a.in[i] = (const float*)d_in[i];
    a.out = (float*)d_out; a.ws = ws; a.ph_lo = 0; a.ph_hi = 9; a.li = 0; a.pad = 0;
    hipLaunchKernelGGL(mega, dim3(grid), dim3(NWAVES * 64), LDS_BYTES, stream, a);
}
```

```cpp
#include <hip/hip_runtime.h>
#include <stdint.h>

typedef unsigned short bf16_t;

constexpr int NB_ = 2, S_ = 8192, T_ = NB_ * S_, D_ = 1024;
constexpr int NA_ = 4096, NBW_ = 5120, KO_ = 1536;
constexpr float EPS_ = 1e-6f;
constexpr float QK_SCALE = 0.08838834764831845f;

constexpr size_t MiB = 1u << 20;
constexpr size_t WS_CTL = 0;
constexpr size_t WS_WINA = 1 * MiB;
constexpr size_t WS_WOUTA = 9 * MiB;
constexpr size_t WS_WB = 12 * MiB;
constexpr size_t WS_WOUTB = 22 * MiB;
constexpr size_t WS_MEMK = 25 * MiB;
constexpr size_t WS_MEMV = 26 * MiB;
constexpr size_t WS_RS0 = 27 * MiB;
constexpr size_t WS_SS1P = 28 * MiB;
#ifndef NGRP
#define NGRP 2
#endif
#if NGRP == 2
constexpr size_t WS_BSTRIDE = 96 * MiB;
constexpr size_t WS_UA = 30 * MiB, WS_UA_STRIDE = WS_BSTRIDE, WS_UB = 30 * MiB, WS_UB_STRIDE = WS_BSTRIDE, WS_KVT = 94 * MiB, WS_KVT_STRIDE = WS_BSTRIDE, WS_X1B = 110 * MiB, WS_X1B_STRIDE = WS_BSTRIDE;
#else
constexpr size_t WS_UA = 30 * MiB, WS_UA_STRIDE = 64 * MiB, WS_UB = 30 * MiB, WS_UB_STRIDE = 80 * MiB, WS_KVT = 158 * MiB, WS_KVT_STRIDE = 16 * MiB, WS_X1B = 190 * MiB, WS_X1B_STRIDE = 16 * MiB;
#endif
__device__ __forceinline__ bf16_t* ua_ptr(unsigned char* ws, int b) { return (bf16_t*)(ws + WS_UA + (size_t)b * WS_UA_STRIDE) - (size_t)b * S_ * NA_; }
__device__ __forceinline__ bf16_t* ub_ptr(unsigned char* ws, int b) { return (bf16_t*)(ws + WS_UB + (size_t)b * WS_UB_STRIDE) - (size_t)b * S_ * NBW_; }
__device__ __forceinline__ bf16_t* kvt_ptr(unsigned char* ws, int b) { return (bf16_t*)(ws + WS_KVT + (size_t)b * WS_KVT_STRIDE) - (size_t)b * 256 * 32768; }
__device__ __forceinline__ bf16_t* x1b_ptr(unsigned char* ws, int b) { return (bf16_t*)(ws + WS_X1B + (size_t)b * WS_X1B_STRIDE) - (size_t)b * S_ * D_; }


__device__ __forceinline__ float bf2f(bf16_t v) { return __uint_as_float(((unsigned)v) << 16); }
__device__ __forceinline__ bf16_t f2bf(float f) { unsigned u = __float_as_uint(f); u += 0x7fffu + ((u >> 16) & 1u); return (bf16_t)(u >> 16); }

__device__ __forceinline__ void rot_sincos(float ang, float& s, float& c) {
    const float n = rintf(ang * 0.15915494309189535f);
    float r = fmaf(-n, 6.28318548202514648f, ang);
    r = fmaf(-n, -1.74845553e-7f, r);
    const float rev = r * 0.15915494309189535f;
    s = __builtin_amdgcn_sinf(rev); c = __builtin_amdgcn_cosf(rev);
}
__device__ __forceinline__ float rope_inv_freq(int i) { return exp2f(-(float)i * 0.20762050593046014f); }

__device__ __forceinline__ int permA_src(int n) {
    if (n >= 1024) return n;
    const int tile = n >> 8, c = n & 255, bj = c >> 7, p = c & 127, hit = p >> 6, i = p & 63;
    return tile * 256 + hit * 128 + bj * 64 + i;
}

namespace pg8 {
#define PG8_LAS __attribute__((address_space(3)))
typedef unsigned short bf16_t;
typedef short bf16x8 __attribute__((ext_vector_type(8)));
typedef float f32x4 __attribute__((ext_vector_type(4)));
typedef unsigned u32x4 __attribute__((ext_vector_type(4)));
constexpr int BM = 256, BK = 64, HALF = 128, HTB = HALF * BK * 2  , STAGE_BYTES = 8 * HTB, NXCD = 8, WGM = 4;

__host__ __device__ __forceinline__ int lds_byte(int r, int c) { const int st = (r >> 4) * 2 + (c >> 5), rr = r & 15, cc = c & 31, ob = rr * 64 + cc * 2; return st * 1024 + (ob ^ (((ob >> 9) & 1) << 5)); }
__host__ __device__ __forceinline__ void stage_rc(int b, int& R, int& C) { const int st = b / 1024, sb = b % 1024, swz = sb ^ (((sb >> 9) & 1) << 5); R = (st >> 1) * 16 + swz / 64; C = (st & 1) * 32 + (swz % 64) / 2; }
__host__ __device__ __forceinline__ int perm32(int rho) { const int n = rho >> 4, i = rho & 15; return 8 * (i >> 2) + 4 * n + (i & 3); }

struct Unit { int pm, pn; };
struct Gemm { const bf16_t* A; const bf16_t* Bt; int M, N, K, lda; };

struct StaticOrder {
    int nM, nN, nwg, G, c;
    __host__ __device__ void init(int M, int N, int G_, int c_) { nM = M / BM; nN = N / BM; nwg = nM * nN; G = G_; c = c_; }
    __host__ __device__ bool next(int i, Unit& u) const {
        const long L = (long)i * G + c; if (L >= nwg) return false;
        int wgid = (int)L; { const int q = nwg / NXCD, r = nwg % NXCD, xcd = wgid % NXCD, off = wgid / NXCD; wgid = (xcd < r ? xcd * (q + 1) : r * (q + 1) + (xcd - r) * q) + off; }
        const int nig = WGM * nN, gid = wgid / nig, fm = gid * WGM, gsz = (nM - fm) < WGM ? (nM - fm) : WGM;
        u.pm = fm + ((wgid % nig) % gsz); u.pn = (wgid % nig) / gsz; return true;
    }
    __device__ __forceinline__ void a_ready(const Unit&) const {}
    __device__ __forceinline__ void done(const Unit&) const {}
};

typedef __bf16 bf16x2_hw __attribute__((ext_vector_type(2)));
typedef float f32x2_hw __attribute__((ext_vector_type(2)));
__device__ __forceinline__ unsigned cvt_pk_bf16_safe(float lo, float hi) { const f32x2_hw v = {lo, hi}; return __builtin_bit_cast(unsigned, __builtin_convertvector(v, bf16x2_hw)); }
__device__ __forceinline__ unsigned cvt_pk_bf16(float lo, float hi) { unsigned r; asm volatile("v_cvt_pk_bf16_f32 %0, %1, %2" : "=v"(r) : "v"(lo), "v"(hi)); return r; }
__device__ __forceinline__ float silu_fast(float v) { return v * __builtin_amdgcn_rcpf(1.0f + __builtin_amdgcn_exp2f(-1.4426950408889634f * v)); }
__device__ __forceinline__ u32x4 pack8_safe(const f32x4 a, const f32x4 b) { u32x4 w; w.x = cvt_pk_bf16_safe(a[0], a[1]); w.y = cvt_pk_bf16_safe(a[2], a[3]); w.z = cvt_pk_bf16_safe(b[0], b[1]); w.w = cvt_pk_bf16_safe(b[2], b[3]); return w; }
__device__ __forceinline__ u32x4 pack8(const f32x4 a, const f32x4 b) { u32x4 w; w.x = cvt_pk_bf16(a[0], a[1]); w.y = cvt_pk_bf16(a[2], a[3]); w.z = cvt_pk_bf16(b[0], b[1]); w.w = cvt_pk_bf16(b[2], b[3]); return w; }

struct EpiA {
    static constexpr bool PERM = true, AFTER_DRAIN = false, ACC_INIT = false, RELAX_STORES = true, ROWTAB = true;
    bf16_t* U; const float* rs0; const int* pos;
    __device__ __forceinline__ void fill_rows(PG8_LAS float* tab, int pm, int tid) const { if (tid < BM) { const int row = pm * BM + tid; tab[tid] = rs0[row]; tab[BM + tid] = (float)pos[row]; } }
    __device__ __forceinline__ void operator()(const f32x4 (&acc)[2][2][4][2], const Unit& u, int wr, int wc, int fr, int fq, const PG8_LAS float* tab) const {
        const int row0 = u.pm * BM + wr * 64 + fr;
        float rsv[8], pfv[8];
        if (tab) {
#pragma unroll
            for (int i = 0; i < 8; ++i) { const int r = wr * 64 + fr + (i >> 2) * HALF + (i & 3) * 16; rsv[i] = tab[r]; pfv[i] = tab[BM + r]; }
        } else {
#pragma unroll
        for (int i = 0; i < 8; ++i) { const int row = row0 + (i >> 2) * HALF + (i & 3) * 16; rsv[i] = rs0[row]; pfv[i] = (float)pos[row]; }
        asm volatile("" : "+v"(rsv[0]), "+v"(rsv[1]), "+v"(rsv[2]), "+v"(rsv[3]), "+v"(rsv[4]), "+v"(rsv[5]), "+v"(rsv[6]), "+v"(rsv[7]));
        asm volatile("s_waitcnt vmcnt(0)" : "+v"(pfv[0]), "+v"(pfv[1]), "+v"(pfv[2]), "+v"(pfv[3]), "+v"(pfv[4]), "+v"(pfv[5]), "+v"(pfv[6]), "+v"(pfv[7]));
        }
        if (u.pn < 4) {
            const int hit = wc >> 1, i0 = 32 * (wc & 1) + 8 * fq; const float sc = u.pn >= 2 ? QK_SCALE : 1.0f;
            float inv[8];
#pragma unroll
            for (int j = 0; j < 8; ++j) inv[j] = rope_inv_freq(i0 + j);
#pragma unroll
            for (int ai = 0; ai < 2; ++ai)
#pragma unroll
                for (int m = 0; m < 4; ++m) { const int row = row0 + ai * HALF + m * 16; const float rs = rsv[ai * 4 + m] * sc, pf = pfv[ai * 4 + m];
                    bf16_t* up = U + (size_t)row * NA_ + u.pn * BM + hit * 128 + i0;
                    f32x4 o1[2], o2[2];
#pragma unroll
                    for (int n = 0; n < 2; ++n)
#pragma unroll
                        for (int e = 0; e < 4; ++e) { float sn, cs; rot_sincos(pf * inv[4 * n + e], sn, cs); const float x1 = acc[ai][0][m][n][e] * rs, x2 = acc[ai][1][m][n][e] * rs;
                            o1[n][e] = x1 * cs - x2 * sn; o2[n][e] = x1 * sn + x2 * cs; }
                    *(u32x4*)up = pack8(o1[0], o1[1]); *(u32x4*)(up + 64) = pack8(o2[0], o2[1]); }
        } else {
            const bool silu = (u.pn >= 8 && u.pn < 12) || u.pn >= 14;
#pragma unroll
            for (int ai = 0; ai < 2; ++ai)
#pragma unroll
                for (int m = 0; m < 4; ++m) { const int row = row0 + ai * HALF + m * 16; const float rs = rsv[ai * 4 + m]; bf16_t* rowp = U + (size_t)row * NA_ + u.pn * BM + wc * 32 + 8 * fq;
#pragma unroll
                    for (int bj = 0; bj < 2; ++bj) { f32x4 v0 = acc[ai][bj][m][0] * rs, v1 = acc[ai][bj][m][1] * rs;
                        if (silu) {
#pragma unroll
                            for (int e = 0; e < 4; ++e) { v0[e] = silu_fast(v0[e]); v1[e] = silu_fast(v1[e]); } }
                        *(u32x4*)(rowp + bj * HALF) = pack8(v0, v1); } }
        }
    }
};
struct EpiOutA {
    static constexpr bool PERM = true, AFTER_DRAIN = false, ACC_INIT = true, RELAX_STORES = false, ROWTAB = false;
    const float* xres; float* out; bf16_t* x1b; float* ss1p;
    __device__ __forceinline__ void init(f32x4 (&acc)[2][2][4][2], const Unit& u, int wr, int wc, int fr, int fq) const {
        const int row0 = u.pm * BM + wr * 64 + fr;
#pragma unroll
        for (int ai = 0; ai < 2; ++ai)
#pragma unroll
            for (int m = 0; m < 4; ++m) { const size_t off = (size_t)(row0 + ai * HALF + m * 16) * D_ + u.pn * BM + wc * 32 + 8 * fq;
#pragma unroll
                for (int bj = 0; bj < 2; ++bj) { const u32x4 w = __builtin_nontemporal_load((const u32x4*)(x1b + off + bj * HALF));
                    acc[ai][bj][m][0] = (f32x4){__uint_as_float(w.x << 16), __uint_as_float(w.x & 0xffff0000u), __uint_as_float(w.y << 16), __uint_as_float(w.y & 0xffff0000u)};
                    acc[ai][bj][m][1] = (f32x4){__uint_as_float(w.z << 16), __uint_as_float(w.z & 0xffff0000u), __uint_as_float(w.w << 16), __uint_as_float(w.w & 0xffff0000u)}; } }
    }
    __device__ __forceinline__ void operator()(const f32x4 (&acc)[2][2][4][2], const Unit& u, int wr, int wc, int fr, int fq) const {
        const int row0 = u.pm * BM + wr * 64 + fr;
#pragma unroll
        for (int ai = 0; ai < 2; ++ai)
#pragma unroll
            for (int m = 0; m < 4; ++m) { const int row = row0 + ai * HALF + m * 16; const size_t off = (size_t)row * D_ + u.pn * BM + wc * 32 + 8 * fq; float ssq = 0.f;
#pragma unroll
                for (int bj = 0; bj < 2; ++bj) { const f32x4 v0 = acc[ai][bj][m][0], v1 = acc[ai][bj][m][1];
                    *(u32x4*)(x1b + off + bj * HALF) = pack8_safe(v0, v1);
                    ssq += (v0[0] * v0[0] + v0[1] * v0[1]) + (v0[2] * v0[2] + v0[3] * v0[3]) + (v1[0] * v1[0] + v1[1] * v1[1]) + (v1[2] * v1[2] + v1[3] * v1[3]); }
                ssq += __shfl_xor(ssq, 16); ssq += __shfl_xor(ssq, 32);
                if (fq == 0) ss1p[(size_t)row * 16 + u.pn * 4 + wc] = ssq; }
    }
};
struct EpiB {
    static constexpr bool PERM = true, AFTER_DRAIN = false, ACC_INIT = false, RELAX_STORES = true, ROWTAB = true;
    bf16_t* U; const float* ss1p;
    __device__ __forceinline__ void fill_rows(PG8_LAS float* tab, int pm, int tid) const {
        const float* pp = ss1p + (size_t)(pm * BM + (tid >> 1)) * 16 + 8 * (tid & 1); const f32x4 a = *(const f32x4*)pp, b = *(const f32x4*)(pp + 4);
        float s = ((a[0] + a[1]) + (a[2] + a[3])) + ((b[0] + b[1]) + (b[2] + b[3])); s += __shfl_xor(s, 1);
        if ((tid & 1) == 0) tab[tid >> 1] = 1.0f / sqrtf(s * (1.0f / D_) + EPS_);
    }
    __device__ __forceinline__ void operator()(const f32x4 (&acc)[2][2][4][2], const Unit& u, int wr, int wc, int fr, int fq, const PG8_LAS float* tab) const {
        const int row0 = u.pm * BM + wr * 64 + fr; const bool silu = (u.pn >= 8 && u.pn < 12) || u.pn >= 18; const float sc = (u.pn >= 12 && u.pn < 16) ? QK_SCALE * 1.4426950408889634f : 1.0f;
        float rsv[8];
        if (tab) {
#pragma unroll
            for (int i = 0; i < 8; ++i) rsv[i] = tab[wr * 64 + fr + (i >> 2) * HALF + (i & 3) * 16];
        } else {
            f32x4 pv[8];
#pragma unroll
            for (int i = 0; i < 8; ++i) pv[i] = *(const f32x4*)(ss1p + (size_t)(row0 + (i >> 2) * HALF + (i & 3) * 16) * 16 + 4 * fq);
            asm volatile("s_waitcnt vmcnt(0)" : "+v"(pv[0]), "+v"(pv[1]), "+v"(pv[2]), "+v"(pv[3]), "+v"(pv[4]), "+v"(pv[5]), "+v"(pv[6]), "+v"(pv[7]));
#pragma unroll
            for (int i = 0; i < 8; ++i) { float s = (pv[i][0] + pv[i][1]) + (pv[i][2] + pv[i][3]); s += __shfl_xor(s, 16); s += __shfl_xor(s, 32); rsv[i] = 1.0f / sqrtf(s * (1.0f / D_) + EPS_); }
        }
#pragma unroll
        for (int ai = 0; ai < 2; ++ai)
#pragma unroll
            for (int m = 0; m < 4; ++m) { const int row = row0 + ai * HALF + m * 16;
                const float rs = sc * rsv[ai * 4 + m]; bf16_t* rowp = U + (size_t)row * NBW_ + u.pn * BM + wc * 32 + 8 * fq;
#pragma unroll
                for (int bj = 0; bj < 2; ++bj) { f32x4 v0 = acc[ai][bj][m][0] * rs, v1 = acc[ai][bj][m][1] * rs;
                    if (silu) {
#pragma unroll
                        for (int e = 0; e < 4; ++e) { v0[e] = silu_fast(v0[e]); v1[e] = silu_fast(v1[e]); } }
                    *(u32x4*)(rowp + bj * HALF) = pack8(v0, v1); } }
    }
};
struct EpiOutB {
    static constexpr bool PERM = false, AFTER_DRAIN = false, ACC_INIT = true, RELAX_STORES = false, ROWTAB = false;
    float* out; const bf16_t* x1b;
    __device__ __forceinline__ void init(f32x4 (&acc)[2][2][4][2], const Unit& u, int wr, int wc, int fr, int fq) const {
        const int row0 = u.pm * BM + wr * 64 + fr;
#pragma unroll
        for (int ai = 0; ai < 2; ++ai)
#pragma unroll
            for (int m = 0; m < 4; ++m) { const size_t off = (size_t)(row0 + ai * HALF + m * 16) * D_ + u.pn * BM + wc * 32 + 4 * fq;
#pragma unroll
                for (int bj = 0; bj < 2; ++bj)
#pragma unroll
                    for (int n = 0; n < 2; ++n) { const unsigned long long w = __builtin_nontemporal_load((const unsigned long long*)(x1b + off + bj * HALF + n * 16)); const unsigned lo = (unsigned)w, hi = (unsigned)(w >> 32);
                        acc[ai][bj][m][n] = (f32x4){__uint_as_float(lo << 16), __uint_as_float(lo & 0xffff0000u), __uint_as_float(hi << 16), __uint_as_float(hi & 0xffff0000u)}; } }
    }
    __device__ __forceinline__ void operator()(const f32x4 (&acc)[2][2][4][2], const Unit& u, int wr, int wc, int fr, int fq) const {
        const int row0 = u.pm * BM + wr * 64 + fr;
#pragma unroll
        for (int ai = 0; ai < 2; ++ai)
#pragma unroll
            for (int m = 0; m < 4; ++m) { const size_t off = (size_t)(row0 + ai * HALF + m * 16) * D_ + u.pn * BM + wc * 32 + 4 * fq;
#pragma unroll
                for (int bj = 0; bj < 2; ++bj)
#pragma unroll
                    for (int n = 0; n < 2; ++n) *(f32x4*)(out + off + bj * HALF + n * 16) = acc[ai][bj][m][n]; }
    }
};

struct EpiNull {
    static constexpr bool PERM = true, AFTER_DRAIN = false, ACC_INIT = false, RELAX_STORES = false, ROWTAB = false;
    float* sink;
    __device__ __forceinline__ void operator()(const f32x4 (&acc)[2][2][4][2], const Unit& u, int wr, int wc, int fr, int fq) const {
        f32x4 s = (f32x4){0.f, 0.f, 0.f, 0.f};
#pragma unroll
        for (int ai = 0; ai < 2; ++ai)
#pragma unroll
            for (int bj = 0; bj < 2; ++bj)
#pragma unroll
                for (int m = 0; m < 4; ++m) s += acc[ai][bj][m][0] + acc[ai][bj][m][1];
        const float t = (s[0] + s[1]) + (s[2] + s[3]);
        if (t == 1.2345678e33f) sink[0] = t;
    }
};
template <class Epi, class Sched, bool ALIGN_EPI = false, bool SP2 = false>
__device__ __forceinline__ void gemm_phase(PG8_LAS unsigned char* lds, const Gemm g, const Sched& S, const Epi& E) {
    int tid = threadIdx.x; asm volatile("" : "+v"(tid));
    const int wid = __builtin_amdgcn_readfirstlane(tid >> 6), lane = tid & 63, wr = wid >> 2, wc = wid & 3, fr = lane & 15, fq = lane >> 4;
    const int K = g.K, nt = K / BK;
    unsigned voffA[2], voffB[2];
#pragma unroll
    for (int i = 0; i < 2; ++i) { int R, C; stage_rc(tid * 16 + i * 8192, R, C); const int Rb = Epi::PERM ? ((R & ~31) + perm32(R & 31)) : R;
        voffA[i] = (unsigned)(R * g.lda + C) * 2u; voffB[i] = (unsigned)(Rb * K + C) * 2u; }
    const size_t kstep = (size_t)(BK * 2);
    const size_t hstepA = (size_t)HALF * g.lda * 2, hstepB = (size_t)HALF * K * 2;
    const size_t tstepA = 2 * hstepA, tstepB = 2 * hstepB;
    const unsigned ldsw = (unsigned)wid * 1024u;
    const int aoff = lds_byte(wr * 64 + fr, fq * 8), boff = lds_byte(wc * 32 + fr, fq * 8);
#define PG8_SA(b, h) (((b) * 2 + (h)) * HTB)
#define PG8_SB(b, h) ((4 + (b) * 2 + (h)) * HTB)
#define PG8_STAGE(bufoff, gbase, voff) do { _Pragma("unroll") for (int _i = 0; _i < 2; ++_i) \
        __builtin_amdgcn_global_load_lds((const unsigned*)((const char*)(gbase) + (voff)[_i]), (PG8_LAS unsigned*)(lds + (bufoff) + ldsw + _i * 8192), 16, 0, 0); } while (0)
#define PG8_LDA(dst, b, h) do { _Pragma("unroll") for (int m = 0; m < 4; ++m) _Pragma("unroll") for (int k = 0; k < 2; ++k) dst[m][k] = *(const PG8_LAS bf16x8*)(lds + PG8_SA(b, h) + aoff + m * 2048 + k * 1024); } while (0)
#define PG8_LDB(dst, b, h) do { _Pragma("unroll") for (int n = 0; n < 2; ++n) _Pragma("unroll") for (int k = 0; k < 2; ++k) dst[n][k] = *(const PG8_LAS bf16x8*)(lds + PG8_SB(b, h) + boff + n * 2048 + k * 1024); } while (0)
#define PG8_MMA(ai, bj, At, Bt) do { __builtin_amdgcn_s_setprio(1); _Pragma("unroll") for (int m = 0; m < 4; ++m) _Pragma("unroll") for (int n = 0; n < 2; ++n) _Pragma("unroll") for (int k = 0; k < 2; ++k) \
        acc[ai][bj][m][n] = __builtin_amdgcn_mfma_f32_16x16x32_bf16(Bt[n][k], At[m][k], acc[ai][bj][m][n], 0, 0, 0); __builtin_amdgcn_s_setprio(0); } while (0)
#define PG8_WAIT_V(n) asm volatile("s_waitcnt vmcnt(" #n ")" ::: "memory")
#define PG8_WAIT_V_RELAX(flag) asm volatile("s_cmp_eq_u32 %0, 0\n\ts_cbranch_scc1 .Lw8_%=\n\ts_waitcnt vmcnt(24)\n\ts_branch .Lwd_%=\n.Lw8_%=:\n\ts_waitcnt vmcnt(8)\n.Lwd_%=:" :: "s"(flag) : "memory", "scc")
#define PG8_WAIT_L(n) asm volatile("s_waitcnt lgkmcnt(" #n ")" ::: "memory")
#define PG8_BAR __builtin_amdgcn_s_barrier()
#define PG8_SCHED __builtin_amdgcn_sched_barrier(0)
    Unit cur, nxt; int ui = 0;
    if (!S.next(0, cur)) return;
    PG8_LAS float* rtab = (PG8_LAS float*)(lds + STAGE_BYTES); int tab_pm = -1;
    if constexpr (Epi::ROWTAB) { E.fill_rows(rtab, cur.pm, tid); tab_pm = cur.pm; __syncthreads(); }
    f32x4 acc[2][2][4][2];
#pragma unroll
    for (int a = 0; a < 2; ++a)
#pragma unroll
        for (int b = 0; b < 2; ++b)
#pragma unroll
            for (int m = 0; m < 4; ++m)
#pragma unroll
                for (int n = 0; n < 2; ++n) acc[a][b][m][n] = (f32x4){0.f, 0.f, 0.f, 0.f};
    if constexpr (Epi::ACC_INIT) E.init(acc, cur, wr, wc, fr, fq);
    bf16x8 At[4][2], B0[2][2], B1[2][2];
    const char* cA = (const char*)g.A + (size_t)cur.pm * tstepA; const char* cB = (const char*)g.Bt + (size_t)cur.pn * tstepB;
    S.a_ready(cur);
    if constexpr (SP2) {
        PG8_STAGE(PG8_SB(0, 0), cB, voffB); PG8_STAGE(PG8_SB(0, 1), cB + hstepB, voffB); PG8_STAGE(PG8_SA(0, 0), cA, voffA); PG8_STAGE(PG8_SA(0, 1), cA + hstepA, voffA);
        if (wr == 1) PG8_BAR;
        PG8_WAIT_V(2); PG8_BAR;
        PG8_STAGE(PG8_SB(1, 0), cB + kstep, voffB); PG8_STAGE(PG8_SA(1, 0), cA + kstep, voffA); PG8_STAGE(PG8_SB(1, 1), cB + hstepB + kstep, voffB);
        PG8_WAIT_V(6); PG8_BAR;
    } else {
        PG8_STAGE(PG8_SB(0, 0), cB, voffB); PG8_STAGE(PG8_SA(0, 0), cA, voffA); PG8_STAGE(PG8_SB(0, 1), cB + hstepB, voffB); PG8_STAGE(PG8_SA(0, 1), cA + hstepA, voffA);
        if (wr == 1) PG8_BAR;
        PG8_WAIT_V(4); PG8_BAR;
        PG8_STAGE(PG8_SB(1, 0), cB + kstep, voffB); PG8_STAGE(PG8_SA(1, 0), cA + kstep, voffA); PG8_STAGE(PG8_SB(1, 1), cB + hstepB + kstep, voffB);
        PG8_WAIT_V(6); PG8_BAR;
    }
    for (;;) {
        const bool has_next = S.next(ui + 1, nxt);
        const char* nA = has_next ? (const char*)g.A + (size_t)nxt.pm * tstepA : cA; const char* nB = has_next ? (const char*)g.Bt + (size_t)nxt.pn * tstepB : cB;
        for (int t = 0; t < nt; t += 2) {
            const bool last = (t == nt - 2);
            const char* a1 = cA + (size_t)(t + 1) * kstep;
            const char* a2 = last ? nA : cA + (size_t)(t + 2) * kstep; const char* b2 = last ? nB : cB + (size_t)(t + 2) * kstep;
            const char* a3 = a2 + kstep; const char* b3 = b2 + kstep;
            if (last && has_next) S.a_ready(nxt);
            const int relax = __builtin_amdgcn_readfirstlane((Epi::RELAX_STORES && ui > 0 && t == 0) ? 1 : 0);
            if constexpr (SP2) {
            PG8_LDB(B0, 0, 0); PG8_LDB(B1, 0, 1); PG8_SCHED; PG8_LDA(At, 0, 0); PG8_STAGE(PG8_SA(1, 1), a1 + hstepA, voffA);
            PG8_WAIT_V_RELAX(relax); PG8_WAIT_L(0); PG8_BAR; PG8_MMA(0, 0, At, B0); PG8_MMA(0, 1, At, B1); PG8_BAR; PG8_SCHED;
            PG8_LDA(At, 0, 1); PG8_STAGE(PG8_SB(0, 0), b2, voffB); PG8_STAGE(PG8_SB(0, 1), b2 + hstepB, voffB); PG8_STAGE(PG8_SA(0, 0), a2, voffA);
            PG8_WAIT_V_RELAX(relax); PG8_WAIT_L(0); PG8_BAR; PG8_MMA(1, 0, At, B0); PG8_MMA(1, 1, At, B1); PG8_BAR; PG8_SCHED;
            PG8_LDB(B0, 1, 0); PG8_LDB(B1, 1, 1); PG8_SCHED; PG8_LDA(At, 1, 0); PG8_STAGE(PG8_SA(0, 1), a2 + hstepA, voffA);
            PG8_WAIT_V(8); PG8_WAIT_L(0); PG8_BAR; PG8_MMA(0, 0, At, B0); PG8_MMA(0, 1, At, B1); PG8_BAR; PG8_SCHED;
            PG8_LDA(At, 1, 1); PG8_STAGE(PG8_SB(1, 0), b3, voffB); PG8_STAGE(PG8_SB(1, 1), b3 + hstepB, voffB); PG8_STAGE(PG8_SA(1, 0), a3, voffA);
            PG8_WAIT_V(8); PG8_WAIT_L(0); PG8_BAR; PG8_MMA(1, 0, At, B0); PG8_MMA(1, 1, At, B1); PG8_BAR; PG8_SCHED;
            } else {
            PG8_LDB(B0, 0, 0); PG8_SCHED; PG8_LDA(At, 0, 0); PG8_STAGE(PG8_SA(1, 1), a1 + hstepA, voffA);
            PG8_WAIT_L(8); PG8_BAR; PG8_WAIT_L(0); PG8_MMA(0, 0, At, B0); PG8_BAR; PG8_SCHED;
            PG8_LDB(B1, 0, 1); PG8_STAGE(PG8_SB(0, 0), b2, voffB);
            PG8_BAR; PG8_WAIT_L(0); PG8_MMA(0, 1, At, B1); PG8_BAR;
            PG8_LDA(At, 0, 1); PG8_STAGE(PG8_SA(0, 0), a2, voffA);
            PG8_BAR; PG8_WAIT_L(0); PG8_MMA(1, 0, At, B0); PG8_BAR; PG8_SCHED;
            PG8_STAGE(PG8_SB(0, 1), b2 + hstepB, voffB);
            PG8_WAIT_V(6); PG8_BAR; PG8_MMA(1, 1, At, B1); PG8_BAR;
            PG8_LDB(B0, 1, 0); PG8_SCHED; PG8_LDA(At, 1, 0); PG8_STAGE(PG8_SA(0, 1), a2 + hstepA, voffA);
            PG8_WAIT_L(8); PG8_BAR; PG8_WAIT_L(0); PG8_MMA(0, 0, At, B0); PG8_BAR; PG8_SCHED;
            PG8_LDB(B1, 1, 1); PG8_STAGE(PG8_SB(1, 0), b3, voffB);
            PG8_BAR; PG8_WAIT_L(0); PG8_MMA(0, 1, At, B1); PG8_BAR;
            PG8_LDA(At, 1, 1); PG8_STAGE(PG8_SA(1, 0), a3, voffA);
            PG8_BAR; PG8_WAIT_L(0); PG8_MMA(1, 0, At, B0); PG8_BAR; PG8_SCHED;
            PG8_STAGE(PG8_SB(1, 1), b3 + hstepB, voffB);
            PG8_WAIT_V(6); PG8_BAR; PG8_MMA(1, 1, At, B1); PG8_BAR;
            }
        }
        if constexpr (ALIGN_EPI) { if (wr == 0) PG8_BAR; }
        if constexpr (!Epi::AFTER_DRAIN) { if constexpr (Epi::ROWTAB) E(acc, cur, wr, wc, fr, fq, cur.pm == tab_pm ? (const PG8_LAS float*)rtab : (const PG8_LAS float*)nullptr); else E(acc, cur, wr, wc, fr, fq); S.done(cur); }
        if (!has_next) break;
#pragma unroll
        for (int a = 0; a < 2; ++a)
#pragma unroll
            for (int b = 0; b < 2; ++b)
#pragma unroll
                for (int m = 0; m < 4; ++m)
#pragma unroll
                    for (int n = 0; n < 2; ++n) acc[a][b][m][n] = (f32x4){0.f, 0.f, 0.f, 0.f};
        cur = nxt; cA = nA; cB = nB; ++ui;
        if constexpr (Epi::ACC_INIT) E.init(acc, cur, wr, wc, fr, fq);
        if constexpr (ALIGN_EPI) { if (wr == 1) PG8_BAR; }
    }
    PG8_WAIT_V(0);
    if constexpr (!ALIGN_EPI) { if (wr == 0) PG8_BAR; }
    PG8_BAR;
    if constexpr (Epi::AFTER_DRAIN) { E.fused(acc, cur, wr, wc, fr, fq, lds, wid, lane); S.done(cur); }
#undef PG8_SA
#undef PG8_SB
#undef PG8_STAGE
#undef PG8_LDA
#undef PG8_LDB
#undef PG8_MMA
#undef PG8_WAIT_V
#undef PG8_WAIT_V_RELAX
#undef PG8_WAIT_L
#undef PG8_BAR
#undef PG8_SCHED
}
}

#define LAS __attribute__((address_space(3)))
#define XB_TMO      128
#define XB_XCNT(j)  (256  + 64 * (j))
#define XB_XSUB(j)  (1280 + 64 * (j))
#define XB_XGEN(j)  (2304 + 64 * (j))
#define XB_TOP      3328
#define XB_TOPGEN   3392
#define XCD_BAR_WORDS 3456
#define XB_SPIN_CAP (1u << 18)

__device__ __forceinline__ unsigned xb_ld(unsigned* p)              { return __hip_atomic_load(p, __ATOMIC_RELAXED, __HIP_MEMORY_SCOPE_AGENT); }
__device__ __forceinline__ unsigned xb_add(unsigned* p, unsigned v) { return __hip_atomic_fetch_add(p, v, __ATOMIC_RELAXED, __HIP_MEMORY_SCOPE_AGENT); }
__device__ __forceinline__ unsigned xb_xcc_id() { return (unsigned)__builtin_amdgcn_s_getreg((3 << 11) | 20) & 0xFu; }
#define XB_SPIN(cond, bar) do { unsigned _sp = 0; while (cond) { __builtin_amdgcn_s_sleep(1); \
    if ((++_sp & 255u) == 0u) { if (xb_ld(&(bar)[XB_TMO])) break; if (_sp > XB_SPIN_CAP) { atomicAdd(&(bar)[XB_TMO], 1u); break; } } } } while (0)

struct XcdBarrier {
    unsigned* bar; unsigned x; unsigned G;
    volatile LAS unsigned* st;
};

__device__ __forceinline__ XcdBarrier xcd_barrier_post(unsigned* bar, volatile LAS unsigned* st, unsigned G) {
    XcdBarrier b; b.bar = bar; b.x = xb_xcc_id(); b.st = st; b.G = G;
    if (threadIdx.x == 0) (void)xb_add(&bar[XB_XCNT(b.x)], 1u);
    return b;
}
__device__ __forceinline__ void xcd_barrier_complete(unsigned* bar, unsigned x, unsigned G, unsigned& nloc, unsigned& nx) {
    unsigned sum, cnt, mine, sp = 0u;
    for (;;) {
        sum = 0u; cnt = 0u; mine = 0u;
#pragma unroll
        for (unsigned j = 0; j < 16; ++j) { const unsigned c = xb_ld(&bar[XB_XCNT(j)]); sum += c; cnt += (c > 0u) ? 1u : 0u; mine = (j == x) ? c : mine; }
        if (sum == G) break;
        __builtin_amdgcn_s_sleep(1);
        if ((++sp & 255u) == 0u) { if (xb_ld(&bar[XB_TMO])) break; if (sp > XB_SPIN_CAP) { atomicAdd(&bar[XB_TMO], 1u); break; } }
    }
    nloc = mine > 0u ? mine : 1u; nx = cnt > 0u ? cnt : 1u;
}

__device__ __forceinline__ void xcd_barrier(const XcdBarrier& b) {
    asm volatile("s_waitcnt vmcnt(0)" ::: "memory");
    __syncthreads();
    if (threadIdx.x == 0) {
        unsigned* bar = b.bar;
        __builtin_amdgcn_s_waitcnt(0);
        unsigned nloc = b.st[0], nx = b.st[1];
        if (nloc == 0u) { xcd_barrier_complete(bar, b.x, b.G, nloc, nx); b.st[0] = nloc; b.st[1] = nx; }
        const unsigned old = xb_add(&bar[XB_XSUB(b.x)], 1u);
        const unsigned gen = old / nloc;
        if (old + 1u == (gen + 1u) * nloc) {
            __builtin_amdgcn_fence(__ATOMIC_RELEASE, "agent");
            asm volatile("s_waitcnt vmcnt(0)" ::: "memory");
            const unsigned og = xb_add(&bar[XB_TOP], 1u);
            const unsigned tg = og / nx;
            if (og + 1u == (tg + 1u) * nx) xb_add(&bar[XB_TOPGEN], 1u);
            else XB_SPIN(xb_ld(&bar[XB_TOPGEN]) == tg, bar);
            __builtin_amdgcn_fence(__ATOMIC_ACQUIRE, "agent");
            xb_add(&bar[XB_XGEN(b.x)], 1u);
            asm volatile("s_waitcnt vmcnt(0)" ::: "memory");
        } else {
            XB_SPIN(xb_ld(&bar[XB_XGEN(b.x)]) == gen, bar);
            __builtin_amdgcn_fence(__ATOMIC_ACQUIRE, "agent");
            asm volatile("s_waitcnt vmcnt(0)" ::: "memory");
        }
    }
    __syncthreads();
}

constexpr int NWAVES = 8;
constexpr int RING_BYTES = 131072;
constexpr int LDSCTL_OFF = 139264;
constexpr int LDS_BYTES = 147456;
constexpr int CW_BAR = 4096;
constexpr size_t CTL_ZERO_BYTES = 131072;
#ifndef OPT_MASK
#define OPT_MASK 0x1FF
#endif

typedef float f32x4 __attribute__((ext_vector_type(4)));
typedef unsigned u32x4v __attribute__((ext_vector_type(4)));
typedef unsigned u32x2v __attribute__((ext_vector_type(2)));
typedef short bf16x8 __attribute__((ext_vector_type(8)));
#define LDS_WAIT() asm volatile("s_waitcnt lgkmcnt(0)" ::: "memory")

struct MArgs { const float* in[16]; float* out; unsigned char* ws; int ph_lo, ph_hi, li, pad; };
struct Frame { LAS unsigned char* lds; int tid, lane, wave, G, bid, grp, gi, gs, b0, nb; const float* in[16]; float* out; unsigned char* ws; };
#ifndef NGRP
#define NGRP 2
#endif
#ifndef LATE_G0
#define LATE_G0 0
#endif
constexpr int CW_LATE = 64;

__device__ __forceinline__ unsigned pk2(float lo, float hi) { return pg8::cvt_pk_bf16(lo, hi); }
__device__ __forceinline__ float wave_sum(float v) {
#pragma unroll
    for (int o = 1; o < 64; o <<= 1) v += __shfl_xor(v, o);
    return v;
}

template <int NR> __device__ __forceinline__ void p0_x_rows(const float* x, bf16_t* xb, float* rs, int row, int lane) {
    f32x4 v[NR][4]; float s[NR];
#pragma unroll
    for (int r = 0; r < NR; ++r) { const f32x4* xr = (const f32x4*)(x + (size_t)(row + r) * D_) + lane;
#pragma unroll
        for (int j = 0; j < 4; ++j) v[r][j] = __builtin_nontemporal_load(xr + 64 * j); }
#pragma unroll
    for (int r = 0; r < NR; ++r) { s[r] = 0.f;
#pragma unroll
        for (int j = 0; j < 4; ++j) s[r] += (v[r][j][0] * v[r][j][0] + v[r][j][1] * v[r][j][1]) + (v[r][j][2] * v[r][j][2] + v[r][j][3] * v[r][j][3]); }
#pragma unroll
    for (int o = 1; o < 64; o <<= 1)
#pragma unroll
        for (int r = 0; r < NR; ++r) s[r] += __shfl_xor(s[r], o);
#pragma unroll
    for (int r = 0; r < NR; ++r) { u32x2v* o8 = (u32x2v*)(xb + (size_t)(row + r) * D_) + lane;
#pragma unroll
        for (int j = 0; j < 4; ++j) { u32x2v w; w.x = pk2(v[r][j][0], v[r][j][1]); w.y = pk2(v[r][j][2], v[r][j][3]); o8[64 * j] = w; }
        if (lane == 0) rs[row + r] = 1.0f / sqrtf(s[r] * (1.0f / D_) + EPS_); }
}
constexpr int TSCR_BYTES = 64 * 65 * 4;
__device__ __forceinline__ void p0_transpose_item(const float* W, int ldw, int csrc, const float* gain, int gmask, bf16_t* WT, int K, int nrow, int k0, LAS float* scr, int lane) {
    const int kk = lane >> 4, nq = lane & 15;
    f32x4 v[16];
#pragma unroll
    for (int j = 0; j < 16; ++j) v[j] = __builtin_nontemporal_load((const f32x4*)(W + (size_t)(k0 + 4 * j + kk) * ldw + csrc + 4 * nq));
#pragma unroll
    for (int j = 0; j < 16; ++j) { const int k = 4 * j + kk; LAS float* d = scr + k * 65 + ((4 * nq + 4 * (j >> 3)) & 63);
        d[0] = v[j][0]; d[1] = v[j][1]; d[2] = v[j][2]; d[3] = v[j][3]; }
    const int c = lane & 7, nr = lane >> 3;
    f32x4 g0 = (f32x4){1.f, 1.f, 1.f, 1.f}, g1 = g0;
    if (gain) { g0 = *(const f32x4*)(gain + ((k0 + 8 * c) & gmask)); g1 = *(const f32x4*)(gain + ((k0 + 8 * c + 4) & gmask)); }
    LDS_WAIT(); asm volatile("" ::: "memory");
#pragma unroll
    for (int jj = 0; jj < 8; ++jj) { const int n = nr + 8 * jj; const LAS float* s = scr + (8 * c) * 65 + ((n + 4 * (c >> 2)) & 63);
        u32x4v o; o.x = pk2(s[0 * 65] * g0[0], s[1 * 65] * g0[1]); o.y = pk2(s[2 * 65] * g0[2], s[3 * 65] * g0[3]); o.z = pk2(s[4 * 65] * g1[0], s[5 * 65] * g1[1]); o.w = pk2(s[6 * 65] * g1[2], s[7 * 65] * g1[3]);
        *(u32x4v*)(WT + (size_t)(nrow + n) * K + k0 + 8 * c) = o; }
    LDS_WAIT(); asm volatile("" ::: "memory");
}
__device__ __forceinline__ void p0_memkv(const Frame& F, int unit) {
    const int l = unit >> 7, b = (unit >> 6) & 1, mt = (unit >> 3) & 7, cg = unit & 7, lane = F.lane, w = F.wave, c = lane & 15, g4 = lane >> 4, cgw = w & 1, kq = w >> 1;
    const float* mem = F.in[1] + ((size_t)b * 256 + mt * 32) * D_; const float* W = F.in[13] + (size_t)l * D_ * 1024 + cg * 128 + 64 * cgw + 4 * c; const float* gm = F.in[12] + l * D_;
    constexpr int MRS = 2064;
    LAS unsigned char* MI = F.lds; LAS float* P = (LAS float*)(F.lds + 32 * MRS); LAS float* RM = (LAS float*)(F.lds + 32 * MRS + 65536);
    f32x4 acc[4][2];
#pragma unroll
    for (int t = 0; t < 4; ++t) { acc[t][0] = (f32x4){0.f, 0.f, 0.f, 0.f}; acc[t][1] = (f32x4){0.f, 0.f, 0.f, 0.f}; }
    struct Raw { f32x4 w[8]; };
#define MKV_LOAD(R_, ks_) do { const int kb_ = kq * 256 + (ks_) * 32 + 8 * g4; \
        _Pragma("unroll") for (int j = 0; j < 8; ++j) (R_).w[j] = *(const f32x4*)(W + (size_t)(kb_ + j) * 1024); } while (0)
#define MKV_MMA(R_, ks_) do { bf16x8 afr[2], bfr[4]; const int ka_ = (kq * 256 + (ks_) * 32 + 8 * g4) * 2; \
        _Pragma("unroll") for (int rb = 0; rb < 2; ++rb) afr[rb] = *(const LAS bf16x8*)(MI + (rb * 16 + c) * MRS + ka_); \
        _Pragma("unroll") for (int t = 0; t < 4; ++t) { u32x4v q_; q_.x = pk2((R_).w[0][t], (R_).w[1][t]); q_.y = pk2((R_).w[2][t], (R_).w[3][t]); q_.z = pk2((R_).w[4][t], (R_).w[5][t]); q_.w = pk2((R_).w[6][t], (R_).w[7][t]); bfr[t] = __builtin_bit_cast(bf16x8, q_); } \
        _Pragma("unroll") for (int t = 0; t < 4; ++t) _Pragma("unroll") for (int rb = 0; rb < 2; ++rb) acc[t][rb] = __builtin_amdgcn_mfma_f32_16x16x32_bf16(afr[rb], bfr[t], acc[t][rb], 0, 0, 0); } while (0)
#define MKV_FENCE() asm volatile("" ::: "memory")
    Raw RA, RB, RC;
    MKV_LOAD(RA, 0); MKV_FENCE();
    { const int row = F.tid >> 4, part = F.tid & 15; const f32x4* mr = (const f32x4*)(mem + (size_t)row * D_) + part; const f32x4* gr = (const f32x4*)gm + part;
      f32x4 v[16];
#pragma unroll
      for (int j = 0; j < 16; ++j) v[j] = mr[16 * j];
      float ss = 0.f;
#pragma unroll
      for (int j = 0; j < 16; ++j) { const f32x4 g = gr[16 * j]; ss += (v[j][0] * v[j][0] + v[j][1] * v[j][1]) + (v[j][2] * v[j][2] + v[j][3] * v[j][3]);
          const f32x4 a = v[j] * g; u32x2v t; t.x = pk2(a[0], a[1]); t.y = pk2(a[2], a[3]); *(LAS u32x2v*)(MI + row * MRS + (part + 16 * j) * 8) = t; }
      ss += __shfl_xor(ss, 1); ss += __shfl_xor(ss, 2); ss += __shfl_xor(ss, 4); ss += __shfl_xor(ss, 8);
      if (part == 0) RM[row] = 1.0f / sqrtf(ss * (1.0f / D_) + EPS_); }
    MKV_LOAD(RB, 1); MKV_FENCE();
    __syncthreads();
#pragma unroll 1
    for (int ks = 0; ks < 6; ks += 3) {
        MKV_LOAD(RC, ks + 2); MKV_FENCE(); MKV_MMA(RA, ks);
        MKV_LOAD(RA, ks + 3); MKV_FENCE(); MKV_MMA(RB, ks + 1);
        MKV_LOAD(RB, ks + 4); MKV_FENCE(); MKV_MMA(RC, ks + 2);
    }
    MKV_MMA(RA, 6);
    MKV_MMA(RB, 7);
#undef MKV_FENCE
#undef MKV_LOAD
#undef MKV_MMA
#pragma unroll
    for (int rb = 0; rb < 2; ++rb)
#pragma unroll
        for (int r = 0; r < 4; ++r) { const int tok = rb * 16 + 4 * g4 + r; *(LAS f32x4*)(P + ((kq * 32 + tok) * 128 + 64 * cgw + 4 * c)) = (f32x4){acc[0][rb][r], acc[1][rb][r], acc[2][rb][r], acc[3][rb][r]}; }
    __syncthreads();
    const int tok = F.tid >> 4, cb = F.tid & 15;
    f32x4 s0 = (f32x4){0.f, 0.f, 0.f, 0.f}, s1 = s0;
#pragma unroll
    for (int q = 0; q < 4; ++q) { s0 += *(const LAS f32x4*)(P + ((q * 32 + tok) * 128 + cb * 8)); s1 += *(const LAS f32x4*)(P + ((q * 32 + tok) * 128 + cb * 8 + 4)); }
    const float rm = RM[tok];
    s0 *= rm; s1 *= rm;
    const size_t orow = ((((size_t)l * 2 + b) * 4 + (cg & 3)) * 256 + mt * 32 + tok) * 128 + cb * 8;
    if (cg < 4) {
        float q = (s0[0] * s0[0] + s0[1] * s0[1]) + (s0[2] * s0[2] + s0[3] * s0[3]) + (s1[0] * s1[0] + s1[1] * s1[1]) + (s1[2] * s1[2] + s1[3] * s1[3]);
        q += __shfl_xor(q, 1); q += __shfl_xor(q, 2); q += __shfl_xor(q, 4); q += __shfl_xor(q, 8);
        const float hn = QK_SCALE / sqrtf(q * (1.0f / 128) + EPS_);
        const f32x4 gk0 = *(const f32x4*)(F.in[15] + l * 128 + cb * 8), gk1 = *(const f32x4*)(F.in[15] + l * 128 + cb * 8 + 4);
        const f32x4 gq0 = *(const f32x4*)(F.in[14] + l * 128 + cb * 8), gq1 = *(const f32x4*)(F.in[14] + l * 128 + cb * 8 + 4);
        s0 = s0 * hn * gk0 * gq0; s1 = s1 * hn * gk1 * gq1;
        *(u32x4v*)((bf16_t*)(F.ws + WS_MEMK) + orow) = pg8::pack8(s0, s1);
    } else *(u32x4v*)((bf16_t*)(F.ws + WS_MEMV) + orow) = pg8::pack8(s0, s1);
    __syncthreads();
}
__device__ __forceinline__ void p0_weight_item(const Frame& F, int r, LAS float* scr) {
    constexpr int I_A = 16 * 64, I_OA = 24 * 16, I_B = 16 * 80;
    if (r < I_A) { const int kb = r / 64, n0 = 64 * (r % 64); p0_transpose_item(F.in[4], 4096, permA_src(n0), F.in[3], 0xffff, (bf16_t*)(F.ws + WS_WINA), 1024, n0, 64 * kb, scr, F.lane); return; } r -= I_A;
    if (r < I_OA) { const int kb = r / 16, n0 = 64 * (r % 16); p0_transpose_item(F.in[6], 1024, n0, kb < 16 ? F.in[5] : nullptr, 255, (bf16_t*)(F.ws + WS_WOUTA), 1536, n0, 64 * kb, scr, F.lane); return; } r -= I_OA;
    if (r < I_B) { const int kb = r / 80, n0 = 64 * (r % 80);
        if (n0 < 2048) p0_transpose_item(F.in[8], 2048, n0, F.in[7], 0xffff, (bf16_t*)(F.ws + WS_WB), 1024, n0, 64 * kb, scr, F.lane);
        else { const int c = n0 - 2048, src = c < 1024 ? 1024 + c : (c < 2048 ? c - 1024 : c); p0_transpose_item(F.in[10], 3072, src, F.in[9], 0xffff, (bf16_t*)(F.ws + WS_WB), 1024, n0, 64 * kb, scr, F.lane); }
        return; } r -= I_B;
    { const int kb = r / 16, n0 = 64 * (r % 16); p0_transpose_item(F.in[11], 1024, n0, nullptr, 0, (bf16_t*)(F.ws + WS_WOUTB), 1536, n0, 64 * kb, scr, F.lane); }
}
__device__ __forceinline__ void p0_prologue(const Frame& F) {
    for (int u = F.bid; u < 256; u += F.G) p0_memkv(F, u);
    const int gw = F.bid * NWAVES + F.wave, NGW = F.G * NWAVES;
    LAS float* scr = (LAS float*)(F.lds + F.wave * TSCR_BYTES);
    float* RS0 = (float*)(F.ws + WS_RS0); const float* x = F.in[0];
    if (NGW == 2048) {
        if (gw < 1024) { p0_weight_item(F, gw, scr); p0_x_rows<4>(x, x1b_ptr(F.ws, (6 * gw) >> 13), RS0, 6 * gw, F.lane); if (NGRP == 1) p0_weight_item(F, gw + 2048, scr); p0_x_rows<2>(x, x1b_ptr(F.ws, (6 * gw + 4) >> 13), RS0, 6 * gw + 4, F.lane); }
        else { const int r0 = 6144 + 10 * (gw - 1024); p0_x_rows<4>(x, x1b_ptr(F.ws, r0 >> 13), RS0, r0, F.lane); if (NGRP == 1) p0_weight_item(F, gw, scr); p0_x_rows<4>(x, x1b_ptr(F.ws, (r0 + 4) >> 13), RS0, r0 + 4, F.lane); p0_x_rows<2>(x, x1b_ptr(F.ws, (r0 + 8) >> 13), RS0, r0 + 8, F.lane); }
    } else {
        for (int it = gw; it < (NGRP == 2 ? 1024 : 3072); it += NGW) p0_weight_item(F, it, scr);
        for (int m = 4 * gw; m < T_; m += 4 * NGW) p0_x_rows<4>(x, x1b_ptr(F.ws, m >> 13), RS0, m, F.lane);
    }
}
__device__ __forceinline__ void p0_late_weights(const Frame& F) {
    LAS float* scr = (LAS float*)(F.lds + F.wave * TSCR_BYTES);
    const int wv = F.gi * NWAVES + F.wave, nw = F.gs * NWAVES;
    if (F.grp == 0) { for (int it = 1024 + wv; it < 1024 + LATE_G0; it += nw) p0_weight_item(F, it, scr); }
    else { for (int it = 1024 + LATE_G0 + wv; it < 3072; it += nw) p0_weight_item(F, it, scr); }
}

typedef float f32x16 __attribute__((ext_vector_type(16)));
typedef short s16x4 __attribute__((ext_vector_type(4)));
#define KSWZ(row, colB) ((row) * 256 + ((colB) ^ (((row) & 7) << 4)))
#define SBAR() __builtin_amdgcn_sched_barrier(0)
constexpr float LOG2E = 1.4426950408889634f;
__device__ __forceinline__ int crow(int r, int hi) { return (r & 3) + 8 * (r >> 2) + 4 * hi; }
__device__ __forceinline__ unsigned lds_addr(const LAS void* p) { return (unsigned)(size_t)p; }
__device__ __forceinline__ int v_st(int k, int c) { const int kk = (k & ~0xC) | ((k & 4) << 1) | ((k & 8) >> 1); return ((kk >> 3) * 4 + (c >> 5)) * 512 + ((kk & 7) * 32 + (c & 31)) * 2; }
__device__ __forceinline__ int v_rd_base(int lane) { return ((lane & 3) << 3) | (((lane >> 2) & 3) << 6) | (((lane >> 4) & 1) << 5) | (((lane >> 5) & 1) << 8); }
constexpr int v_rd_off(int d0, int ks, int half) { return d0 * 512 + ks * 4096 + half * 2048; }
template <int OFF> __device__ __forceinline__ s16x4 tr_read(unsigned vb) { s16x4 r; asm volatile("ds_read_b64_tr_b16 %0, %1 offset:%2" : "=&v"(r) : "v"(vb), "i"(OFF) : "memory"); return r; }
#define PKLH(L, H) (bf16x8){L[0], L[1], L[2], L[3], H[0], H[1], H[2], H[3]}
__device__ __forceinline__ float partner32(float x, int hi) { auto rr = __builtin_amdgcn_permlane32_swap(__float_as_uint(x), __float_as_uint(x), false, false); return __uint_as_float(hi ? rr[0] : rr[1]); }

__device__ __forceinline__ void qkt(f32x16& p0, f32x16& p1, const LAS unsigned char* Ks, const bf16x8* qr, int r32, int hi) {
    p0 = f32x16{}; p1 = f32x16{};
#pragma unroll
    for (int d0 = 0; d0 < 8; ++d0) { const int cb = (d0 * 16 + hi * 8) * 2;
        const bf16x8 b0 = *(const LAS bf16x8*)(Ks + KSWZ(r32, cb)), b1 = *(const LAS bf16x8*)(Ks + KSWZ(32 + r32, cb));
        p0 = __builtin_amdgcn_mfma_f32_32x32x16_bf16(b0, qr[d0], p0, 0, 0, 0);
        p1 = __builtin_amdgcn_mfma_f32_32x32x16_bf16(b1, qr[d0], p1, 0, 0, 0); }
}
#define PK4(P, BASE, OUT) do { unsigned a0_ = pg8::cvt_pk_bf16(P[BASE + 0], P[BASE + 1]), a1_ = pg8::cvt_pk_bf16(P[BASE + 2], P[BASE + 3]); \
    unsigned b0_ = pg8::cvt_pk_bf16(P[BASE + 4], P[BASE + 5]), b1_ = pg8::cvt_pk_bf16(P[BASE + 6], P[BASE + 7]); \
    auto r0_ = __builtin_amdgcn_permlane32_swap(a0_, b0_, false, false); auto r1_ = __builtin_amdgcn_permlane32_swap(a1_, b1_, false, false); \
    u32x4v w_ = {r0_[0], r1_[0], r0_[1], r1_[1]}; OUT = __builtin_bit_cast(bf16x8, w_); } while (0)
template <int D0> __device__ __forceinline__ void pv_one(f32x16& od, unsigned vb, bf16x8 pa0, bf16x8 pa1, bf16x8 pa2, bf16x8 pa3) {
    const s16x4 l0 = tr_read<v_rd_off(D0, 0, 0)>(vb), h0 = tr_read<v_rd_off(D0, 0, 1)>(vb), l1 = tr_read<v_rd_off(D0, 1, 0)>(vb), h1 = tr_read<v_rd_off(D0, 1, 1)>(vb);
    const s16x4 l2 = tr_read<v_rd_off(D0, 2, 0)>(vb), h2 = tr_read<v_rd_off(D0, 2, 1)>(vb), l3 = tr_read<v_rd_off(D0, 3, 0)>(vb), h3 = tr_read<v_rd_off(D0, 3, 1)>(vb);
    asm volatile("s_waitcnt lgkmcnt(0)" ::: "memory"); SBAR();
    od = __builtin_amdgcn_mfma_f32_32x32x16_bf16(pa0, PKLH(l0, h0), od, 0, 0, 0);
    od = __builtin_amdgcn_mfma_f32_32x32x16_bf16(pa1, PKLH(l1, h1), od, 0, 0, 0);
    od = __builtin_amdgcn_mfma_f32_32x32x16_bf16(pa2, PKLH(l2, h2), od, 0, 0, 0);
    od = __builtin_amdgcn_mfma_f32_32x32x16_bf16(pa3, PKLH(l3, h3), od, 0, 0, 0);
}
__device__ __forceinline__ void pv_d0(f32x16* o, unsigned vb, bf16x8 pa0, bf16x8 pa1, bf16x8 pa2, bf16x8 pa3) {
    pv_one<0>(o[0], vb, pa0, pa1, pa2, pa3); pv_one<1>(o[1], vb, pa0, pa1, pa2, pa3); pv_one<2>(o[2], vb, pa0, pa1, pa2, pa3); pv_one<3>(o[3], vb, pa0, pa1, pa2, pa3);
}
constexpr int WSCR_OFF = LDSCTL_OFF + 1024, WFLAG_OFF = LDSCTL_OFF + 512;


template <int H2> __device__ __forceinline__ void o_half_stage(const f32x16* o, const float* rsc, LAS unsigned char* stg, int r32, int hi) {
#pragma unroll
    for (int r = 8 * H2; r < 8 * H2 + 8; ++r) { LAS bf16_t* sp = (LAS bf16_t*)(stg + ((r & 3) + 8 * ((r >> 2) & 1) + 4 * hi) * 256) + r32;
#pragma unroll
        for (int db = 0; db < 4; ++db) sp[32 * db] = (bf16_t)(pg8::cvt_pk_bf16_safe(o[db][r] * rsc[r], 0.f) & 0xffffu); }
}
__device__ __forceinline__ bf16x8 mul8_bf16(bf16x8 v, bf16x8 g) {
    u32x4v w; w.x = pk2(bf2f((bf16_t)v[0]) * bf2f((bf16_t)g[0]), bf2f((bf16_t)v[1]) * bf2f((bf16_t)g[1])); w.y = pk2(bf2f((bf16_t)v[2]) * bf2f((bf16_t)g[2]), bf2f((bf16_t)v[3]) * bf2f((bf16_t)g[3]));
    w.z = pk2(bf2f((bf16_t)v[4]) * bf2f((bf16_t)g[4]), bf2f((bf16_t)v[5]) * bf2f((bf16_t)g[5])); w.w = pk2(bf2f((bf16_t)v[6]) * bf2f((bf16_t)g[6]), bf2f((bf16_t)v[7]) * bf2f((bf16_t)g[7]));
    return __builtin_bit_cast(bf16x8, w);
}
__device__ __forceinline__ void o_tile_stage(const f32x16* o, const float* rsc, LAS unsigned char* stg, int r32, int hi) {
#pragma unroll
    for (int r = 0; r < 16; ++r) { LAS bf16_t* sp = (LAS bf16_t*)(stg + crow(r, hi) * 256) + r32;
#pragma unroll
        for (int db = 0; db < 4; ++db) sp[32 * db] = (bf16_t)(pg8::cvt_pk_bf16_safe(o[db][r] * rsc[r], 0.f) & 0xffffu); }
}
__device__ __forceinline__ void o_tile_out(const LAS unsigned char* stg, const bf16_t* gate, bf16_t* out, size_t ld, int lane) {
    const int rr = lane >> 4, ch = lane & 15;
    bf16x8 g[8];
#pragma unroll
    for (int ps = 0; ps < 8; ++ps) g[ps] = __builtin_nontemporal_load((const bf16x8*)(gate + (size_t)(4 * ps + rr) * ld + ch * 8));
#pragma unroll
    for (int ps = 0; ps < 8; ++ps) { const int row = 4 * ps + rr; *(bf16x8*)(out + (size_t)row * ld + ch * 8) = mul8_bf16(*(const LAS bf16x8*)(stg + row * 256 + ch * 16), g[ps]); }
}


template <bool MASK, int KOFF> __device__ __forceinline__ void sb_half_a(f32x16& p, float* go, int lim) {
#pragma unroll
    for (int i = 0; i < 4; ++i) { float l[4];
#pragma unroll
        for (int e = 0; e < 4; ++e) { float y = fminf(p[4 * i + e], 60.f); if (MASK) y = KOFF + 8 * i + e < lim ? y : -1e30f;
            const float sp = __builtin_amdgcn_logf(1.0f + __builtin_amdgcn_exp2f(y));
            l[e] = -sp; p[4 * i + e] = y - sp; }
        go[i] = (l[0] + l[1]) + (l[2] + l[3]);
        const float s2 = l[3], s1 = s2 + l[2], s0 = s1 + l[1]; p[4 * i + 2] += s2; p[4 * i + 1] += s1; p[4 * i] += s0; }
}
template <bool MASK, int KOFF> __device__ __forceinline__ void sb_half_b(f32x16& p, const float* go, int lim, float carry, float& tail, int hi) {
#pragma unroll
    for (int i = 3; i >= 0; --i) { const float gpi = partner32(go[i], hi); const float so = tail + (hi ? 0.f : gpi) + carry; tail += go[i] + gpi;
#pragma unroll
        for (int e = 0; e < 4; ++e) p[4 * i + e] = __builtin_amdgcn_exp2f(p[4 * i + e] + so); }
}
template <bool MASK> __device__ __forceinline__ float sb_weights(f32x16& p0, f32x16& p1, int lim, float carry, int hi) {
    float go[8], tail = 0.f;
    sb_half_a<MASK, 0>(p0, go, lim); sb_half_a<MASK, 32>(p1, go + 4, lim);
    sb_half_b<MASK, 32>(p1, go + 4, lim, carry, tail, hi); sb_half_b<MASK, 0>(p0, go, lim, carry, tail, hi);
    return tail;
}

constexpr float SB_EXIT = -64.0f;
__device__ __forceinline__ int swap23(int k) { return (k & ~0xC) | ((k & 4) << 1) | ((k & 8) >> 1); }
__device__ __forceinline__ void sb_unit(const Frame& F, int b, int hp, int qb) {
    int tid = F.tid; asm volatile("" : "+v"(tid));
    const int w = F.wave, lane = tid & 63, r32 = lane & 31, hi = lane >> 5;
    const int hh = w >> 2, wl = w & 3, rg = hh ? ((w + 2) & 3) : w, h = 2 * hp + hh;
    bf16_t* UB = ub_ptr(F.ws, b); const size_t rowb = (size_t)b * S_;
    const int q0 = qb * 128, tq = q0 + 32 * rg + r32;
    LAS unsigned char* ring = F.lds + hh * 65536;
    unsigned offK[4], offV[4];
#pragma unroll
    for (int i = 0; i < 4; ++i) { const int pc = wl + 4 * i;
        { const int row = pc * 4 + (lane >> 4), colB = ((lane & 15) * 16) ^ ((row & 7) << 4); offK[i] = (unsigned)(row * NBW_ + colB / 2); }
        { const int d = pc * 1024 + lane * 16, st = d >> 9, o = d & 511, kk = ((st >> 2) << 3) | (o >> 6), k = swap23(kk), c = (st & 3) * 32 + (o & 63) / 2; offV[i] = (unsigned)(k * NBW_ + c); } }
    const bf16_t* kg = UB + rowb * NBW_ + h * 128; const bf16_t* vg = kg + 1024;
#define SB_DMA(kt_) do { const int bo_ = ((kt_) & 1) * 32768; const bf16_t* kt0_ = kg + (size_t)(kt_) * 64 * NBW_; const bf16_t* vt0_ = vg + (size_t)(kt_) * 64 * NBW_; \
        _Pragma("unroll") for (int i_ = 0; i_ < 4; ++i_) { \
            __builtin_amdgcn_global_load_lds((const unsigned*)(kt0_ + offK[i_]), (LAS unsigned*)(ring + bo_ + (wl + 4 * i_) * 1024), 16, 0, 0); \
            __builtin_amdgcn_global_load_lds((const unsigned*)(vt0_ + offV[i_]), (LAS unsigned*)(ring + bo_ + 16384 + (wl + 4 * i_) * 1024), 16, 0, 0); } } while (0)
    volatile LAS unsigned* flags = (volatile LAS unsigned*)(F.lds + WFLAG_OFF);
    f32x16 o[4] = {}; float carry = 0.f; bool wdone = false;
    const int kt_hi = qb * 2 + 1;
    __syncthreads();
    if (lane == 0) { flags[w] = 0u; flags[8 + w] = 0u; }
    SB_DMA(kt_hi);
    bf16x8 qr[8];
    { const bf16_t* qp = UB + (rowb + tq) * NBW_ + 3072 + h * 128 + hi * 8;
#pragma unroll
      for (int d0 = 0; d0 < 8; ++d0) qr[d0] = __builtin_nontemporal_load((const bf16x8*)(qp + d0 * 16)); }
    const unsigned vbase = lds_addr(ring) + 16384 + v_rd_base(lane);
    for (int kt = kt_hi; kt >= 0; --kt) {
        asm volatile("s_waitcnt vmcnt(0)" ::: "memory");
        asm volatile("s_waitcnt lgkmcnt(0)" ::: "memory"); __builtin_amdgcn_s_barrier(); asm volatile("" ::: "memory");
        unsigned alld = 1u;
#pragma unroll
        for (int j = 0; j < 8; ++j) alld &= flags[8 * (kt & 1) + j];
        if (alld) break;
        if (kt >= 1) SB_DMA(kt - 1);
        const int bo = (kt & 1) * 32768;
        if (!wdone && kt * 64 < q0 + 32 * rg + 31) {
            f32x16 p0, p1;
            qkt(p0, p1, ring + bo, qr, r32, hi);
            const int lim = tq - kt * 64 - 4 * hi;
            const bool need_mask = kt * 64 + 63 >= q0 + 32 * rg;
            carry += need_mask ? sb_weights<true>(p0, p1, lim, carry, hi) : sb_weights<false>(p0, p1, lim, carry, hi);
            bf16x8 pa0, pa1, pa2, pa3;
            PK4(p0, 0, pa0); PK4(p0, 8, pa1); PK4(p1, 0, pa2); PK4(p1, 8, pa3);
            pv_d0(o, vbase + bo, pa0, pa1, pa2, pa3);
            wdone = __all(carry < SB_EXIT);
        }
        if (lane == 0) flags[8 * ((kt & 1) ^ 1) + w] = wdone ? 1u : 0u;
    }
#undef SB_DMA
    asm volatile("s_waitcnt vmcnt(0) lgkmcnt(0)" ::: "memory"); __builtin_amdgcn_s_barrier(); asm volatile("" ::: "memory");
    { float one[16];
#pragma unroll
      for (int r = 0; r < 16; ++r) one[r] = 1.0f;
      LAS unsigned char* stg = F.lds + w * 8192; bf16_t* base = UB + (rowb + q0 + 32 * rg) * NBW_ + h * 128;
      o_tile_stage(o, one, stg, r32, hi); LDS_WAIT();
      o_tile_out(stg, base + 2048, base + 3072, NBW_, lane); LDS_WAIT(); }
}

template <bool STORE = true> __device__ __forceinline__ void memattn_unit(const Frame& F, bf16_t* U, int ld, int qoff, int goff, int layer, int unit) {
    int tid = F.tid; asm volatile("" : "+v"(tid));
    const int w = F.wave, lane = tid & 63, r32 = lane & 31, hi = lane >> 5;
    const int qblk = unit >> 2, hd = unit & 3, row0 = qblk * 256, b = row0 / S_;
    const bf16_t* Kg = (const bf16_t*)(F.ws + WS_MEMK) + (((size_t)layer * 2 + b) * 4 + hd) * 256 * 128; const bf16_t* Vg = (const bf16_t*)(F.ws + WS_MEMV) + (((size_t)layer * 2 + b) * 4 + hd) * 256 * 128;
    LAS unsigned char* Kb = F.lds; LAS unsigned char* Vb = F.lds + 65536;
    __syncthreads();
    { bf16x8 kst_[8], vst_[8];
#pragma unroll
      for (int j = 0; j < 8; ++j) { const int c = tid + 512 * j, row = c >> 4, ch = c & 15; kst_[j] = *(const bf16x8*)(Kg + (size_t)row * 128 + ch * 8); vst_[j] = *(const bf16x8*)(Vg + (size_t)row * 128 + ch * 8); }
#pragma unroll
      for (int j = 0; j < 8; ++j) { const int c = tid + 512 * j, row = c >> 4, ch = c & 15;
          *(LAS bf16x8*)(Kb + KSWZ(row, ch * 16)) = kst_[j]; *(LAS bf16x8*)(Vb + (row >> 6) * 16384 + v_st(row & 63, ch * 8)) = vst_[j]; } }
    bf16x8 qr[8]; float ssq = 0.f;
    { const bf16_t* qp = U + (size_t)(row0 + 32 * w + r32) * ld + qoff + hd * 128 + hi * 8;
#pragma unroll
      for (int d0 = 0; d0 < 8; ++d0) { qr[d0] = __builtin_nontemporal_load((const bf16x8*)(qp + d0 * 16));
#pragma unroll
          for (int j = 0; j < 8; ++j) { const float v = bf2f((bf16_t)qr[d0][j]); ssq += v * v; } } }
    ssq += partner32(ssq, hi);
    const float C = LOG2E / sqrtf(ssq * (1.0f / 128) + EPS_);
    __syncthreads();
    LAS float* wscr = (LAS float*)(F.lds + WSCR_OFF) + w * 64;
    const unsigned vb0 = lds_addr(Vb) + v_rd_base(lane);
    f32x16 o[4] = {}; float m_reg = -1e30f, l_reg = 0.f;
#pragma unroll 1
    for (int t = 0; t < 4; ++t) {
        f32x16 p0, p1;
        qkt(p0, p1, Kb + t * 16384, qr, r32, hi);
        float pmax = p0[0];
#pragma unroll
        for (int r = 1; r < 16; ++r) pmax = fmaxf(pmax, p0[r]);
#pragma unroll
        for (int r = 0; r < 16; ++r) pmax = fmaxf(pmax, p1[r]);
        pmax = fmaxf(pmax, partner32(pmax, hi));
        float alpha = 1.f;
        if (!__all((pmax - m_reg) * C <= 8.0f)) { const float mn = fmaxf(m_reg, pmax); alpha = __builtin_amdgcn_exp2f((m_reg - mn) * C); m_reg = mn;
            if (t > 0) {
                if (hi == 0) wscr[r32] = alpha; LDS_WAIT();
#pragma unroll
                for (int d = 0; d < 4; ++d)
#pragma unroll
                    for (int r = 0; r < 16; ++r) o[d][r] *= wscr[crow(r, hi)];
                LDS_WAIT(); } }
        const float mC = -m_reg * C; float ps = 0.f;
#pragma unroll
        for (int r = 0; r < 16; ++r) { p0[r] = __builtin_amdgcn_exp2f(fmaf(p0[r], C, mC)); p1[r] = __builtin_amdgcn_exp2f(fmaf(p1[r], C, mC)); ps += p0[r] + p1[r]; }
        ps += partner32(ps, hi);
        l_reg = l_reg * alpha + ps;
        bf16x8 pa0, pa1, pa2, pa3;
        PK4(p0, 0, pa0); PK4(p0, 8, pa1); PK4(p1, 0, pa2); PK4(p1, 8, pa3);
        pv_d0(o, vb0 + t * 16384, pa0, pa1, pa2, pa3);
    }
    if (hi == 0) wscr[32 + r32] = l_reg; LDS_WAIT();
    { float rl[16];
#pragma unroll
      for (int r = 0; r < 16; ++r) rl[r] = 1.0f / wscr[32 + crow(r, hi)];
      __syncthreads();
      LAS unsigned char* stg = F.lds + w * 8192; bf16_t* base = U + (size_t)(row0 + 32 * w) * ld + hd * 128;
      o_tile_stage(o, rl, stg, r32, hi); LDS_WAIT();
      if (STORE) o_tile_out(stg, base + goff, base + qoff, ld, lane); else if (rl[0] == 1.2345e33f) o_tile_out(stg, base + goff, base + qoff, ld, lane);
      LDS_WAIT(); }
}

__device__ __forceinline__ float ret_lg2(int h) { return log2f(1.0f - exp2f(-5.0f - (float)h)); }
__device__ __forceinline__ void kvt_unit(const Frame& F, int u) {
    int tid = F.tid; asm volatile("" : "+v"(tid));
    const int w = F.wave, lane = tid & 63, r32 = lane & 31, hi = lane >> 5;
    const int b = u >> 8, h = (u >> 6) & 3, n = u & 63; const size_t row0 = (size_t)b * S_ + n * 128; const float lg2 = ret_lg2(h);
    const bf16_t* UA = ua_ptr(F.ws, b); bf16_t* KVT = kvt_ptr(F.ws, b);
    LAS unsigned char* Vb = F.lds; LAS unsigned char* Kb = F.lds + 65536;
    __syncthreads();
    bf16x8 vst_[8], kst_[4];
#pragma unroll
    for (int j = 0; j < 8; ++j) { const int c = tid + 512 * j, row = c >> 5, col = (c & 31) * 8; vst_[j] = *(const bf16x8*)(UA + (row0 + row) * NA_ + 1024 + h * 256 + col); }
#pragma unroll
    for (int j = 0; j < 4; ++j) { const int c = tid + 512 * j, row = c >> 4, col = (c & 15) * 8; kst_[j] = *(const bf16x8*)(UA + (row0 + row) * NA_ + 512 + h * 128 + col); }
#pragma unroll
    for (int j = 0; j < 8; ++j) { const int c = tid + 512 * j, row = c >> 5, col = (c & 31) * 8;
        *(LAS bf16x8*)(Vb + ((row >> 6) * 2 + (col >> 7)) * 16384 + v_st(row & 63, col & 127)) = vst_[j]; }
#pragma unroll
    for (int j = 0; j < 4; ++j) { const int c = tid + 512 * j, row = c >> 4, col = (c & 15) * 8; const float z = exp2f((float)(127 - row) * lg2);
        const bf16x8 kv = kst_[j];
        u32x4v t; t.x = pk2(bf2f((bf16_t)kv[0]) * z, bf2f((bf16_t)kv[1]) * z); t.y = pk2(bf2f((bf16_t)kv[2]) * z, bf2f((bf16_t)kv[3]) * z);
        t.z = pk2(bf2f((bf16_t)kv[4]) * z, bf2f((bf16_t)kv[5]) * z); t.w = pk2(bf2f((bf16_t)kv[6]) * z, bf2f((bf16_t)kv[7]) * z);
        *(LAS u32x4v*)(Kb + (row >> 6) * 16384 + v_st(row & 63, col)) = t; }
    __syncthreads();
    f32x16 acc[4] = {};
    const unsigned vbV = lds_addr(Vb) + v_rd_base(lane) + (w >> 2) * 16384 + (w & 3) * 512, vbK = lds_addr(Kb) + v_rd_base(lane);
#define KVT_STEP(TH, KS) do { const unsigned va_ = vbV + (TH) * 32768, vk_ = vbK + (TH) * 16384; \
        const s16x4 al_ = tr_read<v_rd_off(0, KS, 0)>(va_), ah_ = tr_read<v_rd_off(0, KS, 1)>(va_); \
        const s16x4 b0l_ = tr_read<v_rd_off(0, KS, 0)>(vk_), b0h_ = tr_read<v_rd_off(0, KS, 1)>(vk_), b1l_ = tr_read<v_rd_off(1, KS, 0)>(vk_), b1h_ = tr_read<v_rd_off(1, KS, 1)>(vk_); \
        const s16x4 b2l_ = tr_read<v_rd_off(2, KS, 0)>(vk_), b2h_ = tr_read<v_rd_off(2, KS, 1)>(vk_), b3l_ = tr_read<v_rd_off(3, KS, 0)>(vk_), b3h_ = tr_read<v_rd_off(3, KS, 1)>(vk_); \
        asm volatile("s_waitcnt lgkmcnt(0)" ::: "memory"); SBAR(); const bf16x8 a_ = PKLH(al_, ah_); \
        acc[0] = __builtin_amdgcn_mfma_f32_32x32x16_bf16(a_, PKLH(b0l_, b0h_), acc[0], 0, 0, 0); acc[1] = __builtin_amdgcn_mfma_f32_32x32x16_bf16(a_, PKLH(b1l_, b1h_), acc[1], 0, 0, 0); \
        acc[2] = __builtin_amdgcn_mfma_f32_32x32x16_bf16(a_, PKLH(b2l_, b2h_), acc[2], 0, 0, 0); acc[3] = __builtin_amdgcn_mfma_f32_32x32x16_bf16(a_, PKLH(b3l_, b3h_), acc[3], 0, 0, 0); } while (0)
    KVT_STEP(0, 0); KVT_STEP(0, 1); KVT_STEP(0, 2); KVT_STEP(0, 3); KVT_STEP(1, 0); KVT_STEP(1, 1); KVT_STEP(1, 2); KVT_STEP(1, 3);
#undef KVT_STEP
    bf16_t* ob = KVT + ((size_t)u * 256 + 32 * w) * 128 + r32;
#pragma unroll
    for (int r = 0; r < 16; ++r)
#pragma unroll
        for (int db = 0; db < 4; ++db) ob[(size_t)crow(r, hi) * 128 + 32 * db] = f2bf(acc[db][r]);
}
__device__ __forceinline__ void scan_phase(const Frame& F) {
    for (int idx = F.gi * (NWAVES * 64) + F.tid; idx < F.nb * 4 * 16384; idx += F.gs * NWAVES * 64) {
        const int bh = F.b0 * 4 + (idx >> 14), off = idx & 16383; const float gc = exp2f(128.0f * ret_lg2(bh & 3));
        unsigned* p = (unsigned*)kvt_ptr(F.ws, bh >> 2) + (size_t)bh * 64 * 16384 + off; float s0 = 0.f, s1 = 0.f;
        unsigned v[16], vn[16];
#pragma unroll
        for (int j = 0; j < 16; ++j) v[j] = __builtin_nontemporal_load(p + (size_t)j * 16384);
#pragma unroll
        for (int n0 = 0; n0 < 64; n0 += 16) {
            if (n0 + 16 < 64) {
#pragma unroll
                for (int j = 0; j < 16; ++j) vn[j] = __builtin_nontemporal_load(p + (size_t)(n0 + 16 + j) * 16384); }
#pragma unroll
            for (int j = 0; j < 16; ++j) { p[(size_t)(n0 + j) * 16384] = pk2(s0, s1); s0 = fmaf(gc, s0, __uint_as_float(v[j] << 16)); s1 = fmaf(gc, s1, __uint_as_float(v[j] & 0xffff0000u)); }
#pragma unroll
            for (int j = 0; j < 16; ++j) v[j] = vn[j];
        }
    }
}
__device__ __forceinline__ void ret_unit(const Frame& F, int u) {
    int tid = F.tid; asm volatile("" : "+v"(tid));
    const int w = F.wave, lane = tid & 63, r32 = lane & 31, hi = lane >> 5, wq = w & 3, eh = w >> 2;
    const int b = u >> 8, h = (u >> 6) & 3, n = u & 63; const size_t row0 = (size_t)b * S_ + n * 128; const float lg2 = ret_lg2(h);
    bf16_t* UA = ua_ptr(F.ws, b); const bf16_t* KVT = kvt_ptr(F.ws, b);
    LAS unsigned char* R1 = F.lds; LAS unsigned char* R2 = F.lds + 65536;
    __syncthreads();
    { bf16x8 sst_[8], kst_[4];
#pragma unroll
      for (int j = 0; j < 8; ++j) { const int c = tid + 512 * j, row = c >> 4, ch = c & 15; sst_[j] = __builtin_nontemporal_load((const bf16x8*)(KVT + ((size_t)u * 256 + row) * 128 + ch * 8)); }
#pragma unroll
      for (int j = 0; j < 4; ++j) { const int c = tid + 512 * j, row = c >> 4, ch = c & 15; kst_[j] = *(const bf16x8*)(UA + (row0 + row) * NA_ + 512 + h * 128 + ch * 8); }
#pragma unroll
      for (int j = 0; j < 8; ++j) { const int c = tid + 512 * j, row = c >> 4, ch = c & 15; *(LAS bf16x8*)(R1 + KSWZ(row, ch * 16)) = sst_[j]; }
#pragma unroll
      for (int j = 0; j < 4; ++j) { const int c = tid + 512 * j, row = c >> 4, ch = c & 15; *(LAS bf16x8*)(R2 + KSWZ(row, ch * 16)) = kst_[j]; } }
    bf16x8 qr[8];
    { const bf16_t* qp = UA + (row0 + 32 * wq + r32) * NA_ + h * 128 + hi * 8;
#pragma unroll
      for (int d0 = 0; d0 < 8; ++d0) qr[d0] = __builtin_nontemporal_load((const bf16x8*)(qp + d0 * 16)); }
    __syncthreads();
    f32x16 o[4] = {};
#pragma unroll
    for (int db = 0; db < 4; ++db) {
#pragma unroll
        for (int d0 = 0; d0 < 8; ++d0) { const bf16x8 bs = *(const LAS bf16x8*)(R1 + KSWZ(128 * eh + 32 * db + r32, (d0 * 16 + hi * 8) * 2)); o[db] = __builtin_amdgcn_mfma_f32_32x32x16_bf16(qr[d0], bs, o[db], 0, 0, 0); }
        asm volatile("" ::: "memory"); }
    const float gm1 = exp2f(lg2), gm2 = gm1 * gm1, gm4 = gm2 * gm2, gm8 = gm4 * gm4, gm16 = gm8 * gm8;
    const float gi1 = exp2f(-lg2), gi2 = gi1 * gi1, gi4 = gi2 * gi2, gi8 = gi4 * gi4, gi16 = gi8 * gi8, gi32 = gi16 * gi16;
    const float ga[4] = {1.0f, gm1, gm2, gm2 * gm1}, gb[4] = {1.0f, gm8, gm16, gm16 * gm8};
    const float ia[4] = {1.0f, gi1, gi2, gi2 * gi1}, ib[4] = {1.0f, gi8, gi16, gi16 * gi8};
    { const float xl = exp2f((float)(32 * wq + 4 * hi + 1) * lg2);
#pragma unroll
      for (int r = 0; r < 16; ++r) { const float xi = xl * (ga[r & 3] * gb[r >> 2]);
#pragma unroll
          for (int db = 0; db < 4; ++db) o[db][r] *= xi; } }
    bf16x8 pa[2][4]; const int cq = 32 * wq + r32;
#define RET_P(ST) do { f32x16 p0, p1; qkt(p0, p1, R2 + (ST) * 16384, qr, r32, hi); const int limq_ = cq - 64 * (ST) - 4 * hi; const float al_ = exp2f((float)limq_ * lg2); \
        _Pragma("unroll") for (int r = 0; r < 16; ++r) { const int cr_ = (r & 3) + 8 * (r >> 2); const float f_ = al_ * (ia[r & 3] * ib[r >> 2]); \
            p0[r] = cr_ <= limq_ ? p0[r] * f_ : 0.f; p1[r] = cr_ + 32 <= limq_ ? p1[r] * (f_ * gi32) : 0.f; } \
        PK4(p0, 0, pa[ST][0]); PK4(p0, 8, pa[ST][1]); PK4(p1, 0, pa[ST][2]); PK4(p1, 8, pa[ST][3]); } while (0)
    RET_P(0);
    if (wq >= 2) RET_P(1);
#undef RET_P
    __syncthreads();
    { bf16x8 vst_[8];
#pragma unroll
      for (int j = 0; j < 8; ++j) { const int c = tid + 512 * j, row = c >> 5, col = (c & 31) * 8; vst_[j] = *(const bf16x8*)(UA + (row0 + row) * NA_ + 1024 + h * 256 + col); }
#pragma unroll
      for (int j = 0; j < 8; ++j) { const int c = tid + 512 * j, row = c >> 5, col = (c & 31) * 8; *(LAS bf16x8*)(R1 + ((row >> 6) * 2 + (col >> 7)) * 16384 + v_st(row & 63, col & 127)) = vst_[j]; } }
    __syncthreads();
    const unsigned vb = lds_addr(R1) + v_rd_base(lane) + eh * 16384;
    pv_d0(o, vb, pa[0][0], pa[0][1], pa[0][2], pa[0][3]);
    if (wq >= 2) pv_d0(o, vb + 32768, pa[1][0], pa[1][1], pa[1][2], pa[1][3]);
    LAS float* ssq = (LAS float*)(F.lds + WSCR_OFF);
    float qs[16];
#pragma unroll
    for (int r = 0; r < 16; ++r) { float q = (o[0][r] * o[0][r] + o[1][r] * o[1][r]) + (o[2][r] * o[2][r] + o[3][r] * o[3][r]);
        q += __shfl_xor(q, 1); q += __shfl_xor(q, 2); q += __shfl_xor(q, 4); q += __shfl_xor(q, 8); q += __shfl_xor(q, 16); qs[r] = q;
        if (r32 == 0) ssq[w * 32 + crow(r, hi)] = q; }
    __syncthreads();
    { float rn[16];
#pragma unroll
      for (int r = 0; r < 16; ++r) rn[r] = 1.0f / sqrtf((qs[r] + ssq[(w ^ 4) * 32 + crow(r, hi)]) * (1.0f / 256) + EPS_);
      bf16_t* gbase = UA + (row0 + 32 * wq) * NA_ + 2048 + h * 256 + 128 * eh;
      const int rr = lane >> 4, ch = lane & 15;
      bf16x8 greg[8];
#pragma unroll
      for (int j = 0; j < 8; ++j) greg[j] = __builtin_nontemporal_load((const bf16x8*)(gbase + (size_t)(16 * (j >> 2) + 4 * (j & 3) + rr) * NA_ + ch * 8));
      LAS unsigned char* stg = F.lds + 98304 + w * 4096;
      o_half_stage<0>(o, rn, stg, r32, hi); LDS_WAIT();
#pragma unroll
      for (int ps = 0; ps < 4; ++ps) { const int row = 4 * ps + rr; *(bf16x8*)(gbase + (size_t)row * NA_ + ch * 8) = mul8_bf16(*(const LAS bf16x8*)(stg + row * 256 + ch * 16), greg[ps]); }
      LDS_WAIT();
      o_half_stage<1>(o, rn, stg, r32, hi); LDS_WAIT();
#pragma unroll
      for (int ps = 0; ps < 4; ++ps) { const int row = 4 * ps + rr; *(bf16x8*)(gbase + (size_t)(16 + row) * NA_ + ch * 8) = mul8_bf16(*(const LAS bf16x8*)(stg + row * 256 + ch * 16), greg[4 + ps]); } }
    LDS_WAIT();
}
#ifndef PG8_SP2
#define PG8_SP2 true
#endif
#ifndef PG8_ALIGN
#define PG8_ALIGN true
#endif
#define RET_UNIT(i) (i)
__device__ __forceinline__ void phase1(const Frame& F) {
    const size_t rb = (size_t)F.b0 * S_;
    pg8::Gemm g{(const bf16_t*)x1b_ptr(F.ws, F.b0) + rb * D_, (const bf16_t*)(F.ws + WS_WINA), F.nb * S_, NA_, D_, D_}; pg8::StaticOrder S; S.init(F.nb * S_, NA_, F.gs, F.gi);
    pg8::EpiA E{ua_ptr(F.ws, F.b0) + rb * NA_, (const float*)(F.ws + WS_RS0) + rb, (const int*)F.in[2] + rb};
    pg8::gemm_phase<pg8::EpiA, pg8::StaticOrder, PG8_ALIGN, PG8_SP2>(F.lds, g, S, E);
}
__device__ __forceinline__ void late_publish(const Frame& F) {
    asm volatile("s_waitcnt vmcnt(0)" ::: "memory"); __syncthreads();
    if (F.tid == 0) { __builtin_amdgcn_fence(__ATOMIC_RELEASE, "agent"); asm volatile("s_waitcnt vmcnt(0)" ::: "memory");
        __hip_atomic_fetch_add((unsigned*)(F.ws + WS_CTL) + CW_LATE, 1u, __ATOMIC_RELAXED, __HIP_MEMORY_SCOPE_AGENT); }
}
__device__ __forceinline__ void late_poll(const Frame& F) {
    if (F.tid == 0) { unsigned* c = (unsigned*)(F.ws + WS_CTL) + CW_LATE; unsigned sp = 0;
        while (__hip_atomic_load(c, __ATOMIC_RELAXED, __HIP_MEMORY_SCOPE_AGENT) < (unsigned)F.G) { __builtin_amdgcn_s_sleep(2); if (++sp > (1u << 22)) break; } }
}
__device__ __forceinline__ void phase2(const Frame& F) {
    for (int i = F.gi; i < F.nb * 256; i += F.gs) kvt_unit(F, RET_UNIT(F.b0 * 256 + i));
    for (int u = F.gi; u < F.nb * 128; u += F.gs) memattn_unit(F, ua_ptr(F.ws, (F.b0 * 128 + u) >> 7), NA_, 3072, 3584, 0, F.b0 * 128 + u);
}
__device__ __forceinline__ void phase4(const Frame& F) { for (int i = F.gi; i < F.nb * 256; i += F.gs) ret_unit(F, RET_UNIT(F.b0 * 256 + i)); }
__device__ __forceinline__ void phase5(const Frame& F) {
    const size_t rb = (size_t)F.b0 * S_;
    pg8::Gemm g{(const bf16_t*)ua_ptr(F.ws, F.b0) + rb * NA_ + 2048, (const bf16_t*)(F.ws + WS_WOUTA), F.nb * S_, D_, KO_, NA_}; pg8::StaticOrder S; S.init(F.nb * S_, D_, F.gs, F.gi);
    pg8::EpiOutA E{F.in[0] + rb * D_, F.out + rb * D_, x1b_ptr(F.ws, F.b0) + rb * D_, (float*)(F.ws + WS_SS1P) + rb * 16};
    pg8::gemm_phase<pg8::EpiOutA, pg8::StaticOrder, PG8_ALIGN, PG8_SP2>(F.lds, g, S, E);
}
__device__ __forceinline__ void phase6(const Frame& F) {
    const size_t rb = (size_t)F.b0 * S_;
    pg8::Gemm g{(const bf16_t*)x1b_ptr(F.ws, F.b0) + rb * D_, (const bf16_t*)(F.ws + WS_WB), F.nb * S_, NBW_, D_, D_}; pg8::StaticOrder S; S.init(F.nb * S_, NBW_, F.gs, F.gi);
    pg8::EpiB E{ub_ptr(F.ws, F.b0) + rb * NBW_, (const float*)(F.ws + WS_SS1P) + rb * 16};
    pg8::gemm_phase<pg8::EpiB, pg8::StaticOrder, PG8_ALIGN, PG8_SP2>(F.lds, g, S, E);
}
__device__ __forceinline__ void phase7(const Frame& F) {
    for (int u = F.gi; u < F.nb * 256; u += F.gs) { const int U = F.b0 * 256 + u; sb_unit(F, U >> 8, (U >> 6) & 3, U & 63); }
    for (int u = F.gi; u < F.nb * 128; u += F.gs) memattn_unit(F, ub_ptr(F.ws, (F.b0 * 128 + u) >> 7), NBW_, 4096, 4608, 1, F.b0 * 128 + u);
}
__device__ __forceinline__ void phase8(const Frame& F) {
    const size_t rb = (size_t)F.b0 * S_;
    pg8::Gemm g{(const bf16_t*)ub_ptr(F.ws, F.b0) + rb * NBW_ + 3072, (const bf16_t*)(F.ws + WS_WOUTB), F.nb * S_, D_, KO_, NBW_}; pg8::StaticOrder S; S.init(F.nb * S_, D_, F.gs, F.gi);
    pg8::EpiOutB E{F.out + rb * D_, (const bf16_t*)x1b_ptr(F.ws, F.b0) + rb * D_};
    pg8::gemm_phase<pg8::EpiOutB, pg8::StaticOrder, PG8_ALIGN, PG8_SP2>(F.lds, g, S, E);
}

__global__ void __launch_bounds__(NWAVES * 64, 2) mega(MArgs args) {
    extern __shared__ __attribute__((aligned(16))) unsigned char lds_raw[];
    Frame F;
    F.lds = (LAS unsigned char*)lds_raw; F.tid = threadIdx.x; F.lane = F.tid & 63; F.wave = __builtin_amdgcn_readfirstlane(F.tid >> 6); F.G = gridDim.x; F.bid = blockIdx.x;
    if (NGRP == 2 && (F.G & 15) == 0) { F.grp = (F.bid >> 3) & 1; F.gi = (F.bid & 7) + 8 * (F.bid >> 4); F.gs = F.G >> 1; F.b0 = F.grp; F.nb = 1; }
    else { F.grp = 0; F.gi = F.bid; F.gs = F.G; F.b0 = 0; F.nb = 2; }
#pragma unroll
    for (int i = 0; i < 16; ++i) F.in[i] = args.in[i];
    F.out = args.out; F.ws = args.ws;
    for (int u = F.tid; u < (LDS_BYTES - LDSCTL_OFF) / 4; u += NWAVES * 64) ((LAS unsigned*)(F.lds + LDSCTL_OFF))[u] = 0u;
    __syncthreads();
    unsigned* ctl = (unsigned*)(F.ws + WS_CTL);
    volatile LAS unsigned* lw = (volatile LAS unsigned*)(F.lds + LDSCTL_OFF);
    XcdBarrier barG = xcd_barrier_post(ctl + CW_BAR, lw + 8, (unsigned)F.G);
    XcdBarrier bar = xcd_barrier_post(ctl + CW_BAR + (1 + F.grp) * XCD_BAR_WORDS, lw + 12, (unsigned)F.gs);
#define PHB(call) do { call; xcd_barrier(bar); } while (0)
    p0_prologue(F); xcd_barrier(barG);
    if (NGRP == 2 && F.nb == 1) { p0_late_weights(F); late_publish(F);
    }
    PHB(phase1(F));
    PHB(phase2(F));
    PHB(scan_phase(F));
    phase4(F); if (NGRP == 2) late_poll(F); xcd_barrier(bar);
    PHB(phase5(F));
    PHB(phase6(F));
    PHB(phase7(F));
    phase8(F);
#undef PHB
}

extern "C" void kernel_launch(void* const* d_in, const int* in_sizes, int n_in, void* d_out, int out_size, void* d_ws, size_t ws_size, hipStream_t stream) {
    static int grid = 0;
    if (grid == 0) {
        int dev = 0, cus = 0;
        if (hipGetDevice(&dev) != hipSuccess || hipDeviceGetAttribute(&cus, hipDeviceAttributeMultiprocessorCount, dev) != hipSuccess) { grid = -1; return; }
        if (hipFuncSetAttribute((const void*)mega, hipFuncAttributeMaxDynamicSharedMemorySize, LDS_BYTES) != hipSuccess) { grid = -1; return; }
        (void)hipGetLastError();
        grid = (cus / 16) * 16;
        if (grid == 0) { grid = -1; return; }
    }
    if (grid < 0) return;
    unsigned char* ws = (unsigned char*)d_ws;
    (void)hipMemsetAsync(ws + WS_CTL, 0, CTL_ZERO_BYTES, stream);
    MArgs a{};
    for (int i = 0; i < 16; ++i) a.in[i] = (const float*)d_in[i];
    a.out = (float*)d_out; a.ws = ws; a.ph_lo = 0; a.ph_hi = 9; a.li = 0; a.pad = 0;
    hipLaunchKernelGGL(mega, dim3(grid), dim3(NWAVES * 64), LDS_BYTES, stream, a);
}
```
